# Optimizing an MI355X kernel written in HIP

```python
import math
import jax, jax.numpy as jnp
from jax import lax
import numpy as np

D_MODEL = 1024
BATCH = 32
SEQ = 2048
DEPTH = 4

N_MIXERS = 2
N_GDN_LAYERS = (DEPTH + 1) // 2
N_DIFF_LAYERS = DEPTH // 2

GDN_HEADS = 8
GDN_DK = 128
GDN_DV = 128
GDN_QK = GDN_HEADS * GDN_DK
GDN_V = GDN_HEADS * GDN_DV
GDN_CONV = 4
GDN_CHUNK = 64
GDN_IN = 2 * GDN_QK + 2 * GDN_V + 2 * GDN_HEADS

DIFF_HEADS = 8
DIFF_HD = D_MODEL // (2 * DIFF_HEADS)
DIFF_IN = 3 * D_MODEL
DIFF_Q_BLOCK = 128
ROPE_THETA = 10000.0

FFN_HIDDEN = 2816
FFN_CONV = 3

DEEPNORM_ALPHA = (2.0 * DEPTH) ** 0.25
DEEPNORM_BETA = (8.0 * DEPTH) ** -0.25
LN_EPS = 1e-5
RMS_EPS = 1e-6

kernel_name = "hybrid_gdn_diffattn_convffn_deepnorm"


def layer_norm(x, g, b):
    xf = x.astype(jnp.float32)
    mu = jnp.mean(xf, -1, keepdims=True)
    var = jnp.mean(jnp.square(xf - mu), -1, keepdims=True)
    return ((xf - mu) * lax.rsqrt(var + LN_EPS)).astype(x.dtype) * g + b


def rms_norm(x, w):
    xf = x.astype(jnp.float32)
    return (xf * lax.rsqrt(jnp.mean(xf * xf, -1, keepdims=True) + RMS_EPS)).astype(x.dtype) * w


def l2_norm(x):
    xf = x.astype(jnp.float32)
    return xf * lax.rsqrt(jnp.sum(xf * xf, -1, keepdims=True) + RMS_EPS)


def causal_dwconv(x, w):
    K = w.shape[0]
    T = x.shape[1]
    xp = jnp.pad(x, ((0, 0), (K - 1, 0), (0, 0)))
    y = xp[:, K - 1:K - 1 + T] * w[K - 1]
    for j in range(K - 1):
        y = y + xp[:, j:j + T] * w[j]
    return y


def rope_tables(positions, head_dim):
    inv_freq = ROPE_THETA ** (-jnp.arange(0, head_dim, 2, dtype=jnp.float32) / head_dim)
    ang = positions.astype(jnp.float32)[..., None] * inv_freq
    return jnp.cos(ang)[:, :, None, None, :], jnp.sin(ang)[:, :, None, None, :]


def apply_rope(x, cos, sin):
    xf = x.astype(jnp.float32)
    x1, x2 = jnp.split(xf, 2, -1)
    return jnp.concatenate([x1 * cos - x2 * sin, x2 * cos + x1 * sin], -1).astype(x.dtype)


def gated_delta_rule_chunked(q, k, v, g, beta):
    f32 = jnp.float32
    B, T, H, dk = q.shape
    dv = v.shape[-1]
    C = GDN_CHUNK
    N = T // C

    def to_chunks(t):
        t = t.astype(f32).reshape((B, N, C, H) + t.shape[3:])
        return jnp.moveaxis(t, (1, 3), (0, 2))

    q = to_chunks(q) * (dk ** -0.5)
    k = to_chunks(k)
    v = to_chunks(v)
    beta = to_chunks(beta)
    gc = jnp.cumsum(to_chunks(g), axis=-1)
    causal = jnp.tril(jnp.ones((C, C), bool))
    strict = jnp.tril(jnp.ones((C, C), bool), -1)
    decay = jnp.exp(jnp.where(causal, gc[..., :, None] - gc[..., None, :], -jnp.inf))

    kb = k * beta[..., None]
    low = jnp.where(strict, jnp.einsum('nbhid,nbhjd->nbhij', kb, k) * decay, 0.0)
    a_mat = low + jnp.eye(C, dtype=f32)
    rhs = jnp.concatenate([v * beta[..., None], kb * jnp.exp(gc)[..., None]], -1)
    sol = lax.linalg.triangular_solve(a_mat, rhs, left_side=True, lower=True, unit_diagonal=True)
    u, w = sol[..., :dv], sol[..., dv:]

    attn_intra = jnp.where(causal, jnp.einsum('nbhid,nbhjd->nbhij', q, k) * decay, 0.0)
    q_dec = q * jnp.exp(gc)[..., None]
    g_last = gc[..., -1]
    k_dec = k * jnp.exp(g_last[..., None] - gc)[..., None]

    def step(S, xs):
        q_i, k_i, u_i, w_i, a_i, gl = xs
        v_new = u_i - jnp.einsum('bhcd,bhde->bhce', w_i, S)
        o = jnp.einsum('bhcd,bhde->bhce', q_i, S) + jnp.einsum('bhij,bhje->bhie', a_i, v_new)
        S = S * jnp.exp(gl)[..., None, None] + jnp.einsum('bhcd,bhce->bhde', k_i, v_new)
        return S, o

    S0 = jnp.zeros((B, H, dk, dv), f32)
    _, o = lax.scan(step, S0, (q_dec, k_dec, u, w, attn_intra, g_last))
    return jnp.moveaxis(o, (0, 2), (1, 3)).reshape(B, T, H, dv)


def gated_deltanet(x, w_in, conv_w, a_log, dt_bias, norm_w, w_out):
    B, T, _ = x.shape
    h = x @ w_in
    s0 = 2 * GDN_QK + GDN_V
    qkv, gate, a, b = jnp.split(h, [s0, s0 + GDN_V, s0 + GDN_V + GDN_HEADS], axis=-1)
    qkv = jax.nn.silu(causal_dwconv(qkv, conv_w))
    q, k, v = jnp.split(qkv, [GDN_QK, 2 * GDN_QK], axis=-1)
    q = l2_norm(q.reshape(B, T, GDN_HEADS, GDN_DK))
    k = l2_norm(k.reshape(B, T, GDN_HEADS, GDN_DK))
    v = v.reshape(B, T, GDN_HEADS, GDN_DV)
    beta = jax.nn.sigmoid(b.astype(jnp.float32))
    g = -jnp.exp(a_log.astype(jnp.float32)) * jax.nn.softplus(a.astype(jnp.float32) + dt_bias.astype(jnp.float32))
    o = gated_delta_rule_chunked(q, k, v, g, beta).astype(x.dtype)
    o = rms_norm(o, norm_w) * jax.nn.silu(gate.reshape(B, T, GDN_HEADS, GDN_DV))
    return o.reshape(B, T, GDN_V) @ w_out


def diff_attention(x, cos, sin, w_in, lam_q1, lam_k1, lam_q2, lam_k2, subln_w, w_out, lambda_init):
    B, T, _ = x.shape
    q, k, v = jnp.split(x @ w_in, 3, axis=-1)
    q = apply_rope(q.reshape(B, T, DIFF_HEADS, 2, DIFF_HD), cos, sin)
    k = apply_rope(k.reshape(B, T, DIFF_HEADS, 2, DIFF_HD), cos, sin)
    v = v.reshape(B, T, DIFF_HEADS, 2 * DIFF_HD)
    f32 = jnp.float32
    lam = (jnp.exp(jnp.sum(lam_q1.astype(f32) * lam_k1.astype(f32)))
           - jnp.exp(jnp.sum(lam_q2.astype(f32) * lam_k2.astype(f32))) + lambda_init)
    nb = T // DIFF_Q_BLOCK
    q_blocks = jnp.moveaxis(q.reshape(B, nb, DIFF_Q_BLOCK, DIFF_HEADS, 2, DIFF_HD), 1, 0)
    kpos = jnp.arange(T)
    scale = DIFF_HD ** -0.5

    def block(args):
        q_blk, i = args
        s = jnp.einsum('bqhcd,bkhcd->bhcqk', q_blk, k, preferred_element_type=f32) * scale
        qpos = i * DIFF_Q_BLOCK + jnp.arange(DIFF_Q_BLOCK)
        s = jnp.where(kpos[None, :] <= qpos[:, None], s, -jnp.inf)
        p = jax.nn.softmax(s, axis=-1)
        p = p[:, :, 0] - lam * p[:, :, 1]
        return jnp.einsum('bhqk,bkhe->bqhe', p.astype(v.dtype), v)

    o = lax.map(block, (q_blocks, jnp.arange(nb)))
    o = jnp.moveaxis(o, 0, 1).reshape(B, T, DIFF_HEADS, 2 * DIFF_HD)
    o = rms_norm(o, subln_w) * (1.0 - lambda_init)
    return o.reshape(B, T, D_MODEL) @ w_out


def conv_ffn(x, w_up, conv_w, conv_b, w_down):
    h = causal_dwconv(x @ w_up, conv_w) + conv_b
    a, b = jnp.split(h, 2, axis=-1)
    return (jax.nn.silu(a) * b) @ w_down


def setup_inputs(seed: int = 0) -> dict:
    key = jax.random.key(seed)
    ks = jax.random.split(key, 24)
    f32 = jnp.float32
    nrm = lambda k, shape, s: jax.random.normal(k, shape, f32) * s
    x = jax.random.normal(ks[0], (BATCH, SEQ, D_MODEL), f32)
    offset = jax.random.randint(ks[1], (BATCH, 1), 0, 4096, dtype=jnp.int32)
    positions = offset + jnp.arange(SEQ, dtype=jnp.int32)[None, :]
    ng, nd = N_GDN_LAYERS, N_DIFF_LAYERS
    conv_ch = 2 * GDN_QK + GDN_V
    dt = jnp.exp(jax.random.uniform(ks[2], (ng, GDN_HEADS), f32, math.log(1e-3), math.log(1e-1)))
    return {
        "x": x,
        "positions": positions,
        "gdn_w_in": nrm(ks[3], (ng, D_MODEL, GDN_IN), D_MODEL ** -0.5),
        "gdn_conv_w": nrm(ks[4], (ng, GDN_CONV, conv_ch), GDN_CONV ** -0.5),
        "gdn_a_log": jnp.log(jax.random.uniform(ks[5], (ng, GDN_HEADS), f32, 1.0, 16.0)),
        "gdn_dt_bias": dt + jnp.log(-jnp.expm1(-dt)),
        "gdn_norm_w": 1.0 + nrm(ks[6], (ng, GDN_DV), 0.02),
        "gdn_w_out": nrm(ks[7], (ng, GDN_V, D_MODEL), GDN_V ** -0.5 * DEEPNORM_BETA),
        "diff_w_in": nrm(ks[8], (nd, D_MODEL, DIFF_IN), D_MODEL ** -0.5),
        "diff_lam_q1": nrm(ks[9], (nd, DIFF_HD), 0.1),
        "diff_lam_k1": nrm(ks[10], (nd, DIFF_HD), 0.1),
        "diff_lam_q2": nrm(ks[11], (nd, DIFF_HD), 0.1),
        "diff_lam_k2": nrm(ks[12], (nd, DIFF_HD), 0.1),
        "diff_subln_w": 1.0 + nrm(ks[13], (nd, 2 * DIFF_HD), 0.02),
        "diff_w_out": nrm(ks[14], (nd, D_MODEL, D_MODEL), D_MODEL ** -0.5 * DEEPNORM_BETA),
        "ffn_w_up": nrm(ks[15], (DEPTH, D_MODEL, 2 * FFN_HIDDEN), D_MODEL ** -0.5),
        "ffn_conv_w": nrm(ks[16], (DEPTH, FFN_CONV, 2 * FFN_HIDDEN), FFN_CONV ** -0.5),
        "ffn_conv_b": nrm(ks[17], (DEPTH, 2 * FFN_HIDDEN), 0.01),
        "ffn_w_down": nrm(ks[18], (DEPTH, FFN_HIDDEN, D_MODEL), FFN_HIDDEN ** -0.5 * DEEPNORM_BETA),
        "ln_mix_g": 1.0 + nrm(ks[19], (DEPTH, D_MODEL), 0.02),
        "ln_mix_b": nrm(ks[20], (DEPTH, D_MODEL), 0.01),
        "ln_ffn_g": 1.0 + nrm(ks[21], (DEPTH, D_MODEL), 0.02),
        "ln_ffn_b": nrm(ks[22], (DEPTH, D_MODEL), 0.01),
    }


def reference(x, positions, gdn_w_in, gdn_conv_w, gdn_a_log, gdn_dt_bias, gdn_norm_w, gdn_w_out,
              diff_w_in, diff_lam_q1, diff_lam_k1, diff_lam_q2, diff_lam_k2, diff_subln_w, diff_w_out,
              ffn_w_up, ffn_conv_w, ffn_conv_b, ffn_w_down, ln_mix_g, ln_mix_b, ln_ffn_g, ln_ffn_b):
    cos, sin = rope_tables(positions, DIFF_HD)
    for i in range(DEPTH):
        j = i // N_MIXERS
        if i % N_MIXERS == 0:
            m = gated_deltanet(x, gdn_w_in[j], gdn_conv_w[j], gdn_a_log[j], gdn_dt_bias[j],
                               gdn_norm_w[j], gdn_w_out[j])
        else:
            lambda_init = 0.8 - 0.6 * math.exp(-0.3 * i)
            m = diff_attention(x, cos, sin, diff_w_in[j], diff_lam_q1[j], diff_lam_k1[j],
                               diff_lam_q2[j], diff_lam_k2[j], diff_subln_w[j], diff_w_out[j],
                               lambda_init)
        x = layer_norm(DEEPNORM_ALPHA * x + m, ln_mix_g[i], ln_mix_b[i])
        f = conv_ffn(x, ffn_w_up[i], ffn_conv_w[i], ffn_conv_b[i], ffn_w_down[i])
        x = layer_norm(DEEPNORM_ALPHA * x + f, ln_ffn_g[i], ln_ffn_b[i])
    return x
```

```cpp
#include <hip/hip_runtime.h>
#include <hip/hip_cooperative_groups.h>
#include <cstdio>
#include <cstdint>
namespace cg = cooperative_groups;
namespace pg8 {
#define PG8_LAS __attribute__((address_space(3)))
typedef unsigned short bf16_t;
typedef short bf16x8 __attribute__((ext_vector_type(8)));
typedef float f32x4 __attribute__((ext_vector_type(4)));
typedef unsigned u32x4 __attribute__((ext_vector_type(4)));
constexpr int BM = 256, BK = 64, HALF = 128, HTB = HALF * BK * 2  , STAGE_BYTES = 8 * HTB, NXCD = 8, WGM = 8;

__host__ __device__ __forceinline__ int lds_byte(int r, int c) { const int st = (r >> 4) * 2 + (c >> 5), rr = r & 15, cc = c & 31, ob = rr * 64 + cc * 2; return st * 1024 + (ob ^ (((ob >> 9) & 1) << 5)); }
__host__ __device__ __forceinline__ void stage_rc(int b, int& R, int& C) { const int st = b / 1024, sb = b % 1024, swz = sb ^ (((sb >> 9) & 1) << 5); R = (st >> 1) * 16 + swz / 64; C = (st & 1) * 32 + (swz % 64) / 2; }
__host__ __device__ __forceinline__ int perm32(int rho) { const int n = rho >> 4, i = rho & 15; return 8 * (i >> 2) + 4 * n + (i & 3); }

struct Unit { int pm, pn; };
struct Gemm { const bf16_t* A; const bf16_t* Bt; int M, N, K, lda; };

struct StaticOrder {
    int nM, nN, nwg, G, c;
    __host__ __device__ void init(int M, int N, int G_, int c_) { nM = M / BM; nN = N / BM; nwg = nM * nN; G = G_; c = c_; }
    __host__ __device__ bool next(int i, Unit& u) const {
        const long L = (long)i * G + c; if (L >= nwg) return false;
        int wgid = (int)L; { const int q = nwg / NXCD, r = nwg % NXCD, xcd = wgid % NXCD, off = wgid / NXCD; wgid = (xcd < r ? xcd * (q + 1) : r * (q + 1) + (xcd - r) * q) + off; }
        const int nig = WGM * nN, gid = wgid / nig, fm = gid * WGM, gsz = (nM - fm) < WGM ? (nM - fm) : WGM;
        u.pm = fm + ((wgid % nig) % gsz); u.pn = (wgid % nig) / gsz; return true;
    }
    __device__ __forceinline__ void a_ready(const Unit&) const {}
    __device__ __forceinline__ void done(const Unit&) const {}
};
typedef float f32x2 __attribute__((ext_vector_type(2)));
typedef __bf16 bf16x2v __attribute__((ext_vector_type(2)));
__device__ __forceinline__ unsigned cvt_pk_bf16(float lo, float hi) { f32x2 v = {lo, hi}; bf16x2v b = __builtin_convertvector(v, bf16x2v); return __builtin_bit_cast(unsigned, b); }

struct EpiBf16 {
    static constexpr bool PERM = true, AFTER_DRAIN = false;
    bf16_t* O; int ldc;
    __device__ __forceinline__ void operator()(const f32x4 (&acc)[2][2][4][2], const Unit& u, int wr, int wc, int fr, int fq) const {
        const int row0 = u.pm * BM + wr * 64 + fr; const int col0 = u.pn * BM + wc * 32 + 8 * fq;
#pragma unroll
        for (int ai = 0; ai < 2; ++ai)
#pragma unroll
            for (int m = 0; m < 4; ++m) { bf16_t* rowp = O + (size_t)(row0 + ai * HALF + m * 16) * ldc + col0;
#pragma unroll
                for (int bj = 0; bj < 2; ++bj) { const f32x4 v0 = acc[ai][bj][m][0], v1 = acc[ai][bj][m][1];
                    u32x4 w; w.x = cvt_pk_bf16(v0[0], v0[1]); w.y = cvt_pk_bf16(v0[2], v0[3]); w.z = cvt_pk_bf16(v1[0], v1[1]); w.w = cvt_pk_bf16(v1[2], v1[3]);
                    *(u32x4*)(rowp + bj * HALF) = w; } }
    }
};
struct EpiResid {
    static constexpr bool PERM = false, AFTER_DRAIN = false;
    const float* base; float* out; int ldc; float alpha;
    __device__ __forceinline__ void operator()(const f32x4 (&acc)[2][2][4][2], const Unit& u, int wr, int wc, int fr, int fq) const {
        const int col0 = u.pn * BM + wc * 32 + 4 * fq;
#pragma unroll
        for (int ai = 0; ai < 2; ++ai)
#pragma unroll
            for (int m = 0; m < 4; ++m) { const int r = ai * HALF + wr * 64 + m * 16 + fr; const size_t off = (size_t)(u.pm * BM + r) * ldc + col0;
#pragma unroll
                for (int bj = 0; bj < 2; ++bj)
#pragma unroll
                    for (int n = 0; n < 2; ++n) { const f32x4 bs = *(const f32x4*)(base + off + bj * HALF + n * 16); const f32x4 o = bs * alpha + acc[ai][bj][m][n];
                        *(f32x4*)(out + off + bj * HALF + n * 16) = o; }
                asm volatile("" ::: "memory"); }
    }
};

template <class Epi, class Sched, bool ALIGN_EPI, bool SP2, int KC, int LDAC>
__device__ __forceinline__ void gemm_phase(PG8_LAS unsigned char* lds, const Gemm g, const Sched& S, const Epi& E) {
    int tid_ = threadIdx.x; asm volatile("" : "+v"(tid_));
    const int tid = tid_, wid = __builtin_amdgcn_readfirstlane(tid >> 6), lane = tid & 63, wr = wid >> 2, wc = wid & 3, fr = lane & 15, fq = lane >> 4;
    constexpr int K = KC, nt = K / BK;
    unsigned voffA[2], voffB[2];
#pragma unroll
    for (int i = 0; i < 2; ++i) { int R, C; stage_rc(tid * 16 + i * 8192, R, C); const int Rb = Epi::PERM ? ((R & ~31) + perm32(R & 31)) : R;
        voffA[i] = (unsigned)(R * LDAC + C) * 2u; voffB[i] = (unsigned)(Rb * K + C) * 2u; }
    const size_t kstep = (size_t)(BK * 2);
    const size_t hstepA = (size_t)HALF * LDAC * 2, hstepB = (size_t)HALF * K * 2;
    const size_t tstepA = 2 * hstepA, tstepB = 2 * hstepB;
    const unsigned ldsw = (unsigned)wid * 1024u;
    const int aoff = lds_byte(wr * 64 + fr, fq * 8), boff = lds_byte(wc * 32 + fr, fq * 8);
#define PG8_SA(b, h) (((b) * 2 + (h)) * HTB)
#define PG8_SB(b, h) ((4 + (b) * 2 + (h)) * HTB)
#define PG8_STAGE(bufoff, gbase, voff) do { _Pragma("unroll") for (int _i = 0; _i < 2; ++_i) \
        __builtin_amdgcn_global_load_lds((const unsigned*)((const char*)(gbase) + (voff)[_i]), (PG8_LAS unsigned*)(lds + (bufoff) + ldsw + _i * 8192), 16, 0, 0); } while (0)
#define PG8_LDA(dst, b, h) do { _Pragma("unroll") for (int m = 0; m < 4; ++m) _Pragma("unroll") for (int k = 0; k < 2; ++k) dst[m][k] = *(const PG8_LAS bf16x8*)(lds + PG8_SA(b, h) + aoff + m * 2048 + k * 1024); } while (0)
#define PG8_LDB(dst, b, h) do { _Pragma("unroll") for (int n = 0; n < 2; ++n) _Pragma("unroll") for (int k = 0; k < 2; ++k) dst[n][k] = *(const PG8_LAS bf16x8*)(lds + PG8_SB(b, h) + boff + n * 2048 + k * 1024); } while (0)
#define PG8_MMA(ai, bj, At, Bt) do { __builtin_amdgcn_s_setprio(1); _Pragma("unroll") for (int m = 0; m < 4; ++m) _Pragma("unroll") for (int n = 0; n < 2; ++n) _Pragma("unroll") for (int k = 0; k < 2; ++k) \
        acc[ai][bj][m][n] = __builtin_amdgcn_mfma_f32_16x16x32_bf16(Bt[n][k], At[m][k], acc[ai][bj][m][n], 0, 0, 0); __builtin_amdgcn_s_setprio(0); } while (0)
#define PG8_WAIT_V(n) asm volatile("s_waitcnt vmcnt(" #n ")" ::: "memory")
#define PG8_WAIT_L(n) asm volatile("s_waitcnt lgkmcnt(" #n ")" ::: "memory")
#define PG8_BAR __builtin_amdgcn_s_barrier()
#define PG8_SCHED __builtin_amdgcn_sched_barrier(0)
    Unit cur, nxt; int ui = 0;
    if (!S.next(0, cur)) return;
    f32x4 acc[2][2][4][2];
#pragma unroll
    for (int a = 0; a < 2; ++a)
#pragma unroll
        for (int b = 0; b < 2; ++b)
#pragma unroll
            for (int m = 0; m < 4; ++m)
#pragma unroll
                for (int n = 0; n < 2; ++n) acc[a][b][m][n] = (f32x4){0.f, 0.f, 0.f, 0.f};
    bf16x8 At[4][2], B0[2][2], B1[2][2];
    const char* cA = (const char*)g.A + (size_t)cur.pm * tstepA; const char* cB = (const char*)g.Bt + (size_t)cur.pn * tstepB;
    S.a_ready(cur);
    if constexpr (SP2) {
        PG8_STAGE(PG8_SB(0, 0), cB, voffB); PG8_STAGE(PG8_SB(0, 1), cB + hstepB, voffB); PG8_STAGE(PG8_SA(0, 0), cA, voffA); PG8_STAGE(PG8_SA(0, 1), cA + hstepA, voffA);
        if (wr == 1) PG8_BAR;
        PG8_WAIT_V(2); PG8_BAR;
        PG8_STAGE(PG8_SB(1, 0), cB + kstep, voffB); PG8_STAGE(PG8_SA(1, 0), cA + kstep, voffA); PG8_STAGE(PG8_SB(1, 1), cB + hstepB + kstep, voffB);
        PG8_WAIT_V(6); PG8_BAR;
    } else {
        PG8_STAGE(PG8_SB(0, 0), cB, voffB); PG8_STAGE(PG8_SA(0, 0), cA, voffA); PG8_STAGE(PG8_SB(0, 1), cB + hstepB, voffB); PG8_STAGE(PG8_SA(0, 1), cA + hstepA, voffA);
        if (wr == 1) PG8_BAR;
        PG8_WAIT_V(4); PG8_BAR;
        PG8_STAGE(PG8_SB(1, 0), cB + kstep, voffB); PG8_STAGE(PG8_SA(1, 0), cA + kstep, voffA); PG8_STAGE(PG8_SB(1, 1), cB + hstepB + kstep, voffB);
        PG8_WAIT_V(6); PG8_BAR;
    }
    for (;;) {
        const bool has_next = S.next(ui + 1, nxt);
        const char* nA = has_next ? (const char*)g.A + (size_t)nxt.pm * tstepA : cA; const char* nB = has_next ? (const char*)g.Bt + (size_t)nxt.pn * tstepB : cB;
        for (int t = 0; t < nt; t += 2) {
            const bool last = (t == nt - 2);
            const char* a1 = cA + (size_t)(t + 1) * kstep;
            const char* a2 = last ? nA : cA + (size_t)(t + 2) * kstep; const char* b2 = last ? nB : cB + (size_t)(t + 2) * kstep;
            const char* a3 = a2 + kstep; const char* b3 = b2 + kstep;
            if (last && has_next) S.a_ready(nxt);
            if constexpr (SP2) {
            PG8_LDB(B0, 0, 0); PG8_LDB(B1, 0, 1); PG8_SCHED; PG8_LDA(At, 0, 0); PG8_STAGE(PG8_SA(1, 1), a1 + hstepA, voffA);
            PG8_WAIT_V(8); PG8_WAIT_L(0); PG8_BAR; PG8_MMA(0, 0, At, B0); PG8_MMA(0, 1, At, B1); PG8_BAR; PG8_SCHED;
            PG8_LDA(At, 0, 1); PG8_STAGE(PG8_SB(0, 0), b2, voffB); PG8_STAGE(PG8_SB(0, 1), b2 + hstepB, voffB); PG8_STAGE(PG8_SA(0, 0), a2, voffA);
            PG8_WAIT_V(8); PG8_WAIT_L(0); PG8_BAR; PG8_MMA(1, 0, At, B0); PG8_MMA(1, 1, At, B1); PG8_BAR; PG8_SCHED;
            PG8_LDB(B0, 1, 0); PG8_LDB(B1, 1, 1); PG8_SCHED; PG8_LDA(At, 1, 0); PG8_STAGE(PG8_SA(0, 1), a2 + hstepA, voffA);
            PG8_WAIT_V(8); PG8_WAIT_L(0); PG8_BAR; PG8_MMA(0, 0, At, B0); PG8_MMA(0, 1, At, B1); PG8_BAR; PG8_SCHED;
            PG8_LDA(At, 1, 1); PG8_STAGE(PG8_SB(1, 0), b3, voffB); PG8_STAGE(PG8_SB(1, 1), b3 + hstepB, voffB); PG8_STAGE(PG8_SA(1, 0), a3, voffA);
            PG8_WAIT_V(8); PG8_WAIT_L(0); PG8_BAR; PG8_MMA(1, 0, At, B0); PG8_MMA(1, 1, At, B1); PG8_BAR; PG8_SCHED;
            } else {
            PG8_LDB(B0, 0, 0); PG8_SCHED; PG8_LDA(At, 0, 0); PG8_STAGE(PG8_SA(1, 1), a1 + hstepA, voffA);
            PG8_WAIT_L(8); PG8_BAR; PG8_WAIT_L(0); PG8_MMA(0, 0, At, B0); PG8_BAR; PG8_SCHED;
            PG8_LDB(B1, 0, 1); PG8_STAGE(PG8_SB(0, 0), b2, voffB);
            PG8_BAR; PG8_WAIT_L(0); PG8_MMA(0, 1, At, B1); PG8_BAR;
            PG8_LDA(At, 0, 1); PG8_STAGE(PG8_SA(0, 0), a2, voffA);
            PG8_BAR; PG8_WAIT_L(0); PG8_MMA(1, 0, At, B0); PG8_BAR; PG8_SCHED;
            PG8_STAGE(PG8_SB(0, 1), b2 + hstepB, voffB);
            PG8_WAIT_V(6); PG8_BAR; PG8_MMA(1, 1, At, B1); PG8_BAR;
            PG8_LDB(B0, 1, 0); PG8_SCHED; PG8_LDA(At, 1, 0); PG8_STAGE(PG8_SA(0, 1), a2 + hstepA, voffA);
            PG8_WAIT_L(8); PG8_BAR; PG8_WAIT_L(0); PG8_MMA(0, 0, At, B0); PG8_BAR; PG8_SCHED;
            PG8_LDB(B1, 1, 1); PG8_STAGE(PG8_SB(1, 0), b3, voffB);
            PG8_BAR; PG8_WAIT_L(0); PG8_MMA(0, 1, At, B1); PG8_BAR;
            PG8_LDA(At, 1, 1); PG8_STAGE(PG8_SA(1, 0), a3, voffA);
            PG8_BAR; PG8_WAIT_L(0); PG8_MMA(1, 0, At, B0); PG8_BAR; PG8_SCHED;
            PG8_STAGE(PG8_SB(1, 1), b3 + hstepB, voffB);
            PG8_WAIT_V(6); PG8_BAR; PG8_MMA(1, 1, At, B1); PG8_BAR;
            }
        }
        if constexpr (ALIGN_EPI) { if (wr == 0) PG8_BAR; }
        if constexpr (!Epi::AFTER_DRAIN) { E(acc, cur, wr, wc, fr, fq); S.done(cur); }
        if (!has_next) break;
#pragma unroll
        for (int a = 0; a < 2; ++a)
#pragma unroll
            for (int b = 0; b < 2; ++b)
#pragma unroll
                for (int m = 0; m < 4; ++m)
#pragma unroll
                    for (int n = 0; n < 2; ++n) acc[a][b][m][n] = (f32x4){0.f, 0.f, 0.f, 0.f};
        cur = nxt; cA = nA; cB = nB; ++ui;
        if constexpr (ALIGN_EPI) { if (wr == 1) PG8_BAR; }
    }
    PG8_WAIT_V(0);
    if constexpr (!ALIGN_EPI) { if (wr == 0) PG8_BAR; }
    PG8_BAR;
    if constexpr (Epi::AFTER_DRAIN) { E.fused(acc, cur, wr, wc, fr, fq, lds, wid, lane); S.done(cur); }
#undef PG8_SA
#undef PG8_SB
#undef PG8_STAGE
#undef PG8_LDA
#undef PG8_LDB
#undef PG8_MMA
#undef PG8_WAIT_V
#undef PG8_WAIT_L
#undef PG8_BAR
#undef PG8_SCHED
}
}

#ifdef NO_GEMMB
#define PH_GEMMB if (0)
#else
#define PH_GEMMB
#endif
#ifdef NO_GEMMR
#define PH_GEMMR if (0)
#else
#define PH_GEMMR
#endif
namespace mk {
#define LAS __attribute__((address_space(3)))
typedef unsigned short bf16_t;
typedef short bf16x8 __attribute__((ext_vector_type(8)));
typedef short s16x4 __attribute__((ext_vector_type(4)));
typedef float f32x4 __attribute__((ext_vector_type(4)));
typedef float f32x16 __attribute__((ext_vector_type(16)));
typedef unsigned u32x4 __attribute__((ext_vector_type(4)));
typedef unsigned u32x2 __attribute__((ext_vector_type(2)));
using pg8::cvt_pk_bf16;

constexpr int NB = 32, T = 2048, D = 1024, M = NB * T, DEPTH = 4;
constexpr int NWAVES = 8, NTHR = 512;
constexpr int GDN_N = 4112, GDN_NMAIN = 4096, DIFF_N = 3072, FFN_H = 2816, FFN_N = 5632;
constexpr float LN_EPS = 1e-5f, RMS_EPS = 1e-6f;
constexpr float ALPHA = 1.6817928305074290f;
constexpr float LOG2E = 1.4426950408889634f;
constexpr int MH = M / 2;

constexpr size_t MiB = 1u << 20;
constexpr size_t WS_W = 2 * MiB;
constexpr size_t W_GWIN = 0, W_GWAB = W_GWIN + 2ull * 4096 * 1024 * 2, W_GWOUT = W_GWAB + 2ull * 16 * 1024 * 2, W_DWIN = W_GWOUT + 2ull * 1024 * 1024 * 2,
                 W_DWOUT = W_DWIN + 2ull * 3072 * 1024 * 2, W_FUP = W_DWOUT + 2ull * 1024 * 1024 * 2, W_FDOWN = W_FUP + 4ull * 5632 * 1024 * 2, W_END = W_FDOWN + 4ull * 1024 * 2816 * 2;
static_assert(WS_W + W_END <= 106 * MiB, "weights region");
constexpr size_t WS_GB = 106 * MiB;
constexpr size_t WS_XN = 112 * MiB;
constexpr size_t WS_H = 240 * MiB;
constexpr size_t WS_ACT = WS_H + 352 * MiB;
constexpr size_t WS_UT = WS_H + 512 * MiB;
constexpr size_t WS_WN = WS_UT + 128 * MiB;
constexpr size_t WS_VT = WS_H + 384 * MiB;
constexpr size_t WS_O = WS_VT + 128 * MiB;
constexpr size_t WS_END = WS_WN + 128 * MiB;
static_assert(WS_END <= 1024 * MiB, "workspace map");
constexpr int LDS_BYTES = 131072 + 2048;

__device__ __forceinline__ float bf2f(unsigned short h) { return __uint_as_float((unsigned)h << 16); }
__device__ __forceinline__ unsigned short f2bf(float f) { return (unsigned short)(cvt_pk_bf16(f, 0.f) & 0xffffu); }
__device__ __forceinline__ float wave_sum(float v) {
#pragma unroll
    for (int o = 1; o < 64; o <<= 1) v += __shfl_xor(v, o);
    return v;
}
__device__ __forceinline__ float silu(float x) { return x / (1.f + __expf(-x)); }
__device__ __forceinline__ void unpack8(const u32x4 v, float (&o)[8]) {
    o[0] = __uint_as_float(v.x << 16); o[1] = __uint_as_float(v.x & 0xffff0000u); o[2] = __uint_as_float(v.y << 16); o[3] = __uint_as_float(v.y & 0xffff0000u);
    o[4] = __uint_as_float(v.z << 16); o[5] = __uint_as_float(v.z & 0xffff0000u); o[6] = __uint_as_float(v.w << 16); o[7] = __uint_as_float(v.w & 0xffff0000u);
}
__device__ __forceinline__ u32x4 pack8(const float (&o)[8]) { u32x4 w; w.x = cvt_pk_bf16(o[0], o[1]); w.y = cvt_pk_bf16(o[2], o[3]); w.z = cvt_pk_bf16(o[4], o[5]); w.w = cvt_pk_bf16(o[6], o[7]); return w; }
__device__ __forceinline__ int crow(int r, int hi) { return (r & 3) + 8 * (r >> 2) + 4 * hi; }
#define LDS_WAIT() asm volatile("s_waitcnt lgkmcnt(0)" ::: "memory")
#define MK_IDS() int tid_ = threadIdx.x; asm volatile("" : "+v"(tid_));   \
    const int tid = tid_, lane = tid & 63, wid = __builtin_amdgcn_readfirstlane(tid >> 6); const int G_ = gridDim.x, gw = blockIdx.x * NWAVES + wid, NGW = G_ * NWAVES, gt = blockIdx.x * NTHR + tid, NGT = G_ * NTHR; \
    (void)lane; (void)wid; (void)gw; (void)NGW; (void)gt; (void)NGT

__device__ __forceinline__ void transpose_item(const float* W, int ldw, int K, int nblk, bf16_t* WT, LAS float* scr, int item, int lane) {
    const int kb = item / nblk, nb = item % nblk, k0 = 64 * kb, n0 = 32 * nb;
#pragma unroll 8
    for (int i = 0; i < 32; ++i) { const int kk = 2 * i + (lane >> 5); scr[kk * 33 + (lane & 31)] = W[(size_t)(k0 + kk) * ldw + n0 + (lane & 31)]; }
    LDS_WAIT();
    const int c = lane & 7;
#pragma unroll
    for (int j = 0; j < 4; ++j) { const int n = (lane >> 3) + 8 * j; const LAS float* s = scr + (8 * c) * 33 + n;
        u32x4 o; o.x = cvt_pk_bf16(s[0 * 33], s[1 * 33]); o.y = cvt_pk_bf16(s[2 * 33], s[3 * 33]); o.z = cvt_pk_bf16(s[4 * 33], s[5 * 33]); o.w = cvt_pk_bf16(s[6 * 33], s[7 * 33]);
        *(u32x4*)(WT + (size_t)(n0 + n) * K + k0 + 8 * c) = o; }
    LDS_WAIT();
}

struct Params {
    const float* in[23];
    const int* positions;
    float* out;
    unsigned char* ws;
};

__device__ __forceinline__ void prologue(const Params& p, LAS unsigned char* lds) {
    MK_IDS(); const int wave = wid;
    LAS float* scr = (LAS float*)(lds + wave * 16384);
    unsigned char* wsw = p.ws + WS_W;
    constexpr int I_GWIN = 16 * 128, I_SQ = 16 * 32, I_DWIN = 16 * 96, I_FUP = 16 * 176, I_FDN = 44 * 32;
    constexpr int NITEMS = 2 * I_GWIN + 2 * I_SQ + 2 * I_DWIN + 2 * I_SQ + 4 * I_FUP + 4 * I_FDN;
    for (int it = gw; it < NITEMS; it += NGW) {
        int r = it;
        if (r < 2 * I_GWIN) { const int j = r / I_GWIN; r %= I_GWIN; transpose_item(p.in[2] + (size_t)j * 1024 * GDN_N, GDN_N, 1024, 128, (bf16_t*)(wsw + W_GWIN) + (size_t)j * 4096 * 1024, scr, r, lane); continue; } r -= 2 * I_GWIN;
        if (r < 2 * I_SQ) { const int j = r / I_SQ; r %= I_SQ; transpose_item(p.in[7] + (size_t)j * 1024 * 1024, 1024, 1024, 32, (bf16_t*)(wsw + W_GWOUT) + (size_t)j * 1024 * 1024, scr, r, lane); continue; } r -= 2 * I_SQ;
        if (r < 2 * I_DWIN) { const int j = r / I_DWIN; r %= I_DWIN; transpose_item(p.in[8] + (size_t)j * 1024 * DIFF_N, DIFF_N, 1024, 96, (bf16_t*)(wsw + W_DWIN) + (size_t)j * 3072 * 1024, scr, r, lane); continue; } r -= 2 * I_DWIN;
        if (r < 2 * I_SQ) { const int j = r / I_SQ; r %= I_SQ; transpose_item(p.in[14] + (size_t)j * 1024 * 1024, 1024, 1024, 32, (bf16_t*)(wsw + W_DWOUT) + (size_t)j * 1024 * 1024, scr, r, lane); continue; } r -= 2 * I_SQ;
        if (r < 4 * I_FUP) { const int j = r / I_FUP; r %= I_FUP; transpose_item(p.in[15] + (size_t)j * 1024 * FFN_N, FFN_N, 1024, 176, (bf16_t*)(wsw + W_FUP) + (size_t)j * 5632 * 1024, scr, r, lane); continue; } r -= 4 * I_FUP;
        { const int j = r / I_FDN; r %= I_FDN; transpose_item(p.in[18] + (size_t)j * 2816 * 1024, 1024, 2816, 32, (bf16_t*)(wsw + W_FDOWN) + (size_t)j * 1024 * 2816, scr, r, lane); }
    }
    for (int e = gt; e < 2 * 16 * 1024; e += NGT) { const int j = e >> 14, n = (e >> 10) & 15, k = e & 1023;
        ((bf16_t*)(wsw + W_GWAB))[e] = f2bf(p.in[2][(size_t)j * 1024 * GDN_N + (size_t)k * GDN_N + GDN_NMAIN + n]); }
    const f32x4* x4 = (const f32x4*)p.in[0]; u32x4* xn = (u32x4*)(p.ws + WS_XN);
    for (int e = gt; e < M * D / 8; e += NGT) { const f32x4 a = x4[2 * e], b = x4[2 * e + 1]; u32x4 w; w.x = cvt_pk_bf16(a[0], a[1]); w.y = cvt_pk_bf16(a[2], a[3]); w.z = cvt_pk_bf16(b[0], b[1]); w.w = cvt_pk_bf16(b[2], b[3]); xn[e] = w; }
}

__device__ __forceinline__ void ln_phase(float* X, bf16_t* XN, const float* g, const float* b) {
    MK_IDS();
    f32x4 gv[4], bv[4];
#pragma unroll
    for (int j = 0; j < 4; ++j) { gv[j] = ((const f32x4*)g)[lane + 64 * j]; bv[j] = ((const f32x4*)b)[lane + 64 * j]; }
    for (int m = gw; m < M; m += NGW) {
        f32x4* xr = (f32x4*)(X + (size_t)m * D) + lane;
        f32x4 v[4]; float s = 0.f;
#pragma unroll
        for (int j = 0; j < 4; ++j) { v[j] = xr[64 * j]; s += (v[j][0] + v[j][1]) + (v[j][2] + v[j][3]); }
        const float mean = wave_sum(s) * (1.f / D); float s2 = 0.f;
#pragma unroll
        for (int j = 0; j < 4; ++j) { v[j] = v[j] - mean; s2 += (v[j][0] * v[j][0] + v[j][1] * v[j][1]) + (v[j][2] * v[j][2] + v[j][3] * v[j][3]); }
        const float rstd = 1.f / sqrtf(wave_sum(s2) * (1.f / D) + LN_EPS);
        u32x2* o8 = (u32x2*)(XN + (size_t)m * D) + lane;
#pragma unroll
        for (int j = 0; j < 4; ++j) { const f32x4 o = v[j] * rstd * gv[j] + bv[j]; xr[64 * j] = o; u32x2 w; w.x = cvt_pk_bf16(o[0], o[1]); w.y = cvt_pk_bf16(o[2], o[3]); o8[64 * j] = w; }
    }
}

__device__ __forceinline__ void ffn_act_phase(const bf16_t* Hh  , bf16_t* ACT  , const float* cw  , const float* cb  ) {
    MK_IDS();
    constexpr int RB = 16, NCG = FFN_H / 8;
    for (int item = gt; item < (MH / RB) * NCG; item += NGT) {
        const int mb = item / NCG, cgp = item % NCG, col = cgp * 8, r0 = mb * RB;
        float wa[3][8], wb[3][8], ba[8], bb[8];
#pragma unroll
        for (int j = 0; j < 3; ++j)
#pragma unroll
            for (int h = 0; h < 2; ++h) { const f32x4 a = *(const f32x4*)(cw + j * FFN_N + col + 4 * h), b = *(const f32x4*)(cw + j * FFN_N + FFN_H + col + 4 * h);
#pragma unroll
                for (int e = 0; e < 4; ++e) { wa[j][4 * h + e] = a[e]; wb[j][4 * h + e] = b[e]; } }
#pragma unroll
        for (int h = 0; h < 2; ++h) { const f32x4 a = *(const f32x4*)(cb + col + 4 * h), b = *(const f32x4*)(cb + FFN_H + col + 4 * h);
#pragma unroll
            for (int e = 0; e < 4; ++e) { ba[4 * h + e] = a[e]; bb[4 * h + e] = b[e]; } }
        float a2[8], a1[8], b2[8], b1[8];
        const bool first = (r0 % T) == 0;
        if (first) {
#pragma unroll
            for (int e = 0; e < 8; ++e) { a2[e] = 0.f; a1[e] = 0.f; b2[e] = 0.f; b1[e] = 0.f; }
        } else {
            unpack8(*(const u32x4*)(Hh + (size_t)(r0 - 2) * FFN_N + col), a2); unpack8(*(const u32x4*)(Hh + (size_t)(r0 - 1) * FFN_N + col), a1);
            unpack8(*(const u32x4*)(Hh + (size_t)(r0 - 2) * FFN_N + FFN_H + col), b2); unpack8(*(const u32x4*)(Hh + (size_t)(r0 - 1) * FFN_N + FFN_H + col), b1);
        }
#pragma unroll 4
        for (int rr = 0; rr < RB; ++rr) {
            float a0[8], b0[8], o[8];
            unpack8(*(const u32x4*)(Hh + (size_t)(r0 + rr) * FFN_N + col), a0); unpack8(*(const u32x4*)(Hh + (size_t)(r0 + rr) * FFN_N + FFN_H + col), b0);
#pragma unroll
            for (int e = 0; e < 8; ++e) {
                const float ya = wa[0][e] * a2[e] + wa[1][e] * a1[e] + wa[2][e] * a0[e] + ba[e];
                const float yb = wb[0][e] * b2[e] + wb[1][e] * b1[e] + wb[2][e] * b0[e] + bb[e];
                o[e] = silu(ya) * yb; a2[e] = a1[e]; a1[e] = a0[e]; b2[e] = b1[e]; b1[e] = b0[e];
            }
            *(u32x4*)(ACT + (size_t)(r0 + rr) * FFN_H + col) = pack8(o);
        }
    }
}

__device__ __forceinline__ void gdn_ab_phase(const bf16_t* XN, const bf16_t* wabT  , const float* a_log, const float* dt_bias, float* G, float* BETA) {
    MK_IDS();
    const int n = lane & 15, q4 = lane >> 4, h = n & 7;
    const float al = -__expf(a_log[h]), db = dt_bias[h];
    for (int it = gw; it < M / 16; it += NGW) {
        const int m0 = it * 16;
        f32x4 acc = {0.f, 0.f, 0.f, 0.f};
        const bf16_t* ap = XN + (size_t)(m0 + n) * D + 8 * q4;
        const bf16_t* bp = wabT + (size_t)n * D + 8 * q4;
#pragma unroll 8
        for (int ks = 0; ks < 32; ++ks) { const bf16x8 a = *(const bf16x8*)(ap + 32 * ks), b = *(const bf16x8*)(bp + 32 * ks); acc = __builtin_amdgcn_mfma_f32_16x16x32_bf16(a, b, acc, 0, 0, 0); }
#pragma unroll
        for (int i = 0; i < 4; ++i) { const int m = m0 + 4 * q4 + i; const float v = acc[i];
            if (n < 8) { const float x = v + db; const float sp = x > 20.f ? x : log1pf(__expf(x)); G[(size_t)m * 8 + h] = al * sp; }
            else BETA[(size_t)m * 8 + h] = 1.f / (1.f + __expf(-v)); }
    }
}

__device__ __forceinline__ void conv_silu16(const bf16_t* hp, int t, const float* cw, float (&y)[16]) {
#pragma unroll
    for (int c = 0; c < 16; ++c) y[c] = 0.f;
#pragma unroll
    for (int j = 0; j < 4; ++j) {
        if (t - 3 + j >= 0) {
            float x[16];
            const bf16_t* rp = hp + (ptrdiff_t)(j - 3) * GDN_NMAIN;
            { float t8[8]; unpack8(*(const u32x4*)rp, t8);
#pragma unroll
              for (int c = 0; c < 8; ++c) x[c] = t8[c];
              unpack8(*(const u32x4*)(rp + 8), t8);
#pragma unroll
              for (int c = 0; c < 8; ++c) x[8 + c] = t8[c]; }
#pragma unroll
            for (int q = 0; q < 4; ++q) { const f32x4 w = *(const f32x4*)(cw + j * 3072 + 4 * q);
#pragma unroll
                for (int e = 0; e < 4; ++e) y[4 * q + e] += w[e] * x[4 * q + e]; }
        }
    }
#pragma unroll
    for (int c = 0; c < 16; ++c) y[c] = silu(y[c]);
}
__device__ __forceinline__ float sumsq16_8lanes(const float (&y)[16]) {
    float s = 0.f;
#pragma unroll
    for (int c = 0; c < 16; ++c) s += y[c] * y[c];
    s += __shfl_xor(s, 1); s += __shfl_xor(s, 2); s += __shfl_xor(s, 4);
    return s;
}
__device__ __forceinline__ void lds_store16(LAS unsigned char* p, const float (&y)[16]) {
    u32x4 a, b; a.x = cvt_pk_bf16(y[0], y[1]); a.y = cvt_pk_bf16(y[2], y[3]); a.z = cvt_pk_bf16(y[4], y[5]); a.w = cvt_pk_bf16(y[6], y[7]);
    b.x = cvt_pk_bf16(y[8], y[9]); b.y = cvt_pk_bf16(y[10], y[11]); b.z = cvt_pk_bf16(y[12], y[13]); b.w = cvt_pk_bf16(y[14], y[15]);
    *(LAS u32x4*)p = a; *(LAS u32x4*)(p + 16) = b;
}
__device__ __forceinline__ bf16x8 lds_frag16(const LAS unsigned char* p) { return *(const LAS bf16x8*)p; }
__device__ __forceinline__ bf16x8 lds_frag8x2(const LAS unsigned char* p0, const LAS unsigned char* p1) {
    const s16x4 a = *(const LAS s16x4*)p0, b = *(const LAS s16x4*)p1; return (bf16x8){a[0], a[1], a[2], a[3], b[0], b[1], b[2], b[3]};
}

constexpr int GA_GC = 0, GA_BT = 256, GA_Q = 512, GA_K = GA_Q + 64 * 272, GA_VB = GA_K + 64 * 272, GA_KBE = GA_VB + 128 * 144, GA_L = GA_KBE + 128 * 144, GA_T = GA_L + 64 * 64 * 4, GA_END = GA_T + 64 * 144;
static_assert(GA_END <= 131072 && GA_L % 16 == 0 && GA_T % 16 == 0, "GDN phase A LDS map");
constexpr int GB_GC = 0, GB_Q = 512, GB_W = GB_Q + 64 * 272, GB_KD = GB_W + 64 * 272, GB_UT = GB_KD + 128 * 144, GB_AT = GB_UT + 128 * 144, GB_O = GB_AT + 64 * 144, GB_END = GB_O + 64 * 528;
static_assert(GB_END <= 131072 && GB_O % 16 == 0, "GDN phase B LDS map");

__device__ __forceinline__ void gdn_phase_a(const bf16_t* H, const float* G, const float* BETA, const float* convw  , bf16_t* UT, bf16_t* WN, bf16_t* ATT, LAS unsigned char* lds) {
    MK_IDS();
    LAS float* gcs = (LAS float*)(lds + GA_GC); LAS float* bts = (LAS float*)(lds + GA_BT); LAS float* Ls = (LAS float*)(lds + GA_L);
    for (int it = blockIdx.x; it < 256 * 32; it += gridDim.x) {
        const int bh = it & 255, n = it >> 8, b = bh >> 3, h = bh & 7, m0 = b * T + n * 64;
        if (wid == 0) { const float g = G[(size_t)(m0 + lane) * 8 + h]; float c = g;
#pragma unroll
            for (int o = 1; o < 64; o <<= 1) { const float t = __shfl_up(c, o); if (lane >= o) c += t; }
            gcs[lane] = c; bts[lane] = BETA[(size_t)(m0 + lane) * 8 + h]; }
        __syncthreads();
        {
            const int r = tid >> 3, c0 = (tid & 7) * 16, t = n * 64 + r; const bf16_t* hp = H + (size_t)(m0 + r) * GDN_NMAIN + h * 128 + c0;
            const float gcr = gcs[r], btr = bts[r], egc = __expf(gcr);
            float y[16];
            conv_silu16(hp, t, convw + h * 128 + c0, y);
            { const float rinv = rsqrtf(sumsq16_8lanes(y) + RMS_EPS) * 0.08838834764831845f;
#pragma unroll
              for (int c = 0; c < 16; ++c) y[c] *= rinv; lds_store16(lds + GA_Q + r * 272 + c0 * 2, y); }
            conv_silu16(hp + 1024, t, convw + 1024 + h * 128 + c0, y);
            { const float rinv = rsqrtf(sumsq16_8lanes(y) + RMS_EPS);
#pragma unroll
              for (int c = 0; c < 16; ++c) y[c] *= rinv; lds_store16(lds + GA_K + r * 272 + c0 * 2, y);
              const float sc = btr * egc;
#pragma unroll
              for (int c = 0; c < 16; ++c) *(LAS bf16_t*)(lds + GA_KBE + (c0 + c) * 144 + r * 2) = f2bf(y[c] * sc); }
            conv_silu16(hp + 2048, t, convw + 2048 + h * 128 + c0, y);
#pragma unroll
            for (int c = 0; c < 16; ++c) *(LAS bf16_t*)(lds + GA_VB + (c0 + c) * 144 + r * 2) = f2bf(y[c] * btr);
        }
        __syncthreads();
        {
            const int which = wid >> 2, bi = (wid >> 1) & 1, bj = wid & 1, l31 = lane & 31, hi = lane >> 5;
            f32x16 acc = {};
            if (!(bi == 0 && bj == 1)) {
                const LAS unsigned char* ap = lds + (which ? GA_Q : GA_K) + (32 * bi + l31) * 272 + hi * 16;
                const LAS unsigned char* bp = lds + GA_K + (32 * bj + l31) * 272 + hi * 16;
#pragma unroll
                for (int ks = 0; ks < 8; ++ks) acc = __builtin_amdgcn_mfma_f32_32x32x16_bf16(lds_frag16(ap + ks * 32), lds_frag16(bp + ks * 32), acc, 0, 0, 0);
            }
            const int j = 32 * bj + l31; const float gcj = gcs[j];
#pragma unroll
            for (int r = 0; r < 16; ++r) { const int i = 32 * bi + crow(r, hi); const float dec = __expf(fminf(gcs[i] - gcj, 0.f));
                if (which == 0) Ls[i * 64 + j] = (i > j) ? bts[i] * acc[r] * dec : 0.f;
                else ATT[((size_t)it * 64 + i) * 64 + j] = f2bf((i >= j) ? acc[r] * dec : 0.f); }
        }
        __syncthreads();
        if (wid == 0) {
            float t[64]; const float flane = (float)lane;
            const LAS float* Lp = Ls; asm volatile("" : "+v"(Lp));
            LAS unsigned char* Tp = lds + GA_T + lane * 2; asm volatile("" : "+v"(Tp));
#pragma unroll
            for (int i = 0; i < 64; ++i) { float s = 1.f - fminf(fabsf(flane - (float)i), 1.f);
#pragma unroll
                for (int j = 0; j < i; ++j) s -= Lp[i * 64 + j] * t[j];
                t[i] = s; }
#pragma unroll
            for (int i = 0; i < 64; ++i) *(LAS bf16_t*)(Tp + i * 144) = f2bf(t[i]);
        }
        __syncthreads();
        {
            const int bi = wid >> 2, fb = wid & 3, l31 = lane & 31, hi = lane >> 5, nks = bi ? 4 : 2;
            f32x16 au = {}, aw = {};
            const LAS unsigned char* tp = lds + GA_T + (32 * bi + l31) * 144 + hi * 16;
            const LAS unsigned char* vp = lds + GA_VB + (32 * fb + l31) * 144 + hi * 16;
            const LAS unsigned char* kp = lds + GA_KBE + (32 * fb + l31) * 144 + hi * 16;
            for (int ks = 0; ks < nks; ++ks) { const bf16x8 tf = lds_frag16(tp + ks * 32);
                au = __builtin_amdgcn_mfma_f32_32x32x16_bf16(tf, lds_frag16(vp + ks * 32), au, 0, 0, 0);
                aw = __builtin_amdgcn_mfma_f32_32x32x16_bf16(lds_frag16(kp + ks * 32), tf, aw, 0, 0, 0); }
            bf16_t* up = UT + ((size_t)it * 128 + 32 * fb + l31) * 64 + 32 * bi + 4 * hi;
            bf16_t* wp = WN + ((size_t)it * 64 + 32 * bi + l31) * 128 + 32 * fb + 4 * hi;
#pragma unroll
            for (int g = 0; g < 4; ++g) { u32x2 a, w; a.x = cvt_pk_bf16(au[4 * g], au[4 * g + 1]); a.y = cvt_pk_bf16(au[4 * g + 2], au[4 * g + 3]);
                w.x = cvt_pk_bf16(-aw[4 * g], -aw[4 * g + 1]); w.y = cvt_pk_bf16(-aw[4 * g + 2], -aw[4 * g + 3]);
                *(u32x2*)(up + 8 * g) = a; *(u32x2*)(wp + 8 * g) = w; }
        }
        __syncthreads();
    }
}

__device__ __forceinline__ void gdn_phase_b(bf16_t* H, const float* G, const float* convw, const float* normw  , const bf16_t* UT, const bf16_t* WN, const bf16_t* ATT, LAS unsigned char* lds) {
    MK_IDS();
    LAS float* gcs = (LAS float*)(lds + GB_GC);
    const int n16 = lane & 15, q4 = lane >> 4;
    for (int bh = blockIdx.x; bh < 256; bh += gridDim.x) {
        const int b = bh >> 3, h = bh & 7;
        f32x4 S[8];
#pragma unroll
        for (int s = 0; s < 8; ++s) S[s] = (f32x4){0.f, 0.f, 0.f, 0.f};
        for (int n = 0; n < 32; ++n) {
            const int it = n * 256 + bh, m0 = b * T + n * 64;
            if (wid == 0) { float c = G[(size_t)(m0 + lane) * 8 + h];
#pragma unroll
                for (int o = 1; o < 64; o <<= 1) { const float t = __shfl_up(c, o); if (lane >= o) c += t; }
                gcs[lane] = c; }
            __syncthreads();
            const float glast = gcs[63];
            {
                const int r = tid >> 3, c0 = (tid & 7) * 16, t = n * 64 + r; const bf16_t* hp = H + (size_t)(m0 + r) * GDN_NMAIN + h * 128 + c0;
                const float gcr = gcs[r];
                float y[16];
                conv_silu16(hp, t, convw + h * 128 + c0, y);
                { const float sc = rsqrtf(sumsq16_8lanes(y) + RMS_EPS) * 0.08838834764831845f * __expf(gcr);
#pragma unroll
                  for (int c = 0; c < 16; ++c) y[c] *= sc; lds_store16(lds + GB_Q + r * 272 + c0 * 2, y); }
                conv_silu16(hp + 1024, t, convw + 1024 + h * 128 + c0, y);
                { const float sc = rsqrtf(sumsq16_8lanes(y) + RMS_EPS) * __expf(glast - gcr);
#pragma unroll
                  for (int c = 0; c < 16; ++c) *(LAS bf16_t*)(lds + GB_KD + (c0 + c) * 144 + r * 2) = f2bf(y[c] * sc); }
                const u32x4* wsrc = (const u32x4*)(WN + (size_t)it * 8192); const u32x4* usrc = (const u32x4*)(UT + (size_t)it * 8192); const u32x4* asrc = (const u32x4*)(ATT + (size_t)it * 4096);
#pragma unroll
                for (int i = 0; i < 2; ++i) { const int ci = tid + 512 * i;
                    *(LAS u32x4*)(lds + GB_W + (ci >> 4) * 272 + (ci & 15) * 16) = wsrc[ci];
                    *(LAS u32x4*)(lds + GB_UT + (ci >> 3) * 144 + (ci & 7) * 16) = usrc[ci]; }
                *(LAS u32x4*)(lds + GB_AT + (tid >> 3) * 144 + (tid & 7) * 16) = asrc[tid];
            }
            __syncthreads();
            {
                bf16x8 Sf[4];
#pragma unroll
                for (int ks = 0; ks < 4; ++ks) { u32x4 w; w.x = cvt_pk_bf16(S[2 * ks][0], S[2 * ks][1]); w.y = cvt_pk_bf16(S[2 * ks][2], S[2 * ks][3]);
                    w.z = cvt_pk_bf16(S[2 * ks + 1][0], S[2 * ks + 1][1]); w.w = cvt_pk_bf16(S[2 * ks + 1][2], S[2 * ks + 1][3]); Sf[ks] = __builtin_bit_cast(bf16x8, w); }
                f32x4 vn[4];
#pragma unroll
                for (int mt = 0; mt < 4; ++mt) {
                    const s16x4 u4 = *(const LAS s16x4*)(lds + GB_UT + (16 * wid + n16) * 144 + (16 * mt + 4 * q4) * 2);
                    vn[mt] = (f32x4){bf2f((unsigned short)u4[0]), bf2f((unsigned short)u4[1]), bf2f((unsigned short)u4[2]), bf2f((unsigned short)u4[3])};
                    const LAS unsigned char* ap = lds + GB_W + (16 * mt + n16) * 272 + 8 * q4;
#pragma unroll
                    for (int ks = 0; ks < 4; ++ks) vn[mt] = __builtin_amdgcn_mfma_f32_16x16x32_bf16(lds_frag8x2(ap + ks * 64, ap + ks * 64 + 32), Sf[ks], vn[mt], 0, 0, 0);
                }
                bf16x8 Vf[2];
#pragma unroll
                for (int kt = 0; kt < 2; ++kt) { u32x4 w; w.x = cvt_pk_bf16(vn[2 * kt][0], vn[2 * kt][1]); w.y = cvt_pk_bf16(vn[2 * kt][2], vn[2 * kt][3]);
                    w.z = cvt_pk_bf16(vn[2 * kt + 1][0], vn[2 * kt + 1][1]); w.w = cvt_pk_bf16(vn[2 * kt + 1][2], vn[2 * kt + 1][3]); Vf[kt] = __builtin_bit_cast(bf16x8, w); }
#pragma unroll
                for (int mt = 0; mt < 4; ++mt) {
                    f32x4 o = {0.f, 0.f, 0.f, 0.f};
                    const LAS unsigned char* qp = lds + GB_Q + (16 * mt + n16) * 272 + 8 * q4;
#pragma unroll
                    for (int ks = 0; ks < 4; ++ks) o = __builtin_amdgcn_mfma_f32_16x16x32_bf16(lds_frag8x2(qp + ks * 64, qp + ks * 64 + 32), Sf[ks], o, 0, 0, 0);
                    const LAS unsigned char* atp = lds + GB_AT + (16 * mt + n16) * 144 + 8 * q4;
#pragma unroll
                    for (int kt = 0; kt < 2; ++kt) if (kt == 0 || mt >= 2) o = __builtin_amdgcn_mfma_f32_16x16x32_bf16(lds_frag8x2(atp + kt * 64, atp + kt * 64 + 32), Vf[kt], o, 0, 0, 0);
#pragma unroll
                    for (int i = 0; i < 4; ++i) *(LAS float*)(lds + GB_O + (16 * mt + 4 * q4 + i) * 528 + (16 * wid + n16) * 4) = o[i];
                }
                const float eg = __expf(glast);
#pragma unroll
                for (int st = 0; st < 8; ++st) { S[st] = S[st] * eg;
                    const LAS unsigned char* kp = lds + GB_KD + (16 * st + n16) * 144 + 8 * q4;
#pragma unroll
                    for (int kt = 0; kt < 2; ++kt) S[st] = __builtin_amdgcn_mfma_f32_16x16x32_bf16(lds_frag8x2(kp + kt * 64, kp + kt * 64 + 32), Vf[kt], S[st], 0, 0, 0); }
            }
            __syncthreads();
            {
                const int r = tid >> 3, c0 = (tid & 7) * 16;
                float o[16];
#pragma unroll
                for (int q = 0; q < 4; ++q) { const f32x4 v = *(const LAS f32x4*)(lds + GB_O + r * 528 + (c0 + 4 * q) * 4); o[4 * q] = v[0]; o[4 * q + 1] = v[1]; o[4 * q + 2] = v[2]; o[4 * q + 3] = v[3]; }
                const float rstd = rsqrtf(sumsq16_8lanes(o) * (1.f / 128.f) + RMS_EPS);
                bf16_t* hp = H + (size_t)(m0 + r) * GDN_NMAIN + h * 128 + c0;
                float gt[16];
                { float t8[8]; unpack8(*(const u32x4*)(hp + 3072), t8);
#pragma unroll
                  for (int c = 0; c < 8; ++c) gt[c] = t8[c];
                  unpack8(*(const u32x4*)(hp + 3072 + 8), t8);
#pragma unroll
                  for (int c = 0; c < 8; ++c) gt[8 + c] = t8[c]; }
                float res[16];
#pragma unroll
                for (int c = 0; c < 16; ++c) res[c] = o[c] * rstd * normw[c0 + c] * silu(gt[c]);
                u32x4 a, bq; a.x = cvt_pk_bf16(res[0], res[1]); a.y = cvt_pk_bf16(res[2], res[3]); a.z = cvt_pk_bf16(res[4], res[5]); a.w = cvt_pk_bf16(res[6], res[7]);
                bq.x = cvt_pk_bf16(res[8], res[9]); bq.y = cvt_pk_bf16(res[10], res[11]); bq.z = cvt_pk_bf16(res[12], res[13]); bq.w = cvt_pk_bf16(res[14], res[15]);
                *(u32x4*)(hp + 2048) = a; *(u32x4*)(hp + 2048 + 8) = bq;
            }
        }
        __syncthreads();
    }
}

__device__ __forceinline__ void diff_prep_phase(bf16_t* H  , const int* positions, bf16_t* VT  , LAS unsigned char* lds) {
    MK_IDS();
    for (int item = gt; item < M * 4; item += NGT) {
        const int m = item >> 2, g4 = item & 3; const float pos = (float)positions[m];
        float cs[8], sn[8];
#pragma unroll
        for (int e = 0; e < 8; ++e) { const float inv = exp2f(-(float)(8 * g4 + e) * (13.287712379549449f / 32.f)); sincosf(pos * inv, &sn[e], &cs[e]); }
        bf16_t* rowp = H + (size_t)m * DIFF_N + 8 * g4;
#pragma unroll 4
        for (int blk = 0; blk < 32; ++blk) {
            bf16_t* p1 = rowp + (blk >> 4) * 1024 + (blk & 15) * 64; const float sc = (blk < 16) ? 0.125f * LOG2E : 1.f;
            float x1[8], x2[8], y1[8], y2[8]; unpack8(*(const u32x4*)p1, x1); unpack8(*(const u32x4*)(p1 + 32), x2);
#pragma unroll
            for (int e = 0; e < 8; ++e) { y1[e] = (x1[e] * cs[e] - x2[e] * sn[e]) * sc; y2[e] = (x2[e] * cs[e] + x1[e] * sn[e]) * sc; }
            *(u32x4*)p1 = pack8(y1); *(u32x4*)(p1 + 32) = pack8(y2);
        }
    }
    LAS unsigned char* scr = lds + wid * 16384;
    for (int item = gw; item < NB * 32 * 16; item += NGW) {
        const int dvh = item & 1, h = (item >> 1) & 7, tb = (item >> 4) & 31, b = item >> 9;
        const bf16_t* src = H + ((size_t)b * T + tb * 64) * DIFF_N + 2048 + h * 128 + dvh * 64;
#pragma unroll
        for (int i = 0; i < 8; ++i) { const int row = (lane >> 3) + 8 * i, ch = lane & 7; *(LAS u32x4*)(scr + row * 144 + ch * 16) = *(const u32x4*)(src + (size_t)row * DIFF_N + ch * 8); }
        LDS_WAIT();
        bf16_t* dst = VT + (((size_t)b * 8 + h) * 128 + dvh * 64 + lane) * T + tb * 64;
#pragma unroll
        for (int k = 0; k < 8; ++k) { unsigned short v[8];
#pragma unroll
            for (int e = 0; e < 8; ++e) v[e] = *(const LAS bf16_t*)(scr + (8 * k + e) * 144 + lane * 2);
            u32x4 w; w.x = v[0] | ((unsigned)v[1] << 16); w.y = v[2] | ((unsigned)v[3] << 16); w.z = v[4] | ((unsigned)v[5] << 16); w.w = v[6] | ((unsigned)v[7] << 16);
            *(u32x4*)(dst + 8 * k) = w; }
        LDS_WAIT();
    }
}

constexpr int AT_STAGE = 36864, AT_K = 0, AT_V = 64 * 272;
__device__ __forceinline__ void diff_attn_phase(const bf16_t* H, const bf16_t* VT, bf16_t* O, const float* lq1, const float* lk1, const float* lq2, const float* lk2, const float* subw, float lambda_init,
                                                LAS unsigned char* lds) {
    MK_IDS();
    const float lam = __expf(wave_sum(lq1[lane] * lk1[lane])) - __expf(wave_sum(lq2[lane] * lk2[lane])) + lambda_init;
    const int c = wid >> 2, rg = wid & 3, l31 = lane & 31, hi = lane >> 5;
    for (int bh = blockIdx.x; bh < 256; bh += gridDim.x) {
        const int b = bh >> 3, h = bh & 7;
        const bf16_t* Kg = H + (size_t)b * T * DIFF_N + 1024 + h * 128;
        const bf16_t* Vg = VT + (size_t)bh * 128 * T;
        for (int ui = 0; ui < 16; ++ui) {
            const int qb = (ui & 1) ? (15 - (ui >> 1)) : (ui >> 1);
            const int q0w = 128 * qb + 32 * rg, nt = 2 * qb + 2;
            bf16x8 qf[4];
            { const bf16_t* qp = H + ((size_t)b * T + q0w + l31) * DIFF_N + h * 128 + c * 64 + 8 * hi;
#pragma unroll
              for (int d0 = 0; d0 < 4; ++d0) qf[d0] = *(const bf16x8*)(qp + 16 * d0); }
            f32x16 o[4];
#pragma unroll
            for (int d = 0; d < 4; ++d) o[d] = (f32x16){};
            float mrun = -1e30f, lrun = 0.f;
            u32x4 pk[2], pv[2];
#define AT_LOAD(j) do { _Pragma("unroll") for (int i_ = 0; i_ < 2; ++i_) { const int ci = tid + 512 * i_; \
                pk[i_] = *(const u32x4*)(Kg + (size_t)((j) * 64 + (ci >> 4)) * DIFF_N + (ci & 15) * 8); \
                pv[i_] = *(const u32x4*)(Vg + (size_t)(ci >> 3) * T + (j) * 64 + (ci & 7) * 8); } } while (0)
            AT_LOAD(0);
            for (int j = 0; j < nt; ++j) {
                LAS unsigned char* st = lds + (j & 1) * AT_STAGE;
#pragma unroll
                for (int i_ = 0; i_ < 2; ++i_) { const int ci = tid + 512 * i_;
                    *(LAS u32x4*)(st + AT_K + (ci >> 4) * 272 + (ci & 15) * 16) = pk[i_];
                    *(LAS u32x4*)(st + AT_V + (ci >> 3) * 144 + (ci & 7) * 16) = pv[i_]; }
                __syncthreads();
                if (j + 1 < nt) AT_LOAD(j + 1);
                if (64 * j <= q0w + 31) {
                    f32x16 p[2];
#pragma unroll
                    for (int kb = 0; kb < 2; ++kb) { p[kb] = (f32x16){};
                        const LAS unsigned char* kp = st + AT_K + (32 * kb + l31) * 272 + c * 128 + hi * 16;
#pragma unroll
                        for (int d0 = 0; d0 < 4; ++d0) p[kb] = __builtin_amdgcn_mfma_f32_32x32x16_bf16(lds_frag16(kp + d0 * 32), qf[d0], p[kb], 0, 0, 0); }
                    if (64 * j + 63 > q0w) {
                        const int q = q0w + l31;
#pragma unroll
                        for (int kb = 0; kb < 2; ++kb)
#pragma unroll
                            for (int r = 0; r < 16; ++r) { const int kv = 64 * j + 32 * kb + crow(r, hi); if (kv > q) p[kb][r] = -1e30f; }
                    }
                    float mx = p[0][0];
#pragma unroll
                    for (int kb = 0; kb < 2; ++kb)
#pragma unroll
                        for (int r = 0; r < 16; ++r) mx = fmaxf(mx, p[kb][r]);
                    mx = fmaxf(mx, __shfl_xor(mx, 32));
                    const float mnew = fmaxf(mrun, mx), al = exp2f(mrun - mnew); mrun = mnew;
                    float ls = 0.f;
#pragma unroll
                    for (int kb = 0; kb < 2; ++kb)
#pragma unroll
                        for (int r = 0; r < 16; ++r) { p[kb][r] = exp2f(p[kb][r] - mnew); ls += p[kb][r]; }
                    lrun = lrun * al + ls;
#pragma unroll
                    for (int d = 0; d < 4; ++d) o[d] = o[d] * al;
#pragma unroll
                    for (int kb = 0; kb < 2; ++kb)
#pragma unroll
                        for (int s = 0; s < 2; ++s) {
                            u32x4 w; w.x = cvt_pk_bf16(p[kb][8 * s], p[kb][8 * s + 1]); w.y = cvt_pk_bf16(p[kb][8 * s + 2], p[kb][8 * s + 3]);
                            w.z = cvt_pk_bf16(p[kb][8 * s + 4], p[kb][8 * s + 5]); w.w = cvt_pk_bf16(p[kb][8 * s + 6], p[kb][8 * s + 7]);
                            const bf16x8 pf = __builtin_bit_cast(bf16x8, w);
                            const LAS unsigned char* vp = st + AT_V + l31 * 144 + (32 * kb + 16 * s + 4 * hi) * 2;
#pragma unroll
                            for (int d = 0; d < 4; ++d) o[d] = __builtin_amdgcn_mfma_f32_32x32x16_bf16(lds_frag8x2(vp + d * 32 * 144, vp + d * 32 * 144 + 16), pf, o[d], 0, 0, 0);
                        }
                }
            }
#undef AT_LOAD
            const float ltot = lrun + __shfl_xor(lrun, 32);
            const float inv = (c ? lam : 1.f) / ltot;
            __syncthreads();
            LAS float* xch = (LAS float*)lds + rg * 4096;
            if (c == 1) {
#pragma unroll
                for (int d = 0; d < 4; ++d)
#pragma unroll
                    for (int r = 0; r < 16; ++r) xch[(d * 16 + r) * 64 + lane] = o[d][r] * inv;
            }
            __syncthreads();
            if (c == 0) {
                float ss = 0.f;
#pragma unroll
                for (int d = 0; d < 4; ++d)
#pragma unroll
                    for (int r = 0; r < 16; ++r) { const float v = o[d][r] * inv - xch[(d * 16 + r) * 64 + lane]; o[d][r] = v; ss += v * v; }
                ss += __shfl_xor(ss, 32);
                const float rstd = rsqrtf(ss * (1.f / 128.f) + RMS_EPS) * (1.f - lambda_init);
                bf16_t* op = O + ((size_t)b * T + q0w + l31) * D + h * 128 + 4 * hi;
#pragma unroll
                for (int d = 0; d < 4; ++d)
#pragma unroll
                    for (int g = 0; g < 4; ++g) { const int dv = 32 * d + 8 * g + 4 * hi; const f32x4 sw = *(const f32x4*)(subw + dv);
                        u32x2 w; w.x = cvt_pk_bf16(o[d][4 * g] * rstd * sw[0], o[d][4 * g + 1] * rstd * sw[1]); w.y = cvt_pk_bf16(o[d][4 * g + 2] * rstd * sw[2], o[d][4 * g + 3] * rstd * sw[3]);
                        *(u32x2*)(op + 32 * d + 8 * g) = w; }
            }
            __syncthreads();
        }
    }
}

__global__ void __launch_bounds__(NTHR, 2) fwd_megakernel(Params p) {
    extern __shared__ __attribute__((aligned(16))) unsigned char lds_raw[];
    LAS unsigned char* lds = (LAS unsigned char*)lds_raw;
    cg::grid_group grid = cg::this_grid();
    const int G = gridDim.x;
    unsigned char* ws = p.ws; unsigned char* wsw = ws + WS_W;
    bf16_t* XN = (bf16_t*)(ws + WS_XN); bf16_t* Hb = (bf16_t*)(ws + WS_H);
    float* Gb = (float*)(ws + WS_GB); float* BETAb = Gb + (size_t)M * 8;

#ifndef NO_PRO
    prologue(p, lds);
#endif
    grid.sync();
    for (int layer = 0; layer < DEPTH; ++layer) {
        const int j = layer >> 1;
        const float* resid = (layer == 0) ? p.in[0] : p.out;
        if ((layer & 1) == 0) {
            {   pg8::Gemm g{XN, (const bf16_t*)(wsw + W_GWIN) + (size_t)j * 4096 * 1024, M, GDN_NMAIN, D, D}; pg8::StaticOrder S; S.init(M, GDN_NMAIN, G, (int)blockIdx.x);
                pg8::EpiBf16 E{Hb, GDN_NMAIN};
                PH_GEMMB pg8::gemm_phase<pg8::EpiBf16, pg8::StaticOrder, true, true, D, D>(lds, g, S, E); }
#ifndef NO_AB
            gdn_ab_phase(XN, (const bf16_t*)(wsw + W_GWAB) + (size_t)j * 16 * 1024, p.in[4] + j * 8, p.in[5] + j * 8, Gb, BETAb);
#endif
            grid.sync();
#ifndef NO_GA
            gdn_phase_a(Hb, Gb, BETAb, p.in[3] + (size_t)j * 4 * 3072, (bf16_t*)(ws + WS_UT), (bf16_t*)(ws + WS_WN), (bf16_t*)(ws + WS_XN), lds);
#endif
            grid.sync();
#ifndef NO_GB
            gdn_phase_b(Hb, Gb, p.in[3] + (size_t)j * 4 * 3072, p.in[6] + j * 128, (const bf16_t*)(ws + WS_UT), (const bf16_t*)(ws + WS_WN), (const bf16_t*)(ws + WS_XN), lds);
#endif
            grid.sync();
            {   pg8::Gemm g{Hb + 2048, (const bf16_t*)(wsw + W_GWOUT) + (size_t)j * 1024 * 1024, M, D, D, GDN_NMAIN}; pg8::StaticOrder S; S.init(M, D, G, (int)blockIdx.x);
                pg8::EpiResid E{resid, p.out, D, ALPHA};
                PH_GEMMR pg8::gemm_phase<pg8::EpiResid, pg8::StaticOrder, true, true, D, GDN_NMAIN>(lds, g, S, E); }
        } else {
            const float lambda_init = 0.8f - 0.6f * expf(-0.3f * (float)layer);
            {   pg8::Gemm g{XN, (const bf16_t*)(wsw + W_DWIN) + (size_t)j * 3072 * 1024, M, DIFF_N, D, D}; pg8::StaticOrder S; S.init(M, DIFF_N, G, (int)blockIdx.x);
                pg8::EpiBf16 E{Hb, DIFF_N};
                PH_GEMMB pg8::gemm_phase<pg8::EpiBf16, pg8::StaticOrder, true, true, D, D>(lds, g, S, E); }
            grid.sync();
#ifndef NO_PREP
            diff_prep_phase(Hb, p.positions, (bf16_t*)(ws + WS_VT), lds);
#endif
            grid.sync();
#ifndef NO_ATT
            diff_attn_phase(Hb, (const bf16_t*)(ws + WS_VT), (bf16_t*)(ws + WS_O), p.in[9] + j * 64, p.in[10] + j * 64, p.in[11] + j * 64, p.in[12] + j * 64, p.in[13] + j * 128, lambda_init, lds);
#endif
            grid.sync();
            {   pg8::Gemm g{(const bf16_t*)(ws + WS_O), (const bf16_t*)(wsw + W_DWOUT) + (size_t)j * 1024 * 1024, M, D, D, D}; pg8::StaticOrder S; S.init(M, D, G, (int)blockIdx.x);
                pg8::EpiResid E{resid, p.out, D, ALPHA};
                PH_GEMMR pg8::gemm_phase<pg8::EpiResid, pg8::StaticOrder, true, true, D, D>(lds, g, S, E); }
        }
        grid.sync();
#ifndef NO_LN
        ln_phase(p.out, XN, p.in[19] + layer * D, p.in[20] + layer * D);
#endif
        grid.sync();
        for (int half = 0; half < 2; ++half) {
            bf16_t* ACT = (bf16_t*)(ws + WS_ACT);
            {   pg8::Gemm g{XN + (size_t)half * MH * D, (const bf16_t*)(wsw + W_FUP) + (size_t)layer * 5632 * 1024, MH, FFN_N, D, D}; pg8::StaticOrder S; S.init(MH, FFN_N, G, (int)blockIdx.x);
                pg8::EpiBf16 E{Hb, FFN_N};
                PH_GEMMB pg8::gemm_phase<pg8::EpiBf16, pg8::StaticOrder, true, true, D, D>(lds, g, S, E); }
            grid.sync();
#ifndef NO_ACT
            ffn_act_phase(Hb, ACT, p.in[16] + (size_t)layer * 3 * FFN_N, p.in[17] + (size_t)layer * FFN_N);
#endif
            grid.sync();
            {   pg8::Gemm g{ACT, (const bf16_t*)(wsw + W_FDOWN) + (size_t)layer * 1024 * 2816, MH, D, FFN_H, FFN_H}; pg8::StaticOrder S; S.init(MH, D, G, (int)blockIdx.x);
                pg8::EpiResid E{p.out + (size_t)half * MH * D, p.out + (size_t)half * MH * D, D, ALPHA};
                PH_GEMMR pg8::gemm_phase<pg8::EpiResid, pg8::StaticOrder, true, true, FFN_H, FFN_H>(lds, g, S, E); }
        }
        grid.sync();
#ifndef NO_LN
        ln_phase(p.out, XN, p.in[21] + layer * D, p.in[22] + layer * D);
#endif
        grid.sync();
    }
}
}

extern "C" void kernel_launch(void* const* d_in, const int* in_sizes, int n_in, void* d_out, int out_size, void* d_ws, size_t ws_size, hipStream_t stream) {
    static int grid = 0;
    if (grid == 0) {
        if (n_in != 23 || ws_size < mk::WS_END) { fprintf(stderr, "kernel_launch: unexpected n_in %d / ws_size %zu (need %zu)\n", n_in, ws_size, (size_t)mk::WS_END); grid = -1; return; }
        int dev = 0, cus = 0, per_cu = 0;
        hipGetDevice(&dev); hipDeviceGetAttribute(&cus, hipDeviceAttributeMultiprocessorCount, dev);
        if (hipFuncSetAttribute((const void*)mk::fwd_megakernel, hipFuncAttributeMaxDynamicSharedMemorySize, mk::LDS_BYTES) != hipSuccess) { fprintf(stderr, "kernel_launch: hipFuncSetAttribute failed\n"); grid = -1; return; }
        if (hipOccupancyMaxActiveBlocksPerMultiprocessor(&per_cu, (const void*)mk::fwd_megakernel, mk::NTHR, mk::LDS_BYTES) != hipSuccess || per_cu < 1) { fprintf(stderr, "kernel_launch: occupancy query gave %d\n", per_cu); per_cu = 1; }
        (void)hipGetLastError();
        grid = cus * per_cu;
        fprintf(stderr, "kernel_launch: grid %d (cus %d x %d)\n", grid, cus, per_cu);
    }
    if (grid < 0) return;
    mk::Params p{};
    for (int i = 0; i < 23; ++i) p.in[i] = (const float*)d_in[i];
    p.positions = (const int*)d_in[1]; p.out = (float*)d_out; p.ws = (unsigned char*)d_ws;
    void* args[] = {&p};
    hipError_t e = hipLaunchCooperativeKernel((const void*)mk::fwd_megakernel, dim3(grid), dim3(mk::NTHR), args, mk::LDS_BYTES, stream);
    if (e != hipSuccess) fprintf(stderr, "cooperative launch failed: %s (grid %d)\n", hipGetErrorString(e), grid);
}
```

```cpp
#include <hip/hip_runtime.h>
#include <hip/hip_cooperative_groups.h>
#include <cstdio>
#include <cstdint>
namespace cg = cooperative_groups;
#ifndef PROBE_REP
#define PROBE_REP 0
#endif
#define REPS(k) for (int rep_ = 0; rep_ < ((PROBE_REP) == (k) ? 2 : 1); ++rep_)
namespace pg8 {
#define PG8_LAS __attribute__((address_space(3)))
typedef unsigned short bf16_t;
typedef short bf16x8 __attribute__((ext_vector_type(8)));
typedef float f32x4 __attribute__((ext_vector_type(4)));
typedef unsigned u32x4 __attribute__((ext_vector_type(4)));
constexpr int BM = 256, BK = 64, HALF = 128, HTB = HALF * BK * 2  , STAGE_BYTES = 8 * HTB, NXCD = 8, WGM = 8;

__host__ __device__ __forceinline__ int lds_byte(int r, int c) { const int st = (r >> 4) * 2 + (c >> 5), rr = r & 15, cc = c & 31, ob = rr * 64 + cc * 2; return st * 1024 + (ob ^ (((ob >> 9) & 1) << 5)); }
__host__ __device__ __forceinline__ void stage_rc(int b, int& R, int& C) { const int st = b / 1024, sb = b % 1024, swz = sb ^ (((sb >> 9) & 1) << 5); R = (st >> 1) * 16 + swz / 64; C = (st & 1) * 32 + (swz % 64) / 2; }
__host__ __device__ __forceinline__ int perm32(int rho) { const int n = rho >> 4, i = rho & 15; return 8 * (i >> 2) + 4 * n + (i & 3); }

struct Unit { int pm, pn; };
struct Gemm { const bf16_t* A; const bf16_t* Bt; int M, N, K, lda; };

struct StaticOrder {
    int nM, nN, nwg, G, c;
    __host__ __device__ void init(int M, int N, int G_, int c_) { nM = M / BM; nN = N / BM; nwg = nM * nN; G = G_; c = c_; }
    __host__ __device__ bool next(int i, Unit& u) const {
        const long L = (long)i * G + c; if (L >= nwg) return false;
        int wgid = (int)L; { const int q = nwg / NXCD, r = nwg % NXCD, xcd = wgid % NXCD, off = wgid / NXCD; wgid = (xcd < r ? xcd * (q + 1) : r * (q + 1) + (xcd - r) * q) + off; }
        const int nig = WGM * nN, gid = wgid / nig, fm = gid * WGM, gsz = (nM - fm) < WGM ? (nM - fm) : WGM;
        u.pm = fm + ((wgid % nig) % gsz); u.pn = (wgid % nig) / gsz; return true;
    }
    __device__ __forceinline__ void a_ready(const Unit&) const {}
    __device__ __forceinline__ void done(const Unit&) const {}
};
typedef float f32x2 __attribute__((ext_vector_type(2)));
typedef __bf16 bf16x2v __attribute__((ext_vector_type(2)));
__device__ __forceinline__ unsigned cvt_pk_bf16(float lo, float hi) { f32x2 v = {lo, hi}; bf16x2v b = __builtin_convertvector(v, bf16x2v); return __builtin_bit_cast(unsigned, b); }

struct EpiBf16 {
    static constexpr bool PERM = true, AFTER_DRAIN = false;
    bf16_t* O; int ldc;
    __device__ __forceinline__ void operator()(const f32x4 (&acc)[2][2][4][2], const Unit& u, int wr, int wc, int fr, int fq) const {
        const int row0 = u.pm * BM + wr * 64 + fr; const int col0 = u.pn * BM + wc * 32 + 8 * fq;
#pragma unroll
        for (int ai = 0; ai < 2; ++ai)
#pragma unroll
            for (int m = 0; m < 4; ++m) { bf16_t* rowp = O + (size_t)(row0 + ai * HALF + m * 16) * ldc + col0;
#pragma unroll
                for (int bj = 0; bj < 2; ++bj) { const f32x4 v0 = acc[ai][bj][m][0], v1 = acc[ai][bj][m][1];
                    u32x4 w; w.x = cvt_pk_bf16(v0[0], v0[1]); w.y = cvt_pk_bf16(v0[2], v0[3]); w.z = cvt_pk_bf16(v1[0], v1[1]); w.w = cvt_pk_bf16(v1[2], v1[3]);
                    *(u32x4*)(rowp + bj * HALF) = w; } }
    }
};
struct EpiResid {
    static constexpr bool PERM = false, AFTER_DRAIN = false;
    const float* base; float* out; int ldc; float alpha;
    __device__ __forceinline__ void operator()(const f32x4 (&acc)[2][2][4][2], const Unit& u, int wr, int wc, int fr, int fq) const {
        const int col0 = u.pn * BM + wc * 32 + 4 * fq;
#pragma unroll
        for (int ai = 0; ai < 2; ++ai)
#pragma unroll
            for (int m = 0; m < 4; ++m) { const int r = ai * HALF + wr * 64 + m * 16 + fr; const size_t off = (size_t)(u.pm * BM + r) * ldc + col0;
#pragma unroll
                for (int bj = 0; bj < 2; ++bj)
#pragma unroll
                    for (int n = 0; n < 2; ++n) { const f32x4 bs = *(const f32x4*)(base + off + bj * HALF + n * 16); const f32x4 o = bs * alpha + acc[ai][bj][m][n];
                        *(f32x4*)(out + off + bj * HALF + n * 16) = o; }
                asm volatile("" ::: "memory"); }
    }
};

template <class Epi, class Sched, bool ALIGN_EPI, bool SP2, int KC, int LDAC>
__device__ __forceinline__ void gemm_phase(PG8_LAS unsigned char* lds, const Gemm g, const Sched& S, const Epi& E) {
    int tid_ = threadIdx.x; asm volatile("" : "+v"(tid_));
    const int tid = tid_, wid = __builtin_amdgcn_readfirstlane(tid >> 6), lane = tid & 63, wr = wid >> 2, wc = wid & 3, fr = lane & 15, fq = lane >> 4;
    constexpr int K = KC, nt = K / BK;
    unsigned voffA[2], voffB[2];
#pragma unroll
    for (int i = 0; i < 2; ++i) { int R, C; stage_rc(tid * 16 + i * 8192, R, C); const int Rb = Epi::PERM ? ((R & ~31) + perm32(R & 31)) : R;
        voffA[i] = (unsigned)(R * LDAC + C) * 2u; voffB[i] = (unsigned)(Rb * K + C) * 2u; }
    const size_t kstep = (size_t)(BK * 2);
    const size_t hstepA = (size_t)HALF * LDAC * 2, hstepB = (size_t)HALF * K * 2;
    const size_t tstepA = 2 * hstepA, tstepB = 2 * hstepB;
    const unsigned ldsw = (unsigned)wid * 1024u;
    const int aoff = lds_byte(wr * 64 + fr, fq * 8), boff = lds_byte(wc * 32 + fr, fq * 8);
#define PG8_SA(b, h) (((b) * 2 + (h)) * HTB)
#define PG8_SB(b, h) ((4 + (b) * 2 + (h)) * HTB)
#define PG8_STAGE(bufoff, gbase, voff) do { _Pragma("unroll") for (int _i = 0; _i < 2; ++_i) \
        __builtin_amdgcn_global_load_lds((const unsigned*)((const char*)(gbase) + (voff)[_i]), (PG8_LAS unsigned*)(lds + (bufoff) + ldsw + _i * 8192), 16, 0, 0); } while (0)
#define PG8_LDA(dst, b, h) do { _Pragma("unroll") for (int m = 0; m < 4; ++m) _Pragma("unroll") for (int k = 0; k < 2; ++k) dst[m][k] = *(const PG8_LAS bf16x8*)(lds + PG8_SA(b, h) + aoff + m * 2048 + k * 1024); } while (0)
#define PG8_LDB(dst, b, h) do { _Pragma("unroll") for (int n = 0; n < 2; ++n) _Pragma("unroll") for (int k = 0; k < 2; ++k) dst[n][k] = *(const PG8_LAS bf16x8*)(lds + PG8_SB(b, h) + boff + n * 2048 + k * 1024); } while (0)
#define PG8_MMA(ai, bj, At, Bt) do { __builtin_amdgcn_s_setprio(1); _Pragma("unroll") for (int m = 0; m < 4; ++m) _Pragma("unroll") for (int n = 0; n < 2; ++n) _Pragma("unroll") for (int k = 0; k < 2; ++k) \
        acc[ai][bj][m][n] = __builtin_amdgcn_mfma_f32_16x16x32_bf16(Bt[n][k], At[m][k], acc[ai][bj][m][n], 0, 0, 0); __builtin_amdgcn_s_setprio(0); } while (0)
#define PG8_WAIT_V(n) asm volatile("s_waitcnt vmcnt(" #n ")" ::: "memory")
#define PG8_WAIT_L(n) asm volatile("s_waitcnt lgkmcnt(" #n ")" ::: "memory")
#define PG8_BAR __builtin_amdgcn_s_barrier()
#define PG8_SCHED __builtin_amdgcn_sched_barrier(0)
    Unit cur, nxt; int ui = 0;
    if (!S.next(0, cur)) return;
    f32x4 acc[2][2][4][2];
#pragma unroll
    for (int a = 0; a < 2; ++a)
#pragma unroll
        for (int b = 0; b < 2; ++b)
#pragma unroll
            for (int m = 0; m < 4; ++m)
#pragma unroll
                for (int n = 0; n < 2; ++n) acc[a][b][m][n] = (f32x4){0.f, 0.f, 0.f, 0.f};
    bf16x8 At[4][2], B0[2][2], B1[2][2];
    const char* cA = (const char*)g.A + (size_t)cur.pm * tstepA; const char* cB = (const char*)g.Bt + (size_t)cur.pn * tstepB;
    S.a_ready(cur);
    if constexpr (SP2) {
        PG8_STAGE(PG8_SB(0, 0), cB, voffB); PG8_STAGE(PG8_SB(0, 1), cB + hstepB, voffB); PG8_STAGE(PG8_SA(0, 0), cA, voffA); PG8_STAGE(PG8_SA(0, 1), cA + hstepA, voffA);
        if (wr == 1) PG8_BAR;
        PG8_WAIT_V(2); PG8_BAR;
        PG8_STAGE(PG8_SB(1, 0), cB + kstep, voffB); PG8_STAGE(PG8_SA(1, 0), cA + kstep, voffA); PG8_STAGE(PG8_SB(1, 1), cB + hstepB + kstep, voffB);
        PG8_WAIT_V(6); PG8_BAR;
    } else {
        PG8_STAGE(PG8_SB(0, 0), cB, voffB); PG8_STAGE(PG8_SA(0, 0), cA, voffA); PG8_STAGE(PG8_SB(0, 1), cB + hstepB, voffB); PG8_STAGE(PG8_SA(0, 1), cA + hstepA, voffA);
        if (wr == 1) PG8_BAR;
        PG8_WAIT_V(4); PG8_BAR;
        PG8_STAGE(PG8_SB(1, 0), cB + kstep, voffB); PG8_STAGE(PG8_SA(1, 0), cA + kstep, voffA); PG8_STAGE(PG8_SB(1, 1), cB + hstepB + kstep, voffB);
        PG8_WAIT_V(6); PG8_BAR;
    }
    for (;;) {
        const bool has_next = S.next(ui + 1, nxt);
        const char* nA = has_next ? (const char*)g.A + (size_t)nxt.pm * tstepA : cA; const char* nB = has_next ? (const char*)g.Bt + (size_t)nxt.pn * tstepB : cB;
        for (int t = 0; t < nt; t += 2) {
            const bool last = (t == nt - 2);
            const char* a1 = cA + (size_t)(t + 1) * kstep;
            const char* a2 = last ? nA : cA + (size_t)(t + 2) * kstep; const char* b2 = last ? nB : cB + (size_t)(t + 2) * kstep;
            const char* a3 = a2 + kstep; const char* b3 = b2 + kstep;
            if (last && has_next) S.a_ready(nxt);
            if constexpr (SP2) {
            PG8_LDB(B0, 0, 0); PG8_LDB(B1, 0, 1); PG8_SCHED; PG8_LDA(At, 0, 0); PG8_STAGE(PG8_SA(1, 1), a1 + hstepA, voffA);
            PG8_WAIT_V(8); PG8_WAIT_L(0); PG8_BAR; PG8_MMA(0, 0, At, B0); PG8_MMA(0, 1, At, B1); PG8_BAR; PG8_SCHED;
            PG8_LDA(At, 0, 1); PG8_STAGE(PG8_SB(0, 0), b2, voffB); PG8_STAGE(PG8_SB(0, 1), b2 + hstepB, voffB); PG8_STAGE(PG8_SA(0, 0), a2, voffA);
            PG8_WAIT_V(8); PG8_WAIT_L(0); PG8_BAR; PG8_MMA(1, 0, At, B0); PG8_MMA(1, 1, At, B1); PG8_BAR; PG8_SCHED;
            PG8_LDB(B0, 1, 0); PG8_LDB(B1, 1, 1); PG8_SCHED; PG8_LDA(At, 1, 0); PG8_STAGE(PG8_SA(0, 1), a2 + hstepA, voffA);
            PG8_WAIT_V(8); PG8_WAIT_L(0); PG8_BAR; PG8_MMA(0, 0, At, B0); PG8_MMA(0, 1, At, B1); PG8_BAR; PG8_SCHED;
            PG8_LDA(At, 1, 1); PG8_STAGE(PG8_SB(1, 0), b3, voffB); PG8_STAGE(PG8_SB(1, 1), b3 + hstepB, voffB); PG8_STAGE(PG8_SA(1, 0), a3, voffA);
            PG8_WAIT_V(8); PG8_WAIT_L(0); PG8_BAR; PG8_MMA(1, 0, At, B0); PG8_MMA(1, 1, At, B1); PG8_BAR; PG8_SCHED;
            } else {
            PG8_LDB(B0, 0, 0); PG8_SCHED; PG8_LDA(At, 0, 0); PG8_STAGE(PG8_SA(1, 1), a1 + hstepA, voffA);
            PG8_WAIT_L(8); PG8_BAR; PG8_WAIT_L(0); PG8_MMA(0, 0, At, B0); PG8_BAR; PG8_SCHED;
            PG8_LDB(B1, 0, 1); PG8_STAGE(PG8_SB(0, 0), b2, voffB);
            PG8_BAR; PG8_WAIT_L(0); PG8_MMA(0, 1, At, B1); PG8_BAR;
            PG8_LDA(At, 0, 1); PG8_STAGE(PG8_SA(0, 0), a2, voffA);
            PG8_BAR; PG8_WAIT_L(0); PG8_MMA(1, 0, At, B0); PG8_BAR; PG8_SCHED;
            PG8_STAGE(PG8_SB(0, 1), b2 + hstepB, voffB);
            PG8_WAIT_V(6); PG8_BAR; PG8_MMA(1, 1, At, B1); PG8_BAR;
            PG8_LDB(B0, 1, 0); PG8_SCHED; PG8_LDA(At, 1, 0); PG8_STAGE(PG8_SA(0, 1), a2 + hstepA, voffA);
            PG8_WAIT_L(8); PG8_BAR; PG8_WAIT_L(0); PG8_MMA(0, 0, At, B0); PG8_BAR; PG8_SCHED;
            PG8_LDB(B1, 1, 1); PG8_STAGE(PG8_SB(1, 0), b3, voffB);
            PG8_BAR; PG8_WAIT_L(0); PG8_MMA(0, 1, At, B1); PG8_BAR;
            PG8_LDA(At, 1, 1); PG8_STAGE(PG8_SA(1, 0), a3, voffA);
            PG8_BAR; PG8_WAIT_L(0); PG8_MMA(1, 0, At, B0); PG8_BAR; PG8_SCHED;
            PG8_STAGE(PG8_SB(1, 1), b3 + hstepB, voffB);
            PG8_WAIT_V(6); PG8_BAR; PG8_MMA(1, 1, At, B1); PG8_BAR;
            }
        }
        if constexpr (ALIGN_EPI) { if (wr == 0) PG8_BAR; }
        if constexpr (!Epi::AFTER_DRAIN) { E(acc, cur, wr, wc, fr, fq); S.done(cur); }
        if (!has_next) break;
#pragma unroll
        for (int a = 0; a < 2; ++a)
#pragma unroll
            for (int b = 0; b < 2; ++b)
#pragma unroll
                for (int m = 0; m < 4; ++m)
#pragma unroll
                    for (int n = 0; n < 2; ++n) acc[a][b][m][n] = (f32x4){0.f, 0.f, 0.f, 0.f};
        cur = nxt; cA = nA; cB = nB; ++ui;
        if constexpr (ALIGN_EPI) { if (wr == 1) PG8_BAR; }
    }
    PG8_WAIT_V(0);
    if constexpr (!ALIGN_EPI) { if (wr == 0) PG8_BAR; }
    PG8_BAR;
    if constexpr (Epi::AFTER_DRAIN) { E.fused(acc, cur, wr, wc, fr, fq, lds, wid, lane); S.done(cur); }
#undef PG8_SA
#undef PG8_SB
#undef PG8_STAGE
#undef PG8_LDA
#undef PG8_LDB
#undef PG8_MMA
#undef PG8_WAIT_V
#undef PG8_WAIT_L
#undef PG8_BAR
#undef PG8_SCHED
}
}

#ifdef NO_GEMMB
#define PH_GEMMB if (0)
#else
#define PH_GEMMB
#endif
#ifdef NO_GEMMR
#define PH_GEMMR if (0)
#else
#define PH_GEMMR
#endif
namespace mk {
#define LAS __attribute__((address_space(3)))
typedef unsigned short bf16_t;
typedef short bf16x8 __attribute__((ext_vector_type(8)));
typedef short s16x4 __attribute__((ext_vector_type(4)));
typedef float f32x4 __attribute__((ext_vector_type(4)));
typedef float f32x16 __attribute__((ext_vector_type(16)));
typedef unsigned u32x4 __attribute__((ext_vector_type(4)));
typedef unsigned u32x2 __attribute__((ext_vector_type(2)));
using pg8::cvt_pk_bf16;

constexpr int NB = 32, T = 2048, D = 1024, M = NB * T, DEPTH = 4;
constexpr int NWAVES = 8, NTHR = 512;
constexpr int GDN_N = 4112, GDN_NMAIN = 4096, DIFF_N = 3072, FFN_H = 2816, FFN_N = 5632;
constexpr float LN_EPS = 1e-5f, RMS_EPS = 1e-6f;
constexpr float ALPHA = 1.6817928305074290f;
constexpr float LOG2E = 1.4426950408889634f;
constexpr int MH = M / 2;

constexpr size_t MiB = 1u << 20;
constexpr size_t WS_W = 2 * MiB;
constexpr size_t W_GWIN = 0, W_GWAB = W_GWIN + 2ull * 4096 * 1024 * 2, W_GWOUT = W_GWAB + 2ull * 16 * 1024 * 2, W_DWIN = W_GWOUT + 2ull * 1024 * 1024 * 2,
                 W_DWOUT = W_DWIN + 2ull * 3072 * 1024 * 2, W_FUP = W_DWOUT + 2ull * 1024 * 1024 * 2, W_FDOWN = W_FUP + 4ull * 5632 * 1024 * 2, W_END = W_FDOWN + 4ull * 1024 * 2816 * 2;
static_assert(WS_W + W_END <= 106 * MiB, "weights region");
constexpr size_t WS_GB = 106 * MiB;
constexpr size_t WS_XN = 112 * MiB;
constexpr size_t WS_H = 240 * MiB;
constexpr size_t WS_ACT = WS_H + 352 * MiB;
constexpr size_t WS_UT = WS_H + 512 * MiB;
constexpr size_t WS_WN = WS_UT + 128 * MiB;
constexpr size_t WS_VT = WS_H + 384 * MiB;
constexpr size_t WS_O = WS_VT + 128 * MiB;
constexpr size_t WS_END = WS_WN + 128 * MiB;
static_assert(WS_END <= 1024 * MiB, "workspace map");
constexpr int LDS_BYTES = 131072 + 2048;

__device__ __forceinline__ float bf2f(unsigned short h) { return __uint_as_float((unsigned)h << 16); }
__device__ __forceinline__ unsigned short f2bf(float f) { return (unsigned short)(cvt_pk_bf16(f, 0.f) & 0xffffu); }
__device__ __forceinline__ float wave_sum(float v) {
#pragma unroll
    for (int o = 1; o < 64; o <<= 1) v += __shfl_xor(v, o);
    return v;
}
__device__ __forceinline__ float silu(float x) { return x / (1.f + __expf(-x)); }
__device__ __forceinline__ void unpack8(const u32x4 v, float (&o)[8]) {
    o[0] = __uint_as_float(v.x << 16); o[1] = __uint_as_float(v.x & 0xffff0000u); o[2] = __uint_as_float(v.y << 16); o[3] = __uint_as_float(v.y & 0xffff0000u);
    o[4] = __uint_as_float(v.z << 16); o[5] = __uint_as_float(v.z & 0xffff0000u); o[6] = __uint_as_float(v.w << 16); o[7] = __uint_as_float(v.w & 0xffff0000u);
}
__device__ __forceinline__ u32x4 pack8(const float (&o)[8]) { u32x4 w; w.x = cvt_pk_bf16(o[0], o[1]); w.y = cvt_pk_bf16(o[2], o[3]); w.z = cvt_pk_bf16(o[4], o[5]); w.w = cvt_pk_bf16(o[6], o[7]); return w; }
__device__ __forceinline__ int crow(int r, int hi) { return (r & 3) + 8 * (r >> 2) + 4 * hi; }
#define LDS_WAIT() asm volatile("s_waitcnt lgkmcnt(0)" ::: "memory")
#define MK_IDS() int tid_ = threadIdx.x; asm volatile("" : "+v"(tid_));   \
    const int tid = tid_, lane = tid & 63, wid = __builtin_amdgcn_readfirstlane(tid >> 6); const int G_ = gridDim.x, gw = blockIdx.x * NWAVES + wid, NGW = G_ * NWAVES, gt = blockIdx.x * NTHR + tid, NGT = G_ * NTHR; \
    (void)lane; (void)wid; (void)gw; (void)NGW; (void)gt; (void)NGT

__device__ __forceinline__ void transpose_item(const float* W, int ldw, int K, int nblk, bf16_t* WT, LAS float* scr, int item, int lane) {
    const int kb = item / nblk, nb = item % nblk, k0 = 64 * kb, n0 = 32 * nb;
#pragma unroll 8
    for (int i = 0; i < 32; ++i) { const int kk = 2 * i + (lane >> 5); scr[kk * 33 + (lane & 31)] = W[(size_t)(k0 + kk) * ldw + n0 + (lane & 31)]; }
    LDS_WAIT();
    const int c = lane & 7;
#pragma unroll
    for (int j = 0; j < 4; ++j) { const int n = (lane >> 3) + 8 * j; const LAS float* s = scr + (8 * c) * 33 + n;
        u32x4 o; o.x = cvt_pk_bf16(s[0 * 33], s[1 * 33]); o.y = cvt_pk_bf16(s[2 * 33], s[3 * 33]); o.z = cvt_pk_bf16(s[4 * 33], s[5 * 33]); o.w = cvt_pk_bf16(s[6 * 33], s[7 * 33]);
        *(u32x4*)(WT + (size_t)(n0 + n) * K + k0 + 8 * c) = o; }
    LDS_WAIT();
}

#define XB_TMO      128
#define XB_XCNT(j)  (256  + 64 * (j))
#define XB_XSUB(j)  (1280 + 64 * (j))
#define XB_XGEN(j)  (2304 + 64 * (j))
#define XB_TOP      3328
#define XB_TOPGEN   3392
#define XCD_BAR_WORDS 3456
#define XB_SPIN_CAP (1u << 18)

__device__ __forceinline__ unsigned xb_ld(unsigned* p)              { return __hip_atomic_load(p, __ATOMIC_RELAXED, __HIP_MEMORY_SCOPE_AGENT); }
__device__ __forceinline__ unsigned xb_add(unsigned* p, unsigned v) { return __hip_atomic_fetch_add(p, v, __ATOMIC_RELAXED, __HIP_MEMORY_SCOPE_AGENT); }
__device__ __forceinline__ unsigned xb_xcc_id() { return (unsigned)__builtin_amdgcn_s_getreg((3 << 11) | 20) & 0xFu; }
#define XB_SPIN(cond, bar) do { unsigned _sp = 0; while (cond) { __builtin_amdgcn_s_sleep(1); \
    if ((++_sp & 255u) == 0u) { if (xb_ld(&(bar)[XB_TMO])) break; if (_sp > XB_SPIN_CAP) { atomicAdd(&(bar)[XB_TMO], 1u); break; } } } } while (0)

struct XcdBarrier {
    unsigned* bar; unsigned x;
    volatile LAS unsigned* st;
};

__device__ __forceinline__ XcdBarrier xcd_barrier_post(unsigned* bar, volatile LAS unsigned* st) {
    XcdBarrier b; b.bar = bar; b.x = xb_xcc_id(); b.st = st;
    if (threadIdx.x == 0) (void)xb_add(&bar[XB_XCNT(b.x)], 1u);
    return b;
}
__device__ __forceinline__ void xcd_barrier_complete(unsigned* bar, unsigned x, unsigned& nloc, unsigned& nx) {
    const unsigned G = gridDim.x * gridDim.y * gridDim.z;
    unsigned sum, cnt, mine, sp = 0u;
    for (;;) {
        sum = 0u; cnt = 0u; mine = 0u;
#pragma unroll
        for (unsigned j = 0; j < 16; ++j) { const unsigned c = xb_ld(&bar[XB_XCNT(j)]); sum += c; cnt += (c > 0u) ? 1u : 0u; mine = (j == x) ? c : mine; }
        if (sum == G) break;
        __builtin_amdgcn_s_sleep(1);
        if ((++sp & 255u) == 0u) { if (xb_ld(&bar[XB_TMO])) break; if (sp > XB_SPIN_CAP) { atomicAdd(&bar[XB_TMO], 1u); break; } }
    }
    nloc = mine > 0u ? mine : 1u; nx = cnt > 0u ? cnt : 1u;
}

__device__ __forceinline__ void xcd_barrier(const XcdBarrier& b) {
    asm volatile("s_waitcnt vmcnt(0)" ::: "memory");
    __syncthreads();
    if (threadIdx.x == 0) {
        unsigned* bar = b.bar;
        __builtin_amdgcn_s_waitcnt(0);
        unsigned nloc = b.st[0], nx = b.st[1];
        if (nloc == 0u) { xcd_barrier_complete(bar, b.x, nloc, nx); b.st[0] = nloc; b.st[1] = nx; }
        const unsigned old = xb_add(&bar[XB_XSUB(b.x)], 1u);
        const unsigned gen = old / nloc;
        if (old + 1u == (gen + 1u) * nloc) {
            __builtin_amdgcn_fence(__ATOMIC_RELEASE, "agent");
            asm volatile("s_waitcnt vmcnt(0)" ::: "memory");
            const unsigned og = xb_add(&bar[XB_TOP], 1u);
            const unsigned tg = og / nx;
            if (og + 1u == (tg + 1u) * nx) xb_add(&bar[XB_TOPGEN], 1u);
            else XB_SPIN(xb_ld(&bar[XB_TOPGEN]) == tg, bar);
            __builtin_amdgcn_fence(__ATOMIC_ACQUIRE, "agent");
            xb_add(&bar[XB_XGEN(b.x)], 1u);
            asm volatile("s_waitcnt vmcnt(0)" ::: "memory");
        } else {
            XB_SPIN(xb_ld(&bar[XB_XGEN(b.x)]) == gen, bar);
            __builtin_amdgcn_fence(__ATOMIC_ACQUIRE, "agent");
            asm volatile("s_waitcnt vmcnt(0)" ::: "memory");
        }
    }
    __syncthreads();
}

struct Params {
    const float* in[23];
    const int* positions;
    float* out;
    unsigned char* ws;
};

__device__ __forceinline__ void prologue(const Params& p, LAS unsigned char* lds) {
    MK_IDS(); const int wave = wid;
    LAS float* scr = (LAS float*)(lds + wave * 16384);
    unsigned char* wsw = p.ws + WS_W;
    constexpr int I_GWIN = 16 * 128, I_SQ = 16 * 32, I_DWIN = 16 * 96, I_FUP = 16 * 176, I_FDN = 44 * 32;
    constexpr int NITEMS = 2 * I_GWIN + 2 * I_SQ + 2 * I_DWIN + 2 * I_SQ + 4 * I_FUP + 4 * I_FDN;
    for (int it = gw; it < NITEMS; it += NGW) {
        int r = it;
        if (r < 2 * I_GWIN) { const int j = r / I_GWIN; r %= I_GWIN; transpose_item(p.in[2] + (size_t)j * 1024 * GDN_N, GDN_N, 1024, 128, (bf16_t*)(wsw + W_GWIN) + (size_t)j * 4096 * 1024, scr, r, lane); continue; } r -= 2 * I_GWIN;
        if (r < 2 * I_SQ) { const int j = r / I_SQ; r %= I_SQ; transpose_item(p.in[7] + (size_t)j * 1024 * 1024, 1024, 1024, 32, (bf16_t*)(wsw + W_GWOUT) + (size_t)j * 1024 * 1024, scr, r, lane); continue; } r -= 2 * I_SQ;
        if (r < 2 * I_DWIN) { const int j = r / I_DWIN; r %= I_DWIN; transpose_item(p.in[8] + (size_t)j * 1024 * DIFF_N, DIFF_N, 1024, 96, (bf16_t*)(wsw + W_DWIN) + (size_t)j * 3072 * 1024, scr, r, lane); continue; } r -= 2 * I_DWIN;
        if (r < 2 * I_SQ) { const int j = r / I_SQ; r %= I_SQ; transpose_item(p.in[14] + (size_t)j * 1024 * 1024, 1024, 1024, 32, (bf16_t*)(wsw + W_DWOUT) + (size_t)j * 1024 * 1024, scr, r, lane); continue; } r -= 2 * I_SQ;
        if (r < 4 * I_FUP) { const int j = r / I_FUP; r %= I_FUP; transpose_item(p.in[15] + (size_t)j * 1024 * FFN_N, FFN_N, 1024, 176, (bf16_t*)(wsw + W_FUP) + (size_t)j * 5632 * 1024, scr, r, lane); continue; } r -= 4 * I_FUP;
        { const int j = r / I_FDN; r %= I_FDN; transpose_item(p.in[18] + (size_t)j * 2816 * 1024, 1024, 2816, 32, (bf16_t*)(wsw + W_FDOWN) + (size_t)j * 1024 * 2816, scr, r, lane); }
    }
    for (int e = gt; e < 2 * 16 * 1024; e += NGT) { const int j = e >> 14, n = (e >> 10) & 15, k = e & 1023;
        ((bf16_t*)(wsw + W_GWAB))[e] = f2bf(p.in[2][(size_t)j * 1024 * GDN_N + (size_t)k * GDN_N + GDN_NMAIN + n]); }
    const f32x4* x4 = (const f32x4*)p.in[0]; u32x4* xn = (u32x4*)(p.ws + WS_XN);
    for (int e = gt; e < M * D / 8; e += NGT) { const f32x4 a = x4[2 * e], b = x4[2 * e + 1]; u32x4 w; w.x = cvt_pk_bf16(a[0], a[1]); w.y = cvt_pk_bf16(a[2], a[3]); w.z = cvt_pk_bf16(b[0], b[1]); w.w = cvt_pk_bf16(b[2], b[3]); xn[e] = w; }
}

__device__ __forceinline__ void ln_phase(float* X, bf16_t* XN, const float* g, const float* b) {
    MK_IDS();
    f32x4 gv[4], bv[4];
#pragma unroll
    for (int j = 0; j < 4; ++j) { gv[j] = ((const f32x4*)g)[lane + 64 * j]; bv[j] = ((const f32x4*)b)[lane + 64 * j]; }
    for (int m = gw; m < M; m += NGW) {
        f32x4* xr = (f32x4*)(X + (size_t)m * D) + lane;
        f32x4 v[4]; float s = 0.f;
#pragma unroll
        for (int j = 0; j < 4; ++j) { v[j] = xr[64 * j]; s += (v[j][0] + v[j][1]) + (v[j][2] + v[j][3]); }
        const float mean = wave_sum(s) * (1.f / D); float s2 = 0.f;
#pragma unroll
        for (int j = 0; j < 4; ++j) { v[j] = v[j] - mean; s2 += (v[j][0] * v[j][0] + v[j][1] * v[j][1]) + (v[j][2] * v[j][2] + v[j][3] * v[j][3]); }
        const float rstd = 1.f / sqrtf(wave_sum(s2) * (1.f / D) + LN_EPS);
        u32x2* o8 = (u32x2*)(XN + (size_t)m * D) + lane;
#pragma unroll
        for (int j = 0; j < 4; ++j) { const f32x4 o = v[j] * rstd * gv[j] + bv[j]; xr[64 * j] = o; u32x2 w; w.x = cvt_pk_bf16(o[0], o[1]); w.y = cvt_pk_bf16(o[2], o[3]); o8[64 * j] = w; }
    }
}

__device__ __forceinline__ void ffn_act_phase(const bf16_t* Hh  , bf16_t* ACT  , const float* cw  , const float* cb  ) {
    MK_IDS();
    constexpr int RB = 16, NCG = FFN_H / 8;
    for (int item = gt; item < (MH / RB) * NCG; item += NGT) {
        const int mb = item / NCG, cgp = item % NCG, col = cgp * 8, r0 = mb * RB;
        float wa[3][8], wb[3][8], ba[8], bb[8];
#pragma unroll
        for (int j = 0; j < 3; ++j)
#pragma unroll
            for (int h = 0; h < 2; ++h) { const f32x4 a = *(const f32x4*)(cw + j * FFN_N + col + 4 * h), b = *(const f32x4*)(cw + j * FFN_N + FFN_H + col + 4 * h);
#pragma unroll
                for (int e = 0; e < 4; ++e) { wa[j][4 * h + e] = a[e]; wb[j][4 * h + e] = b[e]; } }
#pragma unroll
        for (int h = 0; h < 2; ++h) { const f32x4 a = *(const f32x4*)(cb + col + 4 * h), b = *(const f32x4*)(cb + FFN_H + col + 4 * h);
#pragma unroll
            for (int e = 0; e < 4; ++e) { ba[4 * h + e] = a[e]; bb[4 * h + e] = b[e]; } }
        float a2[8], a1[8], b2[8], b1[8];
        const bool first = (r0 % T) == 0;
        if (first) {
#pragma unroll
            for (int e = 0; e < 8; ++e) { a2[e] = 0.f; a1[e] = 0.f; b2[e] = 0.f; b1[e] = 0.f; }
        } else {
            unpack8(*(const u32x4*)(Hh + (size_t)(r0 - 2) * FFN_N + col), a2); unpack8(*(const u32x4*)(Hh + (size_t)(r0 - 1) * FFN_N + col), a1);
            unpack8(*(const u32x4*)(Hh + (size_t)(r0 - 2) * FFN_N + FFN_H + col), b2); unpack8(*(const u32x4*)(Hh + (size_t)(r0 - 1) * FFN_N + FFN_H + col), b1);
        }
#pragma unroll 4
        for (int rr = 0; rr < RB; ++rr) {
            float a0[8], b0[8], o[8];
            unpack8(*(const u32x4*)(Hh + (size_t)(r0 + rr) * FFN_N + col), a0); unpack8(*(const u32x4*)(Hh + (size_t)(r0 + rr) * FFN_N + FFN_H + col), b0);
#pragma unroll
            for (int e = 0; e < 8; ++e) {
                const float ya = wa[0][e] * a2[e] + wa[1][e] * a1[e] + wa[2][e] * a0[e] + ba[e];
                const float yb = wb[0][e] * b2[e] + wb[1][e] * b1[e] + wb[2][e] * b0[e] + bb[e];
                o[e] = silu(ya) * yb; a2[e] = a1[e]; a1[e] = a0[e]; b2[e] = b1[e]; b1[e] = b0[e];
            }
            *(u32x4*)(ACT + (size_t)(r0 + rr) * FFN_H + col) = pack8(o);
        }
    }
}

__device__ __forceinline__ void gdn_ab_phase(const bf16_t* XN, const bf16_t* wabT  , const float* a_log, const float* dt_bias, float* G, float* BETA) {
    MK_IDS();
    const int n = lane & 15, q4 = lane >> 4, h = n & 7;
    const float al = -__expf(a_log[h]), db = dt_bias[h];
    for (int it = gw; it < M / 16; it += NGW) {
        const int m0 = it * 16;
        f32x4 acc = {0.f, 0.f, 0.f, 0.f};
        const bf16_t* ap = XN + (size_t)(m0 + n) * D + 8 * q4;
        const bf16_t* bp = wabT + (size_t)n * D + 8 * q4;
#pragma unroll 8
        for (int ks = 0; ks < 32; ++ks) { const bf16x8 a = *(const bf16x8*)(ap + 32 * ks), b = *(const bf16x8*)(bp + 32 * ks); acc = __builtin_amdgcn_mfma_f32_16x16x32_bf16(a, b, acc, 0, 0, 0); }
#pragma unroll
        for (int i = 0; i < 4; ++i) { const int m = m0 + 4 * q4 + i; const float v = acc[i];
            if (n < 8) { const float x = v + db; const float sp = x > 20.f ? x : log1pf(__expf(x)); G[(size_t)m * 8 + h] = al * sp; }
            else BETA[(size_t)m * 8 + h] = 1.f / (1.f + __expf(-v)); }
    }
}

__device__ __forceinline__ void conv_silu16(const bf16_t* hp, int t, const float* cw, float (&y)[16]) {
#pragma unroll
    for (int c = 0; c < 16; ++c) y[c] = 0.f;
#pragma unroll
    for (int j = 0; j < 4; ++j) {
        if (t - 3 + j >= 0) {
            float x[16];
            const bf16_t* rp = hp + (ptrdiff_t)(j - 3) * GDN_NMAIN;
            { float t8[8]; unpack8(*(const u32x4*)rp, t8);
#pragma unroll
              for (int c = 0; c < 8; ++c) x[c] = t8[c];
              unpack8(*(const u32x4*)(rp + 8), t8);
#pragma unroll
              for (int c = 0; c < 8; ++c) x[8 + c] = t8[c]; }
#pragma unroll
            for (int q = 0; q < 4; ++q) { const f32x4 w = *(const f32x4*)(cw + j * 3072 + 4 * q);
#pragma unroll
                for (int e = 0; e < 4; ++e) y[4 * q + e] += w[e] * x[4 * q + e]; }
        }
    }
#pragma unroll
    for (int c = 0; c < 16; ++c) y[c] = silu(y[c]);
}
__device__ __forceinline__ float sumsq16_8lanes(const float (&y)[16]) {
    float s = 0.f;
#pragma unroll
    for (int c = 0; c < 16; ++c) s += y[c] * y[c];
    s += __shfl_xor(s, 1); s += __shfl_xor(s, 2); s += __shfl_xor(s, 4);
    return s;
}
__device__ __forceinline__ void lds_store16(LAS unsigned char* p, const float (&y)[16]) {
    u32x4 a, b; a.x = cvt_pk_bf16(y[0], y[1]); a.y = cvt_pk_bf16(y[2], y[3]); a.z = cvt_pk_bf16(y[4], y[5]); a.w = cvt_pk_bf16(y[6], y[7]);
    b.x = cvt_pk_bf16(y[8], y[9]); b.y = cvt_pk_bf16(y[10], y[11]); b.z = cvt_pk_bf16(y[12], y[13]); b.w = cvt_pk_bf16(y[14], y[15]);
    *(LAS u32x4*)p = a; *(LAS u32x4*)(p + 16) = b;
}
__device__ __forceinline__ bf16x8 lds_frag16(const LAS unsigned char* p) { return *(const LAS bf16x8*)p; }
__device__ __forceinline__ bf16x8 lds_frag8x2(const LAS unsigned char* p0, const LAS unsigned char* p1) {
    const s16x4 a = *(const LAS s16x4*)p0, b = *(const LAS s16x4*)p1; return (bf16x8){a[0], a[1], a[2], a[3], b[0], b[1], b[2], b[3]};
}

constexpr int GA_GC = 0, GA_BT = 256, GA_Q = 512, GA_K = GA_Q + 64 * 272, GA_VB = GA_K + 64 * 272, GA_KBE = GA_VB + 128 * 144, GA_L = GA_KBE + 128 * 144, GA_T = GA_L + 64 * 64 * 4, GA_END = GA_T + 64 * 144;
static_assert(GA_END <= 131072 && GA_L % 16 == 0 && GA_T % 16 == 0, "GDN phase A LDS map");
constexpr int GB_GC = 0, GB_Q = 512, GB_W = GB_Q + 64 * 272, GB_KD = GB_W + 64 * 272, GB_UT = GB_KD + 128 * 144, GB_AT = GB_UT + 128 * 144, GB_O = GB_AT + 64 * 144, GB_END = GB_O + 64 * 528;
static_assert(GB_END <= 131072 && GB_O % 16 == 0, "GDN phase B LDS map");


template <int I, int J> __device__ __forceinline__ void inv_row(float& s0, float& s1, const float lr, const float (&t)[64]) {
    if constexpr (J + 8 <= I) {
        int a0, a1, a2, a3, a4, a5, a6, a7;
        asm volatile("v_readlane_b32 %2, %10, %19\n\tv_readlane_b32 %3, %10, %19+1\n\tv_readlane_b32 %4, %10, %19+2\n\tv_readlane_b32 %5, %10, %19+3\n\t"
                     "v_readlane_b32 %6, %10, %19+4\n\tv_readlane_b32 %7, %10, %19+5\n\tv_readlane_b32 %8, %10, %19+6\n\tv_readlane_b32 %9, %10, %19+7\n\t"
                     "v_fma_f32 %0, -%11, %2, %0\n\tv_fma_f32 %1, -%12, %3, %1\n\tv_fma_f32 %0, -%13, %4, %0\n\tv_fma_f32 %1, -%14, %5, %1\n\t"
                     "v_fma_f32 %0, -%15, %6, %0\n\tv_fma_f32 %1, -%16, %7, %1\n\tv_fma_f32 %0, -%17, %8, %0\n\tv_fma_f32 %1, -%18, %9, %1"
                     : "+v"(s0), "+v"(s1), "=&s"(a0), "=&s"(a1), "=&s"(a2), "=&s"(a3), "=&s"(a4), "=&s"(a5), "=&s"(a6), "=&s"(a7)
                     : "v"(lr), "v"(t[J]), "v"(t[J + 1]), "v"(t[J + 2]), "v"(t[J + 3]), "v"(t[J + 4]), "v"(t[J + 5]), "v"(t[J + 6]), "v"(t[J + 7]), "i"(J));
        inv_row<I, J + 8>(s0, s1, lr, t);
    } else {
#pragma unroll
        for (int j = J; j < I; ++j) { const float lj = __int_as_float(__builtin_amdgcn_readlane(__float_as_int(lr), j)); if (j & 1) s1 -= lj * t[j]; else s0 -= lj * t[j]; }
    }
}
template <int I0> __device__ __forceinline__ void inv_rows8(const LAS float* Lp, const float flane, float (&t)[64]) {
    float lr[8];
#pragma unroll
    for (int k = 0; k < 8; ++k) lr[k] = Lp[(I0 + k) * 64];
#define INV_ROW(k) { float s0 = 1.f - fminf(fabsf(flane - (float)(I0 + k)), 1.f), s1 = 0.f; inv_row<I0 + k, 0>(s0, s1, lr[k], t); t[I0 + k] = s0 + s1; }
    INV_ROW(0) INV_ROW(1) INV_ROW(2) INV_ROW(3) INV_ROW(4) INV_ROW(5) INV_ROW(6) INV_ROW(7)
#undef INV_ROW
}

__device__ __forceinline__ void gdn_phase_a(const bf16_t* H, const float* G, const float* BETA, const float* convw  , bf16_t* UT, bf16_t* WN, bf16_t* ATT, LAS unsigned char* lds) {
    MK_IDS();
    LAS float* gcs = (LAS float*)(lds + GA_GC); LAS float* bts = (LAS float*)(lds + GA_BT); LAS float* Ls = (LAS float*)(lds + GA_L);
    for (int it = blockIdx.x; it < 256 * 32; it += gridDim.x) {
        const int bh = it & 255, n = it >> 8, b = bh >> 3, h = bh & 7, m0 = b * T + n * 64;
        if (wid == 0) { const float g = G[(size_t)(m0 + lane) * 8 + h]; float c = g;
#pragma unroll
            for (int o = 1; o < 64; o <<= 1) { const float t = __shfl_up(c, o); if (lane >= o) c += t; }
            gcs[lane] = c; bts[lane] = BETA[(size_t)(m0 + lane) * 8 + h]; }
        __syncthreads();
        {
            const int r = tid >> 3, c0 = (tid & 7) * 16, t = n * 64 + r; const bf16_t* hp = H + (size_t)(m0 + r) * GDN_NMAIN + h * 128 + c0;
            const float gcr = gcs[r], btr = bts[r], egc = __expf(gcr);
            float y[16];
            conv_silu16(hp, t, convw + h * 128 + c0, y);
            { const float rinv = rsqrtf(sumsq16_8lanes(y) + RMS_EPS) * 0.08838834764831845f;
#pragma unroll
              for (int c = 0; c < 16; ++c) y[c] *= rinv; lds_store16(lds + GA_Q + r * 272 + c0 * 2, y); }
            conv_silu16(hp + 1024, t, convw + 1024 + h * 128 + c0, y);
            { const float rinv = rsqrtf(sumsq16_8lanes(y) + RMS_EPS);
#pragma unroll
              for (int c = 0; c < 16; ++c) y[c] *= rinv; lds_store16(lds + GA_K + r * 272 + c0 * 2, y);
              const float sc = btr * egc;
#pragma unroll
              for (int c = 0; c < 16; ++c) *(LAS bf16_t*)(lds + GA_KBE + (c0 + c) * 144 + r * 2) = f2bf(y[c] * sc); }
            conv_silu16(hp + 2048, t, convw + 2048 + h * 128 + c0, y);
#pragma unroll
            for (int c = 0; c < 16; ++c) *(LAS bf16_t*)(lds + GA_VB + (c0 + c) * 144 + r * 2) = f2bf(y[c] * btr);
        }
        __syncthreads();
        {
            const int which = wid >> 2, bi = (wid >> 1) & 1, bj = wid & 1, l31 = lane & 31, hi = lane >> 5;
            f32x16 acc = {};
            if (!(bi == 0 && bj == 1)) {
                const LAS unsigned char* ap = lds + (which ? GA_Q : GA_K) + (32 * bi + l31) * 272 + hi * 16;
                const LAS unsigned char* bp = lds + GA_K + (32 * bj + l31) * 272 + hi * 16;
#pragma unroll
                for (int ks = 0; ks < 8; ++ks) acc = __builtin_amdgcn_mfma_f32_32x32x16_bf16(lds_frag16(ap + ks * 32), lds_frag16(bp + ks * 32), acc, 0, 0, 0);
            }
            const int j = 32 * bj + l31; const float gcj = gcs[j];
#pragma unroll
            for (int r = 0; r < 16; ++r) { const int i = 32 * bi + crow(r, hi); const float dec = __expf(fminf(gcs[i] - gcj, 0.f));
                if (which == 0) Ls[i * 64 + j] = (i > j) ? bts[i] * acc[r] * dec : 0.f;
                else ATT[((size_t)it * 64 + i) * 64 + j] = f2bf((i >= j) ? acc[r] * dec : 0.f); }
        }
        __syncthreads();
        if (wid == 0) {
            float t[64]; const float flane = (float)lane;
            const LAS float* Lp = Ls + lane; asm volatile("" : "+v"(Lp));
            LAS unsigned char* Tp = lds + GA_T + lane * 2; asm volatile("" : "+v"(Tp));
            inv_rows8<0>(Lp, flane, t); inv_rows8<8>(Lp, flane, t); inv_rows8<16>(Lp, flane, t); inv_rows8<24>(Lp, flane, t);
            inv_rows8<32>(Lp, flane, t); inv_rows8<40>(Lp, flane, t); inv_rows8<48>(Lp, flane, t); inv_rows8<56>(Lp, flane, t);
#pragma unroll
            for (int i = 0; i < 64; ++i) *(LAS bf16_t*)(Tp + i * 144) = f2bf(t[i]);
        }
        __syncthreads();
        {
            const int bi = wid >> 2, fb = wid & 3, l31 = lane & 31, hi = lane >> 5, nks = bi ? 4 : 2;
            f32x16 au = {}, aw = {};
            const LAS unsigned char* tp = lds + GA_T + (32 * bi + l31) * 144 + hi * 16;
            const LAS unsigned char* vp = lds + GA_VB + (32 * fb + l31) * 144 + hi * 16;
            const LAS unsigned char* kp = lds + GA_KBE + (32 * fb + l31) * 144 + hi * 16;
            for (int ks = 0; ks < nks; ++ks) { const bf16x8 tf = lds_frag16(tp + ks * 32);
                au = __builtin_amdgcn_mfma_f32_32x32x16_bf16(tf, lds_frag16(vp + ks * 32), au, 0, 0, 0);
                aw = __builtin_amdgcn_mfma_f32_32x32x16_bf16(lds_frag16(kp + ks * 32), tf, aw, 0, 0, 0); }
            bf16_t* up = UT + ((size_t)it * 128 + 32 * fb + l31) * 64 + 32 * bi + 4 * hi;
            bf16_t* wp = WN + ((size_t)it * 64 + 32 * bi + l31) * 128 + 32 * fb + 4 * hi;
#pragma unroll
            for (int g = 0; g < 4; ++g) { u32x2 a, w; a.x = cvt_pk_bf16(au[4 * g], au[4 * g + 1]); a.y = cvt_pk_bf16(au[4 * g + 2], au[4 * g + 3]);
                w.x = cvt_pk_bf16(-aw[4 * g], -aw[4 * g + 1]); w.y = cvt_pk_bf16(-aw[4 * g + 2], -aw[4 * g + 3]);
                *(u32x2*)(up + 8 * g) = a; *(u32x2*)(wp + 8 * g) = w; }
        }
        __syncthreads();
    }
}

__device__ __forceinline__ void gdn_phase_b(bf16_t* H, const float* G, const float* convw, const float* normw  , const bf16_t* UT, const bf16_t* WN, const bf16_t* ATT, LAS unsigned char* lds) {
    MK_IDS();
    LAS float* gcs = (LAS float*)(lds + GB_GC);
    const int n16 = lane & 15, q4 = lane >> 4;
    for (int bh = blockIdx.x; bh < 256; bh += gridDim.x) {
        const int b = bh >> 3, h = bh & 7;
        f32x4 S[8];
#pragma unroll
        for (int s = 0; s < 8; ++s) S[s] = (f32x4){0.f, 0.f, 0.f, 0.f};
        for (int n = 0; n < 32; ++n) {
            const int it = n * 256 + bh, m0 = b * T + n * 64;
            if (wid == 0) { float c = G[(size_t)(m0 + lane) * 8 + h];
#pragma unroll
                for (int o = 1; o < 64; o <<= 1) { const float t = __shfl_up(c, o); if (lane >= o) c += t; }
                gcs[lane] = c; }
            __syncthreads();
            const float glast = gcs[63];
            {
                const int r = tid >> 3, c0 = (tid & 7) * 16, t = n * 64 + r; const bf16_t* hp = H + (size_t)(m0 + r) * GDN_NMAIN + h * 128 + c0;
                const float gcr = gcs[r];
                float y[16];
                conv_silu16(hp, t, convw + h * 128 + c0, y);
                { const float sc = rsqrtf(sumsq16_8lanes(y) + RMS_EPS) * 0.08838834764831845f * __expf(gcr);
#pragma unroll
                  for (int c = 0; c < 16; ++c) y[c] *= sc; lds_store16(lds + GB_Q + r * 272 + c0 * 2, y); }
                conv_silu16(hp + 1024, t, convw + 1024 + h * 128 + c0, y);
                { const float sc = rsqrtf(sumsq16_8lanes(y) + RMS_EPS) * __expf(glast - gcr);
#pragma unroll
                  for (int c = 0; c < 16; ++c) *(LAS bf16_t*)(lds + GB_KD + (c0 + c) * 144 + r * 2) = f2bf(y[c] * sc); }
                const u32x4* wsrc = (const u32x4*)(WN + (size_t)it * 8192); const u32x4* usrc = (const u32x4*)(UT + (size_t)it * 8192); const u32x4* asrc = (const u32x4*)(ATT + (size_t)it * 4096);
#pragma unroll
                for (int i = 0; i < 2; ++i) { const int ci = tid + 512 * i;
                    *(LAS u32x4*)(lds + GB_W + (ci >> 4) * 272 + (ci & 15) * 16) = wsrc[ci];
                    *(LAS u32x4*)(lds + GB_UT + (ci >> 3) * 144 + (ci & 7) * 16) = usrc[ci]; }
                *(LAS u32x4*)(lds + GB_AT + (tid >> 3) * 144 + (tid & 7) * 16) = asrc[tid];
            }
            __syncthreads();
            {
                bf16x8 Sf[4];
#pragma unroll
                for (int ks = 0; ks < 4; ++ks) { u32x4 w; w.x = cvt_pk_bf16(S[2 * ks][0], S[2 * ks][1]); w.y = cvt_pk_bf16(S[2 * ks][2], S[2 * ks][3]);
                    w.z = cvt_pk_bf16(S[2 * ks + 1][0], S[2 * ks + 1][1]); w.w = cvt_pk_bf16(S[2 * ks + 1][2], S[2 * ks + 1][3]); Sf[ks] = __builtin_bit_cast(bf16x8, w); }
                f32x4 vn[4];
#pragma unroll
                for (int mt = 0; mt < 4; ++mt) {
                    const s16x4 u4 = *(const LAS s16x4*)(lds + GB_UT + (16 * wid + n16) * 144 + (16 * mt + 4 * q4) * 2);
                    vn[mt] = (f32x4){bf2f((unsigned short)u4[0]), bf2f((unsigned short)u4[1]), bf2f((unsigned short)u4[2]), bf2f((unsigned short)u4[3])};
                    const LAS unsigned char* ap = lds + GB_W + (16 * mt + n16) * 272 + 8 * q4;
#pragma unroll
                    for (int ks = 0; ks < 4; ++ks) vn[mt] = __builtin_amdgcn_mfma_f32_16x16x32_bf16(lds_frag8x2(ap + ks * 64, ap + ks * 64 + 32), Sf[ks], vn[mt], 0, 0, 0);
                }
                bf16x8 Vf[2];
#pragma unroll
                for (int kt = 0; kt < 2; ++kt) { u32x4 w; w.x = cvt_pk_bf16(vn[2 * kt][0], vn[2 * kt][1]); w.y = cvt_pk_bf16(vn[2 * kt][2], vn[2 * kt][3]);
                    w.z = cvt_pk_bf16(vn[2 * kt + 1][0], vn[2 * kt + 1][1]); w.w = cvt_pk_bf16(vn[2 * kt + 1][2], vn[2 * kt + 1][3]); Vf[kt] = __builtin_bit_cast(bf16x8, w); }
#pragma unroll
                for (int mt = 0; mt < 4; ++mt) {
                    f32x4 o = {0.f, 0.f, 0.f, 0.f};
                    const LAS unsigned char* qp = lds + GB_Q + (16 * mt + n16) * 272 + 8 * q4;
#pragma unroll
                    for (int ks = 0; ks < 4; ++ks) o = __builtin_amdgcn_mfma_f32_16x16x32_bf16(lds_frag8x2(qp + ks * 64, qp + ks * 64 + 32), Sf[ks], o, 0, 0, 0);
                    const LAS unsigned char* atp = lds + GB_AT + (16 * mt + n16) * 144 + 8 * q4;
#pragma unroll
                    for (int kt = 0; kt < 2; ++kt) if (kt == 0 || mt >= 2) o = __builtin_amdgcn_mfma_f32_16x16x32_bf16(lds_frag8x2(atp + kt * 64, atp + kt * 64 + 32), Vf[kt], o, 0, 0, 0);
#pragma unroll
                    for (int i = 0; i < 4; ++i) *(LAS float*)(lds + GB_O + (16 * mt + 4 * q4 + i) * 528 + (16 * wid + n16) * 4) = o[i];
                }
                const float eg = __expf(glast);
#pragma unroll
                for (int st = 0; st < 8; ++st) { S[st] = S[st] * eg;
                    const LAS unsigned char* kp = lds + GB_KD + (16 * st + n16) * 144 + 8 * q4;
#pragma unroll
                    for (int kt = 0; kt < 2; ++kt) S[st] = __builtin_amdgcn_mfma_f32_16x16x32_bf16(lds_frag8x2(kp + kt * 64, kp + kt * 64 + 32), Vf[kt], S[st], 0, 0, 0); }
            }
            __syncthreads();
            {
                const int r = tid >> 3, c0 = (tid & 7) * 16;
                float o[16];
#pragma unroll
                for (int q = 0; q < 4; ++q) { const f32x4 v = *(const LAS f32x4*)(lds + GB_O + r * 528 + (c0 + 4 * q) * 4); o[4 * q] = v[0]; o[4 * q + 1] = v[1]; o[4 * q + 2] = v[2]; o[4 * q + 3] = v[3]; }
                const float rstd = rsqrtf(sumsq16_8lanes(o) * (1.f / 128.f) + RMS_EPS);
                bf16_t* hp = H + (size_t)(m0 + r) * GDN_NMAIN + h * 128 + c0;
                float gt[16];
                { float t8[8]; unpack8(*(const u32x4*)(hp + 3072), t8);
#pragma unroll
                  for (int c = 0; c < 8; ++c) gt[c] = t8[c];
                  unpack8(*(const u32x4*)(hp + 3072 + 8), t8);
#pragma unroll
                  for (int c = 0; c < 8; ++c) gt[8 + c] = t8[c]; }
                float res[16];
#pragma unroll
                for (int c = 0; c < 16; ++c) res[c] = o[c] * rstd * normw[c0 + c] * silu(gt[c]);
                u32x4 a, bq; a.x = cvt_pk_bf16(res[0], res[1]); a.y = cvt_pk_bf16(res[2], res[3]); a.z = cvt_pk_bf16(res[4], res[5]); a.w = cvt_pk_bf16(res[6], res[7]);
                bq.x = cvt_pk_bf16(res[8], res[9]); bq.y = cvt_pk_bf16(res[10], res[11]); bq.z = cvt_pk_bf16(res[12], res[13]); bq.w = cvt_pk_bf16(res[14], res[15]);
                *(u32x4*)(hp + 2048) = a; *(u32x4*)(hp + 2048 + 8) = bq;
            }
        }
        __syncthreads();
    }
}

__device__ __forceinline__ void diff_prep_phase(bf16_t* H  , const int* positions, bf16_t* VT  , LAS unsigned char* lds) {
    MK_IDS();
    for (int item = gt; item < M * 4; item += NGT) {
        const int m = item >> 2, g4 = item & 3; const float pos = (float)positions[m];
        float cs[8], sn[8];
#pragma unroll
        for (int e = 0; e < 8; ++e) { const float inv = exp2f(-(float)(8 * g4 + e) * (13.287712379549449f / 32.f)); sincosf(pos * inv, &sn[e], &cs[e]); }
        bf16_t* rowp = H + (size_t)m * DIFF_N + 8 * g4;
#pragma unroll 4
        for (int blk = 0; blk < 32; ++blk) {
            bf16_t* p1 = rowp + (blk >> 4) * 1024 + (blk & 15) * 64; const float sc = (blk < 16) ? 0.125f * LOG2E : 1.f;
            float x1[8], x2[8], y1[8], y2[8]; unpack8(*(const u32x4*)p1, x1); unpack8(*(const u32x4*)(p1 + 32), x2);
#pragma unroll
            for (int e = 0; e < 8; ++e) { y1[e] = (x1[e] * cs[e] - x2[e] * sn[e]) * sc; y2[e] = (x2[e] * cs[e] + x1[e] * sn[e]) * sc; }
            *(u32x4*)p1 = pack8(y1); *(u32x4*)(p1 + 32) = pack8(y2);
        }
    }
    LAS unsigned char* scr = lds + wid * 16384;
    for (int item = gw; item < NB * 32 * 16; item += NGW) {
        const int dvh = item & 1, h = (item >> 1) & 7, tb = (item >> 4) & 31, b = item >> 9;
        const bf16_t* src = H + ((size_t)b * T + tb * 64) * DIFF_N + 2048 + h * 128 + dvh * 64;
#pragma unroll
        for (int i = 0; i < 8; ++i) { const int row = (lane >> 3) + 8 * i, ch = lane & 7; *(LAS u32x4*)(scr + row * 144 + ch * 16) = *(const u32x4*)(src + (size_t)row * DIFF_N + ch * 8); }
        LDS_WAIT();
        bf16_t* dst = VT + (((size_t)b * 8 + h) * 128 + dvh * 64 + lane) * T + tb * 64;
#pragma unroll
        for (int k = 0; k < 8; ++k) { unsigned short v[8];
#pragma unroll
            for (int e = 0; e < 8; ++e) v[e] = *(const LAS bf16_t*)(scr + (8 * k + e) * 144 + lane * 2);
            u32x4 w; w.x = v[0] | ((unsigned)v[1] << 16); w.y = v[2] | ((unsigned)v[3] << 16); w.z = v[4] | ((unsigned)v[5] << 16); w.w = v[6] | ((unsigned)v[7] << 16);
            *(u32x4*)(dst + 8 * k) = w; }
        LDS_WAIT();
    }
}

constexpr int AT_STAGE = 36864, AT_K = 0, AT_V = 64 * 272;
__device__ __forceinline__ void diff_attn_phase(const bf16_t* H, const bf16_t* VT, bf16_t* O, const float* lq1, const float* lk1, const float* lq2, const float* lk2, const float* subw, float lambda_init,
                                                LAS unsigned char* lds) {
    MK_IDS();
    const float lam = __expf(wave_sum(lq1[lane] * lk1[lane])) - __expf(wave_sum(lq2[lane] * lk2[lane])) + lambda_init;
    const int c = wid >> 2, rg = wid & 3, l31 = lane & 31, hi = lane >> 5;
    for (int bh = blockIdx.x; bh < 256; bh += gridDim.x) {
        const int b = bh >> 3, h = bh & 7;
        const bf16_t* Kg = H + (size_t)b * T * DIFF_N + 1024 + h * 128;
        const bf16_t* Vg = VT + (size_t)bh * 128 * T;
        for (int ui = 0; ui < 16; ++ui) {
            const int qb = (ui & 1) ? (15 - (ui >> 1)) : (ui >> 1);
            const int q0w = 128 * qb + 32 * rg, nt = 2 * qb + 2;
            bf16x8 qf[4];
            { const bf16_t* qp = H + ((size_t)b * T + q0w + l31) * DIFF_N + h * 128 + c * 64 + 8 * hi;
#pragma unroll
              for (int d0 = 0; d0 < 4; ++d0) qf[d0] = *(const bf16x8*)(qp + 16 * d0); }
            f32x16 o[4];
#pragma unroll
            for (int d = 0; d < 4; ++d) o[d] = (f32x16){};
            float mrun = -1e30f, lrun = 0.f;
            u32x4 pk[2], pv[2];
#define AT_LOAD(j) do { _Pragma("unroll") for (int i_ = 0; i_ < 2; ++i_) { const int ci = tid + 512 * i_; \
                pk[i_] = *(const u32x4*)(Kg + (size_t)((j) * 64 + (ci >> 4)) * DIFF_N + (ci & 15) * 8); \
                pv[i_] = *(const u32x4*)(Vg + (size_t)(ci >> 3) * T + (j) * 64 + (ci & 7) * 8); } } while (0)
            AT_LOAD(0);
            for (int j = 0; j < nt; ++j) {
                LAS unsigned char* st = lds + (j & 1) * AT_STAGE;
#pragma unroll
                for (int i_ = 0; i_ < 2; ++i_) { const int ci = tid + 512 * i_;
                    *(LAS u32x4*)(st + AT_K + (ci >> 4) * 272 + (ci & 15) * 16) = pk[i_];
                    *(LAS u32x4*)(st + AT_V + (ci >> 3) * 144 + (ci & 7) * 16) = pv[i_]; }
                __syncthreads();
                if (j + 1 < nt) AT_LOAD(j + 1);
                if (64 * j <= q0w + 31) {
                    f32x16 p[2];
#pragma unroll
                    for (int kb = 0; kb < 2; ++kb) { p[kb] = (f32x16){};
                        const LAS unsigned char* kp = st + AT_K + (32 * kb + l31) * 272 + c * 128 + hi * 16;
#pragma unroll
                        for (int d0 = 0; d0 < 4; ++d0) p[kb] = __builtin_amdgcn_mfma_f32_32x32x16_bf16(lds_frag16(kp + d0 * 32), qf[d0], p[kb], 0, 0, 0); }
                    if (64 * j + 63 > q0w) {
                        const int q = q0w + l31;
#pragma unroll
                        for (int kb = 0; kb < 2; ++kb)
#pragma unroll
                            for (int r = 0; r < 16; ++r) { const int kv = 64 * j + 32 * kb + crow(r, hi); if (kv > q) p[kb][r] = -1e30f; }
                    }
                    float mx = p[0][0];
#pragma unroll
                    for (int kb = 0; kb < 2; ++kb)
#pragma unroll
                        for (int r = 0; r < 16; ++r) mx = fmaxf(mx, p[kb][r]);
                    mx = fmaxf(mx, __shfl_xor(mx, 32));
                    const float mnew = fmaxf(mrun, mx), al = exp2f(mrun - mnew); mrun = mnew;
                    float ls = 0.f;
#pragma unroll
                    for (int kb = 0; kb < 2; ++kb)
#pragma unroll
                        for (int r = 0; r < 16; ++r) { p[kb][r] = exp2f(p[kb][r] - mnew); ls += p[kb][r]; }
                    lrun = lrun * al + ls;
#pragma unroll
                    for (int d = 0; d < 4; ++d) o[d] = o[d] * al;
#pragma unroll
                    for (int kb = 0; kb < 2; ++kb)
#pragma unroll
                        for (int s = 0; s < 2; ++s) {
                            u32x4 w; w.x = cvt_pk_bf16(p[kb][8 * s], p[kb][8 * s + 1]); w.y = cvt_pk_bf16(p[kb][8 * s + 2], p[kb][8 * s + 3]);
                            w.z = cvt_pk_bf16(p[kb][8 * s + 4], p[kb][8 * s + 5]); w.w = cvt_pk_bf16(p[kb][8 * s + 6], p[kb][8 * s + 7]);
                            const bf16x8 pf = __builtin_bit_cast(bf16x8, w);
                            const LAS unsigned char* vp = st + AT_V + l31 * 144 + (32 * kb + 16 * s + 4 * hi) * 2;
#pragma unroll
                            for (int d = 0; d < 4; ++d) o[d] = __builtin_amdgcn_mfma_f32_32x32x16_bf16(lds_frag8x2(vp + d * 32 * 144, vp + d * 32 * 144 + 16), pf, o[d], 0, 0, 0);
                        }
                }
            }
#undef AT_LOAD
            const float ltot = lrun + __shfl_xor(lrun, 32);
            const float inv = (c ? lam : 1.f) / ltot;
            __syncthreads();
            LAS float* xch = (LAS float*)lds + rg * 4096;
            if (c == 1) {
#pragma unroll
                for (int d = 0; d < 4; ++d)
#pragma unroll
                    for (int r = 0; r < 16; ++r) xch[(d * 16 + r) * 64 + lane] = o[d][r] * inv;
            }
            __syncthreads();
            if (c == 0) {
                float ss = 0.f;
#pragma unroll
                for (int d = 0; d < 4; ++d)
#pragma unroll
                    for (int r = 0; r < 16; ++r) { const float v = o[d][r] * inv - xch[(d * 16 + r) * 64 + lane]; o[d][r] = v; ss += v * v; }
                ss += __shfl_xor(ss, 32);
                const float rstd = rsqrtf(ss * (1.f / 128.f) + RMS_EPS) * (1.f - lambda_init);
                bf16_t* op = O + ((size_t)b * T + q0w + l31) * D + h * 128 + 4 * hi;
#pragma unroll
                for (int d = 0; d < 4; ++d)
#pragma unroll
                    for (int g = 0; g < 4; ++g) { const int dv = 32 * d + 8 * g + 4 * hi; const f32x4 sw = *(const f32x4*)(subw + dv);
                        u32x2 w; w.x = cvt_pk_bf16(o[d][4 * g] * rstd * sw[0], o[d][4 * g + 1] * rstd * sw[1]); w.y = cvt_pk_bf16(o[d][4 * g + 2] * rstd * sw[2], o[d][4 * g + 3] * rstd * sw[3]);
                        *(u32x2*)(op + 32 * d + 8 * g) = w; }
            }
            __syncthreads();
        }
    }
}

__global__ void __launch_bounds__(NTHR, 2) fwd_megakernel(Params p) {
    extern __shared__ __attribute__((aligned(16))) unsigned char lds_raw[];
    LAS unsigned char* lds = (LAS unsigned char*)lds_raw;
    cg::grid_group grid = cg::this_grid();
    volatile LAS unsigned* bst = (volatile LAS unsigned*)(lds + 131072 + 1024);
    if (threadIdx.x < 2) bst[threadIdx.x] = 0u;
    __syncthreads();
    const XcdBarrier xbar = xcd_barrier_post((unsigned*)p.ws, bst);
    const int G = gridDim.x;
    unsigned char* ws = p.ws; unsigned char* wsw = ws + WS_W;
    bf16_t* XN = (bf16_t*)(ws + WS_XN); bf16_t* Hb = (bf16_t*)(ws + WS_H);
    float* Gb = (float*)(ws + WS_GB); float* BETAb = Gb + (size_t)M * 8;

#ifndef NO_PRO
    REPS(4) prologue(p, lds);
#endif
    grid.sync();
    for (int layer = 0; layer < DEPTH; ++layer) {
        const int j = layer >> 1;
        const float* resid = (layer == 0) ? p.in[0] : p.out;
        if ((layer & 1) == 0) {
            {   pg8::Gemm g{XN, (const bf16_t*)(wsw + W_GWIN) + (size_t)j * 4096 * 1024, M, GDN_NMAIN, D, D}; pg8::StaticOrder S; S.init(M, GDN_NMAIN, G, (int)blockIdx.x);
                pg8::EpiBf16 E{Hb, GDN_NMAIN};
                REPS(1) PH_GEMMB pg8::gemm_phase<pg8::EpiBf16, pg8::StaticOrder, true, true, D, D>(lds, g, S, E); }
#ifndef NO_AB
            REPS(4) gdn_ab_phase(XN, (const bf16_t*)(wsw + W_GWAB) + (size_t)j * 16 * 1024, p.in[4] + j * 8, p.in[5] + j * 8, Gb, BETAb);
#endif
            xcd_barrier(xbar);
#ifndef NO_GA
            REPS(2) gdn_phase_a(Hb, Gb, BETAb, p.in[3] + (size_t)j * 4 * 3072, (bf16_t*)(ws + WS_UT), (bf16_t*)(ws + WS_WN), (bf16_t*)(ws + WS_XN), lds);
#endif
            xcd_barrier(xbar);
#ifndef NO_GB
            REPS(6) gdn_phase_b(Hb, Gb, p.in[3] + (size_t)j * 4 * 3072, p.in[6] + j * 128, (const bf16_t*)(ws + WS_UT), (const bf16_t*)(ws + WS_WN), (const bf16_t*)(ws + WS_XN), lds);
#endif
            xcd_barrier(xbar);
            {   pg8::Gemm g{Hb + 2048, (const bf16_t*)(wsw + W_GWOUT) + (size_t)j * 1024 * 1024, M, D, D, GDN_NMAIN}; pg8::StaticOrder S; S.init(M, D, G, (int)blockIdx.x);
                pg8::EpiResid E{resid, p.out, D, ALPHA};
                PH_GEMMR pg8::gemm_phase<pg8::EpiResid, pg8::StaticOrder, true, true, D, GDN_NMAIN>(lds, g, S, E); }
        } else {
            const float lambda_init = 0.8f - 0.6f * expf(-0.3f * (float)layer);
            {   pg8::Gemm g{XN, (const bf16_t*)(wsw + W_DWIN) + (size_t)j * 3072 * 1024, M, DIFF_N, D, D}; pg8::StaticOrder S; S.init(M, DIFF_N, G, (int)blockIdx.x);
                pg8::EpiBf16 E{Hb, DIFF_N};
                REPS(1) PH_GEMMB pg8::gemm_phase<pg8::EpiBf16, pg8::StaticOrder, true, true, D, D>(lds, g, S, E); }
            xcd_barrier(xbar);
#ifndef NO_PREP
            diff_prep_phase(Hb, p.positions, (bf16_t*)(ws + WS_VT), lds);
#endif
            xcd_barrier(xbar);
#ifndef NO_ATT
            REPS(3) diff_attn_phase(Hb, (const bf16_t*)(ws + WS_VT), (bf16_t*)(ws + WS_O), p.in[9] + j * 64, p.in[10] + j * 64, p.in[11] + j * 64, p.in[12] + j * 64, p.in[13] + j * 128, lambda_init, lds);
#endif
            xcd_barrier(xbar);
            {   pg8::Gemm g{(const bf16_t*)(ws + WS_O), (const bf16_t*)(wsw + W_DWOUT) + (size_t)j * 1024 * 1024, M, D, D, D}; pg8::StaticOrder S; S.init(M, D, G, (int)blockIdx.x);
                pg8::EpiResid E{resid, p.out, D, ALPHA};
                PH_GEMMR pg8::gemm_phase<pg8::EpiResid, pg8::StaticOrder, true, true, D, D>(lds, g, S, E); }
        }
        xcd_barrier(xbar);
#ifndef NO_LN
        ln_phase(p.out, XN, p.in[19] + layer * D, p.in[20] + layer * D);
#endif
        xcd_barrier(xbar);
        for (int half = 0; half < 2; ++half) {
            bf16_t* ACT = (bf16_t*)(ws + WS_ACT);
            {   pg8::Gemm g{XN + (size_t)half * MH * D, (const bf16_t*)(wsw + W_FUP) + (size_t)layer * 5632 * 1024, MH, FFN_N, D, D}; pg8::StaticOrder S; S.init(MH, FFN_N, G, (int)blockIdx.x);
                pg8::EpiBf16 E{Hb, FFN_N};
                REPS(1) PH_GEMMB pg8::gemm_phase<pg8::EpiBf16, pg8::StaticOrder, true, true, D, D>(lds, g, S, E); }
            xcd_barrier(xbar);
#ifndef NO_ACT
            REPS(4) ffn_act_phase(Hb, ACT, p.in[16] + (size_t)layer * 3 * FFN_N, p.in[17] + (size_t)layer * FFN_N);
#endif
            xcd_barrier(xbar);
            {   pg8::Gemm g{ACT, (const bf16_t*)(wsw + W_FDOWN) + (size_t)layer * 1024 * 2816, MH, D, FFN_H, FFN_H}; pg8::StaticOrder S; S.init(MH, D, G, (int)blockIdx.x);
                pg8::EpiResid E{p.out + (size_t)half * MH * D, p.out + (size_t)half * MH * D, D, ALPHA};
                PH_GEMMR pg8::gemm_phase<pg8::EpiResid, pg8::StaticOrder, true, true, FFN_H, FFN_H>(lds, g, S, E); }
        }
        xcd_barrier(xbar);
#ifndef NO_LN
        ln_phase(p.out, XN, p.in[21] + layer * D, p.in[22] + layer * D);
        if (PROBE_REP == 5) { for (int e_ = 0; e_ < 12; ++e_) xcd_barrier(xbar); }
#endif
        xcd_barrier(xbar);
    }
}
}

extern "C" void kernel_launch(void* const* d_in, const int* in_sizes, int n_in, void* d_out, int out_size, void* d_ws, size_t ws_size, hipStream_t stream) {
    static int grid = 0;
    if (grid == 0) {
        if (n_in != 23 || ws_size < mk::WS_END) { fprintf(stderr, "kernel_launch: unexpected n_in %d / ws_size %zu (need %zu)\n", n_in, ws_size, (size_t)mk::WS_END); grid = -1; return; }
        int dev = 0, cus = 0, per_cu = 0;
        hipGetDevice(&dev); hipDeviceGetAttribute(&cus, hipDeviceAttributeMultiprocessorCount, dev);
        if (hipFuncSetAttribute((const void*)mk::fwd_megakernel, hipFuncAttributeMaxDynamicSharedMemorySize, mk::LDS_BYTES) != hipSuccess) { fprintf(stderr, "kernel_launch: hipFuncSetAttribute failed\n"); grid = -1; return; }
        if (hipOccupancyMaxActiveBlocksPerMultiprocessor(&per_cu, (const void*)mk::fwd_megakernel, mk::NTHR, mk::LDS_BYTES) != hipSuccess || per_cu < 1) { fprintf(stderr, "kernel_launch: occupancy query gave %d\n", per_cu); per_cu = 1; }
        (void)hipGetLastError();
        grid = cus * per_cu;
        fprintf(stderr, "kernel_launch: grid %d (cus %d x %d)\n", grid, cus, per_cu);
    }
    if (grid < 0) return;
    mk::Params p{};
    for (int i = 0; i < 23; ++i) p.in[i] = (const float*)d_in[i];
    p.positions = (const int*)d_in[1]; p.out = (float*)d_out; p.ws = (unsigned char*)d_ws;
    if (hipMemsetAsync(d_ws, 0, 16384, stream) != hipSuccess) { fprintf(stderr, "kernel_launch: memset failed\n"); return; }
    void* args[] = {&p};
    hipError_t e = hipLaunchCooperativeKernel((const void*)mk::fwd_megakernel, dim3(grid), dim3(mk::NTHR), args, mk::LDS_BYTES, stream);
    if (e != hipSuccess) fprintf(stderr, "cooperative launch failed: %s (grid %d)\n", hipGetErrorString(e), grid);
}
```

```cpp
#include <hip/hip_runtime.h>
#include <hip/hip_cooperative_groups.h>
#include <cstdio>
#include <cstdint>
namespace cg = cooperative_groups;
#ifndef PROBE_REP
#define PROBE_REP 0
#endif
#define REPS(k) for (int rep_ = 0; rep_ < ((PROBE_REP) == (k) ? 2 : 1); ++rep_)
namespace pg8 {
#define PG8_LAS __attribute__((address_space(3)))
typedef unsigned short bf16_t;
typedef short bf16x8 __attribute__((ext_vector_type(8)));
typedef float f32x4 __attribute__((ext_vector_type(4)));
typedef unsigned u32x4 __attribute__((ext_vector_type(4)));
constexpr int BM = 256, BK = 64, HALF = 128, HTB = HALF * BK * 2  , STAGE_BYTES = 8 * HTB, NXCD = 8, WGM = 8;

__host__ __device__ __forceinline__ int lds_byte(int r, int c) { const int st = (r >> 4) * 2 + (c >> 5), rr = r & 15, cc = c & 31, ob = rr * 64 + cc * 2; return st * 1024 + (ob ^ (((ob >> 9) & 1) << 5)); }
__host__ __device__ __forceinline__ void stage_rc(int b, int& R, int& C) { const int st = b / 1024, sb = b % 1024, swz = sb ^ (((sb >> 9) & 1) << 5); R = (st >> 1) * 16 + swz / 64; C = (st & 1) * 32 + (swz % 64) / 2; }
__host__ __device__ __forceinline__ int perm32(int rho) { const int n = rho >> 4, i = rho & 15; return 8 * (i >> 2) + 4 * n + (i & 3); }

struct Unit { int pm, pn; };
struct Gemm { const bf16_t* A; const bf16_t* Bt; int M, N, K, lda; };

struct StaticOrder {
    int nM, nN, nwg, G, c;
    __host__ __device__ void init(int M, int N, int G_, int c_) { nM = M / BM; nN = N / BM; nwg = nM * nN; G = G_; c = c_; }
    __host__ __device__ bool next(int i, Unit& u) const {
        const long L = (long)i * G + c; if (L >= nwg) return false;
        int wgid = (int)L; { const int q = nwg / NXCD, r = nwg % NXCD, xcd = wgid % NXCD, off = wgid / NXCD; wgid = (xcd < r ? xcd * (q + 1) : r * (q + 1) + (xcd - r) * q) + off; }
        const int nig = WGM * nN, gid = wgid / nig, fm = gid * WGM, gsz = (nM - fm) < WGM ? (nM - fm) : WGM;
        u.pm = fm + ((wgid % nig) % gsz); u.pn = (wgid % nig) / gsz; return true;
    }
    __device__ __forceinline__ void a_ready(const Unit&) const {}
    __device__ __forceinline__ void done(const Unit&) const {}
};
typedef float f32x2 __attribute__((ext_vector_type(2)));
typedef __bf16 bf16x2v __attribute__((ext_vector_type(2)));
__device__ __forceinline__ unsigned cvt_pk_bf16(float lo, float hi) { f32x2 v = {lo, hi}; bf16x2v b = __builtin_convertvector(v, bf16x2v); return __builtin_bit_cast(unsigned, b); }

struct EpiBf16 {
    static constexpr bool PERM = true, AFTER_DRAIN = false;
    bf16_t* O; int ldc;
    __device__ __forceinline__ void operator()(const f32x4 (&acc)[2][2][4][2], const Unit& u, int wr, int wc, int fr, int fq) const {
        const int row0 = u.pm * BM + wr * 64 + fr; const int col0 = u.pn * BM + wc * 32 + 8 * fq;
#pragma unroll
        for (int ai = 0; ai < 2; ++ai)
#pragma unroll
            for (int m = 0; m < 4; ++m) { bf16_t* rowp = O + (size_t)(row0 + ai * HALF + m * 16) * ldc + col0;
#pragma unroll
                for (int bj = 0; bj < 2; ++bj) { const f32x4 v0 = acc[ai][bj][m][0], v1 = acc[ai][bj][m][1];
                    u32x4 w; w.x = cvt_pk_bf16(v0[0], v0[1]); w.y = cvt_pk_bf16(v0[2], v0[3]); w.z = cvt_pk_bf16(v1[0], v1[1]); w.w = cvt_pk_bf16(v1[2], v1[3]);
                    *(u32x4*)(rowp + bj * HALF) = w; } }
    }
};
struct EpiResid {
    static constexpr bool PERM = false, AFTER_DRAIN = false;
    const float* base; float* out; int ldc; float alpha;
    __device__ __forceinline__ void operator()(const f32x4 (&acc)[2][2][4][2], const Unit& u, int wr, int wc, int fr, int fq) const {
        const int col0 = u.pn * BM + wc * 32 + 4 * fq;
#pragma unroll
        for (int ai = 0; ai < 2; ++ai)
#pragma unroll
            for (int m = 0; m < 4; ++m) { const int r = ai * HALF + wr * 64 + m * 16 + fr; const size_t off = (size_t)(u.pm * BM + r) * ldc + col0;
#pragma unroll
                for (int bj = 0; bj < 2; ++bj)
#pragma unroll
                    for (int n = 0; n < 2; ++n) { const f32x4 bs = *(const f32x4*)(base + off + bj * HALF + n * 16); const f32x4 o = bs * alpha + acc[ai][bj][m][n];
                        *(f32x4*)(out + off + bj * HALF + n * 16) = o; }
                asm volatile("" ::: "memory"); }
    }
};

__device__ __forceinline__ float dpp_ror1(float v) { float r; asm volatile("s_nop 1\n\tv_mov_b32_dpp %0, %1 row_ror:1 row_mask:0xf bank_mask:0xf" : "=&v"(r) : "v"(v)); return r; }
__device__ __forceinline__ float dpp_ror2(float v) { float r; asm volatile("s_nop 1\n\tv_mov_b32_dpp %0, %1 row_ror:2 row_mask:0xf bank_mask:0xf" : "=&v"(r) : "v"(v)); return r; }
__device__ __forceinline__ float silu_f(float x) { return x / (1.f + __expf(-x)); }
struct EpiFfnAct {
    static constexpr bool PERM = true, AFTER_DRAIN = false;
    bf16_t* ACT; const float* cw; const float* cb; float* HALO; float* HALO2; PG8_LAS float* hl;
    __device__ __forceinline__ void operator()(const f32x4 (&acc)[2][2][4][2], const Unit& u, int wr, int wc, int fr, int fq) const {
        const int cc0 = wc * 32 + 8 * fq, colA = u.pn * 128 + cc0;
        if (fr >= 14) {
#pragma unroll
            for (int ai = 0; ai < 2; ++ai) { PG8_LAS float* hp = hl + ((2 * ai + wr) * 2 + (fr - 14)) * 256 + cc0;
#pragma unroll
                for (int bj = 0; bj < 2; ++bj)
#pragma unroll
                    for (int n = 0; n < 2; ++n) *(PG8_LAS f32x4*)(hp + bj * 128 + 4 * n) = acc[ai][bj][3][n]; }
            if (wr == 1) { float* gp = HALO + ((size_t)u.pm * 2 + (fr - 14)) * 5632 + colA;
#pragma unroll
                for (int bj = 0; bj < 2; ++bj)
#pragma unroll
                    for (int n = 0; n < 2; ++n) *(f32x4*)(gp + bj * 2816 + 4 * n) = acc[1][bj][3][n]; }
        }
        if (fr < 2 && wr == 0) { float* gp = HALO2 + ((size_t)u.pm * 2 + fr) * 5632 + colA;
#pragma unroll
            for (int bj = 0; bj < 2; ++bj)
#pragma unroll
                for (int n = 0; n < 2; ++n) *(f32x4*)(gp + bj * 2816 + 4 * n) = acc[0][bj][0][n]; }
        asm volatile("s_waitcnt lgkmcnt(0)" ::: "memory"); __builtin_amdgcn_s_barrier(); asm volatile("" ::: "memory");
#pragma unroll
        for (int n = 0; n < 2; ++n) {
            f32x4 wa[3], wb[3];
#pragma unroll
            for (int j = 0; j < 3; ++j) { wa[j] = *(const f32x4*)(cw + j * 5632 + colA + 4 * n); wb[j] = *(const f32x4*)(cw + j * 5632 + 2816 + colA + 4 * n); }
            const f32x4 ba = *(const f32x4*)(cb + colA + 4 * n), bb = *(const f32x4*)(cb + 2816 + colA + 4 * n);
#pragma unroll
            for (int ai = 0; ai < 2; ++ai) {
                const int strip = 2 * ai + wr;
                f32x4 h1a = {0.f, 0.f, 0.f, 0.f}, h2a = h1a, h1b = h1a, h2b = h1a;
                if (strip > 0) { const PG8_LAS float* hp = hl + ((strip - 1) * 2) * 256 + cc0 + 4 * n;
                    h2a = *(const PG8_LAS f32x4*)hp; h1a = *(const PG8_LAS f32x4*)(hp + 256); h2b = *(const PG8_LAS f32x4*)(hp + 128); h1b = *(const PG8_LAS f32x4*)(hp + 256 + 128); }
#pragma unroll
                for (int m = 0; m < 4; ++m) {
                    const f32x4 ca = acc[ai][0][m][n], cbv = acc[ai][1][m][n];
                    float o[4];
#pragma unroll
                    for (int e = 0; e < 4; ++e) {
                        float x1a, x2a, x1b, x2b;
                        if (m > 0) { x1a = dpp_ror1(acc[ai][0][m > 0 ? m - 1 : 0][n][e]); x2a = dpp_ror2(acc[ai][0][m > 0 ? m - 1 : 0][n][e]); x1b = dpp_ror1(acc[ai][1][m > 0 ? m - 1 : 0][n][e]); x2b = dpp_ror2(acc[ai][1][m > 0 ? m - 1 : 0][n][e]); }
                        else { x1a = h1a[e]; x2a = (fr == 0) ? h2a[e] : h1a[e]; x1b = h1b[e]; x2b = (fr == 0) ? h2b[e] : h1b[e]; }
                        const float r1a = dpp_ror1(ca[e]), r2a = dpp_ror2(ca[e]), r1b = dpp_ror1(cbv[e]), r2b = dpp_ror2(cbv[e]);
                        const float p1a = (fr == 0) ? x1a : r1a, p2a = (fr < 2) ? x2a : r2a;
                        const float p1b = (fr == 0) ? x1b : r1b, p2b = (fr < 2) ? x2b : r2b;
                        const float ya = wa[0][e] * p2a + wa[1][e] * p1a + wa[2][e] * ca[e] + ba[e];
                        const float yb = wb[0][e] * p2b + wb[1][e] * p1b + wb[2][e] * cbv[e] + bb[e];
                        o[e] = silu_f(ya) * yb;
                    }
                    typedef unsigned u32x2 __attribute__((ext_vector_type(2)));
                    u32x2 w; w.x = cvt_pk_bf16(o[0], o[1]); w.y = cvt_pk_bf16(o[2], o[3]);
                    *(u32x2*)(ACT + (size_t)(u.pm * BM + ai * HALF + wr * 64 + m * 16 + fr) * 2816 + colA + 4 * n) = w;
                }
            }
        }
    }
};

template <class Epi, class Sched, bool ALIGN_EPI, bool SP2, int KC, int LDAC>
__device__ __forceinline__ void gemm_phase(PG8_LAS unsigned char* lds, const Gemm g, const Sched& S, const Epi& E) {
    int tid_ = threadIdx.x; asm volatile("" : "+v"(tid_));
    const int tid = tid_, wid = __builtin_amdgcn_readfirstlane(tid >> 6), lane = tid & 63, wr = wid >> 2, wc = wid & 3, fr = lane & 15, fq = lane >> 4;
    constexpr int K = KC, nt = K / BK;
    unsigned voffA[2], voffB[2];
#pragma unroll
    for (int i = 0; i < 2; ++i) { int R, C; stage_rc(tid * 16 + i * 8192, R, C); const int Rb = Epi::PERM ? ((R & ~31) + perm32(R & 31)) : R;
        voffA[i] = (unsigned)(R * LDAC + C) * 2u; voffB[i] = (unsigned)(Rb * K + C) * 2u; }
    const size_t kstep = (size_t)(BK * 2);
    const size_t hstepA = (size_t)HALF * LDAC * 2, hstepB = (size_t)HALF * K * 2;
    const size_t tstepA = 2 * hstepA, tstepB = 2 * hstepB;
    const unsigned ldsw = (unsigned)wid * 1024u;
    const int aoff = lds_byte(wr * 64 + fr, fq * 8), boff = lds_byte(wc * 32 + fr, fq * 8);
#define PG8_SA(b, h) (((b) * 2 + (h)) * HTB)
#define PG8_SB(b, h) ((4 + (b) * 2 + (h)) * HTB)
#define PG8_STAGE(bufoff, gbase, voff) do { _Pragma("unroll") for (int _i = 0; _i < 2; ++_i) \
        __builtin_amdgcn_global_load_lds((const unsigned*)((const char*)(gbase) + (voff)[_i]), (PG8_LAS unsigned*)(lds + (bufoff) + ldsw + _i * 8192), 16, 0, 0); } while (0)
#define PG8_LDA(dst, b, h) do { _Pragma("unroll") for (int m = 0; m < 4; ++m) _Pragma("unroll") for (int k = 0; k < 2; ++k) dst[m][k] = *(const PG8_LAS bf16x8*)(lds + PG8_SA(b, h) + aoff + m * 2048 + k * 1024); } while (0)
#define PG8_LDB(dst, b, h) do { _Pragma("unroll") for (int n = 0; n < 2; ++n) _Pragma("unroll") for (int k = 0; k < 2; ++k) dst[n][k] = *(const PG8_LAS bf16x8*)(lds + PG8_SB(b, h) + boff + n * 2048 + k * 1024); } while (0)
#define PG8_MMA(ai, bj, At, Bt) do { __builtin_amdgcn_s_setprio(1); _Pragma("unroll") for (int m = 0; m < 4; ++m) _Pragma("unroll") for (int n = 0; n < 2; ++n) _Pragma("unroll") for (int k = 0; k < 2; ++k) \
        acc[ai][bj][m][n] = __builtin_amdgcn_mfma_f32_16x16x32_bf16(Bt[n][k], At[m][k], acc[ai][bj][m][n], 0, 0, 0); __builtin_amdgcn_s_setprio(0); } while (0)
#define PG8_WAIT_V(n) asm volatile("s_waitcnt vmcnt(" #n ")" ::: "memory")
#define PG8_WAIT_L(n) asm volatile("s_waitcnt lgkmcnt(" #n ")" ::: "memory")
#define PG8_BAR __builtin_amdgcn_s_barrier()
#define PG8_SCHED __builtin_amdgcn_sched_barrier(0)
    Unit cur, nxt; int ui = 0;
    if (!S.next(0, cur)) return;
    f32x4 acc[2][2][4][2];
#pragma unroll
    for (int a = 0; a < 2; ++a)
#pragma unroll
        for (int b = 0; b < 2; ++b)
#pragma unroll
            for (int m = 0; m < 4; ++m)
#pragma unroll
                for (int n = 0; n < 2; ++n) acc[a][b][m][n] = (f32x4){0.f, 0.f, 0.f, 0.f};
    bf16x8 At[4][2], B0[2][2], B1[2][2];
    const char* cA = (const char*)g.A + (size_t)cur.pm * tstepA; const char* cB = (const char*)g.Bt + (size_t)cur.pn * tstepB;
    S.a_ready(cur);
    if constexpr (SP2) {
        PG8_STAGE(PG8_SB(0, 0), cB, voffB); PG8_STAGE(PG8_SB(0, 1), cB + hstepB, voffB); PG8_STAGE(PG8_SA(0, 0), cA, voffA); PG8_STAGE(PG8_SA(0, 1), cA + hstepA, voffA);
        if (wr == 1) PG8_BAR;
        PG8_WAIT_V(2); PG8_BAR;
        PG8_STAGE(PG8_SB(1, 0), cB + kstep, voffB); PG8_STAGE(PG8_SA(1, 0), cA + kstep, voffA); PG8_STAGE(PG8_SB(1, 1), cB + hstepB + kstep, voffB);
        PG8_WAIT_V(6); PG8_BAR;
    } else {
        PG8_STAGE(PG8_SB(0, 0), cB, voffB); PG8_STAGE(PG8_SA(0, 0), cA, voffA); PG8_STAGE(PG8_SB(0, 1), cB + hstepB, voffB); PG8_STAGE(PG8_SA(0, 1), cA + hstepA, voffA);
        if (wr == 1) PG8_BAR;
        PG8_WAIT_V(4); PG8_BAR;
        PG8_STAGE(PG8_SB(1, 0), cB + kstep, voffB); PG8_STAGE(PG8_SA(1, 0), cA + kstep, voffA); PG8_STAGE(PG8_SB(1, 1), cB + hstepB + kstep, voffB);
        PG8_WAIT_V(6); PG8_BAR;
    }
    for (;;) {
        const bool has_next = S.next(ui + 1, nxt);
        const char* nA = has_next ? (const char*)g.A + (size_t)nxt.pm * tstepA : cA; const char* nB = has_next ? (const char*)g.Bt + (size_t)nxt.pn * tstepB : cB;
        for (int t = 0; t < nt; t += 2) {
            const bool last = (t == nt - 2);
            const char* a1 = cA + (size_t)(t + 1) * kstep;
            const char* a2 = last ? nA : cA + (size_t)(t + 2) * kstep; const char* b2 = last ? nB : cB + (size_t)(t + 2) * kstep;
            const char* a3 = a2 + kstep; const char* b3 = b2 + kstep;
            if (last && has_next) S.a_ready(nxt);
            if constexpr (SP2) {
            PG8_LDB(B0, 0, 0); PG8_LDB(B1, 0, 1); PG8_SCHED; PG8_LDA(At, 0, 0); PG8_STAGE(PG8_SA(1, 1), a1 + hstepA, voffA);
            PG8_WAIT_V(8); PG8_WAIT_L(0); PG8_BAR; PG8_MMA(0, 0, At, B0); PG8_MMA(0, 1, At, B1); PG8_BAR; PG8_SCHED;
            PG8_LDA(At, 0, 1); PG8_STAGE(PG8_SB(0, 0), b2, voffB); PG8_STAGE(PG8_SB(0, 1), b2 + hstepB, voffB); PG8_STAGE(PG8_SA(0, 0), a2, voffA);
            PG8_WAIT_V(8); PG8_WAIT_L(0); PG8_BAR; PG8_MMA(1, 0, At, B0); PG8_MMA(1, 1, At, B1); PG8_BAR; PG8_SCHED;
            PG8_LDB(B0, 1, 0); PG8_LDB(B1, 1, 1); PG8_SCHED; PG8_LDA(At, 1, 0); PG8_STAGE(PG8_SA(0, 1), a2 + hstepA, voffA);
            PG8_WAIT_V(8); PG8_WAIT_L(0); PG8_BAR; PG8_MMA(0, 0, At, B0); PG8_MMA(0, 1, At, B1); PG8_BAR; PG8_SCHED;
            PG8_LDA(At, 1, 1); PG8_STAGE(PG8_SB(1, 0), b3, voffB); PG8_STAGE(PG8_SB(1, 1), b3 + hstepB, voffB); PG8_STAGE(PG8_SA(1, 0), a3, voffA);
            PG8_WAIT_V(8); PG8_WAIT_L(0); PG8_BAR; PG8_MMA(1, 0, At, B0); PG8_MMA(1, 1, At, B1); PG8_BAR; PG8_SCHED;
            } else {
            PG8_LDB(B0, 0, 0); PG8_SCHED; PG8_LDA(At, 0, 0); PG8_STAGE(PG8_SA(1, 1), a1 + hstepA, voffA);
            PG8_WAIT_L(8); PG8_BAR; PG8_WAIT_L(0); PG8_MMA(0, 0, At, B0); PG8_BAR; PG8_SCHED;
            PG8_LDB(B1, 0, 1); PG8_STAGE(PG8_SB(0, 0), b2, voffB);
            PG8_BAR; PG8_WAIT_L(0); PG8_MMA(0, 1, At, B1); PG8_BAR;
            PG8_LDA(At, 0, 1); PG8_STAGE(PG8_SA(0, 0), a2, voffA);
            PG8_BAR; PG8_WAIT_L(0); PG8_MMA(1, 0, At, B0); PG8_BAR; PG8_SCHED;
            PG8_STAGE(PG8_SB(0, 1), b2 + hstepB, voffB);
            PG8_WAIT_V(6); PG8_BAR; PG8_MMA(1, 1, At, B1); PG8_BAR;
            PG8_LDB(B0, 1, 0); PG8_SCHED; PG8_LDA(At, 1, 0); PG8_STAGE(PG8_SA(0, 1), a2 + hstepA, voffA);
            PG8_WAIT_L(8); PG8_BAR; PG8_WAIT_L(0); PG8_MMA(0, 0, At, B0); PG8_BAR; PG8_SCHED;
            PG8_LDB(B1, 1, 1); PG8_STAGE(PG8_SB(1, 0), b3, voffB);
            PG8_BAR; PG8_WAIT_L(0); PG8_MMA(0, 1, At, B1); PG8_BAR;
            PG8_LDA(At, 1, 1); PG8_STAGE(PG8_SA(1, 0), a3, voffA);
            PG8_BAR; PG8_WAIT_L(0); PG8_MMA(1, 0, At, B0); PG8_BAR; PG8_SCHED;
            PG8_STAGE(PG8_SB(1, 1), b3 + hstepB, voffB);
            PG8_WAIT_V(6); PG8_BAR; PG8_MMA(1, 1, At, B1); PG8_BAR;
            }
        }
        if constexpr (ALIGN_EPI) { if (wr == 0) PG8_BAR; }
        if constexpr (!Epi::AFTER_DRAIN) { E(acc, cur, wr, wc, fr, fq); S.done(cur); }
        if (!has_next) break;
#pragma unroll
        for (int a = 0; a < 2; ++a)
#pragma unroll
            for (int b = 0; b < 2; ++b)
#pragma unroll
                for (int m = 0; m < 4; ++m)
#pragma unroll
                    for (int n = 0; n < 2; ++n) acc[a][b][m][n] = (f32x4){0.f, 0.f, 0.f, 0.f};
        cur = nxt; cA = nA; cB = nB; ++ui;
        if constexpr (ALIGN_EPI) { if (wr == 1) PG8_BAR; }
    }
    PG8_WAIT_V(0);
    if constexpr (!ALIGN_EPI) { if (wr == 0) PG8_BAR; }
    PG8_BAR;
    if constexpr (Epi::AFTER_DRAIN) { E.fused(acc, cur, wr, wc, fr, fq, lds, wid, lane); S.done(cur); }
#undef PG8_SA
#undef PG8_SB
#undef PG8_STAGE
#undef PG8_LDA
#undef PG8_LDB
#undef PG8_MMA
#undef PG8_WAIT_V
#undef PG8_WAIT_L
#undef PG8_BAR
#undef PG8_SCHED
}
}

#ifdef NO_GEMMB
#define PH_GEMMB if (0)
#else
#define PH_GEMMB
#endif
#ifdef NO_GEMMR
#define PH_GEMMR if (0)
#else
#define PH_GEMMR
#endif
namespace mk {
#define LAS __attribute__((address_space(3)))
typedef unsigned short bf16_t;
typedef short bf16x8 __attribute__((ext_vector_type(8)));
typedef short s16x4 __attribute__((ext_vector_type(4)));
typedef float f32x4 __attribute__((ext_vector_type(4)));
typedef float f32x16 __attribute__((ext_vector_type(16)));
typedef unsigned u32x4 __attribute__((ext_vector_type(4)));
typedef unsigned u32x2 __attribute__((ext_vector_type(2)));
using pg8::cvt_pk_bf16;

constexpr int NB = 32, T = 2048, D = 1024, M = NB * T, DEPTH = 4;
constexpr int NWAVES = 8, NTHR = 512;
constexpr int GDN_N = 4112, GDN_NMAIN = 4096, DIFF_N = 3072, FFN_H = 2816, FFN_N = 5632;
constexpr float LN_EPS = 1e-5f, RMS_EPS = 1e-6f;
constexpr float ALPHA = 1.6817928305074290f;
constexpr float LOG2E = 1.4426950408889634f;
constexpr int MH = M / 2;

constexpr size_t MiB = 1u << 20;
constexpr size_t WS_W = 2 * MiB;
constexpr size_t W_GWIN = 0, W_GWAB = W_GWIN + 2ull * 4096 * 1024 * 2, W_GWOUT = W_GWAB + 2ull * 16 * 1024 * 2, W_DWIN = W_GWOUT + 2ull * 1024 * 1024 * 2,
                 W_DWOUT = W_DWIN + 2ull * 3072 * 1024 * 2, W_FUP = W_DWOUT + 2ull * 1024 * 1024 * 2, W_FDOWN = W_FUP + 4ull * 5632 * 1024 * 2, W_END = W_FDOWN + 4ull * 1024 * 2816 * 2;
static_assert(WS_W + W_END <= 106 * MiB, "weights region");
constexpr size_t WS_GB = 106 * MiB;
constexpr size_t WS_XN = 112 * MiB;
constexpr size_t WS_H = 240 * MiB;
constexpr size_t WS_ACT = WS_H;
constexpr size_t WS_HALO = WS_H + 352 * MiB;
constexpr size_t WS_HALO2 = WS_HALO + 12 * MiB;
constexpr size_t WS_UT = WS_H + 512 * MiB;
constexpr size_t WS_WN = WS_UT + 128 * MiB;
constexpr size_t WS_VT = WS_H + 384 * MiB;
constexpr size_t WS_O = WS_VT + 128 * MiB;
constexpr size_t WS_END = WS_WN + 128 * MiB;
static_assert(WS_END <= 1024 * MiB, "workspace map");
constexpr int LDS_BYTES = 131072 + 2048 + 8192;

__device__ __forceinline__ float bf2f(unsigned short h) { return __uint_as_float((unsigned)h << 16); }
__device__ __forceinline__ unsigned short f2bf(float f) { return (unsigned short)(cvt_pk_bf16(f, 0.f) & 0xffffu); }
__device__ __forceinline__ float wave_sum(float v) {
#pragma unroll
    for (int o = 1; o < 64; o <<= 1) v += __shfl_xor(v, o);
    return v;
}
__device__ __forceinline__ float silu(float x) { return x / (1.f + __expf(-x)); }
__device__ __forceinline__ void unpack8(const u32x4 v, float (&o)[8]) {
    o[0] = __uint_as_float(v.x << 16); o[1] = __uint_as_float(v.x & 0xffff0000u); o[2] = __uint_as_float(v.y << 16); o[3] = __uint_as_float(v.y & 0xffff0000u);
    o[4] = __uint_as_float(v.z << 16); o[5] = __uint_as_float(v.z & 0xffff0000u); o[6] = __uint_as_float(v.w << 16); o[7] = __uint_as_float(v.w & 0xffff0000u);
}
__device__ __forceinline__ u32x4 pack8(const float (&o)[8]) { u32x4 w; w.x = cvt_pk_bf16(o[0], o[1]); w.y = cvt_pk_bf16(o[2], o[3]); w.z = cvt_pk_bf16(o[4], o[5]); w.w = cvt_pk_bf16(o[6], o[7]); return w; }
__device__ __forceinline__ int crow(int r, int hi) { return (r & 3) + 8 * (r >> 2) + 4 * hi; }
#define LDS_WAIT() asm volatile("s_waitcnt lgkmcnt(0)" ::: "memory")
#define MK_IDS() int tid_ = threadIdx.x; asm volatile("" : "+v"(tid_));   \
    const int tid = tid_, lane = tid & 63, wid = __builtin_amdgcn_readfirstlane(tid >> 6); const int G_ = gridDim.x, gw = blockIdx.x * NWAVES + wid, NGW = G_ * NWAVES, gt = blockIdx.x * NTHR + tid, NGT = G_ * NTHR; \
    (void)lane; (void)wid; (void)gw; (void)NGW; (void)gt; (void)NGT

template <bool UPPERM = false> __device__ __forceinline__ void transpose_item(const float* W, int ldw, int K, int nblk, bf16_t* WT, LAS float* scr, int item, int lane) {
    const int kb = item / nblk, nb = item % nblk, k0 = 64 * kb, n0 = 32 * nb;
    const int r0 = UPPERM ? (n0 < FFN_H ? 256 * (n0 >> 7) + (n0 & 127) : 256 * ((n0 - FFN_H) >> 7) + 128 + ((n0 - FFN_H) & 127)) : n0;
#pragma unroll 8
    for (int i = 0; i < 32; ++i) { const int kk = 2 * i + (lane >> 5); scr[kk * 33 + (lane & 31)] = W[(size_t)(k0 + kk) * ldw + n0 + (lane & 31)]; }
    LDS_WAIT();
    const int c = lane & 7;
#pragma unroll
    for (int j = 0; j < 4; ++j) { const int n = (lane >> 3) + 8 * j; const LAS float* s = scr + (8 * c) * 33 + n;
        u32x4 o; o.x = cvt_pk_bf16(s[0 * 33], s[1 * 33]); o.y = cvt_pk_bf16(s[2 * 33], s[3 * 33]); o.z = cvt_pk_bf16(s[4 * 33], s[5 * 33]); o.w = cvt_pk_bf16(s[6 * 33], s[7 * 33]);
        *(u32x4*)(WT + (size_t)(r0 + n) * K + k0 + 8 * c) = o; }
    LDS_WAIT();
}

#define XB_TMO      128
#define XB_XCNT(j)  (256  + 64 * (j))
#define XB_XSUB(j)  (1280 + 64 * (j))
#define XB_XGEN(j)  (2304 + 64 * (j))
#define XB_TOP      3328
#define XB_TOPGEN   3392
#define XCD_BAR_WORDS 3456
#define XB_SPIN_CAP (1u << 18)

__device__ __forceinline__ unsigned xb_ld(unsigned* p)              { return __hip_atomic_load(p, __ATOMIC_RELAXED, __HIP_MEMORY_SCOPE_AGENT); }
__device__ __forceinline__ unsigned xb_add(unsigned* p, unsigned v) { return __hip_atomic_fetch_add(p, v, __ATOMIC_RELAXED, __HIP_MEMORY_SCOPE_AGENT); }
__device__ __forceinline__ unsigned xb_xcc_id() { return (unsigned)__builtin_amdgcn_s_getreg((3 << 11) | 20) & 0xFu; }
#define XB_SPIN(cond, bar) do { unsigned _sp = 0; while (cond) { __builtin_amdgcn_s_sleep(1); \
    if ((++_sp & 255u) == 0u) { if (xb_ld(&(bar)[XB_TMO])) break; if (_sp > XB_SPIN_CAP) { atomicAdd(&(bar)[XB_TMO], 1u); break; } } } } while (0)

struct XcdBarrier {
    unsigned* bar; unsigned x;
    volatile LAS unsigned* st;
};

__device__ __forceinline__ XcdBarrier xcd_barrier_post(unsigned* bar, volatile LAS unsigned* st) {
    XcdBarrier b; b.bar = bar; b.x = xb_xcc_id(); b.st = st;
    if (threadIdx.x == 0) (void)xb_add(&bar[XB_XCNT(b.x)], 1u);
    return b;
}
__device__ __forceinline__ void xcd_barrier_complete(unsigned* bar, unsigned x, unsigned& nloc, unsigned& nx) {
    const unsigned G = gridDim.x * gridDim.y * gridDim.z;
    unsigned sum, cnt, mine, sp = 0u;
    for (;;) {
        sum = 0u; cnt = 0u; mine = 0u;
#pragma unroll
        for (unsigned j = 0; j < 16; ++j) { const unsigned c = xb_ld(&bar[XB_XCNT(j)]); sum += c; cnt += (c > 0u) ? 1u : 0u; mine = (j == x) ? c : mine; }
        if (sum == G) break;
        __builtin_amdgcn_s_sleep(1);
        if ((++sp & 255u) == 0u) { if (xb_ld(&bar[XB_TMO])) break; if (sp > XB_SPIN_CAP) { atomicAdd(&bar[XB_TMO], 1u); break; } }
    }
    nloc = mine > 0u ? mine : 1u; nx = cnt > 0u ? cnt : 1u;
}

__device__ __forceinline__ void xcd_barrier(const XcdBarrier& b) {
    asm volatile("s_waitcnt vmcnt(0)" ::: "memory");
    __syncthreads();
    if (threadIdx.x == 0) {
        unsigned* bar = b.bar;
        __builtin_amdgcn_s_waitcnt(0);
        unsigned nloc = b.st[0], nx = b.st[1];
        if (nloc == 0u) { xcd_barrier_complete(bar, b.x, nloc, nx); b.st[0] = nloc; b.st[1] = nx; }
        const unsigned old = xb_add(&bar[XB_XSUB(b.x)], 1u);
        const unsigned gen = old / nloc;
        if (old + 1u == (gen + 1u) * nloc) {
            __builtin_amdgcn_fence(__ATOMIC_RELEASE, "agent");
            asm volatile("s_waitcnt vmcnt(0)" ::: "memory");
            const unsigned og = xb_add(&bar[XB_TOP], 1u);
            const unsigned tg = og / nx;
            if (og + 1u == (tg + 1u) * nx) xb_add(&bar[XB_TOPGEN], 1u);
            else XB_SPIN(xb_ld(&bar[XB_TOPGEN]) == tg, bar);
            __builtin_amdgcn_fence(__ATOMIC_ACQUIRE, "agent");
            xb_add(&bar[XB_XGEN(b.x)], 1u);
            asm volatile("s_waitcnt vmcnt(0)" ::: "memory");
        } else {
            XB_SPIN(xb_ld(&bar[XB_XGEN(b.x)]) == gen, bar);
            __builtin_amdgcn_fence(__ATOMIC_ACQUIRE, "agent");
            asm volatile("s_waitcnt vmcnt(0)" ::: "memory");
        }
    }
    __syncthreads();
}

struct Params {
    const float* in[23];
    const int* positions;
    float* out;
    unsigned char* ws;
};

__device__ __forceinline__ void prologue(const Params& p, LAS unsigned char* lds) {
    MK_IDS(); const int wave = wid;
    LAS float* scr = (LAS float*)(lds + wave * 16384);
    unsigned char* wsw = p.ws + WS_W;
    constexpr int I_GWIN = 16 * 128, I_SQ = 16 * 32, I_DWIN = 16 * 96, I_FUP = 16 * 176, I_FDN = 44 * 32;
    constexpr int NITEMS = 2 * I_GWIN + 2 * I_SQ + 2 * I_DWIN + 2 * I_SQ + 4 * I_FUP + 4 * I_FDN;
    for (int it = gw; it < NITEMS; it += NGW) {
        int r = it;
        if (r < 2 * I_GWIN) { const int j = r / I_GWIN; r %= I_GWIN; transpose_item(p.in[2] + (size_t)j * 1024 * GDN_N, GDN_N, 1024, 128, (bf16_t*)(wsw + W_GWIN) + (size_t)j * 4096 * 1024, scr, r, lane); continue; } r -= 2 * I_GWIN;
        if (r < 2 * I_SQ) { const int j = r / I_SQ; r %= I_SQ; transpose_item(p.in[7] + (size_t)j * 1024 * 1024, 1024, 1024, 32, (bf16_t*)(wsw + W_GWOUT) + (size_t)j * 1024 * 1024, scr, r, lane); continue; } r -= 2 * I_SQ;
        if (r < 2 * I_DWIN) { const int j = r / I_DWIN; r %= I_DWIN; transpose_item(p.in[8] + (size_t)j * 1024 * DIFF_N, DIFF_N, 1024, 96, (bf16_t*)(wsw + W_DWIN) + (size_t)j * 3072 * 1024, scr, r, lane); continue; } r -= 2 * I_DWIN;
        if (r < 2 * I_SQ) { const int j = r / I_SQ; r %= I_SQ; transpose_item(p.in[14] + (size_t)j * 1024 * 1024, 1024, 1024, 32, (bf16_t*)(wsw + W_DWOUT) + (size_t)j * 1024 * 1024, scr, r, lane); continue; } r -= 2 * I_SQ;
        if (r < 4 * I_FUP) { const int j = r / I_FUP; r %= I_FUP; transpose_item<true>(p.in[15] + (size_t)j * 1024 * FFN_N, FFN_N, 1024, 176, (bf16_t*)(wsw + W_FUP) + (size_t)j * 5632 * 1024, scr, r, lane); continue; } r -= 4 * I_FUP;
        { const int j = r / I_FDN; r %= I_FDN; transpose_item(p.in[18] + (size_t)j * 2816 * 1024, 1024, 2816, 32, (bf16_t*)(wsw + W_FDOWN) + (size_t)j * 1024 * 2816, scr, r, lane); }
    }
    for (int e = gt; e < 2 * 16 * 1024; e += NGT) { const int j = e >> 14, n = (e >> 10) & 15, k = e & 1023;
        ((bf16_t*)(wsw + W_GWAB))[e] = f2bf(p.in[2][(size_t)j * 1024 * GDN_N + (size_t)k * GDN_N + GDN_NMAIN + n]); }
    const f32x4* x4 = (const f32x4*)p.in[0]; u32x4* xn = (u32x4*)(p.ws + WS_XN);
    for (int e = gt; e < M * D / 8; e += NGT) { const f32x4 a = x4[2 * e], b = x4[2 * e + 1]; u32x4 w; w.x = cvt_pk_bf16(a[0], a[1]); w.y = cvt_pk_bf16(a[2], a[3]); w.z = cvt_pk_bf16(b[0], b[1]); w.w = cvt_pk_bf16(b[2], b[3]); xn[e] = w; }
}

__device__ __forceinline__ void ln_phase(float* X, bf16_t* XN, const float* g, const float* b) {
    MK_IDS();
    f32x4 gv[4], bv[4];
#pragma unroll
    for (int j = 0; j < 4; ++j) { gv[j] = ((const f32x4*)g)[lane + 64 * j]; bv[j] = ((const f32x4*)b)[lane + 64 * j]; }
    for (int m = gw; m < M; m += NGW) {
        f32x4* xr = (f32x4*)(X + (size_t)m * D) + lane;
        f32x4 v[4]; float s = 0.f;
#pragma unroll
        for (int j = 0; j < 4; ++j) { v[j] = xr[64 * j]; s += (v[j][0] + v[j][1]) + (v[j][2] + v[j][3]); }
        const float mean = wave_sum(s) * (1.f / D); float s2 = 0.f;
#pragma unroll
        for (int j = 0; j < 4; ++j) { v[j] = v[j] - mean; s2 += (v[j][0] * v[j][0] + v[j][1] * v[j][1]) + (v[j][2] * v[j][2] + v[j][3] * v[j][3]); }
        const float rstd = 1.f / sqrtf(wave_sum(s2) * (1.f / D) + LN_EPS);
        u32x2* o8 = (u32x2*)(XN + (size_t)m * D) + lane;
#pragma unroll
        for (int j = 0; j < 4; ++j) { const f32x4 o = v[j] * rstd * gv[j] + bv[j]; xr[64 * j] = o; u32x2 w; w.x = cvt_pk_bf16(o[0], o[1]); w.y = cvt_pk_bf16(o[2], o[3]); o8[64 * j] = w; }
    }
}

__device__ __forceinline__ void ffn_fixup_phase(bf16_t* ACT, const float* HALO, const float* HALO2, const float* cw, const float* cb) {
    MK_IDS();
    constexpr int NCG = FFN_H / 4;
    for (int item = gt; item < (M / 256) * NCG; item += NGT) {
        const int pm = item / NCG, col = (item % NCG) * 4;
        if ((pm & 7) == 0) continue;
        f32x4 wa[3], wb[3];
#pragma unroll
        for (int j = 0; j < 3; ++j) { wa[j] = *(const f32x4*)(cw + j * FFN_N + col); wb[j] = *(const f32x4*)(cw + j * FFN_N + FFN_H + col); }
        const f32x4 ba = *(const f32x4*)(cb + col), bb = *(const f32x4*)(cb + FFN_H + col);
        const float* hp = HALO + (size_t)(pm - 1) * 2 * FFN_N + col; const float* h2 = HALO2 + (size_t)pm * 2 * FFN_N + col;
        const f32x4 am2 = *(const f32x4*)hp, am1 = *(const f32x4*)(hp + FFN_N), a0 = *(const f32x4*)h2, a1 = *(const f32x4*)(h2 + FFN_N);
        const f32x4 bm2 = *(const f32x4*)(hp + FFN_H), bm1 = *(const f32x4*)(hp + FFN_N + FFN_H), b0 = *(const f32x4*)(h2 + FFN_H), b1 = *(const f32x4*)(h2 + FFN_N + FFN_H);
        float o0[4], o1[4];
#pragma unroll
        for (int e = 0; e < 4; ++e) {
            o0[e] = silu(wa[0][e] * am2[e] + wa[1][e] * am1[e] + wa[2][e] * a0[e] + ba[e]) * (wb[0][e] * bm2[e] + wb[1][e] * bm1[e] + wb[2][e] * b0[e] + bb[e]);
            o1[e] = silu(wa[0][e] * am1[e] + wa[1][e] * a0[e] + wa[2][e] * a1[e] + ba[e]) * (wb[0][e] * bm1[e] + wb[1][e] * b0[e] + wb[2][e] * b1[e] + bb[e]);
        }
        u32x2 w; w.x = cvt_pk_bf16(o0[0], o0[1]); w.y = cvt_pk_bf16(o0[2], o0[3]); *(u32x2*)(ACT + (size_t)(pm * 256) * FFN_H + col) = w;
        w.x = cvt_pk_bf16(o1[0], o1[1]); w.y = cvt_pk_bf16(o1[2], o1[3]); *(u32x2*)(ACT + (size_t)(pm * 256 + 1) * FFN_H + col) = w;
    }
}

__device__ __forceinline__ void gdn_ab_phase(const bf16_t* XN, const bf16_t* wabT  , const float* a_log, const float* dt_bias, float* G, float* BETA) {
    MK_IDS();
    const int n = lane & 15, q4 = lane >> 4, h = n & 7;
    const float al = -__expf(a_log[h]), db = dt_bias[h];
    for (int it = gw; it < M / 16; it += NGW) {
        const int m0 = it * 16;
        f32x4 acc = {0.f, 0.f, 0.f, 0.f};
        const bf16_t* ap = XN + (size_t)(m0 + n) * D + 8 * q4;
        const bf16_t* bp = wabT + (size_t)n * D + 8 * q4;
#pragma unroll 8
        for (int ks = 0; ks < 32; ++ks) { const bf16x8 a = *(const bf16x8*)(ap + 32 * ks), b = *(const bf16x8*)(bp + 32 * ks); acc = __builtin_amdgcn_mfma_f32_16x16x32_bf16(a, b, acc, 0, 0, 0); }
#pragma unroll
        for (int i = 0; i < 4; ++i) { const int m = m0 + 4 * q4 + i; const float v = acc[i];
            if (n < 8) { const float x = v + db; const float sp = x > 20.f ? x : log1pf(__expf(x)); G[(size_t)m * 8 + h] = al * sp; }
            else BETA[(size_t)m * 8 + h] = 1.f / (1.f + __expf(-v)); }
    }
}

__device__ __forceinline__ void conv_silu16(const bf16_t* hp, int t, const LAS float* cw, float (&y)[16]) {
#pragma unroll
    for (int c = 0; c < 16; ++c) y[c] = 0.f;
#pragma unroll
    for (int j = 0; j < 4; ++j) {
        if (t - 3 + j >= 0) {
            float x[16];
            const bf16_t* rp = hp + (ptrdiff_t)(j - 3) * GDN_NMAIN;
            { float t8[8]; unpack8(*(const u32x4*)rp, t8);
#pragma unroll
              for (int c = 0; c < 8; ++c) x[c] = t8[c];
              unpack8(*(const u32x4*)(rp + 8), t8);
#pragma unroll
              for (int c = 0; c < 8; ++c) x[8 + c] = t8[c]; }
#pragma unroll
            for (int q = 0; q < 4; ++q) { const f32x4 w = *(const LAS f32x4*)(cw + j * 128 + 4 * q);
#pragma unroll
                for (int e = 0; e < 4; ++e) y[4 * q + e] += w[e] * x[4 * q + e]; }
        }
    }
#pragma unroll
    for (int c = 0; c < 16; ++c) y[c] = silu(y[c]);
}
__device__ __forceinline__ float sumsq16_8lanes(const float (&y)[16]) {
    float s = 0.f;
#pragma unroll
    for (int c = 0; c < 16; ++c) s += y[c] * y[c];
    s += __shfl_xor(s, 1); s += __shfl_xor(s, 2); s += __shfl_xor(s, 4);
    return s;
}
__device__ __forceinline__ void pack16(const float (&y)[16], u32x4& a, u32x4& b) {
    a.x = cvt_pk_bf16(y[0], y[1]); a.y = cvt_pk_bf16(y[2], y[3]); a.z = cvt_pk_bf16(y[4], y[5]); a.w = cvt_pk_bf16(y[6], y[7]);
    b.x = cvt_pk_bf16(y[8], y[9]); b.y = cvt_pk_bf16(y[10], y[11]); b.z = cvt_pk_bf16(y[12], y[13]); b.w = cvt_pk_bf16(y[14], y[15]);
}
__device__ __forceinline__ void unpack16(const u32x4 a, const u32x4 b, float (&y)[16]) {
    float t8[8]; unpack8(a, t8);
#pragma unroll
    for (int c = 0; c < 8; ++c) y[c] = t8[c];
    unpack8(b, t8);
#pragma unroll
    for (int c = 0; c < 8; ++c) y[8 + c] = t8[c];
}
__device__ __forceinline__ bf16x8 lds_frag16(const LAS unsigned char* p) { return *(const LAS bf16x8*)p; }
__device__ __forceinline__ bf16x8 lds_frag8x2(const LAS unsigned char* p0, const LAS unsigned char* p1) {
    const s16x4 a = *(const LAS s16x4*)p0, b = *(const LAS s16x4*)p1; return (bf16x8){a[0], a[1], a[2], a[3], b[0], b[1], b[2], b[3]};
}

constexpr int GA_GC = 0, GA_BT = 256, GA_CW = 512, GA_Q = GA_CW + 3 * 4 * 128 * 4, GA_K = GA_Q + 64 * 272, GA_LT = GA_K + 64 * 272, GA_END = GA_LT + 8 * 8192;
static_assert(GA_END <= 131072 && GA_LT % 16 == 0, "GDN phase A LDS map");
constexpr int GB_GC = 0, GB_BT = 256, GB_Q = 512, GB_KB = GB_Q + 64 * 272, GB_VB = GB_KB + 64 * 272, GB_KD = GB_VB + 64 * 272, GB_T = GB_KD + 128 * 144, GB_AT = GB_T + 64 * 144, GB_O = GB_AT + 64 * 144, GB_END = GB_O + 64 * 528;
static_assert(GB_END <= 131072 && GB_O % 16 == 0, "GDN phase B LDS map");

template <int I, int J> __device__ __forceinline__ void inv_row(float& s0, float& s1, const float lr, const float (&t)[64]) {
    if constexpr (J + 8 <= I) {
        int a0, a1, a2, a3, a4, a5, a6, a7;
        asm volatile("v_readlane_b32 %2, %10, %19\n\tv_readlane_b32 %3, %10, %19+1\n\tv_readlane_b32 %4, %10, %19+2\n\tv_readlane_b32 %5, %10, %19+3\n\t"
                     "v_readlane_b32 %6, %10, %19+4\n\tv_readlane_b32 %7, %10, %19+5\n\tv_readlane_b32 %8, %10, %19+6\n\tv_readlane_b32 %9, %10, %19+7\n\t"
                     "v_fma_f32 %0, -%11, %2, %0\n\tv_fma_f32 %1, -%12, %3, %1\n\tv_fma_f32 %0, -%13, %4, %0\n\tv_fma_f32 %1, -%14, %5, %1\n\t"
                     "v_fma_f32 %0, -%15, %6, %0\n\tv_fma_f32 %1, -%16, %7, %1\n\tv_fma_f32 %0, -%17, %8, %0\n\tv_fma_f32 %1, -%18, %9, %1"
                     : "+v"(s0), "+v"(s1), "=&s"(a0), "=&s"(a1), "=&s"(a2), "=&s"(a3), "=&s"(a4), "=&s"(a5), "=&s"(a6), "=&s"(a7)
                     : "v"(lr), "v"(t[J]), "v"(t[J + 1]), "v"(t[J + 2]), "v"(t[J + 3]), "v"(t[J + 4]), "v"(t[J + 5]), "v"(t[J + 6]), "v"(t[J + 7]), "i"(J));
        inv_row<I, J + 8>(s0, s1, lr, t);
    } else {
#pragma unroll
        for (int j = J; j < I; ++j) { const float lj = __int_as_float(__builtin_amdgcn_readlane(__float_as_int(lr), j)); if (j & 1) s1 -= lj * t[j]; else s0 -= lj * t[j]; }
    }
}
template <int I0> __device__ __forceinline__ void inv_rows8(const LAS float* Lp, const float flane, float (&t)[64]) {
    float lr[8];
#pragma unroll
    for (int k = 0; k < 8; ++k) lr[k] = Lp[((I0 + k) * (I0 + k - 1)) / 2];
#define INV_ROW(k) { float s0 = 1.f - fminf(fabsf(flane - (float)(I0 + k)), 1.f), s1 = 0.f; inv_row<I0 + k, 0>(s0, s1, lr[k], t); t[I0 + k] = s0 + s1; }
    INV_ROW(0) INV_ROW(1) INV_ROW(2) INV_ROW(3) INV_ROW(4) INV_ROW(5) INV_ROW(6) INV_ROW(7)
#undef INV_ROW
}

__device__ __forceinline__ void gdn_phase_a(bf16_t* H, const float* G, const float* BETA, const float* convw  , bf16_t* TG, bf16_t* ATT, LAS unsigned char* lds) {
    MK_IDS();
    LAS float* gcs = (LAS float*)(lds + GA_GC); LAS float* bts = (LAS float*)(lds + GA_BT); LAS float* cwl = (LAS float*)(lds + GA_CW);
    for (int bh = blockIdx.x; bh < 256; bh += gridDim.x) {
        const int b = bh >> 3, h = bh & 7;
        __syncthreads();
        for (int e = tid; e < 3 * 4 * 128; e += NTHR) { const int ten = e / 512, tap = (e >> 7) & 3, c = e & 127; cwl[e] = convw[tap * 3072 + ten * 1024 + h * 128 + c]; }
        __syncthreads();
        for (int sg = 3; sg >= 0; --sg) {
            for (int k = 7; k >= 0; --k) {
                const int n = sg * 8 + k, it = n * 256 + bh, m0 = b * T + n * 64;
                if (wid == 0) { const float g = G[(size_t)(m0 + lane) * 8 + h]; float c = g;
#pragma unroll
                    for (int o = 1; o < 64; o <<= 1) { const float t = __shfl_up(c, o); if (lane >= o) c += t; }
                    gcs[lane] = c; bts[lane] = BETA[(size_t)(m0 + lane) * 8 + h]; }
                const int r = tid >> 3, c0 = (tid & 7) * 16, t = n * 64 + r; bf16_t* hp = H + (size_t)(m0 + r) * GDN_NMAIN + h * 128 + c0;
                u32x4 st[6];
                {   float y[16];
                    conv_silu16(hp, t, cwl + c0, y);
                    { const float rinv = rsqrtf(sumsq16_8lanes(y) + RMS_EPS) * 0.08838834764831845f;
#pragma unroll
                      for (int c = 0; c < 16; ++c) y[c] *= rinv; pack16(y, st[0], st[1]); }
                    conv_silu16(hp + 1024, t, cwl + 512 + c0, y);
                    { const float rinv = rsqrtf(sumsq16_8lanes(y) + RMS_EPS);
#pragma unroll
                      for (int c = 0; c < 16; ++c) y[c] *= rinv; pack16(y, st[2], st[3]); }
                    conv_silu16(hp + 2048, t, cwl + 1024 + c0, y);
                    pack16(y, st[4], st[5]);
                    *(LAS u32x4*)(lds + GA_Q + r * 272 + c0 * 2) = st[0]; *(LAS u32x4*)(lds + GA_Q + r * 272 + c0 * 2 + 16) = st[1];
                    *(LAS u32x4*)(lds + GA_K + r * 272 + c0 * 2) = st[2]; *(LAS u32x4*)(lds + GA_K + r * 272 + c0 * 2 + 16) = st[3];
                }
                __syncthreads();
                *(u32x4*)hp = st[0]; *(u32x4*)(hp + 8) = st[1]; *(u32x4*)(hp + 1024) = st[2]; *(u32x4*)(hp + 1024 + 8) = st[3]; *(u32x4*)(hp + 2048) = st[4]; *(u32x4*)(hp + 2048 + 8) = st[5];
                {
                    const int which = wid >> 2, bi = (wid >> 1) & 1, bj = wid & 1, l31 = lane & 31, hi = lane >> 5;
                    LAS float* Lt = (LAS float*)(lds + GA_LT + k * 8192);
                    f32x16 acc = {};
                    if (!(bi == 0 && bj == 1)) {
                        const LAS unsigned char* ap = lds + (which ? GA_Q : GA_K) + (32 * bi + l31) * 272 + hi * 16;
                        const LAS unsigned char* bp = lds + GA_K + (32 * bj + l31) * 272 + hi * 16;
#pragma unroll
                        for (int ks = 0; ks < 8; ++ks) acc = __builtin_amdgcn_mfma_f32_32x32x16_bf16(lds_frag16(ap + ks * 32), lds_frag16(bp + ks * 32), acc, 0, 0, 0);
                    }
                    const int j = 32 * bj + l31; const float gcj = gcs[j];
#pragma unroll
                    for (int rr = 0; rr < 16; ++rr) { const int i = 32 * bi + crow(rr, hi); const float dec = __expf(fminf(gcs[i] - gcj, 0.f));
                        if (which == 0) { if (i > j) Lt[(i * (i - 1)) / 2 + j] = bts[i] * acc[rr] * dec; }
                        else ATT[((size_t)it * 64 + i) * 64 + j] = f2bf((i >= j) ? acc[rr] * dec : 0.f); }
                }
                __syncthreads();
            }
            {
                float t[64]; const float flane = (float)lane;
                const LAS float* Lp = (const LAS float*)(lds + GA_LT + wid * 8192) + lane; asm volatile("" : "+v"(Lp));
                inv_rows8<0>(Lp, flane, t); inv_rows8<8>(Lp, flane, t); inv_rows8<16>(Lp, flane, t); inv_rows8<24>(Lp, flane, t);
                inv_rows8<32>(Lp, flane, t); inv_rows8<40>(Lp, flane, t); inv_rows8<48>(Lp, flane, t); inv_rows8<56>(Lp, flane, t);
                bf16_t* tp = TG + (size_t)((sg * 8 + wid) * 256 + bh) * 4096 + lane;
#pragma unroll
                for (int i = 0; i < 64; ++i) tp[i * 64] = f2bf(t[i]);
            }
        }
    }
    __syncthreads();
}

__device__ __forceinline__ void gdn_phase_b(bf16_t* H, const float* G, const float* BETA, const float* normw  , const bf16_t* TG, const bf16_t* ATT, LAS unsigned char* lds) {
    MK_IDS();
    LAS float* gcs = (LAS float*)(lds + GB_GC); LAS float* bts = (LAS float*)(lds + GB_BT);
    const int n16 = lane & 15, q4 = lane >> 4;
    for (int bh = blockIdx.x; bh < 256; bh += gridDim.x) {
        const int b = bh >> 3, h = bh & 7;
        f32x4 S[8];
#pragma unroll
        for (int s = 0; s < 8; ++s) S[s] = (f32x4){0.f, 0.f, 0.f, 0.f};
        for (int n = 0; n < 32; ++n) {
            const int it = n * 256 + bh, m0 = b * T + n * 64;
            const int r = tid >> 3, c0 = (tid & 7) * 16; bf16_t* hp = H + (size_t)(m0 + r) * GDN_NMAIN + h * 128 + c0;
            const u32x4 q0 = *(const u32x4*)hp, q1 = *(const u32x4*)(hp + 8), k0 = *(const u32x4*)(hp + 1024), k1 = *(const u32x4*)(hp + 1024 + 8), v0 = *(const u32x4*)(hp + 2048), v1 = *(const u32x4*)(hp + 2048 + 8);
            const u32x4 tt = ((const u32x4*)(TG + (size_t)it * 4096))[tid], aa = ((const u32x4*)(ATT + (size_t)it * 4096))[tid];
            if (wid == 0) { float c = G[(size_t)(m0 + lane) * 8 + h];
#pragma unroll
                for (int o = 1; o < 64; o <<= 1) { const float t = __shfl_up(c, o); if (lane >= o) c += t; }
                gcs[lane] = c; bts[lane] = BETA[(size_t)(m0 + lane) * 8 + h]; }
            __syncthreads();
            const float glast = gcs[63];
            {   const float gcr = gcs[r], btr = bts[r], eg = __expf(gcr), ekd = __expf(glast - gcr);
                float y[16]; u32x4 a, bq;
                unpack16(q0, q1, y);
#pragma unroll
                for (int c = 0; c < 16; ++c) y[c] *= eg;
                pack16(y, a, bq); *(LAS u32x4*)(lds + GB_Q + r * 272 + c0 * 2) = a; *(LAS u32x4*)(lds + GB_Q + r * 272 + c0 * 2 + 16) = bq;
                unpack16(k0, k1, y);
#pragma unroll
                for (int c = 0; c < 16; ++c) *(LAS bf16_t*)(lds + GB_KD + (c0 + c) * 144 + r * 2) = f2bf(y[c] * ekd);
                { const float sc = btr * eg;
#pragma unroll
                  for (int c = 0; c < 16; ++c) y[c] *= sc; }
                pack16(y, a, bq); *(LAS u32x4*)(lds + GB_KB + r * 272 + c0 * 2) = a; *(LAS u32x4*)(lds + GB_KB + r * 272 + c0 * 2 + 16) = bq;
                unpack16(v0, v1, y);
#pragma unroll
                for (int c = 0; c < 16; ++c) y[c] *= btr;
                pack16(y, a, bq); *(LAS u32x4*)(lds + GB_VB + r * 272 + c0 * 2) = a; *(LAS u32x4*)(lds + GB_VB + r * 272 + c0 * 2 + 16) = bq;
                *(LAS u32x4*)(lds + GB_T + (tid >> 3) * 144 + (tid & 7) * 16) = tt;
                *(LAS u32x4*)(lds + GB_AT + (tid >> 3) * 144 + (tid & 7) * 16) = aa;
            }
            __syncthreads();
            {
                bf16x8 Sf[4];
#pragma unroll
                for (int ks = 0; ks < 4; ++ks) { u32x4 w; w.x = cvt_pk_bf16(S[2 * ks][0], S[2 * ks][1]); w.y = cvt_pk_bf16(S[2 * ks][2], S[2 * ks][3]);
                    w.z = cvt_pk_bf16(S[2 * ks + 1][0], S[2 * ks + 1][1]); w.w = cvt_pk_bf16(S[2 * ks + 1][2], S[2 * ks + 1][3]); Sf[ks] = __builtin_bit_cast(bf16x8, w); }
                f32x4 rr[4];
#pragma unroll
                for (int mt = 0; mt < 4; ++mt) {
                    const LAS unsigned char* vp = lds + GB_VB + (16 * mt + 4 * q4) * 272 + (16 * wid + n16) * 2;
                    rr[mt] = (f32x4){-bf2f(*(const LAS bf16_t*)vp), -bf2f(*(const LAS bf16_t*)(vp + 272)), -bf2f(*(const LAS bf16_t*)(vp + 544)), -bf2f(*(const LAS bf16_t*)(vp + 816))};
                    const LAS unsigned char* ap = lds + GB_KB + (16 * mt + n16) * 272 + 8 * q4;
#pragma unroll
                    for (int ks = 0; ks < 4; ++ks) rr[mt] = __builtin_amdgcn_mfma_f32_16x16x32_bf16(lds_frag8x2(ap + ks * 64, ap + ks * 64 + 32), Sf[ks], rr[mt], 0, 0, 0);
                }
                bf16x8 Rf[2];
#pragma unroll
                for (int kt = 0; kt < 2; ++kt) { u32x4 w; w.x = cvt_pk_bf16(-rr[2 * kt][0], -rr[2 * kt][1]); w.y = cvt_pk_bf16(-rr[2 * kt][2], -rr[2 * kt][3]);
                    w.z = cvt_pk_bf16(-rr[2 * kt + 1][0], -rr[2 * kt + 1][1]); w.w = cvt_pk_bf16(-rr[2 * kt + 1][2], -rr[2 * kt + 1][3]); Rf[kt] = __builtin_bit_cast(bf16x8, w); }
                f32x4 vn[4];
#pragma unroll
                for (int mt = 0; mt < 4; ++mt) { vn[mt] = (f32x4){0.f, 0.f, 0.f, 0.f};
                    const LAS unsigned char* tp = lds + GB_T + (16 * mt + n16) * 144 + 8 * q4;
#pragma unroll
                    for (int kt = 0; kt < 2; ++kt) if (kt == 0 || mt >= 2) vn[mt] = __builtin_amdgcn_mfma_f32_16x16x32_bf16(lds_frag8x2(tp + kt * 64, tp + kt * 64 + 32), Rf[kt], vn[mt], 0, 0, 0); }
                bf16x8 Vf[2];
#pragma unroll
                for (int kt = 0; kt < 2; ++kt) { u32x4 w; w.x = cvt_pk_bf16(vn[2 * kt][0], vn[2 * kt][1]); w.y = cvt_pk_bf16(vn[2 * kt][2], vn[2 * kt][3]);
                    w.z = cvt_pk_bf16(vn[2 * kt + 1][0], vn[2 * kt + 1][1]); w.w = cvt_pk_bf16(vn[2 * kt + 1][2], vn[2 * kt + 1][3]); Vf[kt] = __builtin_bit_cast(bf16x8, w); }
#pragma unroll
                for (int mt = 0; mt < 4; ++mt) {
                    f32x4 o = {0.f, 0.f, 0.f, 0.f};
                    const LAS unsigned char* qp = lds + GB_Q + (16 * mt + n16) * 272 + 8 * q4;
#pragma unroll
                    for (int ks = 0; ks < 4; ++ks) o = __builtin_amdgcn_mfma_f32_16x16x32_bf16(lds_frag8x2(qp + ks * 64, qp + ks * 64 + 32), Sf[ks], o, 0, 0, 0);
                    const LAS unsigned char* atp = lds + GB_AT + (16 * mt + n16) * 144 + 8 * q4;
#pragma unroll
                    for (int kt = 0; kt < 2; ++kt) if (kt == 0 || mt >= 2) o = __builtin_amdgcn_mfma_f32_16x16x32_bf16(lds_frag8x2(atp + kt * 64, atp + kt * 64 + 32), Vf[kt], o, 0, 0, 0);
#pragma unroll
                    for (int i = 0; i < 4; ++i) *(LAS float*)(lds + GB_O + (16 * mt + 4 * q4 + i) * 528 + (16 * wid + n16) * 4) = o[i];
                }
                const float eg = __expf(glast);
#pragma unroll
                for (int st = 0; st < 8; ++st) { S[st] = S[st] * eg;
                    const LAS unsigned char* kp = lds + GB_KD + (16 * st + n16) * 144 + 8 * q4;
#pragma unroll
                    for (int kt = 0; kt < 2; ++kt) S[st] = __builtin_amdgcn_mfma_f32_16x16x32_bf16(lds_frag8x2(kp + kt * 64, kp + kt * 64 + 32), Vf[kt], S[st], 0, 0, 0); }
            }
            __syncthreads();
            {
                float o[16];
#pragma unroll
                for (int q = 0; q < 4; ++q) { const f32x4 v = *(const LAS f32x4*)(lds + GB_O + r * 528 + (c0 + 4 * q) * 4); o[4 * q] = v[0]; o[4 * q + 1] = v[1]; o[4 * q + 2] = v[2]; o[4 * q + 3] = v[3]; }
                const float rstd = rsqrtf(sumsq16_8lanes(o) * (1.f / 128.f) + RMS_EPS);
                float gt[16]; unpack16(*(const u32x4*)(hp + 3072), *(const u32x4*)(hp + 3072 + 8), gt);
                float res[16];
#pragma unroll
                for (int c = 0; c < 16; ++c) res[c] = o[c] * rstd * normw[c0 + c] * silu(gt[c]);
                u32x4 a, bq; pack16(res, a, bq);
                *(u32x4*)(hp + 2048) = a; *(u32x4*)(hp + 2048 + 8) = bq;
            }
        }
        __syncthreads();
    }
}

__device__ __forceinline__ void diff_prep_phase(bf16_t* H  , const int* positions, bf16_t* VT  , LAS unsigned char* lds) {
    MK_IDS();
    for (int item = gt; item < M * 4; item += NGT) {
        const int m = item >> 2, g4 = item & 3; const float pos = (float)positions[m];
        float cs[8], sn[8];
#pragma unroll
        for (int e = 0; e < 8; ++e) { const float inv = exp2f(-(float)(8 * g4 + e) * (13.287712379549449f / 32.f)); sincosf(pos * inv, &sn[e], &cs[e]); }
        bf16_t* rowp = H + (size_t)m * DIFF_N + 8 * g4;
#pragma unroll 4
        for (int blk = 0; blk < 32; ++blk) {
            bf16_t* p1 = rowp + (blk >> 4) * 1024 + (blk & 15) * 64; const float sc = (blk < 16) ? 0.125f * LOG2E : 1.f;
            float x1[8], x2[8], y1[8], y2[8]; unpack8(*(const u32x4*)p1, x1); unpack8(*(const u32x4*)(p1 + 32), x2);
#pragma unroll
            for (int e = 0; e < 8; ++e) { y1[e] = (x1[e] * cs[e] - x2[e] * sn[e]) * sc; y2[e] = (x2[e] * cs[e] + x1[e] * sn[e]) * sc; }
            *(u32x4*)p1 = pack8(y1); *(u32x4*)(p1 + 32) = pack8(y2);
        }
    }
    LAS unsigned char* scr = lds + wid * 16384;
    for (int item = gw; item < NB * 32 * 16; item += NGW) {
        const int dvh = item & 1, h = (item >> 1) & 7, tb = (item >> 4) & 31, b = item >> 9;
        const bf16_t* src = H + ((size_t)b * T + tb * 64) * DIFF_N + 2048 + h * 128 + dvh * 64;
#pragma unroll
        for (int i = 0; i < 8; ++i) { const int row = (lane >> 3) + 8 * i, ch = lane & 7; *(LAS u32x4*)(scr + row * 144 + ch * 16) = *(const u32x4*)(src + (size_t)row * DIFF_N + ch * 8); }
        LDS_WAIT();
        bf16_t* dst = VT + (((size_t)b * 8 + h) * 128 + dvh * 64 + lane) * T + tb * 64;
#pragma unroll
        for (int k = 0; k < 8; ++k) { unsigned short v[8];
#pragma unroll
            for (int e = 0; e < 8; ++e) v[e] = *(const LAS bf16_t*)(scr + (8 * k + e) * 144 + lane * 2);
            u32x4 w; w.x = v[0] | ((unsigned)v[1] << 16); w.y = v[2] | ((unsigned)v[3] << 16); w.z = v[4] | ((unsigned)v[5] << 16); w.w = v[6] | ((unsigned)v[7] << 16);
            *(u32x4*)(dst + 8 * k) = w; }
        LDS_WAIT();
    }
}

constexpr int AT_STAGE = 36864, AT_K = 0, AT_V = 64 * 272;
__device__ __forceinline__ void diff_attn_phase(const bf16_t* H, const bf16_t* VT, bf16_t* O, const float* lq1, const float* lk1, const float* lq2, const float* lk2, const float* subw, float lambda_init,
                                                LAS unsigned char* lds) {
    MK_IDS();
    const float lam = __expf(wave_sum(lq1[lane] * lk1[lane])) - __expf(wave_sum(lq2[lane] * lk2[lane])) + lambda_init;
    const int c = wid >> 2, rg = wid & 3, l31 = lane & 31, hi = lane >> 5;
    for (int bh = blockIdx.x; bh < 256; bh += gridDim.x) {
        const int b = bh >> 3, h = bh & 7;
        const bf16_t* Kg = H + (size_t)b * T * DIFF_N + 1024 + h * 128;
        const bf16_t* Vg = VT + (size_t)bh * 128 * T;
        for (int ui = 0; ui < 16; ++ui) {
            const int qb = (ui & 1) ? (15 - (ui >> 1)) : (ui >> 1);
            const int q0w = 128 * qb + 32 * rg, nt = 2 * qb + 2;
            bf16x8 qf[4];
            { const bf16_t* qp = H + ((size_t)b * T + q0w + l31) * DIFF_N + h * 128 + c * 64 + 8 * hi;
#pragma unroll
              for (int d0 = 0; d0 < 4; ++d0) qf[d0] = *(const bf16x8*)(qp + 16 * d0); }
            f32x16 o[4];
#pragma unroll
            for (int d = 0; d < 4; ++d) o[d] = (f32x16){};
            float mrun = -1e30f, lrun = 0.f;
            u32x4 pk[2], pv[2];
#define AT_LOAD(j) do { _Pragma("unroll") for (int i_ = 0; i_ < 2; ++i_) { const int ci = tid + 512 * i_; \
                pk[i_] = *(const u32x4*)(Kg + (size_t)((j) * 64 + (ci >> 4)) * DIFF_N + (ci & 15) * 8); \
                pv[i_] = *(const u32x4*)(Vg + (size_t)(ci >> 3) * T + (j) * 64 + (ci & 7) * 8); } } while (0)
            AT_LOAD(0);
            for (int j = 0; j < nt; ++j) {
                LAS unsigned char* st = lds + (j & 1) * AT_STAGE;
#pragma unroll
                for (int i_ = 0; i_ < 2; ++i_) { const int ci = tid + 512 * i_;
                    *(LAS u32x4*)(st + AT_K + (ci >> 4) * 272 + (ci & 15) * 16) = pk[i_];
                    *(LAS u32x4*)(st + AT_V + (ci >> 3) * 144 + (ci & 7) * 16) = pv[i_]; }
                __syncthreads();
                if (j + 1 < nt) AT_LOAD(j + 1);
                if (64 * j <= q0w + 31) {
                    f32x16 p[2];
#pragma unroll
                    for (int kb = 0; kb < 2; ++kb) { p[kb] = (f32x16){};
                        const LAS unsigned char* kp = st + AT_K + (32 * kb + l31) * 272 + c * 128 + hi * 16;
#pragma unroll
                        for (int d0 = 0; d0 < 4; ++d0) p[kb] = __builtin_amdgcn_mfma_f32_32x32x16_bf16(lds_frag16(kp + d0 * 32), qf[d0], p[kb], 0, 0, 0); }
                    if (64 * j + 63 > q0w) {
                        const int q = q0w + l31;
#pragma unroll
                        for (int kb = 0; kb < 2; ++kb)
#pragma unroll
                            for (int r = 0; r < 16; ++r) { const int kv = 64 * j + 32 * kb + crow(r, hi); if (kv > q) p[kb][r] = -1e30f; }
                    }
                    float mx = p[0][0];
#pragma unroll
                    for (int kb = 0; kb < 2; ++kb)
#pragma unroll
                        for (int r = 0; r < 16; ++r) mx = fmaxf(mx, p[kb][r]);
                    mx = fmaxf(mx, __shfl_xor(mx, 32));
                    const float mnew = fmaxf(mrun, mx), al = exp2f(mrun - mnew); mrun = mnew;
                    float ls = 0.f;
#pragma unroll
                    for (int kb = 0; kb < 2; ++kb)
#pragma unroll
                        for (int r = 0; r < 16; ++r) { p[kb][r] = exp2f(p[kb][r] - mnew); ls += p[kb][r]; }
                    lrun = lrun * al + ls;
#pragma unroll
                    for (int d = 0; d < 4; ++d) o[d] = o[d] * al;
#pragma unroll
                    for (int kb = 0; kb < 2; ++kb)
#pragma unroll
                        for (int s = 0; s < 2; ++s) {
                            u32x4 w; w.x = cvt_pk_bf16(p[kb][8 * s], p[kb][8 * s + 1]); w.y = cvt_pk_bf16(p[kb][8 * s + 2], p[kb][8 * s + 3]);
                            w.z = cvt_pk_bf16(p[kb][8 * s + 4], p[kb][8 * s + 5]); w.w = cvt_pk_bf16(p[kb][8 * s + 6], p[kb][8 * s + 7]);
                            const bf16x8 pf = __builtin_bit_cast(bf16x8, w);
                            const LAS unsigned char* vp = st + AT_V + l31 * 144 + (32 * kb + 16 * s + 4 * hi) * 2;
#pragma unroll
                            for (int d = 0; d < 4; ++d) o[d] = __builtin_amdgcn_mfma_f32_32x32x16_bf16(lds_frag8x2(vp + d * 32 * 144, vp + d * 32 * 144 + 16), pf, o[d], 0, 0, 0);
                        }
                }
            }
#undef AT_LOAD
            const float ltot = lrun + __shfl_xor(lrun, 32);
            const float inv = (c ? lam : 1.f) / ltot;
            __syncthreads();
            LAS float* xch = (LAS float*)lds + rg * 4096;
            if (c == 1) {
#pragma unroll
                for (int d = 0; d < 4; ++d)
#pragma unroll
                    for (int r = 0; r < 16; ++r) xch[(d * 16 + r) * 64 + lane] = o[d][r] * inv;
            }
            __syncthreads();
            if (c == 0) {
                float ss = 0.f;
#pragma unroll
                for (int d = 0; d < 4; ++d)
#pragma unroll
                    for (int r = 0; r < 16; ++r) { const float v = o[d][r] * inv - xch[(d * 16 + r) * 64 + lane]; o[d][r] = v; ss += v * v; }
                ss += __shfl_xor(ss, 32);
                const float rstd = rsqrtf(ss * (1.f / 128.f) + RMS_EPS) * (1.f - lambda_init);
                bf16_t* op = O + ((size_t)b * T + q0w + l31) * D + h * 128 + 4 * hi;
#pragma unroll
                for (int d = 0; d < 4; ++d)
#pragma unroll
                    for (int g = 0; g < 4; ++g) { const int dv = 32 * d + 8 * g + 4 * hi; const f32x4 sw = *(const f32x4*)(subw + dv);
                        u32x2 w; w.x = cvt_pk_bf16(o[d][4 * g] * rstd * sw[0], o[d][4 * g + 1] * rstd * sw[1]); w.y = cvt_pk_bf16(o[d][4 * g + 2] * rstd * sw[2], o[d][4 * g + 3] * rstd * sw[3]);
                        *(u32x2*)(op + 32 * d + 8 * g) = w; }
            }
            __syncthreads();
        }
    }
}

__global__ void __launch_bounds__(NTHR, 2) fwd_megakernel(Params p) {
    extern __shared__ __attribute__((aligned(16))) unsigned char lds_raw[];
    LAS unsigned char* lds = (LAS unsigned char*)lds_raw;
    cg::grid_group grid = cg::this_grid();
    volatile LAS unsigned* bst = (volatile LAS unsigned*)(lds + 131072 + 1024);
    if (threadIdx.x < 2) bst[threadIdx.x] = 0u;
    __syncthreads();
    const XcdBarrier xbar = xcd_barrier_post((unsigned*)p.ws, bst);
    const int G = gridDim.x;
    unsigned char* ws = p.ws; unsigned char* wsw = ws + WS_W;
    bf16_t* XN = (bf16_t*)(ws + WS_XN); bf16_t* Hb = (bf16_t*)(ws + WS_H);
    float* Gb = (float*)(ws + WS_GB); float* BETAb = Gb + (size_t)M * 8;

#ifndef NO_PRO
    REPS(4) prologue(p, lds);
#endif
    grid.sync();
    for (int layer = 0; layer < DEPTH; ++layer) {
        const int j = layer >> 1;
        const float* resid = (layer == 0) ? p.in[0] : p.out;
        if ((layer & 1) == 0) {
            {   pg8::Gemm g{XN, (const bf16_t*)(wsw + W_GWIN) + (size_t)j * 4096 * 1024, M, GDN_NMAIN, D, D}; pg8::StaticOrder S; S.init(M, GDN_NMAIN, G, (int)blockIdx.x);
                pg8::EpiBf16 E{Hb, GDN_NMAIN};
                REPS(1) PH_GEMMB pg8::gemm_phase<pg8::EpiBf16, pg8::StaticOrder, true, true, D, D>(lds, g, S, E); }
#ifndef NO_AB
            REPS(4) gdn_ab_phase(XN, (const bf16_t*)(wsw + W_GWAB) + (size_t)j * 16 * 1024, p.in[4] + j * 8, p.in[5] + j * 8, Gb, BETAb);
#endif
            xcd_barrier(xbar);
#ifndef NO_GA
            gdn_phase_a(Hb, Gb, BETAb, p.in[3] + (size_t)j * 4 * 3072, (bf16_t*)(ws + WS_XN) + (size_t)32 * 1024 * 1024, (bf16_t*)(ws + WS_XN), lds);
#endif
            xcd_barrier(xbar);
#ifndef NO_GB
            gdn_phase_b(Hb, Gb, BETAb, p.in[6] + j * 128, (const bf16_t*)(ws + WS_XN) + (size_t)32 * 1024 * 1024, (const bf16_t*)(ws + WS_XN), lds);
#endif
            xcd_barrier(xbar);
            {   pg8::Gemm g{Hb + 2048, (const bf16_t*)(wsw + W_GWOUT) + (size_t)j * 1024 * 1024, M, D, D, GDN_NMAIN}; pg8::StaticOrder S; S.init(M, D, G, (int)blockIdx.x);
                pg8::EpiResid E{resid, p.out, D, ALPHA};
                PH_GEMMR pg8::gemm_phase<pg8::EpiResid, pg8::StaticOrder, true, true, D, GDN_NMAIN>(lds, g, S, E); }
        } else {
            const float lambda_init = 0.8f - 0.6f * expf(-0.3f * (float)layer);
            {   pg8::Gemm g{XN, (const bf16_t*)(wsw + W_DWIN) + (size_t)j * 3072 * 1024, M, DIFF_N, D, D}; pg8::StaticOrder S; S.init(M, DIFF_N, G, (int)blockIdx.x);
                pg8::EpiBf16 E{Hb, DIFF_N};
                REPS(1) PH_GEMMB pg8::gemm_phase<pg8::EpiBf16, pg8::StaticOrder, true, true, D, D>(lds, g, S, E); }
            xcd_barrier(xbar);
#ifndef NO_PREP
            diff_prep_phase(Hb, p.positions, (bf16_t*)(ws + WS_VT), lds);
#endif
            xcd_barrier(xbar);
#ifndef NO_ATT
            REPS(3) diff_attn_phase(Hb, (const bf16_t*)(ws + WS_VT), (bf16_t*)(ws + WS_O), p.in[9] + j * 64, p.in[10] + j * 64, p.in[11] + j * 64, p.in[12] + j * 64, p.in[13] + j * 128, lambda_init, lds);
#endif
            xcd_barrier(xbar);
            {   pg8::Gemm g{(const bf16_t*)(ws + WS_O), (const bf16_t*)(wsw + W_DWOUT) + (size_t)j * 1024 * 1024, M, D, D, D}; pg8::StaticOrder S; S.init(M, D, G, (int)blockIdx.x);
                pg8::EpiResid E{resid, p.out, D, ALPHA};
                PH_GEMMR pg8::gemm_phase<pg8::EpiResid, pg8::StaticOrder, true, true, D, D>(lds, g, S, E); }
        }
        xcd_barrier(xbar);
#ifndef NO_LN
        ln_phase(p.out, XN, p.in[19] + layer * D, p.in[20] + layer * D);
#endif
        xcd_barrier(xbar);
        {
            bf16_t* ACT = (bf16_t*)(ws + WS_ACT); float* HALO = (float*)(ws + WS_HALO); float* HALO2 = (float*)(ws + WS_HALO2);
            const float* fcw = p.in[16] + (size_t)layer * 3 * FFN_N; const float* fcb = p.in[17] + (size_t)layer * FFN_N;
            {   pg8::Gemm g{XN, (const bf16_t*)(wsw + W_FUP) + (size_t)layer * 5632 * 1024, M, FFN_N, D, D}; pg8::StaticOrder S; S.init(M, FFN_N, G, (int)blockIdx.x);
                pg8::EpiFfnAct E{ACT, fcw, fcb, HALO, HALO2, (LAS float*)(lds + 131072 + 2048)};
                pg8::gemm_phase<pg8::EpiFfnAct, pg8::StaticOrder, true, true, D, D>(lds, g, S, E); }
            xcd_barrier(xbar);
            ffn_fixup_phase(ACT, HALO, HALO2, fcw, fcb);
            xcd_barrier(xbar);
            {   pg8::Gemm g{ACT, (const bf16_t*)(wsw + W_FDOWN) + (size_t)layer * 1024 * 2816, M, D, FFN_H, FFN_H}; pg8::StaticOrder S; S.init(M, D, G, (int)blockIdx.x);
                pg8::EpiResid E{p.out, p.out, D, ALPHA};
                pg8::gemm_phase<pg8::EpiResid, pg8::StaticOrder, true, true, FFN_H, FFN_H>(lds, g, S, E); }
        }
        xcd_barrier(xbar);
#ifndef NO_LN
        ln_phase(p.out, XN, p.in[21] + layer * D, p.in[22] + layer * D);
        if (PROBE_REP == 5) { for (int e_ = 0; e_ < 12; ++e_) xcd_barrier(xbar); }
#endif
        xcd_barrier(xbar);
    }
}
}

extern "C" void kernel_launch(void* const* d_in, const int* in_sizes, int n_in, void* d_out, int out_size, void* d_ws, size_t ws_size, hipStream_t stream) {
    static int grid = 0;
    if (grid == 0) {
        if (n_in != 23 || ws_size < mk::WS_END) { fprintf(stderr, "kernel_launch: unexpected n_in %d / ws_size %zu (need %zu)\n", n_in, ws_size, (size_t)mk::WS_END); grid = -1; return; }
        int dev = 0, cus = 0, per_cu = 0;
        hipGetDevice(&dev); hipDeviceGetAttribute(&cus, hipDeviceAttributeMultiprocessorCount, dev);
        if (hipFuncSetAttribute((const void*)mk::fwd_megakernel, hipFuncAttributeMaxDynamicSharedMemorySize, mk::LDS_BYTES) != hipSuccess) { fprintf(stderr, "kernel_launch: hipFuncSetAttribute failed\n"); grid = -1; return; }
        if (hipOccupancyMaxActiveBlocksPerMultiprocessor(&per_cu, (const void*)mk::fwd_megakernel, mk::NTHR, mk::LDS_BYTES) != hipSuccess || per_cu < 1) { fprintf(stderr, "kernel_launch: occupancy query gave %d\n", per_cu); per_cu = 1; }
        (void)hipGetLastError();
        grid = cus * per_cu;
        fprintf(stderr, "kernel_launch: grid %d (cus %d x %d)\n", grid, cus, per_cu);
    }
    if (grid < 0) return;
    mk::Params p{};
    for (int i = 0; i < 23; ++i) p.in[i] = (const float*)d_in[i];
    p.positions = (const int*)d_in[1]; p.out = (float*)d_out; p.ws = (unsigned char*)d_ws;
    if (hipMemsetAsync(d_ws, 0, 16384, stream) != hipSuccess) { fprintf(stderr, "kernel_launch: memset failed\n"); return; }
    void* args[] = {&p};
    hipError_t e = hipLaunchCooperativeKernel((const void*)mk::fwd_megakernel, dim3(grid), dim3(mk::NTHR), args, mk::LDS_BYTES, stream);
    if (e != hipSuccess) fprintf(stderr, "cooperative launch failed: %s (grid %d)\n", hipGetErrorString(e), grid);
}
```

```cpp
#include <hip/hip_runtime.h>
#include <hip/hip_cooperative_groups.h>
#include <cstdio>
#include <cstdint>
namespace cg = cooperative_groups;
#ifndef PROBE_REP
#define PROBE_REP 0
#endif
#define REPS(k) for (int rep_ = 0; rep_ < ((PROBE_REP) == (k) ? 2 : 1); ++rep_)
namespace pg8 {
#define PG8_LAS __attribute__((address_space(3)))
typedef unsigned short bf16_t;
typedef short bf16x8 __attribute__((ext_vector_type(8)));
typedef float f32x4 __attribute__((ext_vector_type(4)));
typedef unsigned u32x4 __attribute__((ext_vector_type(4)));
constexpr int BM = 256, BK = 64, HALF = 128, HTB = HALF * BK * 2  , STAGE_BYTES = 8 * HTB, NXCD = 8, WGM = 8;

__host__ __device__ __forceinline__ int lds_byte(int r, int c) { const int st = (r >> 4) * 2 + (c >> 5), rr = r & 15, cc = c & 31, ob = rr * 64 + cc * 2; return st * 1024 + (ob ^ (((ob >> 9) & 1) << 5)); }
__host__ __device__ __forceinline__ void stage_rc(int b, int& R, int& C) { const int st = b / 1024, sb = b % 1024, swz = sb ^ (((sb >> 9) & 1) << 5); R = (st >> 1) * 16 + swz / 64; C = (st & 1) * 32 + (swz % 64) / 2; }
__host__ __device__ __forceinline__ int perm32(int rho) { const int n = rho >> 4, i = rho & 15; return 8 * (i >> 2) + 4 * n + (i & 3); }

struct Unit { int pm, pn; };
struct Gemm { const bf16_t* A; const bf16_t* Bt; int M, N, K, lda; };

struct StaticOrder {
    int nM, nN, nwg, G, c;
    __host__ __device__ void init(int M, int N, int G_, int c_) { nM = M / BM; nN = N / BM; nwg = nM * nN; G = G_; c = c_; }
    __host__ __device__ bool next(int i, Unit& u) const {
        const long L = (long)i * G + c; if (L >= nwg) return false;
        int wgid = (int)L; { const int q = nwg / NXCD, r = nwg % NXCD, xcd = wgid % NXCD, off = wgid / NXCD; wgid = (xcd < r ? xcd * (q + 1) : r * (q + 1) + (xcd - r) * q) + off; }
        const int nig = WGM * nN, gid = wgid / nig, fm = gid * WGM, gsz = (nM - fm) < WGM ? (nM - fm) : WGM;
        u.pm = fm + ((wgid % nig) % gsz); u.pn = (wgid % nig) / gsz; return true;
    }
    __device__ __forceinline__ void a_ready(const Unit&) const {}
    __device__ __forceinline__ void done(const Unit&) const {}
};
typedef float f32x2 __attribute__((ext_vector_type(2)));
typedef __bf16 bf16x2v __attribute__((ext_vector_type(2)));
__device__ __forceinline__ unsigned cvt_pk_bf16(float lo, float hi) { f32x2 v = {lo, hi}; bf16x2v b = __builtin_convertvector(v, bf16x2v); return __builtin_bit_cast(unsigned, b); }

struct EpiBf16 {
    static constexpr bool PERM = true, AFTER_DRAIN = false;
    bf16_t* O; int ldc;
    __device__ __forceinline__ void operator()(const f32x4 (&acc)[2][2][4][2], const Unit& u, int wr, int wc, int fr, int fq) const {
        const int row0 = u.pm * BM + wr * 64 + fr; const int col0 = u.pn * BM + wc * 32 + 8 * fq;
#pragma unroll
        for (int ai = 0; ai < 2; ++ai)
#pragma unroll
            for (int m = 0; m < 4; ++m) { bf16_t* rowp = O + (size_t)(row0 + ai * HALF + m * 16) * ldc + col0;
#pragma unroll
                for (int bj = 0; bj < 2; ++bj) { const f32x4 v0 = acc[ai][bj][m][0], v1 = acc[ai][bj][m][1];
                    u32x4 w; w.x = cvt_pk_bf16(v0[0], v0[1]); w.y = cvt_pk_bf16(v0[2], v0[3]); w.z = cvt_pk_bf16(v1[0], v1[1]); w.w = cvt_pk_bf16(v1[2], v1[3]);
                    *(u32x4*)(rowp + bj * HALF) = w; } }
    }
};
struct EpiResid {
    static constexpr bool PERM = false, AFTER_DRAIN = false;
    const float* base; float* out; int ldc; float alpha;
    __device__ __forceinline__ void operator()(const f32x4 (&acc)[2][2][4][2], const Unit& u, int wr, int wc, int fr, int fq) const {
        const int col0 = u.pn * BM + wc * 32 + 4 * fq;
#pragma unroll
        for (int ai = 0; ai < 2; ++ai)
#pragma unroll
            for (int m = 0; m < 4; ++m) { const int r = ai * HALF + wr * 64 + m * 16 + fr; const size_t off = (size_t)(u.pm * BM + r) * ldc + col0;
#pragma unroll
                for (int bj = 0; bj < 2; ++bj)
#pragma unroll
                    for (int n = 0; n < 2; ++n) { const f32x4 bs = *(const f32x4*)(base + off + bj * HALF + n * 16); const f32x4 o = bs * alpha + acc[ai][bj][m][n];
                        *(f32x4*)(out + off + bj * HALF + n * 16) = o; }
                asm volatile("" ::: "memory"); }
    }
};

struct EpiResidLn {
    static constexpr bool PERM = false, AFTER_DRAIN = false;
    const float* base; float* out; bf16_t* xn; const float* g; const float* b; float alpha, eps;
    unsigned* xbuf;
    unsigned* cnt;
    PG8_LAS float* sl;
    __device__ __forceinline__ void operator()(f32x4 (&acc)[2][2][4][2], const Unit& u, int wr, int wc, int fr_, int fq_) const {
        typedef unsigned u32x2 __attribute__((ext_vector_type(2)));
        int fr = fr_, fq = fq_; asm volatile("" : "+v"(fr), "+v"(fq));
        const int col0 = u.pn * BM + wc * 32 + 4 * fq;
        const int lane = fq * 16 + fr, wid = wr * 4 + wc, tid = wid * 64 + lane;
#pragma unroll
        for (int ai = 0; ai < 2; ++ai)
#pragma unroll
            for (int m = 0; m < 4; ++m) { const int r = ai * HALF + wr * 64 + m * 16 + fr; const size_t off = (size_t)(u.pm * BM + r) * 1024 + col0;
                float s = 0.f, q = 0.f;
#pragma unroll
                for (int bj = 0; bj < 2; ++bj)
#pragma unroll
                    for (int n = 0; n < 2; ++n) { const f32x4 bs = *(const f32x4*)(base + off + bj * HALF + n * 16); const f32x4 y = bs * alpha + acc[ai][bj][m][n]; acc[ai][bj][m][n] = y;
                        s += (y[0] + y[1]) + (y[2] + y[3]); q += (y[0] * y[0] + y[1] * y[1]) + (y[2] * y[2] + y[3] * y[3]); }
                s += __shfl_xor(s, 16); s += __shfl_xor(s, 32); q += __shfl_xor(q, 16); q += __shfl_xor(q, 32);
                if (fq == 0) { sl[(r * 4 + wc) * 2] = s; sl[(r * 4 + wc) * 2 + 1] = q; }
                asm volatile("" ::: "memory"); }
        asm volatile("s_waitcnt lgkmcnt(0)" ::: "memory"); __builtin_amdgcn_s_barrier(); asm volatile("" ::: "memory");
        if (tid < 256) {
            const PG8_LAS f32x4* pp = (const PG8_LAS f32x4*)(sl + tid * 8); const f32x4 p0 = pp[0], p1 = pp[1];
            const float S = (p0[0] + p0[2]) + (p1[0] + p1[2]), Q = (p0[1] + p0[3]) + (p1[1] + p1[3]);
            unsigned* xp = xbuf + (((size_t)u.pm * 4 + u.pn) * 256 + tid) * 2;
            __hip_atomic_store(xp, __float_as_uint(S), __ATOMIC_RELAXED, __HIP_MEMORY_SCOPE_AGENT); __hip_atomic_store(xp + 1, __float_as_uint(Q), __ATOMIC_RELAXED, __HIP_MEMORY_SCOPE_AGENT);
            asm volatile("s_waitcnt vmcnt(0)" ::: "memory");
            if (lane == 0) __hip_atomic_fetch_add(cnt + 16 * u.pm, 1u, __ATOMIC_RELAXED, __HIP_MEMORY_SCOPE_AGENT);
        }
        if (wid == 0) {
            unsigned sp = 0;
            while ((unsigned)__builtin_amdgcn_readfirstlane(__hip_atomic_load(cnt + 16 * u.pm, __ATOMIC_RELAXED, __HIP_MEMORY_SCOPE_AGENT)) < 16u) { __builtin_amdgcn_s_sleep(2); if (++sp > (1u << 22)) break; }
            __builtin_amdgcn_fence(__ATOMIC_ACQUIRE, "agent");
        }
        asm volatile("s_waitcnt vmcnt(0) lgkmcnt(0)" ::: "memory"); __builtin_amdgcn_s_barrier(); asm volatile("" ::: "memory");
        if (tid < 256) {
            float S = 0.f, Q = 0.f;
#pragma unroll
            for (int t = 0; t < 4; ++t) { unsigned* xp = xbuf + (((size_t)u.pm * 4 + t) * 256 + tid) * 2;
                S += __uint_as_float(__hip_atomic_load(xp, __ATOMIC_RELAXED, __HIP_MEMORY_SCOPE_AGENT)); Q += __uint_as_float(__hip_atomic_load(xp + 1, __ATOMIC_RELAXED, __HIP_MEMORY_SCOPE_AGENT)); }
            const float mean = S * (1.f / 1024.f), var = fmaxf(Q * (1.f / 1024.f) - mean * mean, 0.f);
            sl[2048 + tid * 2] = mean; sl[2048 + tid * 2 + 1] = 1.f / sqrtf(var + eps);
        }
        asm volatile("s_waitcnt lgkmcnt(0)" ::: "memory"); __builtin_amdgcn_s_barrier(); asm volatile("" ::: "memory");
#pragma unroll
        for (int bj = 0; bj < 2; ++bj)
#pragma unroll
            for (int n = 0; n < 2; ++n) {
                const f32x4 gv = *(const f32x4*)(g + col0 + bj * HALF + n * 16), bv = *(const f32x4*)(b + col0 + bj * HALF + n * 16);
#pragma unroll
                for (int ai = 0; ai < 2; ++ai)
#pragma unroll
                    for (int m = 0; m < 4; ++m) { const int r = ai * HALF + wr * 64 + m * 16 + fr; const size_t off = (size_t)(u.pm * BM + r) * 1024 + col0 + bj * HALF + n * 16;
                        const float mean = sl[2048 + r * 2], rstd = sl[2048 + r * 2 + 1];
                        const f32x4 o = (acc[ai][bj][m][n] - mean) * rstd * gv + bv;
                        *(f32x4*)(out + off) = o;
                        u32x2 w; w.x = cvt_pk_bf16(o[0], o[1]); w.y = cvt_pk_bf16(o[2], o[3]); *(u32x2*)(xn + off) = w; }
                asm volatile("" ::: "memory");
            }
    }
};

__device__ __forceinline__ float dpp_ror1(float v) { float r; asm volatile("s_nop 1\n\tv_mov_b32_dpp %0, %1 row_ror:1 row_mask:0xf bank_mask:0xf" : "=&v"(r) : "v"(v)); return r; }
__device__ __forceinline__ float dpp_ror2(float v) { float r; asm volatile("s_nop 1\n\tv_mov_b32_dpp %0, %1 row_ror:2 row_mask:0xf bank_mask:0xf" : "=&v"(r) : "v"(v)); return r; }
__device__ __forceinline__ float silu_f(float x) { return x * __builtin_amdgcn_rcpf(1.f + __expf(-x)); }
struct EpiFfnAct {
    static constexpr bool PERM = true, AFTER_DRAIN = false;
    bf16_t* ACT; const float* cw; const float* cb; float* HALO; float* HALO2; PG8_LAS float* hl;
    __device__ __forceinline__ void operator()(const f32x4 (&acc)[2][2][4][2], const Unit& u, int wr, int wc, int fr_, int fq_) const {
        int fr = fr_, fq = fq_; asm volatile("" : "+v"(fr), "+v"(fq));
        const int cc0 = wc * 32 + 8 * fq, colA = u.pn * 128 + cc0;
        if (fr >= 14) {
#pragma unroll
            for (int ai = 0; ai < 2; ++ai) { PG8_LAS float* hp = hl + ((2 * ai + wr) * 2 + (fr - 14)) * 256 + cc0;
#pragma unroll
                for (int bj = 0; bj < 2; ++bj)
#pragma unroll
                    for (int n = 0; n < 2; ++n) *(PG8_LAS f32x4*)(hp + bj * 128 + 4 * n) = acc[ai][bj][3][n]; }
            if (wr == 1) { float* gp = HALO + ((size_t)u.pm * 2 + (fr - 14)) * 5632 + colA;
#pragma unroll
                for (int bj = 0; bj < 2; ++bj)
#pragma unroll
                    for (int n = 0; n < 2; ++n) *(f32x4*)(gp + bj * 2816 + 4 * n) = acc[1][bj][3][n]; }
        }
        if (fr < 2 && wr == 0) { float* gp = HALO2 + ((size_t)u.pm * 2 + fr) * 5632 + colA;
#pragma unroll
            for (int bj = 0; bj < 2; ++bj)
#pragma unroll
                for (int n = 0; n < 2; ++n) *(f32x4*)(gp + bj * 2816 + 4 * n) = acc[0][bj][0][n]; }
        asm volatile("s_waitcnt lgkmcnt(0)" ::: "memory"); __builtin_amdgcn_s_barrier(); asm volatile("" ::: "memory");
#pragma unroll
        for (int n = 0; n < 2; ++n) {
            f32x4 wa[3], wb[3];
#pragma unroll
            for (int j = 0; j < 3; ++j) { wa[j] = *(const f32x4*)(cw + j * 5632 + colA + 4 * n); wb[j] = *(const f32x4*)(cw + j * 5632 + 2816 + colA + 4 * n); }
            const f32x4 ba = *(const f32x4*)(cb + colA + 4 * n), bb = *(const f32x4*)(cb + 2816 + colA + 4 * n);
#pragma unroll
            for (int ai = 0; ai < 2; ++ai) {
                const int strip = 2 * ai + wr;
                f32x4 h1a = {0.f, 0.f, 0.f, 0.f}, h2a = h1a, h1b = h1a, h2b = h1a;
                if (strip > 0) { const PG8_LAS float* hp = hl + ((strip - 1) * 2) * 256 + cc0 + 4 * n;
                    h2a = *(const PG8_LAS f32x4*)hp; h1a = *(const PG8_LAS f32x4*)(hp + 256); h2b = *(const PG8_LAS f32x4*)(hp + 128); h1b = *(const PG8_LAS f32x4*)(hp + 256 + 128); }
#pragma unroll
                for (int m = 0; m < 4; ++m) {
                    const f32x4 ca = acc[ai][0][m][n], cbv = acc[ai][1][m][n];
                    float o[4];
#pragma unroll
                    for (int e = 0; e < 4; ++e) {
                        float x1a, x2a, x1b, x2b;
                        if (m > 0) { x1a = dpp_ror1(acc[ai][0][m > 0 ? m - 1 : 0][n][e]); x2a = dpp_ror2(acc[ai][0][m > 0 ? m - 1 : 0][n][e]); x1b = dpp_ror1(acc[ai][1][m > 0 ? m - 1 : 0][n][e]); x2b = dpp_ror2(acc[ai][1][m > 0 ? m - 1 : 0][n][e]); }
                        else { x1a = h1a[e]; x2a = (fr == 0) ? h2a[e] : h1a[e]; x1b = h1b[e]; x2b = (fr == 0) ? h2b[e] : h1b[e]; }
                        const float r1a = dpp_ror1(ca[e]), r2a = dpp_ror2(ca[e]), r1b = dpp_ror1(cbv[e]), r2b = dpp_ror2(cbv[e]);
                        const float p1a = (fr == 0) ? x1a : r1a, p2a = (fr < 2) ? x2a : r2a;
                        const float p1b = (fr == 0) ? x1b : r1b, p2b = (fr < 2) ? x2b : r2b;
                        const float ya = wa[0][e] * p2a + wa[1][e] * p1a + wa[2][e] * ca[e] + ba[e];
                        const float yb = wb[0][e] * p2b + wb[1][e] * p1b + wb[2][e] * cbv[e] + bb[e];
                        o[e] = silu_f(ya) * yb;
                    }
                    typedef unsigned u32x2 __attribute__((ext_vector_type(2)));
                    u32x2 w; w.x = cvt_pk_bf16(o[0], o[1]); w.y = cvt_pk_bf16(o[2], o[3]);
                    *(u32x2*)(ACT + (size_t)(u.pm * BM + ai * HALF + wr * 64 + m * 16 + fr) * 2816 + colA + 4 * n) = w;
                }
            }
        }
    }
};

template <class Epi, class Sched, bool ALIGN_EPI, bool SP2, int KC, int LDAC>
__device__ __forceinline__ void gemm_phase(int widk, PG8_LAS unsigned char* lds, const Gemm g, const Sched& S, const Epi& E) {
    int lane_; asm volatile("v_mbcnt_lo_u32_b32 %0, -1, 0\n\tv_mbcnt_hi_u32_b32 %0, -1, %0" : "=v"(lane_));
    int wid_ = widk; asm volatile("" : "+s"(wid_));
    const int wid = wid_, lane = lane_, tid = wid * 64 + lane, wr = wid >> 2, wc = wid & 3, fr = lane & 15, fq = lane >> 4;
    constexpr int K = KC, nt = K / BK;
    unsigned voffA[2], voffB[2];
#pragma unroll
    for (int i = 0; i < 2; ++i) { int R, C; stage_rc(tid * 16 + i * 8192, R, C); const int Rb = Epi::PERM ? ((R & ~31) + perm32(R & 31)) : R;
        voffA[i] = (unsigned)(R * LDAC + C) * 2u; voffB[i] = (unsigned)(Rb * K + C) * 2u; }
    const size_t kstep = (size_t)(BK * 2);
    const size_t hstepA = (size_t)HALF * LDAC * 2, hstepB = (size_t)HALF * K * 2;
    const size_t tstepA = 2 * hstepA, tstepB = 2 * hstepB;
    const unsigned ldsw = (unsigned)wid * 1024u;
    const int aoff = lds_byte(wr * 64 + fr, fq * 8), boff = lds_byte(wc * 32 + fr, fq * 8);
#define PG8_SA(b, h) (((b) * 2 + (h)) * HTB)
#define PG8_SB(b, h) ((4 + (b) * 2 + (h)) * HTB)
#define PG8_STAGE(bufoff, gbase, voff) do { _Pragma("unroll") for (int _i = 0; _i < 2; ++_i) \
        __builtin_amdgcn_global_load_lds((const unsigned*)((const char*)(gbase) + (voff)[_i]), (PG8_LAS unsigned*)(lds + (bufoff) + ldsw + _i * 8192), 16, 0, 0); } while (0)
#define PG8_LDA(dst, b, h) do { _Pragma("unroll") for (int m = 0; m < 4; ++m) _Pragma("unroll") for (int k = 0; k < 2; ++k) dst[m][k] = *(const PG8_LAS bf16x8*)(lds + PG8_SA(b, h) + aoff + m * 2048 + k * 1024); } while (0)
#define PG8_LDB(dst, b, h) do { _Pragma("unroll") for (int n = 0; n < 2; ++n) _Pragma("unroll") for (int k = 0; k < 2; ++k) dst[n][k] = *(const PG8_LAS bf16x8*)(lds + PG8_SB(b, h) + boff + n * 2048 + k * 1024); } while (0)
#define PG8_MMA(ai, bj, At, Bt) do { __builtin_amdgcn_s_setprio(1); _Pragma("unroll") for (int m = 0; m < 4; ++m) _Pragma("unroll") for (int n = 0; n < 2; ++n) _Pragma("unroll") for (int k = 0; k < 2; ++k) \
        acc[ai][bj][m][n] = __builtin_amdgcn_mfma_f32_16x16x32_bf16(Bt[n][k], At[m][k], acc[ai][bj][m][n], 0, 0, 0); __builtin_amdgcn_s_setprio(0); } while (0)
#define PG8_WAIT_V(n) asm volatile("s_waitcnt vmcnt(" #n ")" ::: "memory")
#define PG8_WAIT_L(n) asm volatile("s_waitcnt lgkmcnt(" #n ")" ::: "memory")
#define PG8_BAR __builtin_amdgcn_s_barrier()
#define PG8_SCHED __builtin_amdgcn_sched_barrier(0)
    Unit cur, nxt; int ui = 0;
    if (!S.next(0, cur)) return;
    f32x4 acc[2][2][4][2];
#pragma unroll
    for (int a = 0; a < 2; ++a)
#pragma unroll
        for (int b = 0; b < 2; ++b)
#pragma unroll
            for (int m = 0; m < 4; ++m)
#pragma unroll
                for (int n = 0; n < 2; ++n) acc[a][b][m][n] = (f32x4){0.f, 0.f, 0.f, 0.f};
    bf16x8 At[4][2], B0[2][2], B1[2][2];
    const char* cA = (const char*)g.A + (size_t)cur.pm * tstepA; const char* cB = (const char*)g.Bt + (size_t)cur.pn * tstepB;
    S.a_ready(cur);
    if constexpr (SP2) {
        PG8_STAGE(PG8_SB(0, 0), cB, voffB); PG8_STAGE(PG8_SB(0, 1), cB + hstepB, voffB); PG8_STAGE(PG8_SA(0, 0), cA, voffA); PG8_STAGE(PG8_SA(0, 1), cA + hstepA, voffA);
        if (wr == 1) PG8_BAR;
        PG8_WAIT_V(2); PG8_BAR;
        PG8_STAGE(PG8_SB(1, 0), cB + kstep, voffB); PG8_STAGE(PG8_SA(1, 0), cA + kstep, voffA); PG8_STAGE(PG8_SB(1, 1), cB + hstepB + kstep, voffB);
        PG8_WAIT_V(6); PG8_BAR;
    } else {
        PG8_STAGE(PG8_SB(0, 0), cB, voffB); PG8_STAGE(PG8_SA(0, 0), cA, voffA); PG8_STAGE(PG8_SB(0, 1), cB + hstepB, voffB); PG8_STAGE(PG8_SA(0, 1), cA + hstepA, voffA);
        if (wr == 1) PG8_BAR;
        PG8_WAIT_V(4); PG8_BAR;
        PG8_STAGE(PG8_SB(1, 0), cB + kstep, voffB); PG8_STAGE(PG8_SA(1, 0), cA + kstep, voffA); PG8_STAGE(PG8_SB(1, 1), cB + hstepB + kstep, voffB);
        PG8_WAIT_V(6); PG8_BAR;
    }
    for (;;) {
        const bool has_next = S.next(ui + 1, nxt);
        const char* nA = has_next ? (const char*)g.A + (size_t)nxt.pm * tstepA : cA; const char* nB = has_next ? (const char*)g.Bt + (size_t)nxt.pn * tstepB : cB;
        for (int t = 0; t < nt; t += 2) {
            const bool last = (t == nt - 2);
            const char* a1 = cA + (size_t)(t + 1) * kstep;
            const char* a2 = last ? nA : cA + (size_t)(t + 2) * kstep; const char* b2 = last ? nB : cB + (size_t)(t + 2) * kstep;
            const char* a3 = a2 + kstep; const char* b3 = b2 + kstep;
            if (last && has_next) S.a_ready(nxt);
            if constexpr (SP2) {
            PG8_LDB(B0, 0, 0); PG8_LDB(B1, 0, 1); PG8_SCHED; PG8_LDA(At, 0, 0); PG8_STAGE(PG8_SA(1, 1), a1 + hstepA, voffA);
            PG8_WAIT_V(8); PG8_WAIT_L(0); PG8_BAR; PG8_MMA(0, 0, At, B0); PG8_MMA(0, 1, At, B1); PG8_BAR; PG8_SCHED;
            PG8_LDA(At, 0, 1); PG8_STAGE(PG8_SB(0, 0), b2, voffB); PG8_STAGE(PG8_SB(0, 1), b2 + hstepB, voffB); PG8_STAGE(PG8_SA(0, 0), a2, voffA);
            PG8_WAIT_V(8); PG8_WAIT_L(0); PG8_BAR; PG8_MMA(1, 0, At, B0); PG8_MMA(1, 1, At, B1); PG8_BAR; PG8_SCHED;
            PG8_LDB(B0, 1, 0); PG8_LDB(B1, 1, 1); PG8_SCHED; PG8_LDA(At, 1, 0); PG8_STAGE(PG8_SA(0, 1), a2 + hstepA, voffA);
            PG8_WAIT_V(8); PG8_WAIT_L(0); PG8_BAR; PG8_MMA(0, 0, At, B0); PG8_MMA(0, 1, At, B1); PG8_BAR; PG8_SCHED;
            PG8_LDA(At, 1, 1); PG8_STAGE(PG8_SB(1, 0), b3, voffB); PG8_STAGE(PG8_SB(1, 1), b3 + hstepB, voffB); PG8_STAGE(PG8_SA(1, 0), a3, voffA);
            PG8_WAIT_V(8); PG8_WAIT_L(0); PG8_BAR; PG8_MMA(1, 0, At, B0); PG8_MMA(1, 1, At, B1); PG8_BAR; PG8_SCHED;
            } else {
            PG8_LDB(B0, 0, 0); PG8_SCHED; PG8_LDA(At, 0, 0); PG8_STAGE(PG8_SA(1, 1), a1 + hstepA, voffA);
            PG8_WAIT_L(8); PG8_BAR; PG8_WAIT_L(0); PG8_MMA(0, 0, At, B0); PG8_BAR; PG8_SCHED;
            PG8_LDB(B1, 0, 1); PG8_STAGE(PG8_SB(0, 0), b2, voffB);
            PG8_BAR; PG8_WAIT_L(0); PG8_MMA(0, 1, At, B1); PG8_BAR;
            PG8_LDA(At, 0, 1); PG8_STAGE(PG8_SA(0, 0), a2, voffA);
            PG8_BAR; PG8_WAIT_L(0); PG8_MMA(1, 0, At, B0); PG8_BAR; PG8_SCHED;
            PG8_STAGE(PG8_SB(0, 1), b2 + hstepB, voffB);
            PG8_WAIT_V(6); PG8_BAR; PG8_MMA(1, 1, At, B1); PG8_BAR;
            PG8_LDB(B0, 1, 0); PG8_SCHED; PG8_LDA(At, 1, 0); PG8_STAGE(PG8_SA(0, 1), a2 + hstepA, voffA);
            PG8_WAIT_L(8); PG8_BAR; PG8_WAIT_L(0); PG8_MMA(0, 0, At, B0); PG8_BAR; PG8_SCHED;
            PG8_LDB(B1, 1, 1); PG8_STAGE(PG8_SB(1, 0), b3, voffB);
            PG8_BAR; PG8_WAIT_L(0); PG8_MMA(0, 1, At, B1); PG8_BAR;
            PG8_LDA(At, 1, 1); PG8_STAGE(PG8_SA(1, 0), a3, voffA);
            PG8_BAR; PG8_WAIT_L(0); PG8_MMA(1, 0, At, B0); PG8_BAR; PG8_SCHED;
            PG8_STAGE(PG8_SB(1, 1), b3 + hstepB, voffB);
            PG8_WAIT_V(6); PG8_BAR; PG8_MMA(1, 1, At, B1); PG8_BAR;
            }
        }
        if constexpr (ALIGN_EPI) { if (wr == 0) PG8_BAR; }
        if constexpr (!Epi::AFTER_DRAIN) { E(acc, cur, wr, wc, fr, fq); S.done(cur); }
        if (!has_next) break;
#pragma unroll
        for (int a = 0; a < 2; ++a)
#pragma unroll
            for (int b = 0; b < 2; ++b)
#pragma unroll
                for (int m = 0; m < 4; ++m)
#pragma unroll
                    for (int n = 0; n < 2; ++n) acc[a][b][m][n] = (f32x4){0.f, 0.f, 0.f, 0.f};
        cur = nxt; cA = nA; cB = nB; ++ui;
        if constexpr (ALIGN_EPI) { if (wr == 1) PG8_BAR; }
    }
    PG8_WAIT_V(0);
    if constexpr (!ALIGN_EPI) { if (wr == 0) PG8_BAR; }
    PG8_BAR;
    if constexpr (Epi::AFTER_DRAIN) { E.fused(acc, cur, wr, wc, fr, fq, lds, wid, lane); S.done(cur); }
#undef PG8_SA
#undef PG8_SB
#undef PG8_STAGE
#undef PG8_LDA
#undef PG8_LDB
#undef PG8_MMA
#undef PG8_WAIT_V
#undef PG8_WAIT_L
#undef PG8_BAR
#undef PG8_SCHED
}
}

#ifdef NO_GEMMB
#define PH_GEMMB if (0)
#else
#define PH_GEMMB
#endif
#ifdef NO_GEMMR
#define PH_GEMMR if (0)
#else
#define PH_GEMMR
#endif
namespace mk {
#define LAS __attribute__((address_space(3)))
typedef unsigned short bf16_t;
typedef short bf16x8 __attribute__((ext_vector_type(8)));
typedef short s16x4 __attribute__((ext_vector_type(4)));
typedef float f32x4 __attribute__((ext_vector_type(4)));
typedef float f32x16 __attribute__((ext_vector_type(16)));
typedef unsigned u32x4 __attribute__((ext_vector_type(4)));
typedef unsigned u32x2 __attribute__((ext_vector_type(2)));
using pg8::cvt_pk_bf16;

constexpr int NB = 32, T = 2048, D = 1024, M = NB * T, DEPTH = 4;
constexpr int NWAVES = 8, NTHR = 512;
constexpr int GDN_N = 4112, GDN_NMAIN = 4096, DIFF_N = 3072, FFN_H = 2816, FFN_N = 5632;
constexpr float LN_EPS = 1e-5f, RMS_EPS = 1e-6f;
constexpr float ALPHA = 1.6817928305074290f;
constexpr float LOG2E = 1.4426950408889634f;
constexpr int MH = M / 2;

constexpr size_t MiB = 1u << 20;
constexpr size_t WS_W = 2 * MiB;
constexpr size_t W_GWIN = 0, W_GWAB = W_GWIN + 2ull * 4096 * 1024 * 2, W_GWOUT = W_GWAB + 2ull * 16 * 1024 * 2, W_DWIN = W_GWOUT + 2ull * 1024 * 1024 * 2,
                 W_DWOUT = W_DWIN + 2ull * 3072 * 1024 * 2, W_FUP = W_DWOUT + 2ull * 1024 * 1024 * 2, W_FDOWN = W_FUP + 4ull * 5632 * 1024 * 2, W_END = W_FDOWN + 4ull * 1024 * 2816 * 2;
static_assert(WS_W + W_END <= 106 * MiB, "weights region");
constexpr size_t WS_CNT = 16384;
constexpr size_t WS_CTL_BYTES = 16384 + 8 * 256 * 16 * 4;
constexpr size_t WS_XBUF = 1 * MiB;
constexpr size_t WS_GB = 106 * MiB;
constexpr size_t WS_XN = 112 * MiB;
constexpr size_t WS_H = 240 * MiB;
constexpr size_t WS_ACT = WS_H;
constexpr size_t WS_HALO = WS_H + 352 * MiB;
constexpr size_t WS_HALO2 = WS_HALO + 12 * MiB;
constexpr size_t WS_UT = WS_H + 512 * MiB;
constexpr size_t WS_WN = WS_UT + 128 * MiB;
constexpr size_t WS_VT = WS_H + 384 * MiB;
constexpr size_t WS_O = WS_VT + 128 * MiB;
constexpr size_t WS_END = WS_WN + 128 * MiB;
static_assert(WS_END <= 1024 * MiB, "workspace map");
constexpr int LDS_BYTES = 131072 + 2048 + 10240;

__device__ __forceinline__ float bf2f(unsigned short h) { return __uint_as_float((unsigned)h << 16); }
__device__ __forceinline__ unsigned short f2bf(float f) { return (unsigned short)(cvt_pk_bf16(f, 0.f) & 0xffffu); }
__device__ __forceinline__ float wave_sum(float v) {
#pragma unroll
    for (int o = 1; o < 64; o <<= 1) v += __shfl_xor(v, o);
    return v;
}
__device__ __forceinline__ float silu(float x) { return x * __builtin_amdgcn_rcpf(1.f + __expf(-x)); }
__device__ __forceinline__ void unpack8(const u32x4 v, float (&o)[8]) {
    o[0] = __uint_as_float(v.x << 16); o[1] = __uint_as_float(v.x & 0xffff0000u); o[2] = __uint_as_float(v.y << 16); o[3] = __uint_as_float(v.y & 0xffff0000u);
    o[4] = __uint_as_float(v.z << 16); o[5] = __uint_as_float(v.z & 0xffff0000u); o[6] = __uint_as_float(v.w << 16); o[7] = __uint_as_float(v.w & 0xffff0000u);
}
__device__ __forceinline__ u32x4 pack8(const float (&o)[8]) { u32x4 w; w.x = cvt_pk_bf16(o[0], o[1]); w.y = cvt_pk_bf16(o[2], o[3]); w.z = cvt_pk_bf16(o[4], o[5]); w.w = cvt_pk_bf16(o[6], o[7]); return w; }
__device__ __forceinline__ int crow(int r, int hi) { return (r & 3) + 8 * (r >> 2) + 4 * hi; }
#define LDS_WAIT() asm volatile("s_waitcnt lgkmcnt(0)" ::: "memory")
#define MK_IDS() int lane_; asm volatile("v_mbcnt_lo_u32_b32 %0, -1, 0\n\tv_mbcnt_hi_u32_b32 %0, -1, %0" : "=v"(lane_));   \
      \
    int wid_ = widk; asm volatile("" : "+s"(wid_)); const int lane = lane_, wid = wid_, tid = wid * 64 + lane; const int G_ = gridDim.x, gw = blockIdx.x * NWAVES + wid, NGW = G_ * NWAVES, gt = blockIdx.x * NTHR + tid, NGT = G_ * NTHR; \
    (void)lane; (void)wid; (void)gw; (void)NGW; (void)gt; (void)NGT

template <bool UPPERM = false> __device__ __forceinline__ void transpose_item(const float* W, int ldw, int K, int nblk, bf16_t* WT, LAS float* scr, int item, int lane) {
    const int kb = item / nblk, nb = item % nblk, k0 = 64 * kb, n0 = 32 * nb;
    const int r0 = UPPERM ? (n0 < FFN_H ? 256 * (n0 >> 7) + (n0 & 127) : 256 * ((n0 - FFN_H) >> 7) + 128 + ((n0 - FFN_H) & 127)) : n0;
#pragma unroll 8
    for (int i = 0; i < 32; ++i) { const int kk = 2 * i + (lane >> 5); scr[kk * 33 + (lane & 31)] = W[(size_t)(k0 + kk) * ldw + n0 + (lane & 31)]; }
    LDS_WAIT();
    const int c = lane & 7;
#pragma unroll
    for (int j = 0; j < 4; ++j) { const int n = (lane >> 3) + 8 * j; const LAS float* s = scr + (8 * c) * 33 + n;
        u32x4 o; o.x = cvt_pk_bf16(s[0 * 33], s[1 * 33]); o.y = cvt_pk_bf16(s[2 * 33], s[3 * 33]); o.z = cvt_pk_bf16(s[4 * 33], s[5 * 33]); o.w = cvt_pk_bf16(s[6 * 33], s[7 * 33]);
        *(u32x4*)(WT + (size_t)(r0 + n) * K + k0 + 8 * c) = o; }
    LDS_WAIT();
}

#define XB_TMO      128
#define XB_XCNT(j)  (256  + 64 * (j))
#define XB_XSUB(j)  (1280 + 64 * (j))
#define XB_XGEN(j)  (2304 + 64 * (j))
#define XB_TOP      3328
#define XB_TOPGEN   3392
#define XCD_BAR_WORDS 3456
#define XB_SPIN_CAP (1u << 18)

__device__ __forceinline__ unsigned xb_ld(unsigned* p)              { return __hip_atomic_load(p, __ATOMIC_RELAXED, __HIP_MEMORY_SCOPE_AGENT); }
__device__ __forceinline__ unsigned xb_add(unsigned* p, unsigned v) { return __hip_atomic_fetch_add(p, v, __ATOMIC_RELAXED, __HIP_MEMORY_SCOPE_AGENT); }
__device__ __forceinline__ unsigned xb_xcc_id() { return (unsigned)__builtin_amdgcn_s_getreg((3 << 11) | 20) & 0xFu; }
#define XB_SPIN(cond, bar) do { unsigned _sp = 0; while (cond) { __builtin_amdgcn_s_sleep(1); \
    if ((++_sp & 255u) == 0u) { if (xb_ld(&(bar)[XB_TMO])) break; if (_sp > XB_SPIN_CAP) { atomicAdd(&(bar)[XB_TMO], 1u); break; } } } } while (0)

struct XcdBarrier {
    unsigned* bar; unsigned x;
    volatile LAS unsigned* st;
};

__device__ __forceinline__ XcdBarrier xcd_barrier_post(unsigned* bar, volatile LAS unsigned* st) {
    XcdBarrier b; b.bar = bar; b.x = xb_xcc_id(); b.st = st;
    if (threadIdx.x == 0) (void)xb_add(&bar[XB_XCNT(b.x)], 1u);
    return b;
}
__device__ __forceinline__ void xcd_barrier_complete(unsigned* bar, unsigned x, unsigned& nloc, unsigned& nx) {
    const unsigned G = gridDim.x * gridDim.y * gridDim.z;
    unsigned sum, cnt, mine, sp = 0u;
    for (;;) {
        sum = 0u; cnt = 0u; mine = 0u;
#pragma unroll
        for (unsigned j = 0; j < 16; ++j) { const unsigned c = xb_ld(&bar[XB_XCNT(j)]); sum += c; cnt += (c > 0u) ? 1u : 0u; mine = (j == x) ? c : mine; }
        if (sum == G) break;
        __builtin_amdgcn_s_sleep(1);
        if ((++sp & 255u) == 0u) { if (xb_ld(&bar[XB_TMO])) break; if (sp > XB_SPIN_CAP) { atomicAdd(&bar[XB_TMO], 1u); break; } }
    }
    nloc = mine > 0u ? mine : 1u; nx = cnt > 0u ? cnt : 1u;
}

__device__ __forceinline__ void xcd_barrier(const XcdBarrier& b, int widk) {
    asm volatile("s_waitcnt vmcnt(0)" ::: "memory");
    __syncthreads();
    int xl_; asm volatile("v_mbcnt_lo_u32_b32 %0, -1, 0\n\tv_mbcnt_hi_u32_b32 %0, -1, %0" : "=v"(xl_));
    if (widk == 0 && xl_ == 0) {
        unsigned* bar = b.bar;
        __builtin_amdgcn_s_waitcnt(0);
        unsigned nloc = b.st[0], nx = b.st[1];
        if (nloc == 0u) { xcd_barrier_complete(bar, b.x, nloc, nx); b.st[0] = nloc; b.st[1] = nx; }
        const unsigned old = xb_add(&bar[XB_XSUB(b.x)], 1u);
        const unsigned gen = old / nloc;
        if (old + 1u == (gen + 1u) * nloc) {
            __builtin_amdgcn_fence(__ATOMIC_RELEASE, "agent");
            asm volatile("s_waitcnt vmcnt(0)" ::: "memory");
            const unsigned og = xb_add(&bar[XB_TOP], 1u);
            const unsigned tg = og / nx;
            if (og + 1u == (tg + 1u) * nx) xb_add(&bar[XB_TOPGEN], 1u);
            else XB_SPIN(xb_ld(&bar[XB_TOPGEN]) == tg, bar);
            __builtin_amdgcn_fence(__ATOMIC_ACQUIRE, "agent");
            xb_add(&bar[XB_XGEN(b.x)], 1u);
            asm volatile("s_waitcnt vmcnt(0)" ::: "memory");
        } else {
            XB_SPIN(xb_ld(&bar[XB_XGEN(b.x)]) == gen, bar);
            __builtin_amdgcn_fence(__ATOMIC_ACQUIRE, "agent");
            asm volatile("s_waitcnt vmcnt(0)" ::: "memory");
        }
    }
    __syncthreads();
}

struct Params {
    const float* in[23];
    const int* positions;
    float* out;
    unsigned char* ws;
};

__device__ __forceinline__ void prologue(int widk, const Params& p, LAS unsigned char* lds) {
    MK_IDS(); const int wave = wid;
    LAS float* scr = (LAS float*)(lds + wave * 16384);
    unsigned char* wsw = p.ws + WS_W;
    constexpr int I_GWIN = 16 * 128, I_SQ = 16 * 32, I_DWIN = 16 * 96, I_FUP = 16 * 176, I_FDN = 44 * 32;
    constexpr int NITEMS = 2 * I_GWIN + 2 * I_SQ + 2 * I_DWIN + 2 * I_SQ + 4 * I_FUP + 4 * I_FDN;
    for (int it = gw; it < NITEMS; it += NGW) {
        int r = it;
        if (r < 2 * I_GWIN) { const int j = r / I_GWIN; r %= I_GWIN; transpose_item(p.in[2] + (size_t)j * 1024 * GDN_N, GDN_N, 1024, 128, (bf16_t*)(wsw + W_GWIN) + (size_t)j * 4096 * 1024, scr, r, lane); continue; } r -= 2 * I_GWIN;
        if (r < 2 * I_SQ) { const int j = r / I_SQ; r %= I_SQ; transpose_item(p.in[7] + (size_t)j * 1024 * 1024, 1024, 1024, 32, (bf16_t*)(wsw + W_GWOUT) + (size_t)j * 1024 * 1024, scr, r, lane); continue; } r -= 2 * I_SQ;
        if (r < 2 * I_DWIN) { const int j = r / I_DWIN; r %= I_DWIN; transpose_item(p.in[8] + (size_t)j * 1024 * DIFF_N, DIFF_N, 1024, 96, (bf16_t*)(wsw + W_DWIN) + (size_t)j * 3072 * 1024, scr, r, lane); continue; } r -= 2 * I_DWIN;
        if (r < 2 * I_SQ) { const int j = r / I_SQ; r %= I_SQ; transpose_item(p.in[14] + (size_t)j * 1024 * 1024, 1024, 1024, 32, (bf16_t*)(wsw + W_DWOUT) + (size_t)j * 1024 * 1024, scr, r, lane); continue; } r -= 2 * I_SQ;
        if (r < 4 * I_FUP) { const int j = r / I_FUP; r %= I_FUP; transpose_item<true>(p.in[15] + (size_t)j * 1024 * FFN_N, FFN_N, 1024, 176, (bf16_t*)(wsw + W_FUP) + (size_t)j * 5632 * 1024, scr, r, lane); continue; } r -= 4 * I_FUP;
        { const int j = r / I_FDN; r %= I_FDN; transpose_item(p.in[18] + (size_t)j * 2816 * 1024, 1024, 2816, 32, (bf16_t*)(wsw + W_FDOWN) + (size_t)j * 1024 * 2816, scr, r, lane); }
    }
    for (int e = gt; e < 2 * 16 * 1024; e += NGT) { const int j = e >> 14, n = (e >> 10) & 15, k = e & 1023;
        ((bf16_t*)(wsw + W_GWAB))[e] = f2bf(p.in[2][(size_t)j * 1024 * GDN_N + (size_t)k * GDN_N + GDN_NMAIN + n]); }
    const f32x4* x4 = (const f32x4*)p.in[0]; u32x4* xn = (u32x4*)(p.ws + WS_XN);
    for (int e = gt; e < M * D / 8; e += NGT) { const f32x4 a = x4[2 * e], b = x4[2 * e + 1]; u32x4 w; w.x = cvt_pk_bf16(a[0], a[1]); w.y = cvt_pk_bf16(a[2], a[3]); w.z = cvt_pk_bf16(b[0], b[1]); w.w = cvt_pk_bf16(b[2], b[3]); xn[e] = w; }
}

__device__ __forceinline__ void ln_phase(int widk, float* X, bf16_t* XN, const float* g, const float* b) {
    MK_IDS();
    f32x4 gv[4], bv[4];
#pragma unroll
    for (int j = 0; j < 4; ++j) { gv[j] = ((const f32x4*)g)[lane + 64 * j]; bv[j] = ((const f32x4*)b)[lane + 64 * j]; }
    for (int m = gw; m < M; m += NGW) {
        f32x4* xr = (f32x4*)(X + (size_t)m * D) + lane;
        f32x4 v[4]; float s = 0.f;
#pragma unroll
        for (int j = 0; j < 4; ++j) { v[j] = xr[64 * j]; s += (v[j][0] + v[j][1]) + (v[j][2] + v[j][3]); }
        const float mean = wave_sum(s) * (1.f / D); float s2 = 0.f;
#pragma unroll
        for (int j = 0; j < 4; ++j) { v[j] = v[j] - mean; s2 += (v[j][0] * v[j][0] + v[j][1] * v[j][1]) + (v[j][2] * v[j][2] + v[j][3] * v[j][3]); }
        const float rstd = 1.f / sqrtf(wave_sum(s2) * (1.f / D) + LN_EPS);
        u32x2* o8 = (u32x2*)(XN + (size_t)m * D) + lane;
#pragma unroll
        for (int j = 0; j < 4; ++j) { const f32x4 o = v[j] * rstd * gv[j] + bv[j]; xr[64 * j] = o; u32x2 w; w.x = cvt_pk_bf16(o[0], o[1]); w.y = cvt_pk_bf16(o[2], o[3]); o8[64 * j] = w; }
    }
}

__device__ __forceinline__ void ffn_fixup_phase(int widk, bf16_t* ACT, const float* HALO, const float* HALO2, const float* cw, const float* cb) {
    MK_IDS();
    constexpr int NCG = FFN_H / 4;
    for (int item = gt; item < (M / 256) * NCG; item += NGT) {
        const int pm = item / NCG, col = (item % NCG) * 4;
        if ((pm & 7) == 0) continue;
        f32x4 wa[3], wb[3];
#pragma unroll
        for (int j = 0; j < 3; ++j) { wa[j] = *(const f32x4*)(cw + j * FFN_N + col); wb[j] = *(const f32x4*)(cw + j * FFN_N + FFN_H + col); }
        const f32x4 ba = *(const f32x4*)(cb + col), bb = *(const f32x4*)(cb + FFN_H + col);
        const float* hp = HALO + (size_t)(pm - 1) * 2 * FFN_N + col; const float* h2 = HALO2 + (size_t)pm * 2 * FFN_N + col;
        const f32x4 am2 = *(const f32x4*)hp, am1 = *(const f32x4*)(hp + FFN_N), a0 = *(const f32x4*)h2, a1 = *(const f32x4*)(h2 + FFN_N);
        const f32x4 bm2 = *(const f32x4*)(hp + FFN_H), bm1 = *(const f32x4*)(hp + FFN_N + FFN_H), b0 = *(const f32x4*)(h2 + FFN_H), b1 = *(const f32x4*)(h2 + FFN_N + FFN_H);
        float o0[4], o1[4];
#pragma unroll
        for (int e = 0; e < 4; ++e) {
            o0[e] = silu(wa[0][e] * am2[e] + wa[1][e] * am1[e] + wa[2][e] * a0[e] + ba[e]) * (wb[0][e] * bm2[e] + wb[1][e] * bm1[e] + wb[2][e] * b0[e] + bb[e]);
            o1[e] = silu(wa[0][e] * am1[e] + wa[1][e] * a0[e] + wa[2][e] * a1[e] + ba[e]) * (wb[0][e] * bm1[e] + wb[1][e] * b0[e] + wb[2][e] * b1[e] + bb[e]);
        }
        u32x2 w; w.x = cvt_pk_bf16(o0[0], o0[1]); w.y = cvt_pk_bf16(o0[2], o0[3]); *(u32x2*)(ACT + (size_t)(pm * 256) * FFN_H + col) = w;
        w.x = cvt_pk_bf16(o1[0], o1[1]); w.y = cvt_pk_bf16(o1[2], o1[3]); *(u32x2*)(ACT + (size_t)(pm * 256 + 1) * FFN_H + col) = w;
    }
}

__device__ __forceinline__ void gdn_ab_phase(int widk, const bf16_t* XN, const bf16_t* wabT  , const float* a_log, const float* dt_bias, float* G, float* BETA) {
    MK_IDS();
    const int n = lane & 15, q4 = lane >> 4, h = n & 7;
    const float al = -__expf(a_log[h]), db = dt_bias[h];
    for (int it = gw; it < M / 16; it += NGW) {
        const int m0 = it * 16;
        f32x4 acc = {0.f, 0.f, 0.f, 0.f};
        const bf16_t* ap = XN + (size_t)(m0 + n) * D + 8 * q4;
        const bf16_t* bp = wabT + (size_t)n * D + 8 * q4;
#pragma unroll 8
        for (int ks = 0; ks < 32; ++ks) { const bf16x8 a = *(const bf16x8*)(ap + 32 * ks), b = *(const bf16x8*)(bp + 32 * ks); acc = __builtin_amdgcn_mfma_f32_16x16x32_bf16(a, b, acc, 0, 0, 0); }
#pragma unroll
        for (int i = 0; i < 4; ++i) { const int m = m0 + 4 * q4 + i; const float v = acc[i];
            if (n < 8) { const float x = v + db; const float sp = x > 20.f ? x : log1pf(__expf(x)); G[(size_t)m * 8 + h] = al * sp; }
            else BETA[(size_t)m * 8 + h] = 1.f / (1.f + __expf(-v)); }
    }
}

__device__ __forceinline__ void conv_silu16(const bf16_t* hp, int t, const LAS float* cw, float (&y)[16]) {
#pragma unroll
    for (int c = 0; c < 16; ++c) y[c] = 0.f;
#pragma unroll
    for (int j = 0; j < 4; ++j) {
        if (t - 3 + j >= 0) {
            float x[16];
            const bf16_t* rp = hp + (ptrdiff_t)(j - 3) * GDN_NMAIN;
            { float t8[8]; unpack8(*(const u32x4*)rp, t8);
#pragma unroll
              for (int c = 0; c < 8; ++c) x[c] = t8[c];
              unpack8(*(const u32x4*)(rp + 8), t8);
#pragma unroll
              for (int c = 0; c < 8; ++c) x[8 + c] = t8[c]; }
#pragma unroll
            for (int q = 0; q < 4; ++q) { const f32x4 w = *(const LAS f32x4*)(cw + j * 128 + 4 * q);
#pragma unroll
                for (int e = 0; e < 4; ++e) y[4 * q + e] += w[e] * x[4 * q + e]; }
        }
    }
#pragma unroll
    for (int c = 0; c < 16; ++c) y[c] = silu(y[c]);
}
__device__ __forceinline__ float sumsq16_8lanes(const float (&y)[16]) {
    float s = 0.f;
#pragma unroll
    for (int c = 0; c < 16; ++c) s += y[c] * y[c];
    s += __shfl_xor(s, 1); s += __shfl_xor(s, 2); s += __shfl_xor(s, 4);
    return s;
}
__device__ __forceinline__ void pack16(const float (&y)[16], u32x4& a, u32x4& b) {
    a.x = cvt_pk_bf16(y[0], y[1]); a.y = cvt_pk_bf16(y[2], y[3]); a.z = cvt_pk_bf16(y[4], y[5]); a.w = cvt_pk_bf16(y[6], y[7]);
    b.x = cvt_pk_bf16(y[8], y[9]); b.y = cvt_pk_bf16(y[10], y[11]); b.z = cvt_pk_bf16(y[12], y[13]); b.w = cvt_pk_bf16(y[14], y[15]);
}
__device__ __forceinline__ void unpack16(const u32x4 a, const u32x4 b, float (&y)[16]) {
    float t8[8]; unpack8(a, t8);
#pragma unroll
    for (int c = 0; c < 8; ++c) y[c] = t8[c];
    unpack8(b, t8);
#pragma unroll
    for (int c = 0; c < 8; ++c) y[8 + c] = t8[c];
}
__device__ __forceinline__ bf16x8 lds_frag16(const LAS unsigned char* p) { return *(const LAS bf16x8*)p; }
__device__ __forceinline__ bf16x8 lds_frag8x2(const LAS unsigned char* p0, const LAS unsigned char* p1) {
    const s16x4 a = *(const LAS s16x4*)p0, b = *(const LAS s16x4*)p1; return (bf16x8){a[0], a[1], a[2], a[3], b[0], b[1], b[2], b[3]};
}

constexpr int GA_GC = 0, GA_BT = 256, GA_CW = 512, GA_Q = GA_CW + 3 * 4 * 128 * 4, GA_K = GA_Q + 64 * 272, GA_LT = GA_K + 64 * 272, GA_END = GA_LT + 8 * 8192;
static_assert(GA_END <= 131072 && GA_LT % 16 == 0, "GDN phase A LDS map");
constexpr int GB_GC = 0, GB_BT = 256, GB_Q = 512, GB_KB = GB_Q + 64 * 272, GB_VB = GB_KB + 64 * 272, GB_KD = GB_VB + 64 * 272, GB_T = GB_KD + 128 * 144, GB_AT = GB_T + 64 * 144, GB_O = GB_AT + 64 * 144, GB_END = GB_O + 64 * 528;
static_assert(GB_END <= 131072 && GB_O % 16 == 0, "GDN phase B LDS map");

template <int I, int J> __device__ __forceinline__ void inv_row(float& s0, float& s1, const float lr, const float (&t)[64]) {
    if constexpr (J + 8 <= I) {
        int a0, a1, a2, a3, a4, a5, a6, a7;
        asm volatile("v_readlane_b32 %2, %10, %19\n\tv_readlane_b32 %3, %10, %19+1\n\tv_readlane_b32 %4, %10, %19+2\n\tv_readlane_b32 %5, %10, %19+3\n\t"
                     "v_readlane_b32 %6, %10, %19+4\n\tv_readlane_b32 %7, %10, %19+5\n\tv_readlane_b32 %8, %10, %19+6\n\tv_readlane_b32 %9, %10, %19+7\n\t"
                     "v_fma_f32 %0, -%11, %2, %0\n\tv_fma_f32 %1, -%12, %3, %1\n\tv_fma_f32 %0, -%13, %4, %0\n\tv_fma_f32 %1, -%14, %5, %1\n\t"
                     "v_fma_f32 %0, -%15, %6, %0\n\tv_fma_f32 %1, -%16, %7, %1\n\tv_fma_f32 %0, -%17, %8, %0\n\tv_fma_f32 %1, -%18, %9, %1"
                     : "+v"(s0), "+v"(s1), "=&s"(a0), "=&s"(a1), "=&s"(a2), "=&s"(a3), "=&s"(a4), "=&s"(a5), "=&s"(a6), "=&s"(a7)
                     : "v"(lr), "v"(t[J]), "v"(t[J + 1]), "v"(t[J + 2]), "v"(t[J + 3]), "v"(t[J + 4]), "v"(t[J + 5]), "v"(t[J + 6]), "v"(t[J + 7]), "i"(J));
        inv_row<I, J + 8>(s0, s1, lr, t);
    } else {
#pragma unroll
        for (int j = J; j < I; ++j) { const float lj = __int_as_float(__builtin_amdgcn_readlane(__float_as_int(lr), j)); if (j & 1) s1 -= lj * t[j]; else s0 -= lj * t[j]; }
    }
}
template <int I0> __device__ __forceinline__ void inv_rows8(const LAS float* Lp, const float flane, float (&t)[64]) {
    float lr[8];
#pragma unroll
    for (int k = 0; k < 8; ++k) lr[k] = Lp[((I0 + k) * (I0 + k - 1)) / 2];
#define INV_ROW(k) { float s0 = 1.f - fminf(fabsf(flane - (float)(I0 + k)), 1.f), s1 = 0.f; inv_row<I0 + k, 0>(s0, s1, lr[k], t); t[I0 + k] = s0 + s1; }
    INV_ROW(0) INV_ROW(1) INV_ROW(2) INV_ROW(3) INV_ROW(4) INV_ROW(5) INV_ROW(6) INV_ROW(7)
#undef INV_ROW
}

__device__ __forceinline__ void gdn_phase_a(int widk, bf16_t* H, const float* G, const float* BETA, const float* convw  , bf16_t* TG, bf16_t* ATT, LAS unsigned char* lds) {
    MK_IDS();
    LAS float* gcs = (LAS float*)(lds + GA_GC); LAS float* bts = (LAS float*)(lds + GA_BT); LAS float* cwl = (LAS float*)(lds + GA_CW);
    for (int bh = blockIdx.x; bh < 256; bh += gridDim.x) {
        const int b = bh >> 3, h = bh & 7;
        __syncthreads();
        for (int e = tid; e < 3 * 4 * 128; e += NTHR) { const int ten = e / 512, tap = (e >> 7) & 3, c = e & 127; cwl[e] = convw[tap * 3072 + ten * 1024 + h * 128 + c]; }
        __syncthreads();
        for (int sg = 3; sg >= 0; --sg) {
            for (int k = 7; k >= 0; --k) {
                const int n = sg * 8 + k, it = n * 256 + bh, m0 = b * T + n * 64;
                if (wid == 0) { const float g = G[(size_t)(m0 + lane) * 8 + h]; float c = g;
#pragma unroll
                    for (int o = 1; o < 64; o <<= 1) { const float t = __shfl_up(c, o); if (lane >= o) c += t; }
                    gcs[lane] = c; bts[lane] = BETA[(size_t)(m0 + lane) * 8 + h]; }
                const int r = tid >> 3, c0 = (tid & 7) * 16, t = n * 64 + r; bf16_t* hp = H + (size_t)(m0 + r) * GDN_NMAIN + h * 128 + c0;
                u32x4 st[6];
                {   float y[16];
                    conv_silu16(hp, t, cwl + c0, y);
                    { const float rinv = rsqrtf(sumsq16_8lanes(y) + RMS_EPS) * 0.08838834764831845f;
#pragma unroll
                      for (int c = 0; c < 16; ++c) y[c] *= rinv; pack16(y, st[0], st[1]); }
                    conv_silu16(hp + 1024, t, cwl + 512 + c0, y);
                    { const float rinv = rsqrtf(sumsq16_8lanes(y) + RMS_EPS);
#pragma unroll
                      for (int c = 0; c < 16; ++c) y[c] *= rinv; pack16(y, st[2], st[3]); }
                    conv_silu16(hp + 2048, t, cwl + 1024 + c0, y);
                    pack16(y, st[4], st[5]);
                    *(LAS u32x4*)(lds + GA_Q + r * 272 + c0 * 2) = st[0]; *(LAS u32x4*)(lds + GA_Q + r * 272 + c0 * 2 + 16) = st[1];
                    *(LAS u32x4*)(lds + GA_K + r * 272 + c0 * 2) = st[2]; *(LAS u32x4*)(lds + GA_K + r * 272 + c0 * 2 + 16) = st[3];
                }
                __syncthreads();
                *(u32x4*)hp = st[0]; *(u32x4*)(hp + 8) = st[1]; *(u32x4*)(hp + 1024) = st[2]; *(u32x4*)(hp + 1024 + 8) = st[3]; *(u32x4*)(hp + 2048) = st[4]; *(u32x4*)(hp + 2048 + 8) = st[5];
                {
                    const int which = wid >> 2, bi = (wid >> 1) & 1, bj = wid & 1, l31 = lane & 31, hi = lane >> 5;
                    LAS float* Lt = (LAS float*)(lds + GA_LT + k * 8192);
                    f32x16 acc = {};
                    if (!(bi == 0 && bj == 1)) {
                        const LAS unsigned char* ap = lds + (which ? GA_Q : GA_K) + (32 * bi + l31) * 272 + hi * 16;
                        const LAS unsigned char* bp = lds + GA_K + (32 * bj + l31) * 272 + hi * 16;
#pragma unroll
                        for (int ks = 0; ks < 8; ++ks) acc = __builtin_amdgcn_mfma_f32_32x32x16_bf16(lds_frag16(ap + ks * 32), lds_frag16(bp + ks * 32), acc, 0, 0, 0);
                    }
                    const int j = 32 * bj + l31; const float gcj = gcs[j];
#pragma unroll
                    for (int rr = 0; rr < 16; ++rr) { const int i = 32 * bi + crow(rr, hi); const float dec = __expf(fminf(gcs[i] - gcj, 0.f));
                        if (which == 0) { if (i > j) Lt[(i * (i - 1)) / 2 + j] = bts[i] * acc[rr] * dec; }
                        else ATT[((size_t)it * 64 + i) * 64 + j] = f2bf((i >= j) ? acc[rr] * dec : 0.f); }
                }
                __syncthreads();
            }
            {
                float t[64]; const float flane = (float)lane;
                const LAS float* Lp = (const LAS float*)(lds + GA_LT + wid * 8192) + lane; asm volatile("" : "+v"(Lp));
                inv_rows8<0>(Lp, flane, t); inv_rows8<8>(Lp, flane, t); inv_rows8<16>(Lp, flane, t); inv_rows8<24>(Lp, flane, t);
                inv_rows8<32>(Lp, flane, t); inv_rows8<40>(Lp, flane, t); inv_rows8<48>(Lp, flane, t); inv_rows8<56>(Lp, flane, t);
                bf16_t* tp = TG + (size_t)((sg * 8 + wid) * 256 + bh) * 4096 + lane;
#pragma unroll
                for (int i = 0; i < 64; ++i) tp[i * 64] = f2bf(t[i]);
            }
        }
    }
    __syncthreads();
}

__device__ __forceinline__ void gdn_phase_b(int widk, bf16_t* H, const float* G, const float* BETA, const float* normw  , const bf16_t* TG, const bf16_t* ATT, LAS unsigned char* lds) {
    MK_IDS();
    LAS float* gcs = (LAS float*)(lds + GB_GC); LAS float* bts = (LAS float*)(lds + GB_BT);
    const int n16 = lane & 15, q4 = lane >> 4;
    for (int bh = blockIdx.x; bh < 256; bh += gridDim.x) {
        const int b = bh >> 3, h = bh & 7;
        f32x4 S[8];
#pragma unroll
        for (int s = 0; s < 8; ++s) S[s] = (f32x4){0.f, 0.f, 0.f, 0.f};
        for (int n = 0; n < 32; ++n) {
            const int it = n * 256 + bh, m0 = b * T + n * 64;
            const int r = tid >> 3, c0 = (tid & 7) * 16; bf16_t* hp = H + (size_t)(m0 + r) * GDN_NMAIN + h * 128 + c0;
            const u32x4 q0 = *(const u32x4*)hp, q1 = *(const u32x4*)(hp + 8), k0 = *(const u32x4*)(hp + 1024), k1 = *(const u32x4*)(hp + 1024 + 8), v0 = *(const u32x4*)(hp + 2048), v1 = *(const u32x4*)(hp + 2048 + 8);
            const u32x4 tt = ((const u32x4*)(TG + (size_t)it * 4096))[tid], aa = ((const u32x4*)(ATT + (size_t)it * 4096))[tid];
            if (wid == 0) { float c = G[(size_t)(m0 + lane) * 8 + h];
#pragma unroll
                for (int o = 1; o < 64; o <<= 1) { const float t = __shfl_up(c, o); if (lane >= o) c += t; }
                gcs[lane] = c; bts[lane] = BETA[(size_t)(m0 + lane) * 8 + h]; }
            __syncthreads();
            const float glast = gcs[63];
            {   const float gcr = gcs[r], btr = bts[r], eg = __expf(gcr), ekd = __expf(glast - gcr);
                float y[16]; u32x4 a, bq;
                unpack16(q0, q1, y);
#pragma unroll
                for (int c = 0; c < 16; ++c) y[c] *= eg;
                pack16(y, a, bq); *(LAS u32x4*)(lds + GB_Q + r * 272 + c0 * 2) = a; *(LAS u32x4*)(lds + GB_Q + r * 272 + c0 * 2 + 16) = bq;
                unpack16(k0, k1, y);
#pragma unroll
                for (int c = 0; c < 16; ++c) *(LAS bf16_t*)(lds + GB_KD + (c0 + c) * 144 + r * 2) = f2bf(y[c] * ekd);
                { const float sc = btr * eg;
#pragma unroll
                  for (int c = 0; c < 16; ++c) y[c] *= sc; }
                pack16(y, a, bq); *(LAS u32x4*)(lds + GB_KB + r * 272 + c0 * 2) = a; *(LAS u32x4*)(lds + GB_KB + r * 272 + c0 * 2 + 16) = bq;
                unpack16(v0, v1, y);
#pragma unroll
                for (int c = 0; c < 16; ++c) y[c] *= btr;
                pack16(y, a, bq); *(LAS u32x4*)(lds + GB_VB + r * 272 + c0 * 2) = a; *(LAS u32x4*)(lds + GB_VB + r * 272 + c0 * 2 + 16) = bq;
                *(LAS u32x4*)(lds + GB_T + (tid >> 3) * 144 + (tid & 7) * 16) = tt;
                *(LAS u32x4*)(lds + GB_AT + (tid >> 3) * 144 + (tid & 7) * 16) = aa;
            }
            __syncthreads();
            {
                bf16x8 Sf[4];
#pragma unroll
                for (int ks = 0; ks < 4; ++ks) { u32x4 w; w.x = cvt_pk_bf16(S[2 * ks][0], S[2 * ks][1]); w.y = cvt_pk_bf16(S[2 * ks][2], S[2 * ks][3]);
                    w.z = cvt_pk_bf16(S[2 * ks + 1][0], S[2 * ks + 1][1]); w.w = cvt_pk_bf16(S[2 * ks + 1][2], S[2 * ks + 1][3]); Sf[ks] = __builtin_bit_cast(bf16x8, w); }
                f32x4 rr[4];
#pragma unroll
                for (int mt = 0; mt < 4; ++mt) {
                    const LAS unsigned char* vp = lds + GB_VB + (16 * mt + 4 * q4) * 272 + (16 * wid + n16) * 2;
                    rr[mt] = (f32x4){-bf2f(*(const LAS bf16_t*)vp), -bf2f(*(const LAS bf16_t*)(vp + 272)), -bf2f(*(const LAS bf16_t*)(vp + 544)), -bf2f(*(const LAS bf16_t*)(vp + 816))};
                    const LAS unsigned char* ap = lds + GB_KB + (16 * mt + n16) * 272 + 8 * q4;
#pragma unroll
                    for (int ks = 0; ks < 4; ++ks) rr[mt] = __builtin_amdgcn_mfma_f32_16x16x32_bf16(lds_frag8x2(ap + ks * 64, ap + ks * 64 + 32), Sf[ks], rr[mt], 0, 0, 0);
                }
                bf16x8 Rf[2];
#pragma unroll
                for (int kt = 0; kt < 2; ++kt) { u32x4 w; w.x = cvt_pk_bf16(-rr[2 * kt][0], -rr[2 * kt][1]); w.y = cvt_pk_bf16(-rr[2 * kt][2], -rr[2 * kt][3]);
                    w.z = cvt_pk_bf16(-rr[2 * kt + 1][0], -rr[2 * kt + 1][1]); w.w = cvt_pk_bf16(-rr[2 * kt + 1][2], -rr[2 * kt + 1][3]); Rf[kt] = __builtin_bit_cast(bf16x8, w); }
                f32x4 vn[4];
#pragma unroll
                for (int mt = 0; mt < 4; ++mt) { vn[mt] = (f32x4){0.f, 0.f, 0.f, 0.f};
                    const LAS unsigned char* tp = lds + GB_T + (16 * mt + n16) * 144 + 8 * q4;
#pragma unroll
                    for (int kt = 0; kt < 2; ++kt) if (kt == 0 || mt >= 2) vn[mt] = __builtin_amdgcn_mfma_f32_16x16x32_bf16(lds_frag8x2(tp + kt * 64, tp + kt * 64 + 32), Rf[kt], vn[mt], 0, 0, 0); }
                bf16x8 Vf[2];
#pragma unroll
                for (int kt = 0; kt < 2; ++kt) { u32x4 w; w.x = cvt_pk_bf16(vn[2 * kt][0], vn[2 * kt][1]); w.y = cvt_pk_bf16(vn[2 * kt][2], vn[2 * kt][3]);
                    w.z = cvt_pk_bf16(vn[2 * kt + 1][0], vn[2 * kt + 1][1]); w.w = cvt_pk_bf16(vn[2 * kt + 1][2], vn[2 * kt + 1][3]); Vf[kt] = __builtin_bit_cast(bf16x8, w); }
#pragma unroll
                for (int mt = 0; mt < 4; ++mt) {
                    f32x4 o = {0.f, 0.f, 0.f, 0.f};
                    const LAS unsigned char* qp = lds + GB_Q + (16 * mt + n16) * 272 + 8 * q4;
#pragma unroll
                    for (int ks = 0; ks < 4; ++ks) o = __builtin_amdgcn_mfma_f32_16x16x32_bf16(lds_frag8x2(qp + ks * 64, qp + ks * 64 + 32), Sf[ks], o, 0, 0, 0);
                    const LAS unsigned char* atp = lds + GB_AT + (16 * mt + n16) * 144 + 8 * q4;
#pragma unroll
                    for (int kt = 0; kt < 2; ++kt) if (kt == 0 || mt >= 2) o = __builtin_amdgcn_mfma_f32_16x16x32_bf16(lds_frag8x2(atp + kt * 64, atp + kt * 64 + 32), Vf[kt], o, 0, 0, 0);
#pragma unroll
                    for (int i = 0; i < 4; ++i) *(LAS float*)(lds + GB_O + (16 * mt + 4 * q4 + i) * 528 + (16 * wid + n16) * 4) = o[i];
                }
                const float eg = __expf(glast);
#pragma unroll
                for (int st = 0; st < 8; ++st) { S[st] = S[st] * eg;
                    const LAS unsigned char* kp = lds + GB_KD + (16 * st + n16) * 144 + 8 * q4;
#pragma unroll
                    for (int kt = 0; kt < 2; ++kt) S[st] = __builtin_amdgcn_mfma_f32_16x16x32_bf16(lds_frag8x2(kp + kt * 64, kp + kt * 64 + 32), Vf[kt], S[st], 0, 0, 0); }
            }
            __syncthreads();
            {
                float o[16];
#pragma unroll
                for (int q = 0; q < 4; ++q) { const f32x4 v = *(const LAS f32x4*)(lds + GB_O + r * 528 + (c0 + 4 * q) * 4); o[4 * q] = v[0]; o[4 * q + 1] = v[1]; o[4 * q + 2] = v[2]; o[4 * q + 3] = v[3]; }
                const float rstd = rsqrtf(sumsq16_8lanes(o) * (1.f / 128.f) + RMS_EPS);
                float gt[16]; unpack16(*(const u32x4*)(hp + 3072), *(const u32x4*)(hp + 3072 + 8), gt);
                float res[16];
#pragma unroll
                for (int c = 0; c < 16; ++c) res[c] = o[c] * rstd * normw[c0 + c] * silu(gt[c]);
                u32x4 a, bq; pack16(res, a, bq);
                *(u32x4*)(hp + 2048) = a; *(u32x4*)(hp + 2048 + 8) = bq;
            }
        }
        __syncthreads();
    }
}

__device__ __forceinline__ void diff_prep_phase(int widk, bf16_t* H  , const int* positions, bf16_t* VT  , LAS unsigned char* lds) {
    MK_IDS();
    for (int item = gt; item < M * 4; item += NGT) {
        const int m = item >> 2, g4 = item & 3; const float pos = (float)positions[m];
        float cs[8], sn[8];
#pragma unroll
        for (int e = 0; e < 8; ++e) { const float inv = exp2f(-(float)(8 * g4 + e) * (13.287712379549449f / 32.f)); sincosf(pos * inv, &sn[e], &cs[e]); }
        bf16_t* rowp = H + (size_t)m * DIFF_N + 8 * g4;
#pragma unroll 4
        for (int blk = 0; blk < 32; ++blk) {
            bf16_t* p1 = rowp + (blk >> 4) * 1024 + (blk & 15) * 64; const float sc = (blk < 16) ? 0.125f * LOG2E : 1.f;
            float x1[8], x2[8], y1[8], y2[8]; unpack8(*(const u32x4*)p1, x1); unpack8(*(const u32x4*)(p1 + 32), x2);
#pragma unroll
            for (int e = 0; e < 8; ++e) { y1[e] = (x1[e] * cs[e] - x2[e] * sn[e]) * sc; y2[e] = (x2[e] * cs[e] + x1[e] * sn[e]) * sc; }
            *(u32x4*)p1 = pack8(y1); *(u32x4*)(p1 + 32) = pack8(y2);
        }
    }
    LAS unsigned char* scr = lds + wid * 16384;
    for (int item = gw; item < NB * 32 * 16; item += NGW) {
        const int dvh = item & 1, h = (item >> 1) & 7, tb = (item >> 4) & 31, b = item >> 9;
        const bf16_t* src = H + ((size_t)b * T + tb * 64) * DIFF_N + 2048 + h * 128 + dvh * 64;
#pragma unroll
        for (int i = 0; i < 8; ++i) { const int row = (lane >> 3) + 8 * i, ch = lane & 7; *(LAS u32x4*)(scr + row * 144 + ch * 16) = *(const u32x4*)(src + (size_t)row * DIFF_N + ch * 8); }
        LDS_WAIT();
        bf16_t* dst = VT + (((size_t)b * 8 + h) * 128 + dvh * 64 + lane) * T + tb * 64;
#pragma unroll
        for (int k = 0; k < 8; ++k) { unsigned short v[8];
#pragma unroll
            for (int e = 0; e < 8; ++e) v[e] = *(const LAS bf16_t*)(scr + (8 * k + e) * 144 + lane * 2);
            u32x4 w; w.x = v[0] | ((unsigned)v[1] << 16); w.y = v[2] | ((unsigned)v[3] << 16); w.z = v[4] | ((unsigned)v[5] << 16); w.w = v[6] | ((unsigned)v[7] << 16);
            *(u32x4*)(dst + 8 * k) = w; }
        LDS_WAIT();
    }
}

constexpr int AT_STAGE = 36864, AT_K = 0, AT_V = 64 * 272;
__device__ __forceinline__ void diff_attn_phase(int widk, const bf16_t* H, const bf16_t* VT, bf16_t* O, const float* lq1, const float* lk1, const float* lq2, const float* lk2, const float* subw, float lambda_init,
                                                LAS unsigned char* lds) {
    MK_IDS();
    const float lam = __expf(wave_sum(lq1[lane] * lk1[lane])) - __expf(wave_sum(lq2[lane] * lk2[lane])) + lambda_init;
    const int c = wid >> 2, rg = wid & 3, l31 = lane & 31, hi = lane >> 5;
    for (int bh = blockIdx.x; bh < 256; bh += gridDim.x) {
        const int b = bh >> 3, h = bh & 7;
        const bf16_t* Kg = H + (size_t)b * T * DIFF_N + 1024 + h * 128;
        const bf16_t* Vg = VT + (size_t)bh * 128 * T;
        for (int ui = 0; ui < 16; ++ui) {
            const int qb = (ui & 1) ? (15 - (ui >> 1)) : (ui >> 1);
            const int q0w = 128 * qb + 32 * rg, nt = 2 * qb + 2;
            bf16x8 qf[4];
            { const bf16_t* qp = H + ((size_t)b * T + q0w + l31) * DIFF_N + h * 128 + c * 64 + 8 * hi;
#pragma unroll
              for (int d0 = 0; d0 < 4; ++d0) qf[d0] = *(const bf16x8*)(qp + 16 * d0); }
            f32x16 o[4];
#pragma unroll
            for (int d = 0; d < 4; ++d) o[d] = (f32x16){};
            float mrun = -1e30f, lrun = 0.f;
            u32x4 pk[2], pv[2];
#define AT_LOAD(j) do { _Pragma("unroll") for (int i_ = 0; i_ < 2; ++i_) { const int ci = tid + 512 * i_; \
                pk[i_] = *(const u32x4*)(Kg + (size_t)((j) * 64 + (ci >> 4)) * DIFF_N + (ci & 15) * 8); \
                pv[i_] = *(const u32x4*)(Vg + (size_t)(ci >> 3) * T + (j) * 64 + (ci & 7) * 8); } } while (0)
            AT_LOAD(0);
            for (int j = 0; j < nt; ++j) {
                LAS unsigned char* st = lds + (j & 1) * AT_STAGE;
#pragma unroll
                for (int i_ = 0; i_ < 2; ++i_) { const int ci = tid + 512 * i_;
                    *(LAS u32x4*)(st + AT_K + (ci >> 4) * 272 + (ci & 15) * 16) = pk[i_];
                    *(LAS u32x4*)(st + AT_V + (ci >> 3) * 144 + (ci & 7) * 16) = pv[i_]; }
                __syncthreads();
                if (j + 1 < nt) AT_LOAD(j + 1);
                if (64 * j <= q0w + 31) {
                    f32x16 p[2];
#pragma unroll
                    for (int kb = 0; kb < 2; ++kb) { p[kb] = (f32x16){};
                        const LAS unsigned char* kp = st + AT_K + (32 * kb + l31) * 272 + c * 128 + hi * 16;
#pragma unroll
                        for (int d0 = 0; d0 < 4; ++d0) p[kb] = __builtin_amdgcn_mfma_f32_32x32x16_bf16(lds_frag16(kp + d0 * 32), qf[d0], p[kb], 0, 0, 0); }
                    if (64 * j + 63 > q0w) {
                        const int q = q0w + l31;
#pragma unroll
                        for (int kb = 0; kb < 2; ++kb)
#pragma unroll
                            for (int r = 0; r < 16; ++r) { const int kv = 64 * j + 32 * kb + crow(r, hi); if (kv > q) p[kb][r] = -1e30f; }
                    }
                    float mx = p[0][0];
#pragma unroll
                    for (int kb = 0; kb < 2; ++kb)
#pragma unroll
                        for (int r = 0; r < 16; ++r) mx = fmaxf(mx, p[kb][r]);
                    mx = fmaxf(mx, __shfl_xor(mx, 32));
                    const float mnew = fmaxf(mrun, mx);
                    if (__any(mnew > mrun)) {
                        const float al = __builtin_amdgcn_exp2f(mrun - mnew); lrun *= al;
#pragma unroll
                        for (int d = 0; d < 4; ++d) o[d] = o[d] * al;
                    }
                    mrun = mnew;
                    float ls = 0.f;
#pragma unroll
                    for (int kb = 0; kb < 2; ++kb)
#pragma unroll
                        for (int r = 0; r < 16; ++r) { p[kb][r] = __builtin_amdgcn_exp2f(p[kb][r] - mnew); ls += p[kb][r]; }
                    lrun += ls;
#pragma unroll
                    for (int kb = 0; kb < 2; ++kb)
#pragma unroll
                        for (int s = 0; s < 2; ++s) {
                            u32x4 w; w.x = cvt_pk_bf16(p[kb][8 * s], p[kb][8 * s + 1]); w.y = cvt_pk_bf16(p[kb][8 * s + 2], p[kb][8 * s + 3]);
                            w.z = cvt_pk_bf16(p[kb][8 * s + 4], p[kb][8 * s + 5]); w.w = cvt_pk_bf16(p[kb][8 * s + 6], p[kb][8 * s + 7]);
                            const bf16x8 pf = __builtin_bit_cast(bf16x8, w);
                            const LAS unsigned char* vp = st + AT_V + l31 * 144 + (32 * kb + 16 * s + 4 * hi) * 2;
#pragma unroll
                            for (int d = 0; d < 4; ++d) o[d] = __builtin_amdgcn_mfma_f32_32x32x16_bf16(lds_frag8x2(vp + d * 32 * 144, vp + d * 32 * 144 + 16), pf, o[d], 0, 0, 0);
                        }
                }
            }
#undef AT_LOAD
            const float ltot = lrun + __shfl_xor(lrun, 32);
            const float inv = (c ? lam : 1.f) / ltot;
            __syncthreads();
            LAS float* xch = (LAS float*)lds + rg * 4096;
            if (c == 1) {
#pragma unroll
                for (int d = 0; d < 4; ++d)
#pragma unroll
                    for (int r = 0; r < 16; ++r) xch[(d * 16 + r) * 64 + lane] = o[d][r] * inv;
            }
            __syncthreads();
            if (c == 0) {
                float ss = 0.f;
#pragma unroll
                for (int d = 0; d < 4; ++d)
#pragma unroll
                    for (int r = 0; r < 16; ++r) { const float v = o[d][r] * inv - xch[(d * 16 + r) * 64 + lane]; o[d][r] = v; ss += v * v; }
                ss += __shfl_xor(ss, 32);
                const float rstd = rsqrtf(ss * (1.f / 128.f) + RMS_EPS) * (1.f - lambda_init);
                bf16_t* op = O + ((size_t)b * T + q0w + l31) * D + h * 128 + 4 * hi;
#pragma unroll
                for (int d = 0; d < 4; ++d)
#pragma unroll
                    for (int g = 0; g < 4; ++g) { const int dv = 32 * d + 8 * g + 4 * hi; const f32x4 sw = *(const f32x4*)(subw + dv);
                        u32x2 w; w.x = cvt_pk_bf16(o[d][4 * g] * rstd * sw[0], o[d][4 * g + 1] * rstd * sw[1]); w.y = cvt_pk_bf16(o[d][4 * g + 2] * rstd * sw[2], o[d][4 * g + 3] * rstd * sw[3]);
                        *(u32x2*)(op + 32 * d + 8 * g) = w; }
            }
            __syncthreads();
        }
    }
}

template <bool FUSED_LN> __global__ void __launch_bounds__(NTHR, 2) fwd_megakernel(Params p) {
    extern __shared__ __attribute__((aligned(16))) unsigned char lds_raw[];
    LAS unsigned char* lds = (LAS unsigned char*)lds_raw;
    cg::grid_group grid = cg::this_grid();
    const int widk = __builtin_amdgcn_readfirstlane((int)threadIdx.x >> 6);
    volatile LAS unsigned* bst = (volatile LAS unsigned*)(lds + 131072 + 1024);
    if (threadIdx.x < 2) bst[threadIdx.x] = 0u;
    __syncthreads();
    const XcdBarrier xbar = xcd_barrier_post((unsigned*)p.ws, bst);
    const int G = gridDim.x;
    constexpr bool fused_ln = FUSED_LN;
    unsigned char* ws = p.ws; unsigned char* wsw = ws + WS_W;
    bf16_t* XN = (bf16_t*)(ws + WS_XN); bf16_t* Hb = (bf16_t*)(ws + WS_H);
    float* Gb = (float*)(ws + WS_GB); float* BETAb = Gb + (size_t)M * 8;

#ifndef NO_PRO
    REPS(4) prologue(widk, p, lds);
#endif
    grid.sync();
    for (int layer = 0; layer < DEPTH; ++layer) {
        const int j = layer >> 1;
        const float* resid = (layer == 0) ? p.in[0] : p.out;
        if ((layer & 1) == 0) {
            {   pg8::Gemm g{XN, (const bf16_t*)(wsw + W_GWIN) + (size_t)j * 4096 * 1024, M, GDN_NMAIN, D, D}; pg8::StaticOrder S; S.init(M, GDN_NMAIN, G, (int)blockIdx.x);
                pg8::EpiBf16 E{Hb, GDN_NMAIN};
                REPS(1) PH_GEMMB pg8::gemm_phase<pg8::EpiBf16, pg8::StaticOrder, true, true, D, D>(widk, lds, g, S, E); }
#ifndef NO_AB
            REPS(4) gdn_ab_phase(widk, XN, (const bf16_t*)(wsw + W_GWAB) + (size_t)j * 16 * 1024, p.in[4] + j * 8, p.in[5] + j * 8, Gb, BETAb);
#endif
            xcd_barrier(xbar, widk);
#ifndef NO_GA
            gdn_phase_a(widk, Hb, Gb, BETAb, p.in[3] + (size_t)j * 4 * 3072, (bf16_t*)(ws + WS_XN) + (size_t)32 * 1024 * 1024, (bf16_t*)(ws + WS_XN), lds);
#endif
            xcd_barrier(xbar, widk);
#ifndef NO_GB
            gdn_phase_b(widk, Hb, Gb, BETAb, p.in[6] + j * 128, (const bf16_t*)(ws + WS_XN) + (size_t)32 * 1024 * 1024, (const bf16_t*)(ws + WS_XN), lds);
#endif
            xcd_barrier(xbar, widk);
            {   pg8::Gemm g{Hb + 2048, (const bf16_t*)(wsw + W_GWOUT) + (size_t)j * 1024 * 1024, M, D, D, GDN_NMAIN}; pg8::StaticOrder S; S.init(M, D, G, (int)blockIdx.x);
                if constexpr (fused_ln) { pg8::EpiResidLn E{resid, p.out, XN, p.in[19] + layer * D, p.in[20] + layer * D, ALPHA, LN_EPS, (unsigned*)(ws + WS_XBUF), (unsigned*)(ws + WS_CNT) + (size_t)(2 * layer) * 4096, (LAS float*)(lds + 131072 + 2048)};
                    pg8::gemm_phase<pg8::EpiResidLn, pg8::StaticOrder, true, true, D, GDN_NMAIN>(widk, lds, g, S, E); }
                else { pg8::EpiResid E{resid, p.out, D, ALPHA};
                    PH_GEMMR pg8::gemm_phase<pg8::EpiResid, pg8::StaticOrder, true, true, D, GDN_NMAIN>(widk, lds, g, S, E); } }
        } else {
            const float lambda_init = 0.8f - 0.6f * expf(-0.3f * (float)layer);
            {   pg8::Gemm g{XN, (const bf16_t*)(wsw + W_DWIN) + (size_t)j * 3072 * 1024, M, DIFF_N, D, D}; pg8::StaticOrder S; S.init(M, DIFF_N, G, (int)blockIdx.x);
                pg8::EpiBf16 E{Hb, DIFF_N};
                REPS(1) PH_GEMMB pg8::gemm_phase<pg8::EpiBf16, pg8::StaticOrder, true, true, D, D>(widk, lds, g, S, E); }
            xcd_barrier(xbar, widk);
#ifndef NO_PREP
            diff_prep_phase(widk, Hb, p.positions, (bf16_t*)(ws + WS_VT), lds);
#endif
            xcd_barrier(xbar, widk);
#ifndef NO_ATT
            REPS(3) diff_attn_phase(widk, Hb, (const bf16_t*)(ws + WS_VT), (bf16_t*)(ws + WS_O), p.in[9] + j * 64, p.in[10] + j * 64, p.in[11] + j * 64, p.in[12] + j * 64, p.in[13] + j * 128, lambda_init, lds);
#endif
            xcd_barrier(xbar, widk);
            {   pg8::Gemm g{(const bf16_t*)(ws + WS_O), (const bf16_t*)(wsw + W_DWOUT) + (size_t)j * 1024 * 1024, M, D, D, D}; pg8::StaticOrder S; S.init(M, D, G, (int)blockIdx.x);
                if constexpr (fused_ln) { pg8::EpiResidLn E{resid, p.out, XN, p.in[19] + layer * D, p.in[20] + layer * D, ALPHA, LN_EPS, (unsigned*)(ws + WS_XBUF), (unsigned*)(ws + WS_CNT) + (size_t)(2 * layer) * 4096, (LAS float*)(lds + 131072 + 2048)};
                    pg8::gemm_phase<pg8::EpiResidLn, pg8::StaticOrder, true, true, D, D>(widk, lds, g, S, E); }
                else { pg8::EpiResid E{resid, p.out, D, ALPHA};
                    PH_GEMMR pg8::gemm_phase<pg8::EpiResid, pg8::StaticOrder, true, true, D, D>(widk, lds, g, S, E); } }
        }
        xcd_barrier(xbar, widk);
        if constexpr (!fused_ln) { ln_phase(widk, p.out, XN, p.in[19] + layer * D, p.in[20] + layer * D); xcd_barrier(xbar, widk); }
        {
            bf16_t* ACT = (bf16_t*)(ws + WS_ACT); float* HALO = (float*)(ws + WS_HALO); float* HALO2 = (float*)(ws + WS_HALO2);
            const float* fcw = p.in[16] + (size_t)layer * 3 * FFN_N; const float* fcb = p.in[17] + (size_t)layer * FFN_N;
            {   pg8::Gemm g{XN, (const bf16_t*)(wsw + W_FUP) + (size_t)layer * 5632 * 1024, M, FFN_N, D, D}; pg8::StaticOrder S; S.init(M, FFN_N, G, (int)blockIdx.x);
                pg8::EpiFfnAct E{ACT, fcw, fcb, HALO, HALO2, (LAS float*)(lds + 131072 + 2048)};
                pg8::gemm_phase<pg8::EpiFfnAct, pg8::StaticOrder, true, true, D, D>(widk, lds, g, S, E); }
            xcd_barrier(xbar, widk);
            ffn_fixup_phase(widk, ACT, HALO, HALO2, fcw, fcb);
            xcd_barrier(xbar, widk);
            {   pg8::Gemm g{ACT, (const bf16_t*)(wsw + W_FDOWN) + (size_t)layer * 1024 * 2816, M, D, FFN_H, FFN_H}; pg8::StaticOrder S; S.init(M, D, G, (int)blockIdx.x);
                if constexpr (fused_ln) { pg8::EpiResidLn E{p.out, p.out, XN, p.in[21] + layer * D, p.in[22] + layer * D, ALPHA, LN_EPS, (unsigned*)(ws + WS_XBUF), (unsigned*)(ws + WS_CNT) + (size_t)(2 * layer + 1) * 4096, (LAS float*)(lds + 131072 + 2048)};
                    pg8::gemm_phase<pg8::EpiResidLn, pg8::StaticOrder, true, true, FFN_H, FFN_H>(widk, lds, g, S, E); }
                else { pg8::EpiResid E{p.out, p.out, D, ALPHA};
                    pg8::gemm_phase<pg8::EpiResid, pg8::StaticOrder, true, true, FFN_H, FFN_H>(widk, lds, g, S, E); } }
        }
        xcd_barrier(xbar, widk);
        if constexpr (!fused_ln) { ln_phase(widk, p.out, XN, p.in[21] + layer * D, p.in[22] + layer * D); xcd_barrier(xbar, widk); }
    }
}
}

extern "C" void kernel_launch(void* const* d_in, const int* in_sizes, int n_in, void* d_out, int out_size, void* d_ws, size_t ws_size, hipStream_t stream) {
    static int grid = 0;
    if (grid == 0) {
        if (n_in != 23 || ws_size < mk::WS_END) { fprintf(stderr, "kernel_launch: unexpected n_in %d / ws_size %zu (need %zu)\n", n_in, ws_size, (size_t)mk::WS_END); grid = -1; return; }
        int dev = 0, cus = 0, per_cu = 0;
        (void)hipGetDevice(&dev); (void)hipDeviceGetAttribute(&cus, hipDeviceAttributeMultiprocessorCount, dev);
        const void* kfn = (const void*)mk::fwd_megakernel<true>; const void* kfn2 = (const void*)mk::fwd_megakernel<false>;
        if (hipFuncSetAttribute(kfn, hipFuncAttributeMaxDynamicSharedMemorySize, mk::LDS_BYTES) != hipSuccess || hipFuncSetAttribute(kfn2, hipFuncAttributeMaxDynamicSharedMemorySize, mk::LDS_BYTES) != hipSuccess) { fprintf(stderr, "kernel_launch: hipFuncSetAttribute failed\n"); grid = -1; return; }
        if (hipOccupancyMaxActiveBlocksPerMultiprocessor(&per_cu, kfn, mk::NTHR, mk::LDS_BYTES) != hipSuccess || per_cu < 1) { fprintf(stderr, "kernel_launch: occupancy query gave %d\n", per_cu); per_cu = 1; }
        (void)hipGetLastError();
        grid = cus * per_cu;
        fprintf(stderr, "kernel_launch: grid %d (cus %d x %d)\n", grid, cus, per_cu);
    }
    if (grid < 0) return;
    mk::Params p{};
    for (int i = 0; i < 23; ++i) p.in[i] = (const float*)d_in[i];
    p.positions = (const int*)d_in[1]; p.out = (float*)d_out; p.ws = (unsigned char*)d_ws;
    if (hipMemsetAsync(d_ws, 0, mk::WS_CTL_BYTES, stream) != hipSuccess) { fprintf(stderr, "kernel_launch: memset failed\n"); return; }
    void* args[] = {&p};
    hipError_t e = hipLaunchCooperativeKernel(grid == 256 ? (const void*)mk::fwd_megakernel<true> : (const void*)mk::fwd_megakernel<false>, dim3(grid), dim3(mk::NTHR), args, mk::LDS_BYTES, stream);
    if (e != hipSuccess) fprintf(stderr, "cooperative launch failed: %s (grid %d)\n", hipGetErrorString(e), grid);
}
```

```cpp
#include <hip/hip_runtime.h>
#include <hip/hip_cooperative_groups.h>
#include <cstdio>
#include <cstdint>
namespace cg = cooperative_groups;
#ifndef PROBE_REP
#define PROBE_REP 0
#endif
#define REPS(k) for (int rep_ = 0; rep_ < ((PROBE_REP) == (k) ? 2 : 1); ++rep_)
#ifndef PROBE_T
#define PROBE_T 0
#endif
#define TBEG(k) if (PROBE_T == (k)) pt0 = __builtin_amdgcn_s_memrealtime()
#define TEND(k) if (PROBE_T == (k)) pticks += __builtin_amdgcn_s_memrealtime() - pt0
namespace pg8 {
#define PG8_LAS __attribute__((address_space(3)))
typedef unsigned short bf16_t;
typedef short bf16x8 __attribute__((ext_vector_type(8)));
typedef float f32x4 __attribute__((ext_vector_type(4)));
typedef unsigned u32x4 __attribute__((ext_vector_type(4)));
constexpr int BM = 256, BK = 64, HALF = 128, HTB = HALF * BK * 2  , STAGE_BYTES = 8 * HTB, NXCD = 8, WGM = 8;

__host__ __device__ __forceinline__ int lds_byte(int r, int c) { const int st = (r >> 4) * 2 + (c >> 5), rr = r & 15, cc = c & 31, ob = rr * 64 + cc * 2; return st * 1024 + (ob ^ (((ob >> 9) & 1) << 5)); }
__host__ __device__ __forceinline__ void stage_rc(int b, int& R, int& C) { const int st = b / 1024, sb = b % 1024, swz = sb ^ (((sb >> 9) & 1) << 5); R = (st >> 1) * 16 + swz / 64; C = (st & 1) * 32 + (swz % 64) / 2; }
__host__ __device__ __forceinline__ int perm32(int rho) { const int n = rho >> 4, i = rho & 15; return 8 * (i >> 2) + 4 * n + (i & 3); }

struct Unit { int pm, pn; };
struct Gemm { const bf16_t* A; const bf16_t* Bt; int M, N, K, lda; };

struct StaticOrder {
    int nM, nN, nwg, G, c;
    __host__ __device__ void init(int M, int N, int G_, int c_) { nM = M / BM; nN = N / BM; nwg = nM * nN; G = G_; c = c_; }
    __host__ __device__ bool next(int i, Unit& u) const {
        const long L = (long)i * G + c; if (L >= nwg) return false;
        int wgid = (int)L; { const int q = nwg / NXCD, r = nwg % NXCD, xcd = wgid % NXCD, off = wgid / NXCD; wgid = (xcd < r ? xcd * (q + 1) : r * (q + 1) + (xcd - r) * q) + off; }
        const int nig = WGM * nN, gid = wgid / nig, fm = gid * WGM, gsz = (nM - fm) < WGM ? (nM - fm) : WGM;
        u.pm = fm + ((wgid % nig) % gsz); u.pn = (wgid % nig) / gsz; return true;
    }
    __device__ __forceinline__ void a_ready(const Unit&) const {}
    __device__ __forceinline__ void done(const Unit&) const {}
};
typedef float f32x2 __attribute__((ext_vector_type(2)));
typedef __bf16 bf16x2v __attribute__((ext_vector_type(2)));
typedef _Float16 f16x2v __attribute__((ext_vector_type(2)));
typedef _Float16 f16x8 __attribute__((ext_vector_type(8)));
__device__ __forceinline__ unsigned cvt_pk_f16(float lo, float hi) { f32x2 v = {lo, hi}; f16x2v b = __builtin_convertvector(v, f16x2v); return __builtin_bit_cast(unsigned, b); }
__device__ __forceinline__ f32x2 unpk_f16(unsigned w) { const f16x2v h = __builtin_bit_cast(f16x2v, w); return __builtin_convertvector(h, f32x2); }
template <bool F16> __device__ __forceinline__ f32x4 mma16(const bf16x8 a, const bf16x8 b, const f32x4 c) {
    if constexpr (F16) return __builtin_amdgcn_mfma_f32_16x16x32_f16(__builtin_bit_cast(f16x8, a), __builtin_bit_cast(f16x8, b), c, 0, 0, 0);
    else return __builtin_amdgcn_mfma_f32_16x16x32_bf16(a, b, c, 0, 0, 0);
}
__device__ __forceinline__ unsigned cvt_pk_bf16(float lo, float hi) { f32x2 v = {lo, hi}; bf16x2v b = __builtin_convertvector(v, bf16x2v); return __builtin_bit_cast(unsigned, b); }

struct EpiBf16 {
    static constexpr bool PERM = true, AFTER_DRAIN = false;
    bf16_t* O; int ldc;
    __device__ __forceinline__ void operator()(const f32x4 (&acc)[2][2][4][2], const Unit& u, int wr, int wc, int fr, int fq) const {
        const int row0 = u.pm * BM + wr * 64 + fr; const int col0 = u.pn * BM + wc * 32 + 8 * fq;
#pragma unroll
        for (int ai = 0; ai < 2; ++ai)
#pragma unroll
            for (int m = 0; m < 4; ++m) { bf16_t* rowp = O + (size_t)(row0 + ai * HALF + m * 16) * ldc + col0;
#pragma unroll
                for (int bj = 0; bj < 2; ++bj) { const f32x4 v0 = acc[ai][bj][m][0], v1 = acc[ai][bj][m][1];
                    u32x4 w; w.x = cvt_pk_bf16(v0[0], v0[1]); w.y = cvt_pk_bf16(v0[2], v0[3]); w.z = cvt_pk_bf16(v1[0], v1[1]); w.w = cvt_pk_bf16(v1[2], v1[3]);
                    *(u32x4*)(rowp + bj * HALF) = w; } }
    }
};
struct EpiResid {
    static constexpr bool PERM = false, AFTER_DRAIN = false;
    const float* base; float* out; int ldc; float alpha;
    __device__ __forceinline__ void operator()(const f32x4 (&acc)[2][2][4][2], const Unit& u, int wr, int wc, int fr, int fq) const {
        const int col0 = u.pn * BM + wc * 32 + 4 * fq;
#pragma unroll
        for (int ai = 0; ai < 2; ++ai)
#pragma unroll
            for (int m = 0; m < 4; ++m) { const int r = ai * HALF + wr * 64 + m * 16 + fr; const size_t off = (size_t)(u.pm * BM + r) * ldc + col0;
#pragma unroll
                for (int bj = 0; bj < 2; ++bj)
#pragma unroll
                    for (int n = 0; n < 2; ++n) { const f32x4 bs = *(const f32x4*)(base + off + bj * HALF + n * 16); const f32x4 o = bs * alpha + acc[ai][bj][m][n];
                        *(f32x4*)(out + off + bj * HALF + n * 16) = o; }
                asm volatile("" ::: "memory"); }
    }
};

struct EpiRope {
    static constexpr bool PERM = true, AFTER_DRAIN = false;
    bf16_t* O; const float* COS; const float* SIN; float qscale; bf16_t* VT;
    __device__ __forceinline__ void operator()(const f32x4 (&acc)[2][2][4][2], const Unit& u, int wr, int wc, int fr_, int fq_) const {
        int fr = fr_, fq = fq_; asm volatile("" : "+v"(fr), "+v"(fq));
        const int row0 = u.pm * BM + wr * 64 + fr;
        if (u.pn >= 8) {
            const int t0 = (u.pm * BM) & 2047, bb = (u.pm * BM) >> 11;
#pragma unroll
            for (int bj = 0; bj < 2; ++bj) {
                bf16_t* vt = VT + ((size_t)(bb * 8 + 2 * (u.pn - 8) + bj) * 128 + wc * 32 + 8 * fq) * 2048 + t0 + wr * 64 + fr;
#pragma unroll
                for (int n = 0; n < 2; ++n)
#pragma unroll
                    for (int e = 0; e < 4; ++e)
#pragma unroll
                        for (int ai = 0; ai < 2; ++ai)
#pragma unroll
                            for (int m = 0; m < 4; ++m) vt[(size_t)(4 * n + e) * 2048 + ai * HALF + m * 16] = (bf16_t)(cvt_pk_bf16(acc[ai][bj][m][n][e], 0.f) & 0xffffu);
            }
        } else {
            const float sc = (u.pn < 4) ? qscale : 1.f;
            const int col1 = u.pn * BM + wc * 64 + 8 * fq;
#pragma unroll
            for (int ai = 0; ai < 2; ++ai)
#pragma unroll
                for (int m = 0; m < 4; ++m) { const int row = row0 + ai * HALF + m * 16;
                    const f32x4 c0 = *(const f32x4*)(COS + (size_t)row * 32 + 8 * fq), c1 = *(const f32x4*)(COS + (size_t)row * 32 + 8 * fq + 4);
                    const f32x4 s0 = *(const f32x4*)(SIN + (size_t)row * 32 + 8 * fq), s1 = *(const f32x4*)(SIN + (size_t)row * 32 + 8 * fq + 4);
                    const f32x4 a0 = acc[ai][0][m][0], a1 = acc[ai][0][m][1], b0 = acc[ai][1][m][0], b1 = acc[ai][1][m][1];
                    const f32x4 y10 = (a0 * c0 - b0 * s0) * sc, y11 = (a1 * c1 - b1 * s1) * sc, y20 = (b0 * c0 + a0 * s0) * sc, y21 = (b1 * c1 + a1 * s1) * sc;
                    u32x4 w1, w2; w1.x = cvt_pk_bf16(y10[0], y10[1]); w1.y = cvt_pk_bf16(y10[2], y10[3]); w1.z = cvt_pk_bf16(y11[0], y11[1]); w1.w = cvt_pk_bf16(y11[2], y11[3]);
                    w2.x = cvt_pk_bf16(y20[0], y20[1]); w2.y = cvt_pk_bf16(y20[2], y20[3]); w2.z = cvt_pk_bf16(y21[0], y21[1]); w2.w = cvt_pk_bf16(y21[2], y21[3]);
                    bf16_t* rowp = O + (size_t)row * 3072 + col1;
                    *(u32x4*)rowp = w1; *(u32x4*)(rowp + 32) = w2;
                    if (m & 1) asm volatile("" ::: "memory"); }
        }
    }
};

template <bool BASE_BF16, bool WRITE_F32> struct EpiResidLn {
    static constexpr bool PERM = true, AFTER_DRAIN = false;
    const float* base; float* out; bf16_t* xn; const float* g; const float* b; float alpha, eps;
    unsigned* xbuf;
    unsigned* cnt;
    PG8_LAS float* sl;
    __device__ __forceinline__ void operator()(f32x4 (&acc)[2][2][4][2], const Unit& u, int wr, int wc, int fr_, int fq_) const {
        typedef unsigned u32x2 __attribute__((ext_vector_type(2)));
        int fr = fr_, fq = fq_; asm volatile("" : "+v"(fr), "+v"(fq));
        const int col0 = u.pn * BM + wc * 32 + 8 * fq;
        const int lane = fq * 16 + fr, wid = wr * 4 + wc, tid = wid * 64 + lane;
#pragma unroll
        for (int ai = 0; ai < 2; ++ai)
#pragma unroll
            for (int m = 0; m < 4; ++m) { const int r = ai * HALF + wr * 64 + m * 16 + fr; const size_t off = (size_t)(u.pm * BM + r) * 1024 + col0;
                float s = 0.f, q = 0.f;
#pragma unroll
                for (int bj = 0; bj < 2; ++bj) { f32x4 bs0, bs1;
                    if constexpr (BASE_BF16) { const u32x4 rb = *(const u32x4*)(xn + off + bj * HALF); const f32x2 a0 = unpk_f16(rb.x), a1 = unpk_f16(rb.y), a2 = unpk_f16(rb.z), a3 = unpk_f16(rb.w);
                        bs0 = (f32x4){a0[0], a0[1], a1[0], a1[1]}; bs1 = (f32x4){a2[0], a2[1], a3[0], a3[1]}; }
                    else { bs0 = *(const f32x4*)(base + off + bj * HALF); bs1 = *(const f32x4*)(base + off + bj * HALF + 4); }
                    const f32x4 y0 = bs0 * alpha + acc[ai][bj][m][0], y1 = bs1 * alpha + acc[ai][bj][m][1]; acc[ai][bj][m][0] = y0; acc[ai][bj][m][1] = y1;
                    s += ((y0[0] + y0[1]) + (y0[2] + y0[3])) + ((y1[0] + y1[1]) + (y1[2] + y1[3]));
                    q += ((y0[0] * y0[0] + y0[1] * y0[1]) + (y0[2] * y0[2] + y0[3] * y0[3])) + ((y1[0] * y1[0] + y1[1] * y1[1]) + (y1[2] * y1[2] + y1[3] * y1[3])); }
                s += __shfl_xor(s, 16); s += __shfl_xor(s, 32); q += __shfl_xor(q, 16); q += __shfl_xor(q, 32);
                if (fq == 0) { sl[(r * 4 + wc) * 2] = s; sl[(r * 4 + wc) * 2 + 1] = q; }
                asm volatile("" ::: "memory"); }
        asm volatile("s_waitcnt lgkmcnt(0)" ::: "memory"); __builtin_amdgcn_s_barrier(); asm volatile("" ::: "memory");
        if (tid < 256) {
            const PG8_LAS f32x4* pp = (const PG8_LAS f32x4*)(sl + tid * 8); const f32x4 p0 = pp[0], p1 = pp[1];
            const float S = (p0[0] + p0[2]) + (p1[0] + p1[2]), Q = (p0[1] + p0[3]) + (p1[1] + p1[3]);
            unsigned* xp = xbuf + (((size_t)u.pm * 4 + u.pn) * 256 + tid) * 2;
            __hip_atomic_store(xp, __float_as_uint(S), __ATOMIC_RELAXED, __HIP_MEMORY_SCOPE_AGENT); __hip_atomic_store(xp + 1, __float_as_uint(Q), __ATOMIC_RELAXED, __HIP_MEMORY_SCOPE_AGENT);
            asm volatile("s_waitcnt vmcnt(0)" ::: "memory");
            if (lane == 0) __hip_atomic_fetch_add(cnt + 16 * u.pm, 1u, __ATOMIC_RELAXED, __HIP_MEMORY_SCOPE_AGENT);
        }
        if (wid == 0) {
            unsigned sp = 0;
            while ((unsigned)__builtin_amdgcn_readfirstlane(__hip_atomic_load(cnt + 16 * u.pm, __ATOMIC_RELAXED, __HIP_MEMORY_SCOPE_AGENT)) < 16u) { __builtin_amdgcn_s_sleep(2); if (++sp > (1u << 22)) break; }
            __builtin_amdgcn_fence(__ATOMIC_ACQUIRE, "agent");
        }
        asm volatile("s_waitcnt vmcnt(0) lgkmcnt(0)" ::: "memory"); __builtin_amdgcn_s_barrier(); asm volatile("" ::: "memory");
        if (tid < 256) {
            float S = 0.f, Q = 0.f;
#pragma unroll
            for (int t = 0; t < 4; ++t) { unsigned* xp = xbuf + (((size_t)u.pm * 4 + t) * 256 + tid) * 2;
                S += __uint_as_float(__hip_atomic_load(xp, __ATOMIC_RELAXED, __HIP_MEMORY_SCOPE_AGENT)); Q += __uint_as_float(__hip_atomic_load(xp + 1, __ATOMIC_RELAXED, __HIP_MEMORY_SCOPE_AGENT)); }
            const float mean = S * (1.f / 1024.f), var = fmaxf(Q * (1.f / 1024.f) - mean * mean, 0.f);
            sl[2048 + tid * 2] = mean; sl[2048 + tid * 2 + 1] = 1.f / sqrtf(var + eps);
        }
        asm volatile("s_waitcnt lgkmcnt(0)" ::: "memory"); __builtin_amdgcn_s_barrier(); asm volatile("" ::: "memory");
#pragma unroll
        for (int bj = 0; bj < 2; ++bj) {
            const f32x4 gv0 = *(const f32x4*)(g + col0 + bj * HALF), gv1 = *(const f32x4*)(g + col0 + bj * HALF + 4), bv0 = *(const f32x4*)(b + col0 + bj * HALF), bv1 = *(const f32x4*)(b + col0 + bj * HALF + 4);
#pragma unroll
            for (int ai = 0; ai < 2; ++ai)
#pragma unroll
                for (int m = 0; m < 4; ++m) { const int r = ai * HALF + wr * 64 + m * 16 + fr; const size_t off = (size_t)(u.pm * BM + r) * 1024 + col0 + bj * HALF;
                    const float mean = sl[2048 + r * 2], rstd = sl[2048 + r * 2 + 1];
                    const f32x4 o0 = (acc[ai][bj][m][0] - mean) * rstd * gv0 + bv0, o1 = (acc[ai][bj][m][1] - mean) * rstd * gv1 + bv1;
                    if constexpr (WRITE_F32) { *(f32x4*)(out + off) = o0; *(f32x4*)(out + off + 4) = o1; }
                    u32x4 w; w.x = cvt_pk_f16(o0[0], o0[1]); w.y = cvt_pk_f16(o0[2], o0[3]); w.z = cvt_pk_f16(o1[0], o1[1]); w.w = cvt_pk_f16(o1[2], o1[3]); *(u32x4*)(xn + off) = w; }
            asm volatile("" ::: "memory");
        }
    }
};

__device__ __forceinline__ float dpp_ror1(float v) { float r; asm volatile("s_nop 1\n\tv_mov_b32_dpp %0, %1 row_ror:1 row_mask:0xf bank_mask:0xf" : "=&v"(r) : "v"(v)); return r; }
__device__ __forceinline__ float dpp_ror2(float v) { float r; asm volatile("s_nop 1\n\tv_mov_b32_dpp %0, %1 row_ror:2 row_mask:0xf bank_mask:0xf" : "=&v"(r) : "v"(v)); return r; }
__device__ __forceinline__ float silu_f(float x) { return x * __builtin_amdgcn_rcpf(1.f + __expf(-x)); }
struct EpiFfnAct {
    static constexpr bool PERM = true, AFTER_DRAIN = false;
    bf16_t* ACT; const float* cw; const float* cb; float* HALO; float* HALO2; PG8_LAS float* hl;
    __device__ __forceinline__ void operator()(const f32x4 (&acc)[2][2][4][2], const Unit& u, int wr, int wc, int fr_, int fq_) const {
        int fr = fr_, fq = fq_; asm volatile("" : "+v"(fr), "+v"(fq));
        const int cc0 = wc * 32 + 8 * fq, colA = u.pn * 128 + cc0;
        if (fr >= 14) {
#pragma unroll
            for (int ai = 0; ai < 2; ++ai) { PG8_LAS float* hp = hl + ((2 * ai + wr) * 2 + (fr - 14)) * 256 + cc0;
#pragma unroll
                for (int bj = 0; bj < 2; ++bj)
#pragma unroll
                    for (int n = 0; n < 2; ++n) *(PG8_LAS f32x4*)(hp + bj * 128 + 4 * n) = acc[ai][bj][3][n]; }
            if (wr == 1) { float* gp = HALO + ((size_t)u.pm * 2 + (fr - 14)) * 5632 + colA;
#pragma unroll
                for (int bj = 0; bj < 2; ++bj)
#pragma unroll
                    for (int n = 0; n < 2; ++n) *(f32x4*)(gp + bj * 2816 + 4 * n) = acc[1][bj][3][n]; }
        }
        if (fr < 2 && wr == 0) { float* gp = HALO2 + ((size_t)u.pm * 2 + fr) * 5632 + colA;
#pragma unroll
            for (int bj = 0; bj < 2; ++bj)
#pragma unroll
                for (int n = 0; n < 2; ++n) *(f32x4*)(gp + bj * 2816 + 4 * n) = acc[0][bj][0][n]; }
        asm volatile("s_waitcnt lgkmcnt(0)" ::: "memory"); __builtin_amdgcn_s_barrier(); asm volatile("" ::: "memory");
#pragma unroll
        for (int ai = 0; ai < 2; ++ai) {
            const int strip = 2 * ai + wr;
            unsigned kx[4], ky[4];
#pragma unroll
            for (int n = 0; n < 2; ++n) {
                f32x4 wa[3], wb[3];
#pragma unroll
                for (int j = 0; j < 3; ++j) { wa[j] = *(const f32x4*)(cw + j * 5632 + colA + 4 * n); wb[j] = *(const f32x4*)(cw + j * 5632 + 2816 + colA + 4 * n); }
                const f32x4 ba = *(const f32x4*)(cb + colA + 4 * n), bb = *(const f32x4*)(cb + 2816 + colA + 4 * n);
                f32x4 h1a = {0.f, 0.f, 0.f, 0.f}, h2a = h1a, h1b = h1a, h2b = h1a;
                if (strip > 0) { const PG8_LAS float* hp = hl + ((strip - 1) * 2) * 256 + cc0 + 4 * n;
                    h2a = *(const PG8_LAS f32x4*)hp; h1a = *(const PG8_LAS f32x4*)(hp + 256); h2b = *(const PG8_LAS f32x4*)(hp + 128); h1b = *(const PG8_LAS f32x4*)(hp + 256 + 128); }
                f32x4 pr1a = h1a, pr2a = h2a, pr1b = h1b, pr2b = h2b;
#pragma unroll
                for (int m = 0; m < 4; ++m) {
                    const f32x4 ca = acc[ai][0][m][n], cbv = acc[ai][1][m][n];
                    f32x4 c1a, c2a, c1b, c2b;
#pragma unroll
                    for (int e = 0; e < 4; ++e) { c1a[e] = dpp_ror1(ca[e]); c2a[e] = dpp_ror2(ca[e]); c1b[e] = dpp_ror1(cbv[e]); c2b[e] = dpp_ror2(cbv[e]); }
                    float o[4];
#pragma unroll
                    for (int e = 0; e < 4; ++e) {
                        float x1a, x2a, x1b, x2b;
                        if (m > 0) { x1a = pr1a[e]; x2a = pr2a[e]; x1b = pr1b[e]; x2b = pr2b[e]; }
                        else { x1a = h1a[e]; x2a = (fr == 0) ? h2a[e] : h1a[e]; x1b = h1b[e]; x2b = (fr == 0) ? h2b[e] : h1b[e]; }
                        const float p1a = (fr == 0) ? x1a : c1a[e], p2a = (fr < 2) ? x2a : c2a[e];
                        const float p1b = (fr == 0) ? x1b : c1b[e], p2b = (fr < 2) ? x2b : c2b[e];
                        const float ya = wa[0][e] * p2a + wa[1][e] * p1a + wa[2][e] * ca[e] + ba[e];
                        const float yb = wb[0][e] * p2b + wb[1][e] * p1b + wb[2][e] * cbv[e] + bb[e];
                        o[e] = silu_f(ya) * yb;
                    }
                    pr1a = c1a; pr2a = c2a; pr1b = c1b; pr2b = c2b;
                    const unsigned w0 = cvt_pk_bf16(o[0], o[1]), w1 = cvt_pk_bf16(o[2], o[3]);
                    asm volatile("" :: "v"(w0), "v"(w1));
                    if (n == 0) { kx[m] = w0; ky[m] = w1; }
                    else { u32x4 w; w.x = kx[m]; w.y = ky[m]; w.z = w0; w.w = w1; *(u32x4*)(ACT + (size_t)(u.pm * BM + ai * HALF + wr * 64 + m * 16 + fr) * 2816 + colA) = w; }
                }
                asm volatile("" ::: "memory");
            }
        }
    }
};

template <class Epi, class Sched, bool ALIGN_EPI, bool SP2, int KC, int LDAC, bool F16 = false>
__device__ __forceinline__ void gemm_phase(int widk, PG8_LAS unsigned char* lds, const Gemm g, const Sched& S, const Epi& E) {
    int lane_; asm volatile("v_mbcnt_lo_u32_b32 %0, -1, 0\n\tv_mbcnt_hi_u32_b32 %0, -1, %0" : "=v"(lane_));
    int wid_ = widk; asm volatile("" : "+s"(wid_));
    const int wid = wid_, lane = lane_, tid = wid * 64 + lane, wr = wid >> 2, wc = wid & 3, fr = lane & 15, fq = lane >> 4;
    constexpr int K = KC, nt = K / BK;
    unsigned voffA[2], voffB[2];
#pragma unroll
    for (int i = 0; i < 2; ++i) { int R, C; stage_rc(tid * 16 + i * 8192, R, C); const int Rb = Epi::PERM ? ((R & ~31) + perm32(R & 31)) : R;
        voffA[i] = (unsigned)(R * LDAC + C) * 2u; voffB[i] = (unsigned)(Rb * K + C) * 2u; }
    const size_t kstep = (size_t)(BK * 2);
    const size_t hstepA = (size_t)HALF * LDAC * 2, hstepB = (size_t)HALF * K * 2;
    const size_t tstepA = 2 * hstepA, tstepB = 2 * hstepB;
    const unsigned ldsw = (unsigned)wid * 1024u;
    const int aoff = lds_byte(wr * 64 + fr, fq * 8), boff = lds_byte(wc * 32 + fr, fq * 8);
#define PG8_SA(b, h) (((b) * 2 + (h)) * HTB)
#define PG8_SB(b, h) ((4 + (b) * 2 + (h)) * HTB)
#define PG8_STAGE(bufoff, gbase, voff) do { _Pragma("unroll") for (int _i = 0; _i < 2; ++_i) \
        __builtin_amdgcn_global_load_lds((const unsigned*)((const char*)(gbase) + (voff)[_i]), (PG8_LAS unsigned*)(lds + (bufoff) + ldsw + _i * 8192), 16, 0, 0); } while (0)
#define PG8_LDA(dst, b, h) do { _Pragma("unroll") for (int m = 0; m < 4; ++m) _Pragma("unroll") for (int k = 0; k < 2; ++k) dst[m][k] = *(const PG8_LAS bf16x8*)(lds + PG8_SA(b, h) + aoff + m * 2048 + k * 1024); } while (0)
#define PG8_LDB(dst, b, h) do { _Pragma("unroll") for (int n = 0; n < 2; ++n) _Pragma("unroll") for (int k = 0; k < 2; ++k) dst[n][k] = *(const PG8_LAS bf16x8*)(lds + PG8_SB(b, h) + boff + n * 2048 + k * 1024); } while (0)
#define PG8_MMA(ai, bj, At, Bt) do { __builtin_amdgcn_s_setprio(1); _Pragma("unroll") for (int m = 0; m < 4; ++m) _Pragma("unroll") for (int n = 0; n < 2; ++n) _Pragma("unroll") for (int k = 0; k < 2; ++k) \
        acc[ai][bj][m][n] = mma16<F16>(Bt[n][k], At[m][k], acc[ai][bj][m][n]); __builtin_amdgcn_s_setprio(0); } while (0)
#define PG8_WAIT_V(n) asm volatile("s_waitcnt vmcnt(" #n ")" ::: "memory")
#define PG8_WAIT_L(n) asm volatile("s_waitcnt lgkmcnt(" #n ")" ::: "memory")
#define PG8_BAR __builtin_amdgcn_s_barrier()
#define PG8_SCHED __builtin_amdgcn_sched_barrier(0)
    Unit cur, nxt; int ui = 0;
    if (!S.next(0, cur)) return;
    f32x4 acc[2][2][4][2];
#pragma unroll
    for (int a = 0; a < 2; ++a)
#pragma unroll
        for (int b = 0; b < 2; ++b)
#pragma unroll
            for (int m = 0; m < 4; ++m)
#pragma unroll
                for (int n = 0; n < 2; ++n) acc[a][b][m][n] = (f32x4){0.f, 0.f, 0.f, 0.f};
    bf16x8 At[4][2], B0[2][2], B1[2][2];
    const char* cA = (const char*)g.A + (size_t)cur.pm * tstepA; const char* cB = (const char*)g.Bt + (size_t)cur.pn * tstepB;
    S.a_ready(cur);
    if constexpr (SP2) {
        PG8_STAGE(PG8_SB(0, 0), cB, voffB); PG8_STAGE(PG8_SB(0, 1), cB + hstepB, voffB); PG8_STAGE(PG8_SA(0, 0), cA, voffA); PG8_STAGE(PG8_SA(0, 1), cA + hstepA, voffA);
        if (wr == 1) PG8_BAR;
        PG8_WAIT_V(2); PG8_BAR;
        PG8_STAGE(PG8_SB(1, 0), cB + kstep, voffB); PG8_STAGE(PG8_SA(1, 0), cA + kstep, voffA); PG8_STAGE(PG8_SB(1, 1), cB + hstepB + kstep, voffB);
        PG8_WAIT_V(6); PG8_BAR;
    } else {
        PG8_STAGE(PG8_SB(0, 0), cB, voffB); PG8_STAGE(PG8_SA(0, 0), cA, voffA); PG8_STAGE(PG8_SB(0, 1), cB + hstepB, voffB); PG8_STAGE(PG8_SA(0, 1), cA + hstepA, voffA);
        if (wr == 1) PG8_BAR;
        PG8_WAIT_V(4); PG8_BAR;
        PG8_STAGE(PG8_SB(1, 0), cB + kstep, voffB); PG8_STAGE(PG8_SA(1, 0), cA + kstep, voffA); PG8_STAGE(PG8_SB(1, 1), cB + hstepB + kstep, voffB);
        PG8_WAIT_V(6); PG8_BAR;
    }
    for (;;) {
        const bool has_next = S.next(ui + 1, nxt);
        const char* nA = has_next ? (const char*)g.A + (size_t)nxt.pm * tstepA : cA; const char* nB = has_next ? (const char*)g.Bt + (size_t)nxt.pn * tstepB : cB;
        for (int t = 0; t < nt; t += 2) {
            const bool last = (t == nt - 2);
            const char* a1 = cA + (size_t)(t + 1) * kstep;
            const char* a2 = last ? nA : cA + (size_t)(t + 2) * kstep; const char* b2 = last ? nB : cB + (size_t)(t + 2) * kstep;
            const char* a3 = a2 + kstep; const char* b3 = b2 + kstep;
            if (last && has_next) S.a_ready(nxt);
            if constexpr (SP2) {
            PG8_LDB(B0, 0, 0); PG8_LDB(B1, 0, 1); PG8_SCHED; PG8_LDA(At, 0, 0); PG8_STAGE(PG8_SA(1, 1), a1 + hstepA, voffA);
            PG8_WAIT_V(8); PG8_WAIT_L(0); PG8_BAR; PG8_MMA(0, 0, At, B0); PG8_MMA(0, 1, At, B1); PG8_BAR; PG8_SCHED;
            PG8_LDA(At, 0, 1); PG8_STAGE(PG8_SB(0, 0), b2, voffB); PG8_STAGE(PG8_SB(0, 1), b2 + hstepB, voffB); PG8_STAGE(PG8_SA(0, 0), a2, voffA);
            PG8_WAIT_V(8); PG8_WAIT_L(0); PG8_BAR; PG8_MMA(1, 0, At, B0); PG8_MMA(1, 1, At, B1); PG8_BAR; PG8_SCHED;
            PG8_LDB(B0, 1, 0); PG8_LDB(B1, 1, 1); PG8_SCHED; PG8_LDA(At, 1, 0); PG8_STAGE(PG8_SA(0, 1), a2 + hstepA, voffA);
            PG8_WAIT_V(8); PG8_WAIT_L(0); PG8_BAR; PG8_MMA(0, 0, At, B0); PG8_MMA(0, 1, At, B1); PG8_BAR; PG8_SCHED;
            PG8_LDA(At, 1, 1); PG8_STAGE(PG8_SB(1, 0), b3, voffB); PG8_STAGE(PG8_SB(1, 1), b3 + hstepB, voffB); PG8_STAGE(PG8_SA(1, 0), a3, voffA);
            PG8_WAIT_V(8); PG8_WAIT_L(0); PG8_BAR; PG8_MMA(1, 0, At, B0); PG8_MMA(1, 1, At, B1); PG8_BAR; PG8_SCHED;
            } else {
            PG8_LDB(B0, 0, 0); PG8_SCHED; PG8_LDA(At, 0, 0); PG8_STAGE(PG8_SA(1, 1), a1 + hstepA, voffA);
            PG8_WAIT_L(8); PG8_BAR; PG8_WAIT_L(0); PG8_MMA(0, 0, At, B0); PG8_BAR; PG8_SCHED;
            PG8_LDB(B1, 0, 1); PG8_STAGE(PG8_SB(0, 0), b2, voffB);
            PG8_BAR; PG8_WAIT_L(0); PG8_MMA(0, 1, At, B1); PG8_BAR;
            PG8_LDA(At, 0, 1); PG8_STAGE(PG8_SA(0, 0), a2, voffA);
            PG8_BAR; PG8_WAIT_L(0); PG8_MMA(1, 0, At, B0); PG8_BAR; PG8_SCHED;
            PG8_STAGE(PG8_SB(0, 1), b2 + hstepB, voffB);
            PG8_WAIT_V(6); PG8_BAR; PG8_MMA(1, 1, At, B1); PG8_BAR;
            PG8_LDB(B0, 1, 0); PG8_SCHED; PG8_LDA(At, 1, 0); PG8_STAGE(PG8_SA(0, 1), a2 + hstepA, voffA);
            PG8_WAIT_L(8); PG8_BAR; PG8_WAIT_L(0); PG8_MMA(0, 0, At, B0); PG8_BAR; PG8_SCHED;
            PG8_LDB(B1, 1, 1); PG8_STAGE(PG8_SB(1, 0), b3, voffB);
            PG8_BAR; PG8_WAIT_L(0); PG8_MMA(0, 1, At, B1); PG8_BAR;
            PG8_LDA(At, 1, 1); PG8_STAGE(PG8_SA(1, 0), a3, voffA);
            PG8_BAR; PG8_WAIT_L(0); PG8_MMA(1, 0, At, B0); PG8_BAR; PG8_SCHED;
            PG8_STAGE(PG8_SB(1, 1), b3 + hstepB, voffB);
            PG8_WAIT_V(6); PG8_BAR; PG8_MMA(1, 1, At, B1); PG8_BAR;
            }
        }
        if constexpr (ALIGN_EPI) { if (wr == 0) PG8_BAR; }
        if constexpr (!Epi::AFTER_DRAIN) { E(acc, cur, wr, wc, fr, fq); S.done(cur); }
        if (!has_next) break;
#pragma unroll
        for (int a = 0; a < 2; ++a)
#pragma unroll
            for (int b = 0; b < 2; ++b)
#pragma unroll
                for (int m = 0; m < 4; ++m)
#pragma unroll
                    for (int n = 0; n < 2; ++n) acc[a][b][m][n] = (f32x4){0.f, 0.f, 0.f, 0.f};
        cur = nxt; cA = nA; cB = nB; ++ui;
        if constexpr (ALIGN_EPI) { if (wr == 1) PG8_BAR; }
    }
    PG8_WAIT_V(0);
    if constexpr (!ALIGN_EPI) { if (wr == 0) PG8_BAR; }
    PG8_BAR;
    if constexpr (Epi::AFTER_DRAIN) { E.fused(acc, cur, wr, wc, fr, fq, lds, wid, lane); S.done(cur); }
#undef PG8_SA
#undef PG8_SB
#undef PG8_STAGE
#undef PG8_LDA
#undef PG8_LDB
#undef PG8_MMA
#undef PG8_WAIT_V
#undef PG8_WAIT_L
#undef PG8_BAR
#undef PG8_SCHED
}
}

#ifdef NO_GEMMB
#define PH_GEMMB if (0)
#else
#define PH_GEMMB
#endif
#ifdef NO_GEMMR
#define PH_GEMMR if (0)
#else
#define PH_GEMMR
#endif
namespace mk {
#define LAS __attribute__((address_space(3)))
typedef unsigned short bf16_t;
typedef short bf16x8 __attribute__((ext_vector_type(8)));
typedef short s16x4 __attribute__((ext_vector_type(4)));
typedef float f32x4 __attribute__((ext_vector_type(4)));
typedef float f32x16 __attribute__((ext_vector_type(16)));
typedef unsigned u32x4 __attribute__((ext_vector_type(4)));
typedef unsigned u32x2 __attribute__((ext_vector_type(2)));
using pg8::cvt_pk_bf16;

constexpr int NB = 32, T = 2048, D = 1024, M = NB * T, DEPTH = 4;
constexpr int NWAVES = 8, NTHR = 512;
constexpr int GDN_N = 4112, GDN_NMAIN = 4096, DIFF_N = 3072, FFN_H = 2816, FFN_N = 5632;
constexpr float LN_EPS = 1e-5f, RMS_EPS = 1e-6f;
constexpr float ALPHA = 1.6817928305074290f;
constexpr float LOG2E = 1.4426950408889634f;
constexpr int MH = M / 2;

constexpr size_t MiB = 1u << 20;
constexpr size_t WS_W = 2 * MiB;
constexpr size_t W_GWIN = 0, W_GWAB = W_GWIN + 2ull * 4096 * 1024 * 2, W_GWOUT = W_GWAB + 2ull * 16 * 1024 * 2, W_DWIN = W_GWOUT + 2ull * 1024 * 1024 * 2,
                 W_DWOUT = W_DWIN + 2ull * 3072 * 1024 * 2, W_FUP = W_DWOUT + 2ull * 1024 * 1024 * 2, W_FDOWN = W_FUP + 4ull * 5632 * 1024 * 2, W_END = W_FDOWN + 4ull * 1024 * 2816 * 2;
static_assert(WS_W + W_END <= 106 * MiB, "weights region");
constexpr size_t WS_CNT = 16384;
constexpr size_t WS_CTL_BYTES = 16384 + 8 * 256 * 16 * 4;
constexpr size_t WS_XBUF = 1 * MiB;
constexpr size_t WS_GB = 106 * MiB;
constexpr size_t WS_XN = 112 * MiB;
constexpr size_t WS_H = 240 * MiB;
constexpr size_t WS_ACT = WS_H;
constexpr size_t WS_HALO = WS_H + 352 * MiB;
constexpr size_t WS_HALO2 = WS_HALO + 12 * MiB;
constexpr size_t WS_UT = WS_H + 512 * MiB;
constexpr size_t WS_WN = WS_UT + 128 * MiB;
constexpr size_t WS_VT = WS_H + 384 * MiB;
constexpr size_t WS_O = WS_VT + 128 * MiB;
constexpr size_t WS_ROPE = WS_WN + 128 * MiB;
constexpr size_t WS_END = WS_ROPE + 16 * MiB;
static_assert(WS_END <= 1024 * MiB, "workspace map");
constexpr int LDS_BYTES = 131072 + 2048 + 10240;

__device__ __forceinline__ float bf2f(unsigned short h) { return __uint_as_float((unsigned)h << 16); }
__device__ __forceinline__ unsigned short f2bf(float f) { return (unsigned short)(cvt_pk_bf16(f, 0.f) & 0xffffu); }
__device__ __forceinline__ float wave_sum(float v) {
#pragma unroll
    for (int o = 1; o < 64; o <<= 1) v += __shfl_xor(v, o);
    return v;
}
__device__ __forceinline__ float silu(float x) { return x * __builtin_amdgcn_rcpf(1.f + __expf(-x)); }
__device__ __forceinline__ void unpack8(const u32x4 v, float (&o)[8]) {
    o[0] = __uint_as_float(v.x << 16); o[1] = __uint_as_float(v.x & 0xffff0000u); o[2] = __uint_as_float(v.y << 16); o[3] = __uint_as_float(v.y & 0xffff0000u);
    o[4] = __uint_as_float(v.z << 16); o[5] = __uint_as_float(v.z & 0xffff0000u); o[6] = __uint_as_float(v.w << 16); o[7] = __uint_as_float(v.w & 0xffff0000u);
}
__device__ __forceinline__ u32x4 pack8(const float (&o)[8]) { u32x4 w; w.x = cvt_pk_bf16(o[0], o[1]); w.y = cvt_pk_bf16(o[2], o[3]); w.z = cvt_pk_bf16(o[4], o[5]); w.w = cvt_pk_bf16(o[6], o[7]); return w; }
__device__ __forceinline__ int crow(int r, int hi) { return (r & 3) + 8 * (r >> 2) + 4 * hi; }
#define LDS_WAIT() asm volatile("s_waitcnt lgkmcnt(0)" ::: "memory")
#define MK_IDS() int lane_; asm volatile("v_mbcnt_lo_u32_b32 %0, -1, 0\n\tv_mbcnt_hi_u32_b32 %0, -1, %0" : "=v"(lane_));   \
      \
    int wid_ = widk; asm volatile("" : "+s"(wid_)); const int lane = lane_, wid = wid_, tid = wid * 64 + lane; const int G_ = gridDim.x, gw = blockIdx.x * NWAVES + wid, NGW = G_ * NWAVES, gt = blockIdx.x * NTHR + tid, NGT = G_ * NTHR; \
    (void)lane; (void)wid; (void)gw; (void)NGW; (void)gt; (void)NGT

template <int UPPERM = 0, bool F16OUT = false> __device__ __forceinline__ void transpose_item(const float* W, int ldw, int K, int nblk, bf16_t* WT, LAS float* scr, int item, int lane) {
    const int kb = item / nblk, nb = item % nblk, k0 = 64 * kb, n0 = 32 * nb;
    const int r0 = UPPERM == 1 ? (n0 < FFN_H ? 256 * (n0 >> 7) + (n0 & 127) : 256 * ((n0 - FFN_H) >> 7) + 128 + ((n0 - FFN_H) & 127))
                 : UPPERM == 2 ? (n0 < 2048 ? (n0 & ~255) + 128 * ((n0 >> 5) & 1) + 32 * ((n0 >> 6) & 3) : n0) : n0;
#pragma unroll 8
    for (int i = 0; i < 32; ++i) { const int kk = 2 * i + (lane >> 5); scr[kk * 33 + (lane & 31)] = W[(size_t)(k0 + kk) * ldw + n0 + (lane & 31)]; }
    LDS_WAIT();
    const int c = lane & 7;
#pragma unroll
    for (int j = 0; j < 4; ++j) { const int n = (lane >> 3) + 8 * j; const LAS float* s = scr + (8 * c) * 33 + n;
        u32x4 o;
        if constexpr (F16OUT) { o.x = pg8::cvt_pk_f16(s[0 * 33], s[1 * 33]); o.y = pg8::cvt_pk_f16(s[2 * 33], s[3 * 33]); o.z = pg8::cvt_pk_f16(s[4 * 33], s[5 * 33]); o.w = pg8::cvt_pk_f16(s[6 * 33], s[7 * 33]); }
        else { o.x = cvt_pk_bf16(s[0 * 33], s[1 * 33]); o.y = cvt_pk_bf16(s[2 * 33], s[3 * 33]); o.z = cvt_pk_bf16(s[4 * 33], s[5 * 33]); o.w = cvt_pk_bf16(s[6 * 33], s[7 * 33]); }
        *(u32x4*)(WT + (size_t)(r0 + n) * K + k0 + 8 * c) = o; }
    LDS_WAIT();
}

#define XB_TMO      128
#define XB_XCNT(j)  (256  + 64 * (j))
#define XB_XSUB(j)  (1280 + 64 * (j))
#define XB_XGEN(j)  (2304 + 64 * (j))
#define XB_TOP      3328
#define XB_TOPGEN   3392
#define XCD_BAR_WORDS 3456
#define XB_SPIN_CAP (1u << 18)

__device__ __forceinline__ unsigned xb_ld(unsigned* p)              { return __hip_atomic_load(p, __ATOMIC_RELAXED, __HIP_MEMORY_SCOPE_AGENT); }
__device__ __forceinline__ unsigned xb_add(unsigned* p, unsigned v) { return __hip_atomic_fetch_add(p, v, __ATOMIC_RELAXED, __HIP_MEMORY_SCOPE_AGENT); }
__device__ __forceinline__ unsigned xb_xcc_id() { return (unsigned)__builtin_amdgcn_s_getreg((3 << 11) | 20) & 0xFu; }
#define XB_SPIN(cond, bar) do { unsigned _sp = 0; while (cond) { __builtin_amdgcn_s_sleep(1); \
    if ((++_sp & 255u) == 0u) { if (xb_ld(&(bar)[XB_TMO])) break; if (_sp > XB_SPIN_CAP) { atomicAdd(&(bar)[XB_TMO], 1u); break; } } } } while (0)

struct XcdBarrier {
    unsigned* bar; unsigned x;
    volatile LAS unsigned* st;
};

__device__ __forceinline__ XcdBarrier xcd_barrier_post(unsigned* bar, volatile LAS unsigned* st) {
    XcdBarrier b; b.bar = bar; b.x = xb_xcc_id(); b.st = st;
    if (threadIdx.x == 0) (void)xb_add(&bar[XB_XCNT(b.x)], 1u);
    return b;
}
__device__ __forceinline__ void xcd_barrier_complete(unsigned* bar, unsigned x, unsigned& nloc, unsigned& nx) {
    const unsigned G = gridDim.x * gridDim.y * gridDim.z;
    unsigned sum, cnt, mine, sp = 0u;
    for (;;) {
        sum = 0u; cnt = 0u; mine = 0u;
#pragma unroll
        for (unsigned j = 0; j < 16; ++j) { const unsigned c = xb_ld(&bar[XB_XCNT(j)]); sum += c; cnt += (c > 0u) ? 1u : 0u; mine = (j == x) ? c : mine; }
        if (sum == G) break;
        __builtin_amdgcn_s_sleep(1);
        if ((++sp & 255u) == 0u) { if (xb_ld(&bar[XB_TMO])) break; if (sp > XB_SPIN_CAP) { atomicAdd(&bar[XB_TMO], 1u); break; } }
    }
    nloc = mine > 0u ? mine : 1u; nx = cnt > 0u ? cnt : 1u;
}

__device__ __forceinline__ void xcd_barrier(const XcdBarrier& b, int widk) {
    asm volatile("s_waitcnt vmcnt(0)" ::: "memory");
    __syncthreads();
    int xl_; asm volatile("v_mbcnt_lo_u32_b32 %0, -1, 0\n\tv_mbcnt_hi_u32_b32 %0, -1, %0" : "=v"(xl_));
    if (widk == 0 && xl_ == 0) {
        unsigned* bar = b.bar;
        __builtin_amdgcn_s_waitcnt(0);
        unsigned nloc = b.st[0], nx = b.st[1];
        if (nloc == 0u) { xcd_barrier_complete(bar, b.x, nloc, nx); b.st[0] = nloc; b.st[1] = nx; }
        const unsigned old = xb_add(&bar[XB_XSUB(b.x)], 1u);
        const unsigned gen = old / nloc;
        if (old + 1u == (gen + 1u) * nloc) {
            __builtin_amdgcn_fence(__ATOMIC_RELEASE, "agent");
            asm volatile("s_waitcnt vmcnt(0)" ::: "memory");
            const unsigned og = xb_add(&bar[XB_TOP], 1u);
            const unsigned tg = og / nx;
            if (og + 1u == (tg + 1u) * nx) xb_add(&bar[XB_TOPGEN], 1u);
            else XB_SPIN(xb_ld(&bar[XB_TOPGEN]) == tg, bar);
            __builtin_amdgcn_fence(__ATOMIC_ACQUIRE, "agent");
            xb_add(&bar[XB_XGEN(b.x)], 1u);
            asm volatile("s_waitcnt vmcnt(0)" ::: "memory");
        } else {
            XB_SPIN(xb_ld(&bar[XB_XGEN(b.x)]) == gen, bar);
            __builtin_amdgcn_fence(__ATOMIC_ACQUIRE, "agent");
            asm volatile("s_waitcnt vmcnt(0)" ::: "memory");
        }
    }
    __syncthreads();
}

struct Params {
    const float* in[23];
    const int* positions;
    float* out;
    unsigned char* ws;
};

__device__ __forceinline__ void prologue(int widk, const Params& p, LAS unsigned char* lds) {
    MK_IDS(); const int wave = wid;
    LAS float* scr = (LAS float*)(lds + wave * 16384);
    unsigned char* wsw = p.ws + WS_W;
    constexpr int I_GWIN = 16 * 128, I_SQ = 16 * 32, I_DWIN = 16 * 96, I_FUP = 16 * 176, I_FDN = 44 * 32;
    constexpr int NITEMS = 2 * I_GWIN + 2 * I_SQ + 2 * I_DWIN + 2 * I_SQ + 4 * I_FUP + 4 * I_FDN;
    for (int it = gw; it < NITEMS; it += NGW) {
        int r = it;
        if (r < 2 * I_GWIN) { const int j = r / I_GWIN; r %= I_GWIN; transpose_item<0, true>(p.in[2] + (size_t)j * 1024 * GDN_N, GDN_N, 1024, 128, (bf16_t*)(wsw + W_GWIN) + (size_t)j * 4096 * 1024, scr, r, lane); continue; } r -= 2 * I_GWIN;
        if (r < 2 * I_SQ) { const int j = r / I_SQ; r %= I_SQ; transpose_item(p.in[7] + (size_t)j * 1024 * 1024, 1024, 1024, 32, (bf16_t*)(wsw + W_GWOUT) + (size_t)j * 1024 * 1024, scr, r, lane); continue; } r -= 2 * I_SQ;
        if (r < 2 * I_DWIN) { const int j = r / I_DWIN; r %= I_DWIN; transpose_item<2, true>(p.in[8] + (size_t)j * 1024 * DIFF_N, DIFF_N, 1024, 96, (bf16_t*)(wsw + W_DWIN) + (size_t)j * 3072 * 1024, scr, r, lane); continue; } r -= 2 * I_DWIN;
        if (r < 2 * I_SQ) { const int j = r / I_SQ; r %= I_SQ; transpose_item(p.in[14] + (size_t)j * 1024 * 1024, 1024, 1024, 32, (bf16_t*)(wsw + W_DWOUT) + (size_t)j * 1024 * 1024, scr, r, lane); continue; } r -= 2 * I_SQ;
        if (r < 4 * I_FUP) { const int j = r / I_FUP; r %= I_FUP; transpose_item<1, true>(p.in[15] + (size_t)j * 1024 * FFN_N, FFN_N, 1024, 176, (bf16_t*)(wsw + W_FUP) + (size_t)j * 5632 * 1024, scr, r, lane); continue; } r -= 4 * I_FUP;
        { const int j = r / I_FDN; r %= I_FDN; transpose_item(p.in[18] + (size_t)j * 2816 * 1024, 1024, 2816, 32, (bf16_t*)(wsw + W_FDOWN) + (size_t)j * 1024 * 2816, scr, r, lane); }
    }
    for (int e = gt; e < 2 * 16 * 1024; e += NGT) { const int j = e >> 14, n = (e >> 10) & 15, k = e & 1023;
        ((bf16_t*)(wsw + W_GWAB))[e] = (unsigned short)(pg8::cvt_pk_f16(p.in[2][(size_t)j * 1024 * GDN_N + (size_t)k * GDN_N + GDN_NMAIN + n], 0.f) & 0xffffu); }
    { float* COS = (float*)(p.ws + WS_ROPE); float* SIN = COS + (size_t)M * 32;
      for (int e = gt; e < M * 32; e += NGT) { const int m = e >> 5, f = e & 31; const float inv = exp2f(-(float)f * (13.287712379549449f / 32.f)); float sn, cs; sincosf((float)p.positions[m] * inv, &sn, &cs); COS[e] = cs; SIN[e] = sn; } }
    const f32x4* x4 = (const f32x4*)p.in[0]; u32x4* xn = (u32x4*)(p.ws + WS_XN);
    for (int e = gt; e < M * D / 8; e += NGT) { const f32x4 a = x4[2 * e], b = x4[2 * e + 1]; u32x4 w; w.x = pg8::cvt_pk_f16(a[0], a[1]); w.y = pg8::cvt_pk_f16(a[2], a[3]); w.z = pg8::cvt_pk_f16(b[0], b[1]); w.w = pg8::cvt_pk_f16(b[2], b[3]); xn[e] = w; }
}

__device__ __forceinline__ void ln_phase(int widk, float* X, bf16_t* XN, const float* g, const float* b) {
    MK_IDS();
    f32x4 gv[4], bv[4];
#pragma unroll
    for (int j = 0; j < 4; ++j) { gv[j] = ((const f32x4*)g)[lane + 64 * j]; bv[j] = ((const f32x4*)b)[lane + 64 * j]; }
    for (int m = gw; m < M; m += NGW) {
        f32x4* xr = (f32x4*)(X + (size_t)m * D) + lane;
        f32x4 v[4]; float s = 0.f;
#pragma unroll
        for (int j = 0; j < 4; ++j) { v[j] = xr[64 * j]; s += (v[j][0] + v[j][1]) + (v[j][2] + v[j][3]); }
        const float mean = wave_sum(s) * (1.f / D); float s2 = 0.f;
#pragma unroll
        for (int j = 0; j < 4; ++j) { v[j] = v[j] - mean; s2 += (v[j][0] * v[j][0] + v[j][1] * v[j][1]) + (v[j][2] * v[j][2] + v[j][3] * v[j][3]); }
        const float rstd = 1.f / sqrtf(wave_sum(s2) * (1.f / D) + LN_EPS);
        u32x2* o8 = (u32x2*)(XN + (size_t)m * D) + lane;
#pragma unroll
        for (int j = 0; j < 4; ++j) { const f32x4 o = v[j] * rstd * gv[j] + bv[j]; xr[64 * j] = o; u32x2 w; w.x = pg8::cvt_pk_f16(o[0], o[1]); w.y = pg8::cvt_pk_f16(o[2], o[3]); o8[64 * j] = w; }
    }
}

__device__ __forceinline__ void ffn_fixup_phase(int widk, bf16_t* ACT, const float* HALO, const float* HALO2, const float* cw, const float* cb) {
    MK_IDS();
    constexpr int NCG = FFN_H / 4;
    for (int item = gt; item < (M / 256) * NCG; item += NGT) {
        const int pm = item / NCG, col = (item % NCG) * 4;
        if ((pm & 7) == 0) continue;
        f32x4 wa[3], wb[3];
#pragma unroll
        for (int j = 0; j < 3; ++j) { wa[j] = *(const f32x4*)(cw + j * FFN_N + col); wb[j] = *(const f32x4*)(cw + j * FFN_N + FFN_H + col); }
        const f32x4 ba = *(const f32x4*)(cb + col), bb = *(const f32x4*)(cb + FFN_H + col);
        const float* hp = HALO + (size_t)(pm - 1) * 2 * FFN_N + col; const float* h2 = HALO2 + (size_t)pm * 2 * FFN_N + col;
        const f32x4 am2 = *(const f32x4*)hp, am1 = *(const f32x4*)(hp + FFN_N), a0 = *(const f32x4*)h2, a1 = *(const f32x4*)(h2 + FFN_N);
        const f32x4 bm2 = *(const f32x4*)(hp + FFN_H), bm1 = *(const f32x4*)(hp + FFN_N + FFN_H), b0 = *(const f32x4*)(h2 + FFN_H), b1 = *(const f32x4*)(h2 + FFN_N + FFN_H);
        float o0[4], o1[4];
#pragma unroll
        for (int e = 0; e < 4; ++e) {
            o0[e] = silu(wa[0][e] * am2[e] + wa[1][e] * am1[e] + wa[2][e] * a0[e] + ba[e]) * (wb[0][e] * bm2[e] + wb[1][e] * bm1[e] + wb[2][e] * b0[e] + bb[e]);
            o1[e] = silu(wa[0][e] * am1[e] + wa[1][e] * a0[e] + wa[2][e] * a1[e] + ba[e]) * (wb[0][e] * bm1[e] + wb[1][e] * b0[e] + wb[2][e] * b1[e] + bb[e]);
        }
        u32x2 w; w.x = cvt_pk_bf16(o0[0], o0[1]); w.y = cvt_pk_bf16(o0[2], o0[3]); *(u32x2*)(ACT + (size_t)(pm * 256) * FFN_H + col) = w;
        w.x = cvt_pk_bf16(o1[0], o1[1]); w.y = cvt_pk_bf16(o1[2], o1[3]); *(u32x2*)(ACT + (size_t)(pm * 256 + 1) * FFN_H + col) = w;
    }
}

__device__ __forceinline__ void gdn_ab_phase(int widk, const bf16_t* XN, const bf16_t* wabT  , const float* a_log, const float* dt_bias, float* G, float* BETA) {
    MK_IDS();
    const int n = lane & 15, q4 = lane >> 4, h = n & 7;
    const float al = -__expf(a_log[h]), db = dt_bias[h];
    for (int it = gw; it < M / 16; it += NGW) {
        const int m0 = it * 16;
        f32x4 acc = {0.f, 0.f, 0.f, 0.f};
        const bf16_t* ap = XN + (size_t)(m0 + n) * D + 8 * q4;
        const bf16_t* bp = wabT + (size_t)n * D + 8 * q4;
#pragma unroll 8
        for (int ks = 0; ks < 32; ++ks) { const bf16x8 a = *(const bf16x8*)(ap + 32 * ks), b = *(const bf16x8*)(bp + 32 * ks); acc = pg8::mma16<true>(a, b, acc); }
#pragma unroll
        for (int i = 0; i < 4; ++i) { const int m = m0 + 4 * q4 + i; const float v = acc[i];
            if (n < 8) { const float x = v + db; const float sp = x > 20.f ? x : log1pf(__expf(x)); G[(size_t)m * 8 + h] = al * sp; }
            else BETA[(size_t)m * 8 + h] = 1.f / (1.f + __expf(-v)); }
    }
}

__device__ __forceinline__ void conv_silu16(const bf16_t* hp, int t, const LAS float* cw, float (&y)[16]) {
#pragma unroll
    for (int c = 0; c < 16; ++c) y[c] = 0.f;
#pragma unroll
    for (int j = 0; j < 4; ++j) {
        if (t - 3 + j >= 0) {
            float x[16];
            const bf16_t* rp = hp + (ptrdiff_t)(j - 3) * GDN_NMAIN;
            { float t8[8]; unpack8(*(const u32x4*)rp, t8);
#pragma unroll
              for (int c = 0; c < 8; ++c) x[c] = t8[c];
              unpack8(*(const u32x4*)(rp + 8), t8);
#pragma unroll
              for (int c = 0; c < 8; ++c) x[8 + c] = t8[c]; }
#pragma unroll
            for (int q = 0; q < 4; ++q) { const f32x4 w = *(const LAS f32x4*)(cw + j * 128 + 4 * q);
#pragma unroll
                for (int e = 0; e < 4; ++e) y[4 * q + e] += w[e] * x[4 * q + e]; }
        }
    }
#pragma unroll
    for (int c = 0; c < 16; ++c) y[c] = silu(y[c]);
}
__device__ __forceinline__ float sumsq16_8lanes(const float (&y)[16]) {
    float s = 0.f;
#pragma unroll
    for (int c = 0; c < 16; ++c) s += y[c] * y[c];
    s += __shfl_xor(s, 1); s += __shfl_xor(s, 2); s += __shfl_xor(s, 4);
    return s;
}
__device__ __forceinline__ void pack16(const float (&y)[16], u32x4& a, u32x4& b) {
    a.x = cvt_pk_bf16(y[0], y[1]); a.y = cvt_pk_bf16(y[2], y[3]); a.z = cvt_pk_bf16(y[4], y[5]); a.w = cvt_pk_bf16(y[6], y[7]);
    b.x = cvt_pk_bf16(y[8], y[9]); b.y = cvt_pk_bf16(y[10], y[11]); b.z = cvt_pk_bf16(y[12], y[13]); b.w = cvt_pk_bf16(y[14], y[15]);
}
__device__ __forceinline__ void unpack16(const u32x4 a, const u32x4 b, float (&y)[16]) {
    float t8[8]; unpack8(a, t8);
#pragma unroll
    for (int c = 0; c < 8; ++c) y[c] = t8[c];
    unpack8(b, t8);
#pragma unroll
    for (int c = 0; c < 8; ++c) y[8 + c] = t8[c];
}
__device__ __forceinline__ bf16x8 lds_frag16(const LAS unsigned char* p) { return *(const LAS bf16x8*)p; }
__device__ __forceinline__ bf16x8 lds_frag8x2(const LAS unsigned char* p0, const LAS unsigned char* p1) {
    const s16x4 a = *(const volatile LAS s16x4*)p0, b = *(const volatile LAS s16x4*)p1; return (bf16x8){a[0], a[1], a[2], a[3], b[0], b[1], b[2], b[3]};
}

constexpr int GA_GC = 0, GA_BT = 256, GA_CW = 512, GA_Q = GA_CW + 3 * 4 * 128 * 4, GA_K = GA_Q + 64 * 272, GA_LT = GA_K + 64 * 272, GA_END = GA_LT + 8 * 8192;
static_assert(GA_END <= 131072 && GA_LT % 16 == 0, "GDN phase A LDS map");
constexpr int GB_GC = 0, GB_BT = 512, GB_Q = 1024,     GB_KB = GB_Q + 64 * 272, GB_VB = GB_KB + 64 * 272, GB_KD = GB_VB + 64 * 272, GB_T = GB_KD + 128 * 144, GB_AT = GB_T + 64 * 144, GB_O = GB_AT + 64 * 144, GB_END = GB_O + 64 * 528;
static_assert(GB_END <= 131072 && GB_O % 16 == 0, "GDN phase B LDS map");

template <int I, int J> __device__ __forceinline__ void inv_row(float& s0, float& s1, const float lr, const float (&t)[64]) {
    if constexpr (J + 8 <= I) {
        int a0, a1, a2, a3, a4, a5, a6, a7;
        asm volatile("v_readlane_b32 %2, %10, %19\n\tv_readlane_b32 %3, %10, %19+1\n\tv_readlane_b32 %4, %10, %19+2\n\tv_readlane_b32 %5, %10, %19+3\n\t"
                     "v_readlane_b32 %6, %10, %19+4\n\tv_readlane_b32 %7, %10, %19+5\n\tv_readlane_b32 %8, %10, %19+6\n\tv_readlane_b32 %9, %10, %19+7\n\t"
                     "v_fma_f32 %0, -%11, %2, %0\n\tv_fma_f32 %1, -%12, %3, %1\n\tv_fma_f32 %0, -%13, %4, %0\n\tv_fma_f32 %1, -%14, %5, %1\n\t"
                     "v_fma_f32 %0, -%15, %6, %0\n\tv_fma_f32 %1, -%16, %7, %1\n\tv_fma_f32 %0, -%17, %8, %0\n\tv_fma_f32 %1, -%18, %9, %1"
                     : "+v"(s0), "+v"(s1), "=&s"(a0), "=&s"(a1), "=&s"(a2), "=&s"(a3), "=&s"(a4), "=&s"(a5), "=&s"(a6), "=&s"(a7)
                     : "v"(lr), "v"(t[J]), "v"(t[J + 1]), "v"(t[J + 2]), "v"(t[J + 3]), "v"(t[J + 4]), "v"(t[J + 5]), "v"(t[J + 6]), "v"(t[J + 7]), "i"(J));
        inv_row<I, J + 8>(s0, s1, lr, t);
    } else {
#pragma unroll
        for (int j = J; j < I; ++j) { const float lj = __int_as_float(__builtin_amdgcn_readlane(__float_as_int(lr), j)); if (j & 1) s1 -= lj * t[j]; else s0 -= lj * t[j]; }
    }
}
template <int I0> __device__ __forceinline__ void inv_rows8(const LAS float* Lp, const float flane, float (&t)[64]) {
    float lr[8];
#pragma unroll
    for (int k = 0; k < 8; ++k) lr[k] = Lp[((I0 + k) * (I0 + k - 1)) / 2];
#define INV_ROW(k) { float s0 = 1.f - fminf(fabsf(flane - (float)(I0 + k)), 1.f), s1 = 0.f; inv_row<I0 + k, 0>(s0, s1, lr[k], t); t[I0 + k] = s0 + s1; }
    INV_ROW(0) INV_ROW(1) INV_ROW(2) INV_ROW(3) INV_ROW(4) INV_ROW(5) INV_ROW(6) INV_ROW(7)
#undef INV_ROW
}

__device__ __forceinline__ void gdn_phase_a(int widk, bf16_t* H, const float* G, const float* BETA, const float* convw  , bf16_t* TG, bf16_t* ATT, LAS unsigned char* lds) {
    MK_IDS();
    LAS float* gcs = (LAS float*)(lds + GA_GC); LAS float* bts = (LAS float*)(lds + GA_BT); LAS float* cwl = (LAS float*)(lds + GA_CW);
    for (int bh = blockIdx.x; bh < 256; bh += gridDim.x) {
        const int b = bh >> 3, h = bh & 7;
        __syncthreads();
        for (int e = tid; e < 3 * 4 * 128; e += NTHR) { const int ten = e / 512, tap = (e >> 7) & 3, c = e & 127; cwl[e] = convw[tap * 3072 + ten * 1024 + h * 128 + c]; }
        __syncthreads();
        float gnext = 0.f, bnext = 0.f;
        if (wid == 0) { gnext = G[(size_t)(b * T + 31 * 64 + lane) * 8 + h]; bnext = BETA[(size_t)(b * T + 31 * 64 + lane) * 8 + h]; }
        for (int sg = 3; sg >= 0; --sg) {
            for (int k = 7; k >= 0; --k) {
                const int n = sg * 8 + k, it = n * 256 + bh, m0 = b * T + n * 64;
                if (wid == 0) { float c = gnext;
#pragma unroll
                    for (int o = 1; o < 64; o <<= 1) { const float t = __shfl_up(c, o); if (lane >= o) c += t; }
                    gcs[lane] = c; bts[lane] = bnext;
                    if (n > 0) { gnext = G[(size_t)(m0 - 64 + lane) * 8 + h]; bnext = BETA[(size_t)(m0 - 64 + lane) * 8 + h]; } }
                const int r = tid >> 3, c0 = (tid & 7) * 16, t = n * 64 + r; bf16_t* hp = H + (size_t)(m0 + r) * GDN_NMAIN + h * 128 + c0;
                u32x4 st[6];
                {   float y[16];
                    conv_silu16(hp, t, cwl + c0, y);
                    { const float rinv = rsqrtf(sumsq16_8lanes(y) + RMS_EPS) * 0.08838834764831845f;
#pragma unroll
                      for (int c = 0; c < 16; ++c) y[c] *= rinv; pack16(y, st[0], st[1]); }
                    conv_silu16(hp + 1024, t, cwl + 512 + c0, y);
                    { const float rinv = rsqrtf(sumsq16_8lanes(y) + RMS_EPS);
#pragma unroll
                      for (int c = 0; c < 16; ++c) y[c] *= rinv; pack16(y, st[2], st[3]); }
                    conv_silu16(hp + 2048, t, cwl + 1024 + c0, y);
                    pack16(y, st[4], st[5]);
                    *(LAS u32x4*)(lds + GA_Q + r * 272 + c0 * 2) = st[0]; *(LAS u32x4*)(lds + GA_Q + r * 272 + c0 * 2 + 16) = st[1];
                    *(LAS u32x4*)(lds + GA_K + r * 272 + c0 * 2) = st[2]; *(LAS u32x4*)(lds + GA_K + r * 272 + c0 * 2 + 16) = st[3];
                }
                __syncthreads();
                *(u32x4*)hp = st[0]; *(u32x4*)(hp + 8) = st[1]; *(u32x4*)(hp + 1024) = st[2]; *(u32x4*)(hp + 1024 + 8) = st[3]; *(u32x4*)(hp + 2048) = st[4]; *(u32x4*)(hp + 2048 + 8) = st[5];
                {
                    const int which = wid >> 2, bi = (wid >> 1) & 1, bj = wid & 1, l31 = lane & 31, hi = lane >> 5;
                    LAS float* Lt = (LAS float*)(lds + GA_LT + k * 8192);
                    f32x16 acc = {};
                    if (!(bi == 0 && bj == 1)) {
                        const LAS unsigned char* ap = lds + (which ? GA_Q : GA_K) + (32 * bi + l31) * 272 + hi * 16;
                        const LAS unsigned char* bp = lds + GA_K + (32 * bj + l31) * 272 + hi * 16;
#pragma unroll
                        for (int ks = 0; ks < 8; ++ks) acc = __builtin_amdgcn_mfma_f32_32x32x16_bf16(lds_frag16(ap + ks * 32), lds_frag16(bp + ks * 32), acc, 0, 0, 0);
                    }
                    const int j = 32 * bj + l31; const float gcj = gcs[j];
#pragma unroll
                    for (int rr = 0; rr < 16; ++rr) { const int i = 32 * bi + crow(rr, hi); const float dec = __expf(fminf(gcs[i] - gcj, 0.f));
                        if (which == 0) { if (i > j) Lt[(i * (i - 1)) / 2 + j] = bts[i] * acc[rr] * dec; }
                        else ATT[((size_t)it * 64 + i) * 64 + j] = f2bf((i >= j) ? acc[rr] * dec : 0.f); }
                }
                __syncthreads();
            }
            {
                float t[64]; const float flane = (float)lane;
                const LAS float* Lp = (const LAS float*)(lds + GA_LT + wid * 8192) + lane; asm volatile("" : "+v"(Lp));
                inv_rows8<0>(Lp, flane, t); inv_rows8<8>(Lp, flane, t); inv_rows8<16>(Lp, flane, t); inv_rows8<24>(Lp, flane, t);
                inv_rows8<32>(Lp, flane, t); inv_rows8<40>(Lp, flane, t); inv_rows8<48>(Lp, flane, t); inv_rows8<56>(Lp, flane, t);
                bf16_t* tp = TG + (size_t)((sg * 8 + wid) * 256 + bh) * 4096 + lane;
#pragma unroll
                for (int i = 0; i < 64; ++i) tp[i * 64] = f2bf(t[i]);
            }
        }
    }
    __syncthreads();
}

__device__ __forceinline__ void gdn_phase_b(int widk, bf16_t* H, const float* G, const float* BETA, const float* normw  , const bf16_t* TG, const bf16_t* ATT, LAS unsigned char* lds) {
    MK_IDS();
    LAS float* gcs = (LAS float*)(lds + GB_GC); LAS float* bts = (LAS float*)(lds + GB_BT);
    const int n16 = lane & 15, q4 = lane >> 4;
    for (int bh = blockIdx.x; bh < 256; bh += gridDim.x) {
        const int b = bh >> 3, h = bh & 7;
        f32x4 S[8];
#pragma unroll
        for (int s = 0; s < 8; ++s) S[s] = (f32x4){0.f, 0.f, 0.f, 0.f};
        const int r = tid >> 3, c0 = (tid & 7) * 16;
        u32x4 q0, q1, k0, k1, v0, v1, tt, aa, ga0, ga1; float gval = 0.f, bval = 0.f;
#define GB_LOAD(n_) do { const int it_ = (n_) * 256 + bh, m_ = b * T + (n_) * 64; const bf16_t* hq = H + (size_t)(m_ + r) * GDN_NMAIN + h * 128 + c0; \
            q0 = *(const u32x4*)hq; q1 = *(const u32x4*)(hq + 8); k0 = *(const u32x4*)(hq + 1024); k1 = *(const u32x4*)(hq + 1024 + 8); v0 = *(const u32x4*)(hq + 2048); v1 = *(const u32x4*)(hq + 2048 + 8); \
            ga0 = *(const u32x4*)(hq + 3072); ga1 = *(const u32x4*)(hq + 3072 + 8); \
            tt = ((const u32x4*)(TG + (size_t)it_ * 4096))[tid]; aa = ((const u32x4*)(ATT + (size_t)it_ * 4096))[tid]; \
            if (wid == 0) { gval = G[(size_t)(m_ + lane) * 8 + h]; bval = BETA[(size_t)(m_ + lane) * 8 + h]; } } while (0)
        GB_LOAD(0);
#define GB_CUMSUM(par_) do { if (wid == 0) { float c = gval; _Pragma("unroll") for (int o = 1; o < 64; o <<= 1) { const float t = __shfl_up(c, o); if (lane >= o) c += t; } \
            gcs[(par_) * 64 + lane] = c; bts[(par_) * 64 + lane] = bval; } } while (0)
        GB_CUMSUM(0);
        __syncthreads();
        for (int n = 0; n < 32; ++n) {
            const int m0 = b * T + n * 64, par = n & 1;
            bf16_t* hp = H + (size_t)(m0 + r) * GDN_NMAIN + h * 128 + c0;
            const float glast = gcs[par * 64 + 63];
            {   const float gcr = gcs[par * 64 + r], btr = bts[par * 64 + r], eg = __expf(gcr), ekd = __expf(glast - gcr);
                float y[16]; u32x4 a, bq;
                unpack16(q0, q1, y);
#pragma unroll
                for (int c = 0; c < 16; ++c) y[c] *= eg;
                pack16(y, a, bq); *(LAS u32x4*)(lds + GB_Q + r * 272 + c0 * 2) = a; *(LAS u32x4*)(lds + GB_Q + r * 272 + c0 * 2 + 16) = bq;
                unpack16(k0, k1, y);
#pragma unroll
                for (int c = 0; c < 16; ++c) *(LAS bf16_t*)(lds + GB_KD + (c0 + c) * 144 + r * 2) = f2bf(y[c] * ekd);
                { const float sc = btr * eg;
#pragma unroll
                  for (int c = 0; c < 16; ++c) y[c] *= sc; }
                pack16(y, a, bq); *(LAS u32x4*)(lds + GB_KB + r * 272 + c0 * 2) = a; *(LAS u32x4*)(lds + GB_KB + r * 272 + c0 * 2 + 16) = bq;
                unpack16(v0, v1, y);
#pragma unroll
                for (int c = 0; c < 16; ++c) y[c] *= btr;
                pack16(y, a, bq); *(LAS u32x4*)(lds + GB_VB + r * 272 + c0 * 2) = a; *(LAS u32x4*)(lds + GB_VB + r * 272 + c0 * 2 + 16) = bq;
                *(LAS u32x4*)(lds + GB_T + (tid >> 3) * 144 + (tid & 7) * 16) = tt;
                *(LAS u32x4*)(lds + GB_AT + (tid >> 3) * 144 + (tid & 7) * 16) = aa;
            }
            const u32x4 gk0 = ga0, gk1 = ga1;
            __syncthreads();
            if (n + 1 < 32) GB_LOAD(n + 1);
            {
                bf16x8 Sf[4];
#pragma unroll
                for (int ks = 0; ks < 4; ++ks) { u32x4 w; w.x = cvt_pk_bf16(S[2 * ks][0], S[2 * ks][1]); w.y = cvt_pk_bf16(S[2 * ks][2], S[2 * ks][3]);
                    w.z = cvt_pk_bf16(S[2 * ks + 1][0], S[2 * ks + 1][1]); w.w = cvt_pk_bf16(S[2 * ks + 1][2], S[2 * ks + 1][3]); Sf[ks] = __builtin_bit_cast(bf16x8, w); }
                f32x4 rr[4];
#pragma unroll
                for (int mt = 0; mt < 4; ++mt) {
                    const LAS unsigned char* vp = lds + GB_VB + (16 * mt + 4 * q4) * 272 + (16 * wid + n16) * 2;
                    rr[mt] = (f32x4){-bf2f(*(const LAS bf16_t*)vp), -bf2f(*(const LAS bf16_t*)(vp + 272)), -bf2f(*(const LAS bf16_t*)(vp + 544)), -bf2f(*(const LAS bf16_t*)(vp + 816))};
                    const LAS unsigned char* ap = lds + GB_KB + (16 * mt + n16) * 272 + 8 * q4;
#pragma unroll
                    for (int ks = 0; ks < 4; ++ks) rr[mt] = __builtin_amdgcn_mfma_f32_16x16x32_bf16(lds_frag8x2(ap + ks * 64, ap + ks * 64 + 32), Sf[ks], rr[mt], 0, 0, 0);
                }
                bf16x8 Rf[2];
#pragma unroll
                for (int kt = 0; kt < 2; ++kt) { u32x4 w; w.x = cvt_pk_bf16(-rr[2 * kt][0], -rr[2 * kt][1]); w.y = cvt_pk_bf16(-rr[2 * kt][2], -rr[2 * kt][3]);
                    w.z = cvt_pk_bf16(-rr[2 * kt + 1][0], -rr[2 * kt + 1][1]); w.w = cvt_pk_bf16(-rr[2 * kt + 1][2], -rr[2 * kt + 1][3]); Rf[kt] = __builtin_bit_cast(bf16x8, w); }
                f32x4 vn[4];
#pragma unroll
                for (int mt = 0; mt < 4; ++mt) { vn[mt] = (f32x4){0.f, 0.f, 0.f, 0.f};
                    const LAS unsigned char* tp = lds + GB_T + (16 * mt + n16) * 144 + 8 * q4;
#pragma unroll
                    for (int kt = 0; kt < 2; ++kt) if (kt == 0 || mt >= 2) vn[mt] = __builtin_amdgcn_mfma_f32_16x16x32_bf16(lds_frag8x2(tp + kt * 64, tp + kt * 64 + 32), Rf[kt], vn[mt], 0, 0, 0); }
                bf16x8 Vf[2];
#pragma unroll
                for (int kt = 0; kt < 2; ++kt) { u32x4 w; w.x = cvt_pk_bf16(vn[2 * kt][0], vn[2 * kt][1]); w.y = cvt_pk_bf16(vn[2 * kt][2], vn[2 * kt][3]);
                    w.z = cvt_pk_bf16(vn[2 * kt + 1][0], vn[2 * kt + 1][1]); w.w = cvt_pk_bf16(vn[2 * kt + 1][2], vn[2 * kt + 1][3]); Vf[kt] = __builtin_bit_cast(bf16x8, w); }
#pragma unroll
                for (int mt = 0; mt < 4; ++mt) {
                    f32x4 o = {0.f, 0.f, 0.f, 0.f};
                    const LAS unsigned char* qp = lds + GB_Q + (16 * mt + n16) * 272 + 8 * q4;
#pragma unroll
                    for (int ks = 0; ks < 4; ++ks) o = __builtin_amdgcn_mfma_f32_16x16x32_bf16(lds_frag8x2(qp + ks * 64, qp + ks * 64 + 32), Sf[ks], o, 0, 0, 0);
                    const LAS unsigned char* atp = lds + GB_AT + (16 * mt + n16) * 144 + 8 * q4;
#pragma unroll
                    for (int kt = 0; kt < 2; ++kt) if (kt == 0 || mt >= 2) o = __builtin_amdgcn_mfma_f32_16x16x32_bf16(lds_frag8x2(atp + kt * 64, atp + kt * 64 + 32), Vf[kt], o, 0, 0, 0);
#pragma unroll
                    for (int i = 0; i < 4; ++i) *(LAS float*)(lds + GB_O + (16 * mt + 4 * q4 + i) * 528 + (16 * wid + n16) * 4) = o[i];
                }
                const float eg = __expf(glast);
#pragma unroll
                for (int st = 0; st < 8; ++st) { S[st] = S[st] * eg;
                    const LAS unsigned char* kp = lds + GB_KD + (16 * st + n16) * 144 + 8 * q4;
#pragma unroll
                    for (int kt = 0; kt < 2; ++kt) S[st] = __builtin_amdgcn_mfma_f32_16x16x32_bf16(lds_frag8x2(kp + kt * 64, kp + kt * 64 + 32), Vf[kt], S[st], 0, 0, 0); }
            }
            if (n + 1 < 32) GB_CUMSUM(par ^ 1);
            __syncthreads();
            {
                float o[16];
#pragma unroll
                for (int q = 0; q < 4; ++q) { const f32x4 v = *(const LAS f32x4*)(lds + GB_O + r * 528 + (c0 + 4 * q) * 4); o[4 * q] = v[0]; o[4 * q + 1] = v[1]; o[4 * q + 2] = v[2]; o[4 * q + 3] = v[3]; }
                const float rstd = rsqrtf(sumsq16_8lanes(o) * (1.f / 128.f) + RMS_EPS);
                float gt[16]; unpack16(gk0, gk1, gt);
                float res[16];
#pragma unroll
                for (int c = 0; c < 16; ++c) res[c] = o[c] * rstd * normw[c0 + c] * silu(gt[c]);
                u32x4 a, bq; pack16(res, a, bq);
                *(u32x4*)(hp + 2048) = a; *(u32x4*)(hp + 2048 + 8) = bq;
            }
        }
        __syncthreads();
    }
}
#undef GB_CUMSUM
#undef GB_LOAD

__device__ __forceinline__ void diff_prep_phase(int widk, bf16_t* H  , const int* positions, bf16_t* VT  , LAS unsigned char* lds) {
    MK_IDS();
    LAS unsigned char* scr = lds + wid * 16384;
    for (int item = gw; item < NB * 32 * 16; item += NGW) {
        const int dvh = item & 1, h = (item >> 1) & 7, tb = (item >> 4) & 31, b = item >> 9;
        const bf16_t* src = H + ((size_t)b * T + tb * 64) * DIFF_N + 2048 + h * 128 + dvh * 64;
#pragma unroll
        for (int i = 0; i < 8; ++i) { const int row = (lane >> 3) + 8 * i, ch = lane & 7; *(LAS u32x4*)(scr + row * 144 + ch * 16) = *(const u32x4*)(src + (size_t)row * DIFF_N + ch * 8); }
        LDS_WAIT();
        bf16_t* dst = VT + (((size_t)b * 8 + h) * 128 + dvh * 64 + lane) * T + tb * 64;
#pragma unroll
        for (int k = 0; k < 8; ++k) { unsigned short v[8];
#pragma unroll
            for (int e = 0; e < 8; ++e) v[e] = *(const LAS bf16_t*)(scr + (8 * k + e) * 144 + lane * 2);
            u32x4 w; w.x = v[0] | ((unsigned)v[1] << 16); w.y = v[2] | ((unsigned)v[3] << 16); w.z = v[4] | ((unsigned)v[5] << 16); w.w = v[6] | ((unsigned)v[7] << 16);
            *(u32x4*)(dst + 8 * k) = w; }
        LDS_WAIT();
    }
}

constexpr int AT_STAGE = 36864, AT_K = 0, AT_V = 64 * 272, AT_OSTG = 2 * AT_STAGE;
static_assert(AT_OSTG + 128 * 272 <= 131072, "attention LDS map");
__device__ __forceinline__ void diff_attn_phase(int widk, const bf16_t* H, const bf16_t* VT, bf16_t* O, const float* lq1, const float* lk1, const float* lq2, const float* lk2, const float* subw, float lambda_init,
                                                LAS unsigned char* lds) {
    MK_IDS();
    const float lam = __expf(wave_sum(lq1[lane] * lk1[lane])) - __expf(wave_sum(lq2[lane] * lk2[lane])) + lambda_init;
    const int c = wid >> 2, rg = wid & 3, l31 = lane & 31, hi = lane >> 5;
    for (int bh = blockIdx.x; bh < 256; bh += gridDim.x) {
        const int b = bh >> 3, h = bh & 7;
        const bf16_t* Kg = H + (size_t)b * T * DIFF_N + 1024 + h * 128;
        const bf16_t* Vg = VT + (size_t)bh * 128 * T;
        for (int ui = 0; ui < 16; ++ui) {
            const int qb = (ui & 1) ? (15 - (ui >> 1)) : (ui >> 1);
            const int q0w = 128 * qb + 32 * rg, nt = 2 * qb + 2;
            bf16x8 qf[4];
            { const bf16_t* qp = H + ((size_t)b * T + q0w + l31) * DIFF_N + h * 128 + c * 64 + 8 * hi;
#pragma unroll
              for (int d0 = 0; d0 < 4; ++d0) qf[d0] = *(const bf16x8*)(qp + 16 * d0); }
            f32x16 o[4];
#pragma unroll
            for (int d = 0; d < 4; ++d) o[d] = (f32x16){};
            float mrun = -1e30f, lrun = 0.f;
            u32x4 pk[2], pv[2];
#define AT_LOAD(j) do { _Pragma("unroll") for (int i_ = 0; i_ < 2; ++i_) { const int ci = tid + 512 * i_; \
                pk[i_] = *(const u32x4*)(Kg + (size_t)((j) * 64 + (ci >> 4)) * DIFF_N + (ci & 15) * 8); \
                pv[i_] = *(const u32x4*)(Vg + (size_t)(ci >> 3) * T + (j) * 64 + (ci & 7) * 8); } } while (0)
            AT_LOAD(0);
            for (int j = 0; j < nt; ++j) {
                LAS unsigned char* st = lds + (j & 1) * AT_STAGE;
#pragma unroll
                for (int i_ = 0; i_ < 2; ++i_) { const int ci = tid + 512 * i_;
                    *(LAS u32x4*)(st + AT_K + (ci >> 4) * 272 + (ci & 15) * 16) = pk[i_];
                    { LAS unsigned char* vd = st + AT_V + (ci >> 3) * 136 + (ci & 7) * 16; *(LAS u32x2*)vd = (u32x2){pv[i_].x, pv[i_].y}; *(LAS u32x2*)(vd + 8) = (u32x2){pv[i_].z, pv[i_].w}; } }
                __syncthreads();
                if (j + 1 < nt) AT_LOAD(j + 1);
                if (64 * j <= q0w + 31) {
                    bf16x8 kf[2][4];
#pragma unroll
                    for (int kb = 0; kb < 2; ++kb) { const LAS unsigned char* kp = st + AT_K + (32 * kb + l31) * 272 + c * 128 + hi * 16;
#pragma unroll
                        for (int d0 = 0; d0 < 4; ++d0) kf[kb][d0] = lds_frag16(kp + d0 * 32); }
                    f32x16 p[2]; p[0] = (f32x16){}; p[1] = (f32x16){};
#pragma unroll
                    for (int d0 = 0; d0 < 4; ++d0) { p[0] = __builtin_amdgcn_mfma_f32_32x32x16_bf16(kf[0][d0], qf[d0], p[0], 0, 0, 0); p[1] = __builtin_amdgcn_mfma_f32_32x32x16_bf16(kf[1][d0], qf[d0], p[1], 0, 0, 0); }
                    const LAS unsigned char* vbase = st + AT_V + l31 * 136 + 8 * hi;
                    bf16x8 va[4], vb[4];
#define AT_LOADV(dst, t_) do { _Pragma("unroll") for (int d = 0; d < 4; ++d) dst[d] = lds_frag8x2(vbase + d * 32 * 136 + (t_) * 32, vbase + d * 32 * 136 + (t_) * 32 + 16); } while (0)
#define AT_MMA(src, pf_) do { _Pragma("unroll") for (int d = 0; d < 4; ++d) o[d] = __builtin_amdgcn_mfma_f32_32x32x16_bf16(src[d], pf_, o[d], 0, 0, 0); } while (0)
                    AT_LOADV(va, 0);
                    asm volatile("" ::: "memory");
                    if (64 * j + 63 > q0w) {
                        const int q = q0w + l31;
#pragma unroll
                        for (int kb = 0; kb < 2; ++kb)
#pragma unroll
                            for (int r = 0; r < 16; ++r) { const int kv = 64 * j + 32 * kb + crow(r, hi); if (kv > q) p[kb][r] = -1e30f; }
                    }
                    float mx0 = fmaxf(p[0][0], p[1][0]), mx1 = fmaxf(p[0][1], p[1][1]);
#pragma unroll
                    for (int r = 2; r < 16; r += 2) { mx0 = fmaxf(mx0, fmaxf(p[0][r], p[1][r])); mx1 = fmaxf(mx1, fmaxf(p[0][r + 1], p[1][r + 1])); }
                    float mx = fmaxf(mx0, mx1);
                    mx = fmaxf(mx, __shfl_xor(mx, 32));
                    const float mnew = fmaxf(mrun, mx);
                    if (__any(mnew > mrun)) {
                        const float al = __builtin_amdgcn_exp2f(mrun - mnew); lrun *= al;
#pragma unroll
                        for (int d = 0; d < 4; ++d) o[d] = o[d] * al;
                    }
                    mrun = mnew;
                    float ls0 = 0.f, ls1 = 0.f, ls2 = 0.f, ls3 = 0.f;
#pragma unroll
                    for (int kb = 0; kb < 2; ++kb)
#pragma unroll
                        for (int r = 0; r < 16; r += 4) { p[kb][r] = __builtin_amdgcn_exp2f(p[kb][r] - mnew); p[kb][r + 1] = __builtin_amdgcn_exp2f(p[kb][r + 1] - mnew);
                            p[kb][r + 2] = __builtin_amdgcn_exp2f(p[kb][r + 2] - mnew); p[kb][r + 3] = __builtin_amdgcn_exp2f(p[kb][r + 3] - mnew);
                            ls0 += p[kb][r]; ls1 += p[kb][r + 1]; ls2 += p[kb][r + 2]; ls3 += p[kb][r + 3]; }
                    lrun += (ls0 + ls1) + (ls2 + ls3);
                    bf16x8 pf[4];
#pragma unroll
                    for (int t = 0; t < 4; ++t) { const int kb = t >> 1, s8 = (t & 1) * 8;
                        u32x4 w; w.x = cvt_pk_bf16(p[kb][s8], p[kb][s8 + 1]); w.y = cvt_pk_bf16(p[kb][s8 + 2], p[kb][s8 + 3]);
                        w.z = cvt_pk_bf16(p[kb][s8 + 4], p[kb][s8 + 5]); w.w = cvt_pk_bf16(p[kb][s8 + 6], p[kb][s8 + 7]); pf[t] = __builtin_bit_cast(bf16x8, w); }
                    asm volatile("" ::: "memory");
                    AT_LOADV(vb, 1); asm volatile("" ::: "memory"); AT_MMA(va, pf[0]);
                    AT_LOADV(va, 2); asm volatile("" ::: "memory"); AT_MMA(vb, pf[1]);
                    AT_LOADV(vb, 3); asm volatile("" ::: "memory"); AT_MMA(va, pf[2]);
                    AT_MMA(vb, pf[3]);
#undef AT_LOADV
#undef AT_MMA
                }
            }
#undef AT_LOAD
            const float ltot = lrun + __shfl_xor(lrun, 32);
            const float inv = (c ? lam : 1.f) / ltot;
            __syncthreads();
            LAS float* xch = (LAS float*)lds + rg * 4096;
            if (c == 1) {
#pragma unroll
                for (int d = 0; d < 4; ++d)
#pragma unroll
                    for (int r = 0; r < 16; ++r) xch[(d * 16 + r) * 64 + lane] = o[d][r] * inv;
            }
            __syncthreads();
            if (c == 0) {
                float ss = 0.f;
#pragma unroll
                for (int d = 0; d < 4; ++d)
#pragma unroll
                    for (int r = 0; r < 16; ++r) { const float v = o[d][r] * inv - xch[(d * 16 + r) * 64 + lane]; o[d][r] = v; ss += v * v; }
                ss += __shfl_xor(ss, 32);
                const float rstd = rsqrtf(ss * (1.f / 128.f) + RMS_EPS) * (1.f - lambda_init);
                LAS unsigned char* op = lds + AT_OSTG + (rg * 32 + l31) * 272 + 8 * hi;
#pragma unroll
                for (int d = 0; d < 4; ++d)
#pragma unroll
                    for (int g = 0; g < 4; ++g) { const int dv = 32 * d + 8 * g + 4 * hi; const f32x4 sw = *(const f32x4*)(subw + dv);
                        u32x2 w; w.x = cvt_pk_bf16(o[d][4 * g] * rstd * sw[0], o[d][4 * g + 1] * rstd * sw[1]); w.y = cvt_pk_bf16(o[d][4 * g + 2] * rstd * sw[2], o[d][4 * g + 3] * rstd * sw[3]);
                        *(LAS u32x2*)(op + (32 * d + 8 * g) * 2) = w; }
            }
            __syncthreads();
            {
                const LAS unsigned char* sp = lds + AT_OSTG + (rg * 32 + c * 16) * 272;
                bf16_t* gp = O + ((size_t)b * T + 128 * qb + rg * 32 + c * 16) * D + h * 128;
#pragma unroll
                for (int i = 0; i < 4; ++i) { const int idx = i * 64 + lane, row = idx >> 4, ch = idx & 15;
                    *(u32x4*)(gp + (size_t)row * D + ch * 8) = *(const LAS u32x4*)(sp + row * 272 + ch * 16); }
            }
        }
    }
}

template <bool FUSED_LN> __global__ void __launch_bounds__(NTHR, 2) fwd_megakernel(Params p) {
    extern __shared__ __attribute__((aligned(16))) unsigned char lds_raw[];
    LAS unsigned char* lds = (LAS unsigned char*)lds_raw;
    cg::grid_group grid = cg::this_grid();
    const int widk = __builtin_amdgcn_readfirstlane((int)threadIdx.x >> 6);
    volatile LAS unsigned* bst = (volatile LAS unsigned*)(lds + 131072 + 1024);
    if (threadIdx.x < 2) bst[threadIdx.x] = 0u;
    if (blockIdx.x == 0) { for (unsigned i = threadIdx.x; i < WS_CTL_BYTES / 4; i += NTHR) ((unsigned*)p.ws)[i] = 0u; }
    __syncthreads();
    const int G = gridDim.x;
    constexpr bool fused_ln = FUSED_LN;
    unsigned char* ws = p.ws; unsigned char* wsw = ws + WS_W;
    bf16_t* XN = (bf16_t*)(ws + WS_XN); bf16_t* Hb = (bf16_t*)(ws + WS_H);
    float* Gb = (float*)(ws + WS_GB); float* BETAb = Gb + (size_t)M * 8;

    unsigned long long pt0 = 0, pticks = 0; (void)pt0;
    TBEG(4);
#ifndef NO_PRO
    REPS(4) prologue(widk, p, lds);
#endif
    grid.sync(); TEND(4);
    const XcdBarrier xbar = xcd_barrier_post((unsigned*)p.ws, bst);
    for (int layer = 0; layer < DEPTH; ++layer) {
        const int j = layer >> 1;
        const float* resid = (layer == 0) ? p.in[0] : p.out;
        if ((layer & 1) == 0) {
            TBEG(1);
            {   pg8::Gemm g{XN, (const bf16_t*)(wsw + W_GWIN) + (size_t)j * 4096 * 1024, M, GDN_NMAIN, D, D}; pg8::StaticOrder S; S.init(M, GDN_NMAIN, G, (int)blockIdx.x);
                pg8::EpiBf16 E{Hb, GDN_NMAIN};
                REPS(1) PH_GEMMB pg8::gemm_phase<pg8::EpiBf16, pg8::StaticOrder, true, true, D, D, true>(widk, lds, g, S, E); }
#ifndef NO_AB
            REPS(4) gdn_ab_phase(widk, XN, (const bf16_t*)(wsw + W_GWAB) + (size_t)j * 16 * 1024, p.in[4] + j * 8, p.in[5] + j * 8, Gb, BETAb);
#endif
            xcd_barrier(xbar, widk); TEND(1); TBEG(2);
#ifndef NO_GA
            gdn_phase_a(widk, Hb, Gb, BETAb, p.in[3] + (size_t)j * 4 * 3072, (bf16_t*)(ws + WS_UT) + (size_t)32 * 1024 * 1024, (bf16_t*)(ws + WS_UT), lds);
#endif
            xcd_barrier(xbar, widk);
#ifndef NO_GB
            gdn_phase_b(widk, Hb, Gb, BETAb, p.in[6] + j * 128, (const bf16_t*)(ws + WS_UT) + (size_t)32 * 1024 * 1024, (const bf16_t*)(ws + WS_UT), lds);
#endif
            xcd_barrier(xbar, widk); TEND(2); TBEG(5);
            {   pg8::Gemm g{Hb + 2048, (const bf16_t*)(wsw + W_GWOUT) + (size_t)j * 1024 * 1024, M, D, D, GDN_NMAIN}; pg8::StaticOrder S; S.init(M, D, G, (int)blockIdx.x);
                if constexpr (fused_ln) {
                    if (layer == 0) { pg8::EpiResidLn<false, false> E{p.in[0], p.out, XN, p.in[19] + layer * D, p.in[20] + layer * D, ALPHA, LN_EPS, (unsigned*)(ws + WS_XBUF), (unsigned*)(ws + WS_CNT) + (size_t)(2 * layer) * 4096, (LAS float*)(lds + 131072 + 2048)};
                        pg8::gemm_phase<pg8::EpiResidLn<false, false>, pg8::StaticOrder, true, true, D, GDN_NMAIN>(widk, lds, g, S, E); }
                    else { pg8::EpiResidLn<true, false> E{nullptr, p.out, XN, p.in[19] + layer * D, p.in[20] + layer * D, ALPHA, LN_EPS, (unsigned*)(ws + WS_XBUF), (unsigned*)(ws + WS_CNT) + (size_t)(2 * layer) * 4096, (LAS float*)(lds + 131072 + 2048)};
                        pg8::gemm_phase<pg8::EpiResidLn<true, false>, pg8::StaticOrder, true, true, D, GDN_NMAIN>(widk, lds, g, S, E); } }
                else { pg8::EpiResid E{resid, p.out, D, ALPHA};
                    PH_GEMMR pg8::gemm_phase<pg8::EpiResid, pg8::StaticOrder, true, true, D, GDN_NMAIN>(widk, lds, g, S, E); } }
        } else {
            const float lambda_init = 0.8f - 0.6f * expf(-0.3f * (float)layer);
            TBEG(1);
            {   pg8::Gemm g{XN, (const bf16_t*)(wsw + W_DWIN) + (size_t)j * 3072 * 1024, M, DIFF_N, D, D}; pg8::StaticOrder S; S.init(M, DIFF_N, G, (int)blockIdx.x);
                pg8::EpiRope E{Hb, (const float*)(ws + WS_ROPE), (const float*)(ws + WS_ROPE) + (size_t)M * 32, 0.125f * LOG2E, (bf16_t*)(ws + WS_VT)};
                pg8::gemm_phase<pg8::EpiRope, pg8::StaticOrder, true, true, D, D, true>(widk, lds, g, S, E); }
            xcd_barrier(xbar, widk); TEND(1); TBEG(4);
#ifndef NO_ATT
            REPS(3) diff_attn_phase(widk, Hb, (const bf16_t*)(ws + WS_VT), (bf16_t*)(ws + WS_O), p.in[9] + j * 64, p.in[10] + j * 64, p.in[11] + j * 64, p.in[12] + j * 64, p.in[13] + j * 128, lambda_init, lds);
#endif
            xcd_barrier(xbar, widk); TEND(3); TBEG(5);
            {   pg8::Gemm g{(const bf16_t*)(ws + WS_O), (const bf16_t*)(wsw + W_DWOUT) + (size_t)j * 1024 * 1024, M, D, D, D}; pg8::StaticOrder S; S.init(M, D, G, (int)blockIdx.x);
                if constexpr (fused_ln) { pg8::EpiResidLn<true, false> E{nullptr, p.out, XN, p.in[19] + layer * D, p.in[20] + layer * D, ALPHA, LN_EPS, (unsigned*)(ws + WS_XBUF), (unsigned*)(ws + WS_CNT) + (size_t)(2 * layer) * 4096, (LAS float*)(lds + 131072 + 2048)};
                    pg8::gemm_phase<pg8::EpiResidLn<true, false>, pg8::StaticOrder, true, true, D, D>(widk, lds, g, S, E); }
                else { pg8::EpiResid E{resid, p.out, D, ALPHA};
                    PH_GEMMR pg8::gemm_phase<pg8::EpiResid, pg8::StaticOrder, true, true, D, D>(widk, lds, g, S, E); } }
        }
        xcd_barrier(xbar, widk); TEND(5);
        if constexpr (!fused_ln) { ln_phase(widk, p.out, XN, p.in[19] + layer * D, p.in[20] + layer * D); xcd_barrier(xbar, widk); }
        {
            bf16_t* ACT = (bf16_t*)(ws + WS_ACT); float* HALO = (float*)(ws + WS_HALO); float* HALO2 = (float*)(ws + WS_HALO2);
            const float* fcw = p.in[16] + (size_t)layer * 3 * FFN_N; const float* fcb = p.in[17] + (size_t)layer * FFN_N;
            TBEG(6);
            {   pg8::Gemm g{XN, (const bf16_t*)(wsw + W_FUP) + (size_t)layer * 5632 * 1024, M, FFN_N, D, D}; pg8::StaticOrder S; S.init(M, FFN_N, G, (int)blockIdx.x);
                pg8::EpiFfnAct E{ACT, fcw, fcb, HALO, HALO2, (LAS float*)(lds + 131072 + 2048)};
                pg8::gemm_phase<pg8::EpiFfnAct, pg8::StaticOrder, true, true, D, D, true>(widk, lds, g, S, E); }
            xcd_barrier(xbar, widk); TEND(6); TBEG(4);
            ffn_fixup_phase(widk, ACT, HALO, HALO2, fcw, fcb);
            xcd_barrier(xbar, widk); TEND(4); TBEG(7);
            {   pg8::Gemm g{ACT, (const bf16_t*)(wsw + W_FDOWN) + (size_t)layer * 1024 * 2816, M, D, FFN_H, FFN_H}; pg8::StaticOrder S; S.init(M, D, G, (int)blockIdx.x);
                if constexpr (fused_ln) {
                    if (layer == DEPTH - 1) { pg8::EpiResidLn<true, true> E{nullptr, p.out, XN, p.in[21] + layer * D, p.in[22] + layer * D, ALPHA, LN_EPS, (unsigned*)(ws + WS_XBUF), (unsigned*)(ws + WS_CNT) + (size_t)(2 * layer + 1) * 4096, (LAS float*)(lds + 131072 + 2048)};
                        pg8::gemm_phase<pg8::EpiResidLn<true, true>, pg8::StaticOrder, true, true, FFN_H, FFN_H>(widk, lds, g, S, E); }
                    else { pg8::EpiResidLn<true, false> E{nullptr, p.out, XN, p.in[21] + layer * D, p.in[22] + layer * D, ALPHA, LN_EPS, (unsigned*)(ws + WS_XBUF), (unsigned*)(ws + WS_CNT) + (size_t)(2 * layer + 1) * 4096, (LAS float*)(lds + 131072 + 2048)};
                        pg8::gemm_phase<pg8::EpiResidLn<true, false>, pg8::StaticOrder, true, true, FFN_H, FFN_H>(widk, lds, g, S, E); } }
                else { pg8::EpiResid E{p.out, p.out, D, ALPHA};
                    pg8::gemm_phase<pg8::EpiResid, pg8::StaticOrder, true, true, FFN_H, FFN_H>(widk, lds, g, S, E); } }
        }
        xcd_barrier(xbar, widk); TEND(7);
        if constexpr (!fused_ln) { ln_phase(widk, p.out, XN, p.in[21] + layer * D, p.in[22] + layer * D); xcd_barrier(xbar, widk); }
    }
    if (PROBE_T) { const unsigned long long ts = __builtin_amdgcn_s_memrealtime(); while (__builtin_amdgcn_s_memrealtime() - ts < pticks) __builtin_amdgcn_s_sleep(8); }
}
}

extern "C" void kernel_launch(void* const* d_in, const int* in_sizes, int n_in, void* d_out, int out_size, void* d_ws, size_t ws_size, hipStream_t stream) {
    static int grid = 0;
    if (grid == 0) {
        if (n_in != 23 || ws_size < mk::WS_END) { fprintf(stderr, "kernel_launch: unexpected n_in %d / ws_size %zu (need %zu)\n", n_in, ws_size, (size_t)mk::WS_END); grid = -1; return; }
        int dev = 0, cus = 0, per_cu = 0;
        (void)hipGetDevice(&dev); (void)hipDeviceGetAttribute(&cus, hipDeviceAttributeMultiprocessorCount, dev);
        const void* kfn = (const void*)mk::fwd_megakernel<true>; const void* kfn2 = (const void*)mk::fwd_megakernel<false>;
        if (hipFuncSetAttribute(kfn, hipFuncAttributeMaxDynamicSharedMemorySize, mk::LDS_BYTES) != hipSuccess || hipFuncSetAttribute(kfn2, hipFuncAttributeMaxDynamicSharedMemorySize, mk::LDS_BYTES) != hipSuccess) { fprintf(stderr, "kernel_launch: hipFuncSetAttribute failed\n"); grid = -1; return; }
        if (hipOccupancyMaxActiveBlocksPerMultiprocessor(&per_cu, kfn, mk::NTHR, mk::LDS_BYTES) != hipSuccess || per_cu < 1) { fprintf(stderr, "kernel_launch: occupancy query gave %d\n", per_cu); per_cu = 1; }
        (void)hipGetLastError();
        grid = cus * per_cu;
        fprintf(stderr, "kernel_launch: grid %d (cus %d x %d)\n", grid, cus, per_cu);
    }
    if (grid < 0) return;
    mk::Params p{};
    for (int i = 0; i < 23; ++i) p.in[i] = (const float*)d_in[i];
    p.positions = (const int*)d_in[1]; p.out = (float*)d_out; p.ws = (unsigned char*)d_ws;
    void* args[] = {&p};
    hipError_t e = hipLaunchCooperativeKernel(grid == 256 ? (const void*)mk::fwd_megakernel<true> : (const void*)mk::fwd_megakernel<false>, dim3(grid), dim3(mk::NTHR), args, mk::LDS_BYTES, stream);
    if (e != hipSuccess) fprintf(stderr, "cooperative launch failed: %s (grid %d)\n", hipGetErrorString(e), grid);
}
```

```cpp
#include <hip/hip_runtime.h>
#include <hip/hip_cooperative_groups.h>
#include <cstdio>
#include <cstdint>
namespace cg = cooperative_groups;
#ifndef PROBE_REP
#define PROBE_REP 0
#endif
#define REPS(k) for (int rep_ = 0; rep_ < ((PROBE_REP) == (k) ? 2 : 1); ++rep_)
#ifndef PROBE_T
#define PROBE_T 0
#endif
#define TBEG(k) if (PROBE_T == (k)) pt0 = __builtin_amdgcn_s_memrealtime()
#define TEND(k) if (PROBE_T == (k)) pticks += __builtin_amdgcn_s_memrealtime() - pt0
namespace pg8 {
#define PG8_LAS __attribute__((address_space(3)))
typedef unsigned short bf16_t;
typedef short bf16x8 __attribute__((ext_vector_type(8)));
typedef float f32x4 __attribute__((ext_vector_type(4)));
typedef unsigned u32x4 __attribute__((ext_vector_type(4)));
constexpr int BM = 256, BK = 64, HALF = 128, HTB = HALF * BK * 2  , STAGE_BYTES = 8 * HTB, NXCD = 8, WGM = 8;

__host__ __device__ __forceinline__ int lds_byte(int r, int c) { const int st = (r >> 4) * 2 + (c >> 5), rr = r & 15, cc = c & 31, ob = rr * 64 + cc * 2; return st * 1024 + (ob ^ (((ob >> 9) & 1) << 5)); }
__host__ __device__ __forceinline__ void stage_rc(int b, int& R, int& C) { const int st = b / 1024, sb = b % 1024, swz = sb ^ (((sb >> 9) & 1) << 5); R = (st >> 1) * 16 + swz / 64; C = (st & 1) * 32 + (swz % 64) / 2; }
__host__ __device__ __forceinline__ int perm32(int rho) { const int n = rho >> 4, i = rho & 15; return 8 * (i >> 2) + 4 * n + (i & 3); }

struct Unit { int pm, pn; };
struct Gemm { const bf16_t* A; const bf16_t* Bt; int M, N, K, lda; };

struct StaticOrder {
    int nM, nN, nwg, G, c;
    __host__ __device__ void init(int M, int N, int G_, int c_) { nM = M / BM; nN = N / BM; nwg = nM * nN; G = G_; c = c_; }
    __host__ __device__ bool next(int i, Unit& u) const {
        const long L = (long)i * G + c; if (L >= nwg) return false;
        int wgid = (int)L; { const int q = nwg / NXCD, r = nwg % NXCD, xcd = wgid % NXCD, off = wgid / NXCD; wgid = (xcd < r ? xcd * (q + 1) : r * (q + 1) + (xcd - r) * q) + off; }
        const int nig = WGM * nN, gid = wgid / nig, fm = gid * WGM, gsz = (nM - fm) < WGM ? (nM - fm) : WGM;
        u.pm = fm + ((wgid % nig) % gsz); u.pn = (wgid % nig) / gsz; return true;
    }
    __device__ __forceinline__ void a_ready(const Unit&) const {}
    __device__ __forceinline__ void done(const Unit&) const {}
};
typedef float f32x2 __attribute__((ext_vector_type(2)));
typedef __bf16 bf16x2v __attribute__((ext_vector_type(2)));
typedef _Float16 f16x2v __attribute__((ext_vector_type(2)));
typedef _Float16 f16x8 __attribute__((ext_vector_type(8)));
__device__ __forceinline__ unsigned cvt_pk_f16(float lo, float hi) { f32x2 v = {lo, hi}; f16x2v b = __builtin_convertvector(v, f16x2v); return __builtin_bit_cast(unsigned, b); }
__device__ __forceinline__ f32x2 unpk_f16(unsigned w) { const f16x2v h = __builtin_bit_cast(f16x2v, w); return __builtin_convertvector(h, f32x2); }
template <bool F16> __device__ __forceinline__ f32x4 mma16(const bf16x8 a, const bf16x8 b, const f32x4 c) {
    if constexpr (F16) return __builtin_amdgcn_mfma_f32_16x16x32_f16(__builtin_bit_cast(f16x8, a), __builtin_bit_cast(f16x8, b), c, 0, 0, 0);
    else return __builtin_amdgcn_mfma_f32_16x16x32_bf16(a, b, c, 0, 0, 0);
}
__device__ __forceinline__ unsigned cvt_pk_bf16(float lo, float hi) { f32x2 v = {lo, hi}; bf16x2v b = __builtin_convertvector(v, bf16x2v); return __builtin_bit_cast(unsigned, b); }

struct EpiBf16 {
    static constexpr bool PERM = true, AFTER_DRAIN = false;
    bf16_t* O; int ldc;
    __device__ __forceinline__ void operator()(const f32x4 (&acc)[2][2][4][2], const Unit& u, int wr, int wc, int fr, int fq) const {
        const int row0 = u.pm * BM + wr * 64 + fr; const int col0 = u.pn * BM + wc * 32 + 8 * fq;
#pragma unroll
        for (int ai = 0; ai < 2; ++ai)
#pragma unroll
            for (int m = 0; m < 4; ++m) { bf16_t* rowp = O + (size_t)(row0 + ai * HALF + m * 16) * ldc + col0;
#pragma unroll
                for (int bj = 0; bj < 2; ++bj) { const f32x4 v0 = acc[ai][bj][m][0], v1 = acc[ai][bj][m][1];
                    u32x4 w; w.x = cvt_pk_bf16(v0[0], v0[1]); w.y = cvt_pk_bf16(v0[2], v0[3]); w.z = cvt_pk_bf16(v1[0], v1[1]); w.w = cvt_pk_bf16(v1[2], v1[3]);
                    *(u32x4*)(rowp + bj * HALF) = w; } }
    }
};
struct EpiResid {
    static constexpr bool PERM = false, AFTER_DRAIN = false;
    const float* base; float* out; int ldc; float alpha;
    __device__ __forceinline__ void operator()(const f32x4 (&acc)[2][2][4][2], const Unit& u, int wr, int wc, int fr, int fq) const {
        const int col0 = u.pn * BM + wc * 32 + 4 * fq;
#pragma unroll
        for (int ai = 0; ai < 2; ++ai)
#pragma unroll
            for (int m = 0; m < 4; ++m) { const int r = ai * HALF + wr * 64 + m * 16 + fr; const size_t off = (size_t)(u.pm * BM + r) * ldc + col0;
#pragma unroll
                for (int bj = 0; bj < 2; ++bj)
#pragma unroll
                    for (int n = 0; n < 2; ++n) { const f32x4 bs = *(const f32x4*)(base + off + bj * HALF + n * 16); const f32x4 o = bs * alpha + acc[ai][bj][m][n];
                        *(f32x4*)(out + off + bj * HALF + n * 16) = o; }
                asm volatile("" ::: "memory"); }
    }
};

struct EpiRope {
    static constexpr bool PERM = true, AFTER_DRAIN = false;
    bf16_t* O; const unsigned* CS; float qscale; bf16_t* VT;
    __device__ __forceinline__ void operator()(const f32x4 (&acc)[2][2][4][2], const Unit& u, int wr, int wc, int fr_, int fq_) const {
        int fr = fr_, fq = fq_; asm volatile("" : "+v"(fr), "+v"(fq));
        const int row0 = u.pm * BM + wr * 64 + fr;
        if (u.pn >= 8) {
            const int t0 = (u.pm * BM) & 2047, bb = (u.pm * BM) >> 11;
#pragma unroll
            for (int bj = 0; bj < 2; ++bj) {
                bf16_t* vt = VT + ((size_t)(bb * 8 + 2 * (u.pn - 8) + bj) * 128 + wc * 32 + 8 * fq) * 2048 + t0 + wr * 64 + fr;
#pragma unroll
                for (int n = 0; n < 2; ++n)
#pragma unroll
                    for (int e = 0; e < 4; ++e)
#pragma unroll
                        for (int ai = 0; ai < 2; ++ai)
#pragma unroll
                            for (int m = 0; m < 4; ++m) vt[(size_t)(4 * n + e) * 2048 + ai * HALF + m * 16] = (bf16_t)(cvt_pk_bf16(acc[ai][bj][m][n][e], 0.f) & 0xffffu);
            }
        } else {
            const float sc = (u.pn < 4) ? qscale : 1.f;
            const int col1 = u.pn * BM + wc * 64 + 8 * fq;
#pragma unroll
            for (int ai = 0; ai < 2; ++ai)
#pragma unroll
                for (int m = 0; m < 4; ++m) { const int row = row0 + ai * HALF + m * 16;
                    const u32x4 t0 = *(const u32x4*)(CS + (size_t)row * 32 + 8 * fq), t1 = *(const u32x4*)(CS + (size_t)row * 32 + 8 * fq + 4);
                    const f32x2 e0 = unpk_f16(t0.x), e1 = unpk_f16(t0.y), e2 = unpk_f16(t0.z), e3 = unpk_f16(t0.w), e4 = unpk_f16(t1.x), e5 = unpk_f16(t1.y), e6 = unpk_f16(t1.z), e7 = unpk_f16(t1.w);
                    const f32x4 c0 = {e0[0], e1[0], e2[0], e3[0]}, c1 = {e4[0], e5[0], e6[0], e7[0]}, s0 = {e0[1], e1[1], e2[1], e3[1]}, s1 = {e4[1], e5[1], e6[1], e7[1]};
                    const f32x4 a0 = acc[ai][0][m][0], a1 = acc[ai][0][m][1], b0 = acc[ai][1][m][0], b1 = acc[ai][1][m][1];
                    const f32x4 y10 = (a0 * c0 - b0 * s0) * sc, y11 = (a1 * c1 - b1 * s1) * sc, y20 = (b0 * c0 + a0 * s0) * sc, y21 = (b1 * c1 + a1 * s1) * sc;
                    u32x4 w1, w2; w1.x = cvt_pk_bf16(y10[0], y10[1]); w1.y = cvt_pk_bf16(y10[2], y10[3]); w1.z = cvt_pk_bf16(y11[0], y11[1]); w1.w = cvt_pk_bf16(y11[2], y11[3]);
                    w2.x = cvt_pk_bf16(y20[0], y20[1]); w2.y = cvt_pk_bf16(y20[2], y20[3]); w2.z = cvt_pk_bf16(y21[0], y21[1]); w2.w = cvt_pk_bf16(y21[2], y21[3]);
                    bf16_t* rowp = O + (size_t)row * 3072 + col1;
                    *(u32x4*)rowp = w1; *(u32x4*)(rowp + 32) = w2;
                    if (m & 1) asm volatile("" ::: "memory"); }
        }
    }
};

template <bool BASE_BF16, bool WRITE_F32> struct EpiResidLn {
    static constexpr bool PERM = true, AFTER_DRAIN = false;
    const float* base; float* out; bf16_t* xn; const float* g; const float* b; float alpha, eps;
    unsigned* xbuf;
    unsigned* cnt;
    PG8_LAS float* sl;
    __device__ __forceinline__ void operator()(f32x4 (&acc)[2][2][4][2], const Unit& u, int wr, int wc, int fr_, int fq_) const {
        typedef unsigned u32x2 __attribute__((ext_vector_type(2)));
        int fr = fr_, fq = fq_; asm volatile("" : "+v"(fr), "+v"(fq));
        const int col0 = u.pn * BM + wc * 32 + 8 * fq;
        const int lane = fq * 16 + fr, wid = wr * 4 + wc, tid = wid * 64 + lane;
#pragma unroll
        for (int ai = 0; ai < 2; ++ai)
#pragma unroll
            for (int m = 0; m < 4; ++m) { const int r = ai * HALF + wr * 64 + m * 16 + fr; const size_t off = (size_t)(u.pm * BM + r) * 1024 + col0;
                float s = 0.f, q = 0.f;
#pragma unroll
                for (int bj = 0; bj < 2; ++bj) { f32x4 bs0, bs1;
                    if constexpr (BASE_BF16) { const u32x4 rb = *(const u32x4*)(xn + off + bj * HALF); const f32x2 a0 = unpk_f16(rb.x), a1 = unpk_f16(rb.y), a2 = unpk_f16(rb.z), a3 = unpk_f16(rb.w);
                        bs0 = (f32x4){a0[0], a0[1], a1[0], a1[1]}; bs1 = (f32x4){a2[0], a2[1], a3[0], a3[1]}; }
                    else { bs0 = *(const f32x4*)(base + off + bj * HALF); bs1 = *(const f32x4*)(base + off + bj * HALF + 4); }
                    const f32x4 y0 = bs0 * alpha + acc[ai][bj][m][0], y1 = bs1 * alpha + acc[ai][bj][m][1]; acc[ai][bj][m][0] = y0; acc[ai][bj][m][1] = y1;
                    s += ((y0[0] + y0[1]) + (y0[2] + y0[3])) + ((y1[0] + y1[1]) + (y1[2] + y1[3]));
                    q += ((y0[0] * y0[0] + y0[1] * y0[1]) + (y0[2] * y0[2] + y0[3] * y0[3])) + ((y1[0] * y1[0] + y1[1] * y1[1]) + (y1[2] * y1[2] + y1[3] * y1[3])); }
                s += __shfl_xor(s, 16); s += __shfl_xor(s, 32); q += __shfl_xor(q, 16); q += __shfl_xor(q, 32);
                if (fq == 0) { sl[(r * 4 + wc) * 2] = s; sl[(r * 4 + wc) * 2 + 1] = q; }
                asm volatile("" ::: "memory"); }
        asm volatile("s_waitcnt lgkmcnt(0)" ::: "memory"); __builtin_amdgcn_s_barrier(); asm volatile("" ::: "memory");
        if (tid < 256) {
            const PG8_LAS f32x4* pp = (const PG8_LAS f32x4*)(sl + tid * 8); const f32x4 p0 = pp[0], p1 = pp[1];
            const float S = (p0[0] + p0[2]) + (p1[0] + p1[2]), Q = (p0[1] + p0[3]) + (p1[1] + p1[3]);
            unsigned* xp = xbuf + (((size_t)u.pm * 4 + u.pn) * 256 + tid) * 2;
            __hip_atomic_store(xp, __float_as_uint(S), __ATOMIC_RELAXED, __HIP_MEMORY_SCOPE_AGENT); __hip_atomic_store(xp + 1, __float_as_uint(Q), __ATOMIC_RELAXED, __HIP_MEMORY_SCOPE_AGENT);
            asm volatile("s_waitcnt vmcnt(0)" ::: "memory");
            if (lane == 0) __hip_atomic_fetch_add(cnt + 16 * u.pm, 1u, __ATOMIC_RELAXED, __HIP_MEMORY_SCOPE_AGENT);
        }
        if (wid == 0) {
            unsigned sp = 0;
            while ((unsigned)__builtin_amdgcn_readfirstlane(__hip_atomic_load(cnt + 16 * u.pm, __ATOMIC_RELAXED, __HIP_MEMORY_SCOPE_AGENT)) < 16u) { __builtin_amdgcn_s_sleep(2); if (++sp > (1u << 22)) break; }
            __builtin_amdgcn_fence(__ATOMIC_ACQUIRE, "agent");
        }
        asm volatile("s_waitcnt vmcnt(0) lgkmcnt(0)" ::: "memory"); __builtin_amdgcn_s_barrier(); asm volatile("" ::: "memory");
        if (tid < 256) {
            float S = 0.f, Q = 0.f;
#pragma unroll
            for (int t = 0; t < 4; ++t) { unsigned* xp = xbuf + (((size_t)u.pm * 4 + t) * 256 + tid) * 2;
                S += __uint_as_float(__hip_atomic_load(xp, __ATOMIC_RELAXED, __HIP_MEMORY_SCOPE_AGENT)); Q += __uint_as_float(__hip_atomic_load(xp + 1, __ATOMIC_RELAXED, __HIP_MEMORY_SCOPE_AGENT)); }
            const float mean = S * (1.f / 1024.f), var = fmaxf(Q * (1.f / 1024.f) - mean * mean, 0.f);
            sl[2048 + tid * 2] = mean; sl[2048 + tid * 2 + 1] = 1.f / sqrtf(var + eps);
        }
        asm volatile("s_waitcnt lgkmcnt(0)" ::: "memory"); __builtin_amdgcn_s_barrier(); asm volatile("" ::: "memory");
#pragma unroll
        for (int bj = 0; bj < 2; ++bj) {
            const f32x4 gv0 = *(const f32x4*)(g + col0 + bj * HALF), gv1 = *(const f32x4*)(g + col0 + bj * HALF + 4), bv0 = *(const f32x4*)(b + col0 + bj * HALF), bv1 = *(const f32x4*)(b + col0 + bj * HALF + 4);
#pragma unroll
            for (int ai = 0; ai < 2; ++ai)
#pragma unroll
                for (int m = 0; m < 4; ++m) { const int r = ai * HALF + wr * 64 + m * 16 + fr; const size_t off = (size_t)(u.pm * BM + r) * 1024 + col0 + bj * HALF;
                    const float mean = sl[2048 + r * 2], rstd = sl[2048 + r * 2 + 1];
                    const f32x4 o0 = (acc[ai][bj][m][0] - mean) * rstd * gv0 + bv0, o1 = (acc[ai][bj][m][1] - mean) * rstd * gv1 + bv1;
                    if constexpr (WRITE_F32) { *(f32x4*)(out + off) = o0; *(f32x4*)(out + off + 4) = o1; }
                    u32x4 w; w.x = cvt_pk_f16(o0[0], o0[1]); w.y = cvt_pk_f16(o0[2], o0[3]); w.z = cvt_pk_f16(o1[0], o1[1]); w.w = cvt_pk_f16(o1[2], o1[3]); *(u32x4*)(xn + off) = w; }
            asm volatile("" ::: "memory");
        }
    }
};

__device__ __forceinline__ float dpp_ror1(float v) { float r; asm volatile("s_nop 1\n\tv_mov_b32_dpp %0, %1 row_ror:1 row_mask:0xf bank_mask:0xf" : "=&v"(r) : "v"(v)); return r; }
__device__ __forceinline__ float dpp_ror2(float v) { float r; asm volatile("s_nop 1\n\tv_mov_b32_dpp %0, %1 row_ror:2 row_mask:0xf bank_mask:0xf" : "=&v"(r) : "v"(v)); return r; }
__device__ __forceinline__ float silu_f(float x) { return x * __builtin_amdgcn_rcpf(1.f + __expf(-x)); }
struct EpiFfnAct {
    static constexpr bool PERM = true, AFTER_DRAIN = false;
    bf16_t* ACT; const float* cw; const float* cb; float* HALO; float* HALO2; PG8_LAS float* hl;
    __device__ __forceinline__ void operator()(const f32x4 (&acc)[2][2][4][2], const Unit& u, int wr, int wc, int fr_, int fq_) const {
        int fr = fr_, fq = fq_; asm volatile("" : "+v"(fr), "+v"(fq));
        const int cc0 = wc * 32 + 8 * fq, colA = u.pn * 128 + cc0;
        if (fr >= 14) {
#pragma unroll
            for (int ai = 0; ai < 2; ++ai) { PG8_LAS float* hp = hl + ((2 * ai + wr) * 2 + (fr - 14)) * 256 + cc0;
#pragma unroll
                for (int bj = 0; bj < 2; ++bj)
#pragma unroll
                    for (int n = 0; n < 2; ++n) *(PG8_LAS f32x4*)(hp + bj * 128 + 4 * n) = acc[ai][bj][3][n]; }
            if (wr == 1) { float* gp = HALO + ((size_t)u.pm * 2 + (fr - 14)) * 5632 + colA;
#pragma unroll
                for (int bj = 0; bj < 2; ++bj)
#pragma unroll
                    for (int n = 0; n < 2; ++n) *(f32x4*)(gp + bj * 2816 + 4 * n) = acc[1][bj][3][n]; }
        }
        if (fr < 2 && wr == 0) { float* gp = HALO2 + ((size_t)u.pm * 2 + fr) * 5632 + colA;
#pragma unroll
            for (int bj = 0; bj < 2; ++bj)
#pragma unroll
                for (int n = 0; n < 2; ++n) *(f32x4*)(gp + bj * 2816 + 4 * n) = acc[0][bj][0][n]; }
        asm volatile("s_waitcnt lgkmcnt(0)" ::: "memory"); __builtin_amdgcn_s_barrier(); asm volatile("" ::: "memory");
#pragma unroll
        for (int ai = 0; ai < 2; ++ai) {
            const int strip = 2 * ai + wr;
            unsigned kx[4], ky[4];
#pragma unroll
            for (int n = 0; n < 2; ++n) {
                f32x4 wa[3], wb[3];
#pragma unroll
                for (int j = 0; j < 3; ++j) { wa[j] = *(const f32x4*)(cw + j * 5632 + colA + 4 * n); wb[j] = *(const f32x4*)(cw + j * 5632 + 2816 + colA + 4 * n); }
                const f32x4 ba = *(const f32x4*)(cb + colA + 4 * n), bb = *(const f32x4*)(cb + 2816 + colA + 4 * n);
                f32x4 h1a = {0.f, 0.f, 0.f, 0.f}, h2a = h1a, h1b = h1a, h2b = h1a;
                if (strip > 0) { const PG8_LAS float* hp = hl + ((strip - 1) * 2) * 256 + cc0 + 4 * n;
                    h2a = *(const PG8_LAS f32x4*)hp; h1a = *(const PG8_LAS f32x4*)(hp + 256); h2b = *(const PG8_LAS f32x4*)(hp + 128); h1b = *(const PG8_LAS f32x4*)(hp + 256 + 128); }
                f32x4 pr1a = h1a, pr2a = h2a, pr1b = h1b, pr2b = h2b;
#pragma unroll
                for (int m = 0; m < 4; ++m) {
                    const f32x4 ca = acc[ai][0][m][n], cbv = acc[ai][1][m][n];
                    f32x4 c1a, c2a, c1b, c2b;
#pragma unroll
                    for (int e = 0; e < 4; ++e) { c1a[e] = dpp_ror1(ca[e]); c2a[e] = dpp_ror2(ca[e]); c1b[e] = dpp_ror1(cbv[e]); c2b[e] = dpp_ror2(cbv[e]); }
                    float o[4];
#pragma unroll
                    for (int e = 0; e < 4; ++e) {
                        float x1a, x2a, x1b, x2b;
                        if (m > 0) { x1a = pr1a[e]; x2a = pr2a[e]; x1b = pr1b[e]; x2b = pr2b[e]; }
                        else { x1a = h1a[e]; x2a = (fr == 0) ? h2a[e] : h1a[e]; x1b = h1b[e]; x2b = (fr == 0) ? h2b[e] : h1b[e]; }
                        const float p1a = (fr == 0) ? x1a : c1a[e], p2a = (fr < 2) ? x2a : c2a[e];
                        const float p1b = (fr == 0) ? x1b : c1b[e], p2b = (fr < 2) ? x2b : c2b[e];
                        const float ya = wa[0][e] * p2a + wa[1][e] * p1a + wa[2][e] * ca[e] + ba[e];
                        const float yb = wb[0][e] * p2b + wb[1][e] * p1b + wb[2][e] * cbv[e] + bb[e];
                        o[e] = silu_f(ya) * yb;
                    }
                    pr1a = c1a; pr2a = c2a; pr1b = c1b; pr2b = c2b;
                    const unsigned w0 = cvt_pk_bf16(o[0], o[1]), w1 = cvt_pk_bf16(o[2], o[3]);
                    asm volatile("" :: "v"(w0), "v"(w1));
                    if (n == 0) { kx[m] = w0; ky[m] = w1; }
                    else { u32x4 w; w.x = kx[m]; w.y = ky[m]; w.z = w0; w.w = w1; *(u32x4*)(ACT + (size_t)(u.pm * BM + ai * HALF + wr * 64 + m * 16 + fr) * 2816 + colA) = w; }
                }
                asm volatile("" ::: "memory");
            }
        }
    }
};

template <class Epi, class Sched, bool ALIGN_EPI, bool SP2, int KC, int LDAC, bool F16 = false>
__device__ __forceinline__ void gemm_phase(int widk, PG8_LAS unsigned char* lds, const Gemm g, const Sched& S, const Epi& E) {
    int lane_; asm volatile("v_mbcnt_lo_u32_b32 %0, -1, 0\n\tv_mbcnt_hi_u32_b32 %0, -1, %0" : "=v"(lane_));
    int wid_ = widk; asm volatile("" : "+s"(wid_));
    const int wid = wid_, lane = lane_, tid = wid * 64 + lane, wr = wid >> 2, wc = wid & 3, fr = lane & 15, fq = lane >> 4;
    constexpr int K = KC, nt = K / BK;
    unsigned voffA[2], voffB[2];
#pragma unroll
    for (int i = 0; i < 2; ++i) { int R, C; stage_rc(tid * 16 + i * 8192, R, C); const int Rb = Epi::PERM ? ((R & ~31) + perm32(R & 31)) : R;
        voffA[i] = (unsigned)(R * LDAC + C) * 2u; voffB[i] = (unsigned)(Rb * K + C) * 2u; }
    const size_t kstep = (size_t)(BK * 2);
    const size_t hstepA = (size_t)HALF * LDAC * 2, hstepB = (size_t)HALF * K * 2;
    const size_t tstepA = 2 * hstepA, tstepB = 2 * hstepB;
    const unsigned ldsw = (unsigned)wid * 1024u;
    const int aoff = lds_byte(wr * 64 + fr, fq * 8), boff = lds_byte(wc * 32 + fr, fq * 8);
#define PG8_SA(b, h) (((b) * 2 + (h)) * HTB)
#define PG8_SB(b, h) ((4 + (b) * 2 + (h)) * HTB)
#define PG8_STAGE(bufoff, gbase, voff) do { _Pragma("unroll") for (int _i = 0; _i < 2; ++_i) \
        __builtin_amdgcn_global_load_lds((const unsigned*)((const char*)(gbase) + (voff)[_i]), (PG8_LAS unsigned*)(lds + (bufoff) + ldsw + _i * 8192), 16, 0, 0); } while (0)
#define PG8_LDA(dst, b, h) do { _Pragma("unroll") for (int m = 0; m < 4; ++m) _Pragma("unroll") for (int k = 0; k < 2; ++k) dst[m][k] = *(const PG8_LAS bf16x8*)(lds + PG8_SA(b, h) + aoff + m * 2048 + k * 1024); } while (0)
#define PG8_LDB(dst, b, h) do { _Pragma("unroll") for (int n = 0; n < 2; ++n) _Pragma("unroll") for (int k = 0; k < 2; ++k) dst[n][k] = *(const PG8_LAS bf16x8*)(lds + PG8_SB(b, h) + boff + n * 2048 + k * 1024); } while (0)
#define PG8_MMA(ai, bj, At, Bt) do { __builtin_amdgcn_s_setprio(1); _Pragma("unroll") for (int m = 0; m < 4; ++m) _Pragma("unroll") for (int n = 0; n < 2; ++n) _Pragma("unroll") for (int k = 0; k < 2; ++k) \
        acc[ai][bj][m][n] = mma16<F16>(Bt[n][k], At[m][k], acc[ai][bj][m][n]); __builtin_amdgcn_s_setprio(0); } while (0)
#define PG8_WAIT_V(n) asm volatile("s_waitcnt vmcnt(" #n ")" ::: "memory")
#define PG8_WAIT_L(n) asm volatile("s_waitcnt lgkmcnt(" #n ")" ::: "memory")
#define PG8_BAR __builtin_amdgcn_s_barrier()
#define PG8_SCHED __builtin_amdgcn_sched_barrier(0)
    Unit cur, nxt; int ui = 0;
    if (!S.next(0, cur)) return;
    f32x4 acc[2][2][4][2];
#pragma unroll
    for (int a = 0; a < 2; ++a)
#pragma unroll
        for (int b = 0; b < 2; ++b)
#pragma unroll
            for (int m = 0; m < 4; ++m)
#pragma unroll
                for (int n = 0; n < 2; ++n) acc[a][b][m][n] = (f32x4){0.f, 0.f, 0.f, 0.f};
    bf16x8 At[4][2], B0[2][2], B1[2][2];
    const char* cA = (const char*)g.A + (size_t)cur.pm * tstepA; const char* cB = (const char*)g.Bt + (size_t)cur.pn * tstepB;
    S.a_ready(cur);
    if constexpr (SP2) {
        PG8_STAGE(PG8_SB(0, 0), cB, voffB); PG8_STAGE(PG8_SB(0, 1), cB + hstepB, voffB); PG8_STAGE(PG8_SA(0, 0), cA, voffA); PG8_STAGE(PG8_SA(0, 1), cA + hstepA, voffA);
        if (wr == 1) PG8_BAR;
        PG8_WAIT_V(2); PG8_BAR;
        PG8_STAGE(PG8_SB(1, 0), cB + kstep, voffB); PG8_STAGE(PG8_SA(1, 0), cA + kstep, voffA); PG8_STAGE(PG8_SB(1, 1), cB + hstepB + kstep, voffB);
        PG8_WAIT_V(6); PG8_BAR;
    } else {
        PG8_STAGE(PG8_SB(0, 0), cB, voffB); PG8_STAGE(PG8_SA(0, 0), cA, voffA); PG8_STAGE(PG8_SB(0, 1), cB + hstepB, voffB); PG8_STAGE(PG8_SA(0, 1), cA + hstepA, voffA);
        if (wr == 1) PG8_BAR;
        PG8_WAIT_V(4); PG8_BAR;
        PG8_STAGE(PG8_SB(1, 0), cB + kstep, voffB); PG8_STAGE(PG8_SA(1, 0), cA + kstep, voffA); PG8_STAGE(PG8_SB(1, 1), cB + hstepB + kstep, voffB);
        PG8_WAIT_V(6); PG8_BAR;
    }
    for (;;) {
        const bool has_next = S.next(ui + 1, nxt);
        const char* nA = has_next ? (const char*)g.A + (size_t)nxt.pm * tstepA : cA; const char* nB = has_next ? (const char*)g.Bt + (size_t)nxt.pn * tstepB : cB;
        for (int t = 0; t < nt; t += 2) {
            const bool last = (t == nt - 2);
            const char* a1 = cA + (size_t)(t + 1) * kstep;
            const char* a2 = last ? nA : cA + (size_t)(t + 2) * kstep; const char* b2 = last ? nB : cB + (size_t)(t + 2) * kstep;
            const char* a3 = a2 + kstep; const char* b3 = b2 + kstep;
            if (last && has_next) S.a_ready(nxt);
            if constexpr (SP2) {
            PG8_LDB(B0, 0, 0); PG8_LDB(B1, 0, 1); PG8_SCHED; PG8_LDA(At, 0, 0); PG8_STAGE(PG8_SA(1, 1), a1 + hstepA, voffA);
            PG8_WAIT_V(8); PG8_WAIT_L(0); PG8_BAR; PG8_MMA(0, 0, At, B0); PG8_MMA(0, 1, At, B1); PG8_BAR; PG8_SCHED;
            PG8_LDA(At, 0, 1); PG8_STAGE(PG8_SB(0, 0), b2, voffB); PG8_STAGE(PG8_SB(0, 1), b2 + hstepB, voffB); PG8_STAGE(PG8_SA(0, 0), a2, voffA);
            PG8_WAIT_V(8); PG8_WAIT_L(0); PG8_BAR; PG8_MMA(1, 0, At, B0); PG8_MMA(1, 1, At, B1); PG8_BAR; PG8_SCHED;
            PG8_LDB(B0, 1, 0); PG8_LDB(B1, 1, 1); PG8_SCHED; PG8_LDA(At, 1, 0); PG8_STAGE(PG8_SA(0, 1), a2 + hstepA, voffA);
            PG8_WAIT_V(8); PG8_WAIT_L(0); PG8_BAR; PG8_MMA(0, 0, At, B0); PG8_MMA(0, 1, At, B1); PG8_BAR; PG8_SCHED;
            PG8_LDA(At, 1, 1); PG8_STAGE(PG8_SB(1, 0), b3, voffB); PG8_STAGE(PG8_SB(1, 1), b3 + hstepB, voffB); PG8_STAGE(PG8_SA(1, 0), a3, voffA);
            PG8_WAIT_V(8); PG8_WAIT_L(0); PG8_BAR; PG8_MMA(1, 0, At, B0); PG8_MMA(1, 1, At, B1); PG8_BAR; PG8_SCHED;
            } else {
            PG8_LDB(B0, 0, 0); PG8_SCHED; PG8_LDA(At, 0, 0); PG8_STAGE(PG8_SA(1, 1), a1 + hstepA, voffA);
            PG8_WAIT_L(8); PG8_BAR; PG8_WAIT_L(0); PG8_MMA(0, 0, At, B0); PG8_BAR; PG8_SCHED;
            PG8_LDB(B1, 0, 1); PG8_STAGE(PG8_SB(0, 0), b2, voffB);
            PG8_BAR; PG8_WAIT_L(0); PG8_MMA(0, 1, At, B1); PG8_BAR;
            PG8_LDA(At, 0, 1); PG8_STAGE(PG8_SA(0, 0), a2, voffA);
            PG8_BAR; PG8_WAIT_L(0); PG8_MMA(1, 0, At, B0); PG8_BAR; PG8_SCHED;
            PG8_STAGE(PG8_SB(0, 1), b2 + hstepB, voffB);
            PG8_WAIT_V(6); PG8_BAR; PG8_MMA(1, 1, At, B1); PG8_BAR;
            PG8_LDB(B0, 1, 0); PG8_SCHED; PG8_LDA(At, 1, 0); PG8_STAGE(PG8_SA(0, 1), a2 + hstepA, voffA);
            PG8_WAIT_L(8); PG8_BAR; PG8_WAIT_L(0); PG8_MMA(0, 0, At, B0); PG8_BAR; PG8_SCHED;
            PG8_LDB(B1, 1, 1); PG8_STAGE(PG8_SB(1, 0), b3, voffB);
            PG8_BAR; PG8_WAIT_L(0); PG8_MMA(0, 1, At, B1); PG8_BAR;
            PG8_LDA(At, 1, 1); PG8_STAGE(PG8_SA(1, 0), a3, voffA);
            PG8_BAR; PG8_WAIT_L(0); PG8_MMA(1, 0, At, B0); PG8_BAR; PG8_SCHED;
            PG8_STAGE(PG8_SB(1, 1), b3 + hstepB, voffB);
            PG8_WAIT_V(6); PG8_BAR; PG8_MMA(1, 1, At, B1); PG8_BAR;
            }
        }
        if constexpr (ALIGN_EPI) { if (wr == 0) PG8_BAR; }
        if constexpr (!Epi::AFTER_DRAIN) { E(acc, cur, wr, wc, fr, fq); S.done(cur); }
        if (!has_next) break;
#pragma unroll
        for (int a = 0; a < 2; ++a)
#pragma unroll
            for (int b = 0; b < 2; ++b)
#pragma unroll
                for (int m = 0; m < 4; ++m)
#pragma unroll
                    for (int n = 0; n < 2; ++n) acc[a][b][m][n] = (f32x4){0.f, 0.f, 0.f, 0.f};
        cur = nxt; cA = nA; cB = nB; ++ui;
        if constexpr (ALIGN_EPI) { if (wr == 1) PG8_BAR; }
    }
    PG8_WAIT_V(0);
    if constexpr (!ALIGN_EPI) { if (wr == 0) PG8_BAR; }
    PG8_BAR;
    if constexpr (Epi::AFTER_DRAIN) { E.fused(acc, cur, wr, wc, fr, fq, lds, wid, lane); S.done(cur); }
#undef PG8_SA
#undef PG8_SB
#undef PG8_STAGE
#undef PG8_LDA
#undef PG8_LDB
#undef PG8_MMA
#undef PG8_WAIT_V
#undef PG8_WAIT_L
#undef PG8_BAR
#undef PG8_SCHED
}
}

#ifdef NO_GEMMB
#define PH_GEMMB if (0)
#else
#define PH_GEMMB
#endif
#ifdef NO_GEMMR
#define PH_GEMMR if (0)
#else
#define PH_GEMMR
#endif
namespace mk {
#define LAS __attribute__((address_space(3)))
typedef unsigned short bf16_t;
typedef short bf16x8 __attribute__((ext_vector_type(8)));
typedef short s16x4 __attribute__((ext_vector_type(4)));
typedef float f32x4 __attribute__((ext_vector_type(4)));
typedef float f32x16 __attribute__((ext_vector_type(16)));
typedef unsigned u32x4 __attribute__((ext_vector_type(4)));
typedef unsigned u32x2 __attribute__((ext_vector_type(2)));
using pg8::cvt_pk_bf16;

constexpr int NB = 32, T = 2048, D = 1024, M = NB * T, DEPTH = 4;
constexpr int NWAVES = 8, NTHR = 512;
constexpr int GDN_N = 4112, GDN_NMAIN = 4096, DIFF_N = 3072, FFN_H = 2816, FFN_N = 5632;
constexpr float LN_EPS = 1e-5f, RMS_EPS = 1e-6f;
constexpr float ALPHA = 1.6817928305074290f;
constexpr float LOG2E = 1.4426950408889634f;
constexpr int MH = M / 2;

constexpr size_t MiB = 1u << 20;
constexpr size_t WS_W = 2 * MiB;
constexpr size_t W_GWIN = 0, W_GWAB = W_GWIN + 2ull * 4096 * 1024 * 2, W_GWOUT = W_GWAB + 2ull * 16 * 1024 * 2, W_DWIN = W_GWOUT + 2ull * 1024 * 1024 * 2,
                 W_DWOUT = W_DWIN + 2ull * 3072 * 1024 * 2, W_FUP = W_DWOUT + 2ull * 1024 * 1024 * 2, W_FDOWN = W_FUP + 4ull * 5632 * 1024 * 2, W_END = W_FDOWN + 4ull * 1024 * 2816 * 2;
static_assert(WS_W + W_END <= 106 * MiB, "weights region");
constexpr size_t WS_CNT = 16384;
constexpr size_t WS_CTL_BYTES = 16384 + 8 * 256 * 16 * 4;
constexpr size_t WS_XBUF = 1 * MiB;
constexpr size_t WS_GB = 106 * MiB;
constexpr size_t WS_XN = 112 * MiB;
constexpr size_t WS_H = 240 * MiB;
constexpr size_t WS_ACT = WS_H;
constexpr size_t WS_HALO = WS_H + 352 * MiB;
constexpr size_t WS_HALO2 = WS_HALO + 12 * MiB;
constexpr size_t WS_UT = WS_H + 512 * MiB;
constexpr size_t WS_WN = WS_UT + 128 * MiB;
constexpr size_t WS_VT = WS_H + 384 * MiB;
constexpr size_t WS_O = WS_VT + 128 * MiB;
constexpr size_t WS_ROPE = WS_WN + 128 * MiB;
constexpr size_t WS_END = WS_ROPE + 16 * MiB;
static_assert(WS_END <= 1024 * MiB, "workspace map");
constexpr int LDS_BYTES = 131072 + 2048 + 10240;

__device__ __forceinline__ float bf2f(unsigned short h) { return __uint_as_float((unsigned)h << 16); }
__device__ __forceinline__ unsigned short f2bf(float f) { return (unsigned short)(cvt_pk_bf16(f, 0.f) & 0xffffu); }
__device__ __forceinline__ float wave_sum(float v) {
#pragma unroll
    for (int o = 1; o < 64; o <<= 1) v += __shfl_xor(v, o);
    return v;
}
__device__ __forceinline__ float silu(float x) { return x * __builtin_amdgcn_rcpf(1.f + __expf(-x)); }
__device__ __forceinline__ void unpack8(const u32x4 v, float (&o)[8]) {
    o[0] = __uint_as_float(v.x << 16); o[1] = __uint_as_float(v.x & 0xffff0000u); o[2] = __uint_as_float(v.y << 16); o[3] = __uint_as_float(v.y & 0xffff0000u);
    o[4] = __uint_as_float(v.z << 16); o[5] = __uint_as_float(v.z & 0xffff0000u); o[6] = __uint_as_float(v.w << 16); o[7] = __uint_as_float(v.w & 0xffff0000u);
}
__device__ __forceinline__ u32x4 pack8(const float (&o)[8]) { u32x4 w; w.x = cvt_pk_bf16(o[0], o[1]); w.y = cvt_pk_bf16(o[2], o[3]); w.z = cvt_pk_bf16(o[4], o[5]); w.w = cvt_pk_bf16(o[6], o[7]); return w; }
__device__ __forceinline__ int crow(int r, int hi) { return (r & 3) + 8 * (r >> 2) + 4 * hi; }
#define LDS_WAIT() asm volatile("s_waitcnt lgkmcnt(0)" ::: "memory")
#define MK_IDS() int lane_; asm volatile("v_mbcnt_lo_u32_b32 %0, -1, 0\n\tv_mbcnt_hi_u32_b32 %0, -1, %0" : "=v"(lane_));   \
      \
    int wid_ = widk; asm volatile("" : "+s"(wid_)); const int lane = lane_, wid = wid_, tid = wid * 64 + lane; const int G_ = gridDim.x, gw = blockIdx.x * NWAVES + wid, NGW = G_ * NWAVES, gt = blockIdx.x * NTHR + tid, NGT = G_ * NTHR; \
    (void)lane; (void)wid; (void)gw; (void)NGW; (void)gt; (void)NGT

template <int UPPERM = 0, bool F16OUT = false> __device__ __forceinline__ void transpose_item(const float* W, int ldw, int K, int nblk, bf16_t* WT, LAS float* scr, int item, int lane) {
    const int kb = item / nblk, nb = item % nblk, k0 = 64 * kb, n0 = 32 * nb;
    const int r0 = UPPERM == 1 ? (n0 < FFN_H ? 256 * (n0 >> 7) + (n0 & 127) : 256 * ((n0 - FFN_H) >> 7) + 128 + ((n0 - FFN_H) & 127))
                 : UPPERM == 2 ? (n0 < 2048 ? (n0 & ~255) + 128 * ((n0 >> 5) & 1) + 32 * ((n0 >> 6) & 3) : n0) : n0;
#pragma unroll 8
    for (int i = 0; i < 32; ++i) { const int kk = 2 * i + (lane >> 5); scr[kk * 33 + (lane & 31)] = W[(size_t)(k0 + kk) * ldw + n0 + (lane & 31)]; }
    LDS_WAIT();
    const int c = lane & 7;
#pragma unroll
    for (int j = 0; j < 4; ++j) { const int n = (lane >> 3) + 8 * j; const LAS float* s = scr + (8 * c) * 33 + n;
        u32x4 o;
        if constexpr (F16OUT) { o.x = pg8::cvt_pk_f16(s[0 * 33], s[1 * 33]); o.y = pg8::cvt_pk_f16(s[2 * 33], s[3 * 33]); o.z = pg8::cvt_pk_f16(s[4 * 33], s[5 * 33]); o.w = pg8::cvt_pk_f16(s[6 * 33], s[7 * 33]); }
        else { o.x = cvt_pk_bf16(s[0 * 33], s[1 * 33]); o.y = cvt_pk_bf16(s[2 * 33], s[3 * 33]); o.z = cvt_pk_bf16(s[4 * 33], s[5 * 33]); o.w = cvt_pk_bf16(s[6 * 33], s[7 * 33]); }
        *(u32x4*)(WT + (size_t)(r0 + n) * K + k0 + 8 * c) = o; }
    LDS_WAIT();
}

#define XB_TMO      128
#define XB_XCNT(j)  (256  + 64 * (j))
#define XB_XSUB(j)  (1280 + 64 * (j))
#define XB_XGEN(j)  (2304 + 64 * (j))
#define XB_TOP      3328
#define XB_TOPGEN   3392
#define XCD_BAR_WORDS 3456
#define XB_SPIN_CAP (1u << 18)

__device__ __forceinline__ unsigned xb_ld(unsigned* p)              { return __hip_atomic_load(p, __ATOMIC_RELAXED, __HIP_MEMORY_SCOPE_AGENT); }
__device__ __forceinline__ unsigned xb_add(unsigned* p, unsigned v) { return __hip_atomic_fetch_add(p, v, __ATOMIC_RELAXED, __HIP_MEMORY_SCOPE_AGENT); }
__device__ __forceinline__ unsigned xb_xcc_id() { return (unsigned)__builtin_amdgcn_s_getreg((3 << 11) | 20) & 0xFu; }
#define XB_SPIN(cond, bar) do { unsigned _sp = 0; while (cond) { __builtin_amdgcn_s_sleep(1); \
    if ((++_sp & 255u) == 0u) { if (xb_ld(&(bar)[XB_TMO])) break; if (_sp > XB_SPIN_CAP) { atomicAdd(&(bar)[XB_TMO], 1u); break; } } } } while (0)

struct XcdBarrier {
    unsigned* bar; unsigned x;
    volatile LAS unsigned* st;
};

__device__ __forceinline__ XcdBarrier xcd_barrier_post(unsigned* bar, volatile LAS unsigned* st) {
    XcdBarrier b; b.bar = bar; b.x = xb_xcc_id(); b.st = st;
    if (threadIdx.x == 0) (void)xb_add(&bar[XB_XCNT(b.x)], 1u);
    return b;
}
__device__ __forceinline__ void xcd_barrier_complete(unsigned* bar, unsigned x, unsigned& nloc, unsigned& nx) {
    const unsigned G = gridDim.x * gridDim.y * gridDim.z;
    unsigned sum, cnt, mine, sp = 0u;
    for (;;) {
        sum = 0u; cnt = 0u; mine = 0u;
#pragma unroll
        for (unsigned j = 0; j < 16; ++j) { const unsigned c = xb_ld(&bar[XB_XCNT(j)]); sum += c; cnt += (c > 0u) ? 1u : 0u; mine = (j == x) ? c : mine; }
        if (sum == G) break;
        __builtin_amdgcn_s_sleep(1);
        if ((++sp & 255u) == 0u) { if (xb_ld(&bar[XB_TMO])) break; if (sp > XB_SPIN_CAP) { atomicAdd(&bar[XB_TMO], 1u); break; } }
    }
    nloc = mine > 0u ? mine : 1u; nx = cnt > 0u ? cnt : 1u;
}

__device__ __forceinline__ void xcd_barrier(const XcdBarrier& b, int widk) {
    asm volatile("s_waitcnt vmcnt(0)" ::: "memory");
    __syncthreads();
    int xl_; asm volatile("v_mbcnt_lo_u32_b32 %0, -1, 0\n\tv_mbcnt_hi_u32_b32 %0, -1, %0" : "=v"(xl_));
    if (widk == 0 && xl_ == 0) {
        unsigned* bar = b.bar;
        __builtin_amdgcn_s_waitcnt(0);
        unsigned nloc = b.st[0], nx = b.st[1];
        if (nloc == 0u) { xcd_barrier_complete(bar, b.x, nloc, nx); b.st[0] = nloc; b.st[1] = nx; }
        const unsigned old = xb_add(&bar[XB_XSUB(b.x)], 1u);
        const unsigned gen = old / nloc;
        if (old + 1u == (gen + 1u) * nloc) {
            __builtin_amdgcn_fence(__ATOMIC_RELEASE, "agent");
            asm volatile("s_waitcnt vmcnt(0)" ::: "memory");
            const unsigned og = xb_add(&bar[XB_TOP], 1u);
            const unsigned tg = og / nx;
            if (og + 1u == (tg + 1u) * nx) xb_add(&bar[XB_TOPGEN], 1u);
            else XB_SPIN(xb_ld(&bar[XB_TOPGEN]) == tg, bar);
            __builtin_amdgcn_fence(__ATOMIC_ACQUIRE, "agent");
            xb_add(&bar[XB_XGEN(b.x)], 1u);
            asm volatile("s_waitcnt vmcnt(0)" ::: "memory");
        } else {
            XB_SPIN(xb_ld(&bar[XB_XGEN(b.x)]) == gen, bar);
            __builtin_amdgcn_fence(__ATOMIC_ACQUIRE, "agent");
            asm volatile("s_waitcnt vmcnt(0)" ::: "memory");
        }
    }
    __syncthreads();
}

struct Params {
    const float* in[23];
    const int* positions;
    float* out;
    unsigned char* ws;
};

__device__ __forceinline__ void prologue(int widk, const Params& p, LAS unsigned char* lds) {
    MK_IDS(); const int wave = wid;
    LAS float* scr = (LAS float*)(lds + wave * 16384);
    unsigned char* wsw = p.ws + WS_W;
    constexpr int I_GWIN = 16 * 128, I_SQ = 16 * 32, I_DWIN = 16 * 96, I_FUP = 16 * 176, I_FDN = 44 * 32;
    constexpr int NITEMS = 2 * I_GWIN + 2 * I_SQ + 2 * I_DWIN + 2 * I_SQ + 4 * I_FUP + 4 * I_FDN;
    for (int it = gw; it < NITEMS; it += NGW) {
        int r = it;
        if (r < 2 * I_GWIN) { const int j = r / I_GWIN; r %= I_GWIN; transpose_item<0, true>(p.in[2] + (size_t)j * 1024 * GDN_N, GDN_N, 1024, 128, (bf16_t*)(wsw + W_GWIN) + (size_t)j * 4096 * 1024, scr, r, lane); continue; } r -= 2 * I_GWIN;
        if (r < 2 * I_SQ) { const int j = r / I_SQ; r %= I_SQ; transpose_item(p.in[7] + (size_t)j * 1024 * 1024, 1024, 1024, 32, (bf16_t*)(wsw + W_GWOUT) + (size_t)j * 1024 * 1024, scr, r, lane); continue; } r -= 2 * I_SQ;
        if (r < 2 * I_DWIN) { const int j = r / I_DWIN; r %= I_DWIN; transpose_item<2, true>(p.in[8] + (size_t)j * 1024 * DIFF_N, DIFF_N, 1024, 96, (bf16_t*)(wsw + W_DWIN) + (size_t)j * 3072 * 1024, scr, r, lane); continue; } r -= 2 * I_DWIN;
        if (r < 2 * I_SQ) { const int j = r / I_SQ; r %= I_SQ; transpose_item(p.in[14] + (size_t)j * 1024 * 1024, 1024, 1024, 32, (bf16_t*)(wsw + W_DWOUT) + (size_t)j * 1024 * 1024, scr, r, lane); continue; } r -= 2 * I_SQ;
        if (r < 4 * I_FUP) { const int j = r / I_FUP; r %= I_FUP; transpose_item<1, true>(p.in[15] + (size_t)j * 1024 * FFN_N, FFN_N, 1024, 176, (bf16_t*)(wsw + W_FUP) + (size_t)j * 5632 * 1024, scr, r, lane); continue; } r -= 4 * I_FUP;
        { const int j = r / I_FDN; r %= I_FDN; transpose_item(p.in[18] + (size_t)j * 2816 * 1024, 1024, 2816, 32, (bf16_t*)(wsw + W_FDOWN) + (size_t)j * 1024 * 2816, scr, r, lane); }
    }
    for (int e = gt; e < 2 * 16 * 1024; e += NGT) { const int j = e >> 14, n = (e >> 10) & 15, k = e & 1023;
        ((bf16_t*)(wsw + W_GWAB))[e] = (unsigned short)(pg8::cvt_pk_f16(p.in[2][(size_t)j * 1024 * GDN_N + (size_t)k * GDN_N + GDN_NMAIN + n], 0.f) & 0xffffu); }
    { unsigned* CS = (unsigned*)(p.ws + WS_ROPE);
      for (int e = gt; e < M * 32; e += NGT) { const int m = e >> 5, f = e & 31; const float inv = exp2f(-(float)f * (13.287712379549449f / 32.f)); float sn, cs; sincosf((float)p.positions[m] * inv, &sn, &cs); CS[e] = pg8::cvt_pk_f16(cs, sn); } }
    const f32x4* x4 = (const f32x4*)p.in[0]; u32x4* xn = (u32x4*)(p.ws + WS_XN);
    for (int e = gt; e < M * D / 8; e += NGT) { const f32x4 a = x4[2 * e], b = x4[2 * e + 1]; u32x4 w; w.x = pg8::cvt_pk_f16(a[0], a[1]); w.y = pg8::cvt_pk_f16(a[2], a[3]); w.z = pg8::cvt_pk_f16(b[0], b[1]); w.w = pg8::cvt_pk_f16(b[2], b[3]); xn[e] = w; }
}

__device__ __forceinline__ void ln_phase(int widk, float* X, bf16_t* XN, const float* g, const float* b) {
    MK_IDS();
    f32x4 gv[4], bv[4];
#pragma unroll
    for (int j = 0; j < 4; ++j) { gv[j] = ((const f32x4*)g)[lane + 64 * j]; bv[j] = ((const f32x4*)b)[lane + 64 * j]; }
    for (int m = gw; m < M; m += NGW) {
        f32x4* xr = (f32x4*)(X + (size_t)m * D) + lane;
        f32x4 v[4]; float s = 0.f;
#pragma unroll
        for (int j = 0; j < 4; ++j) { v[j] = xr[64 * j]; s += (v[j][0] + v[j][1]) + (v[j][2] + v[j][3]); }
        const float mean = wave_sum(s) * (1.f / D); float s2 = 0.f;
#pragma unroll
        for (int j = 0; j < 4; ++j) { v[j] = v[j] - mean; s2 += (v[j][0] * v[j][0] + v[j][1] * v[j][1]) + (v[j][2] * v[j][2] + v[j][3] * v[j][3]); }
        const float rstd = 1.f / sqrtf(wave_sum(s2) * (1.f / D) + LN_EPS);
        u32x2* o8 = (u32x2*)(XN + (size_t)m * D) + lane;
#pragma unroll
        for (int j = 0; j < 4; ++j) { const f32x4 o = v[j] * rstd * gv[j] + bv[j]; xr[64 * j] = o; u32x2 w; w.x = pg8::cvt_pk_f16(o[0], o[1]); w.y = pg8::cvt_pk_f16(o[2], o[3]); o8[64 * j] = w; }
    }
}

__device__ __forceinline__ void ffn_fixup_phase(int widk, bf16_t* ACT, const float* HALO, const float* HALO2, const float* cw, const float* cb) {
    MK_IDS();
    constexpr int NCG = FFN_H / 4;
    for (int item = gt; item < (M / 256) * NCG; item += NGT) {
        const int pm = item / NCG, col = (item % NCG) * 4;
        if ((pm & 7) == 0) continue;
        f32x4 wa[3], wb[3];
#pragma unroll
        for (int j = 0; j < 3; ++j) { wa[j] = *(const f32x4*)(cw + j * FFN_N + col); wb[j] = *(const f32x4*)(cw + j * FFN_N + FFN_H + col); }
        const f32x4 ba = *(const f32x4*)(cb + col), bb = *(const f32x4*)(cb + FFN_H + col);
        const float* hp = HALO + (size_t)(pm - 1) * 2 * FFN_N + col; const float* h2 = HALO2 + (size_t)pm * 2 * FFN_N + col;
        const f32x4 am2 = *(const f32x4*)hp, am1 = *(const f32x4*)(hp + FFN_N), a0 = *(const f32x4*)h2, a1 = *(const f32x4*)(h2 + FFN_N);
        const f32x4 bm2 = *(const f32x4*)(hp + FFN_H), bm1 = *(const f32x4*)(hp + FFN_N + FFN_H), b0 = *(const f32x4*)(h2 + FFN_H), b1 = *(const f32x4*)(h2 + FFN_N + FFN_H);
        float o0[4], o1[4];
#pragma unroll
        for (int e = 0; e < 4; ++e) {
            o0[e] = silu(wa[0][e] * am2[e] + wa[1][e] * am1[e] + wa[2][e] * a0[e] + ba[e]) * (wb[0][e] * bm2[e] + wb[1][e] * bm1[e] + wb[2][e] * b0[e] + bb[e]);
            o1[e] = silu(wa[0][e] * am1[e] + wa[1][e] * a0[e] + wa[2][e] * a1[e] + ba[e]) * (wb[0][e] * bm1[e] + wb[1][e] * b0[e] + wb[2][e] * b1[e] + bb[e]);
        }
        u32x2 w; w.x = cvt_pk_bf16(o0[0], o0[1]); w.y = cvt_pk_bf16(o0[2], o0[3]); *(u32x2*)(ACT + (size_t)(pm * 256) * FFN_H + col) = w;
        w.x = cvt_pk_bf16(o1[0], o1[1]); w.y = cvt_pk_bf16(o1[2], o1[3]); *(u32x2*)(ACT + (size_t)(pm * 256 + 1) * FFN_H + col) = w;
    }
}

__device__ __forceinline__ void gdn_ab_phase(int widk, const bf16_t* XN, const bf16_t* wabT  , const float* a_log, const float* dt_bias, float* G, float* BETA) {
    MK_IDS();
    const int n = lane & 15, q4 = lane >> 4, h = n & 7;
    const float al = -__expf(a_log[h]), db = dt_bias[h];
    for (int it = gw; it < M / 16; it += NGW) {
        const int m0 = it * 16;
        f32x4 acc = {0.f, 0.f, 0.f, 0.f};
        const bf16_t* ap = XN + (size_t)(m0 + n) * D + 8 * q4;
        const bf16_t* bp = wabT + (size_t)n * D + 8 * q4;
#pragma unroll 8
        for (int ks = 0; ks < 32; ++ks) { const bf16x8 a = *(const bf16x8*)(ap + 32 * ks), b = *(const bf16x8*)(bp + 32 * ks); acc = pg8::mma16<true>(a, b, acc); }
#pragma unroll
        for (int i = 0; i < 4; ++i) { const int m = m0 + 4 * q4 + i; const float v = acc[i];
            if (n < 8) { const float x = v + db; const float sp = x > 20.f ? x : log1pf(__expf(x)); G[(size_t)m * 8 + h] = al * sp; }
            else BETA[(size_t)m * 8 + h] = 1.f / (1.f + __expf(-v)); }
    }
}

__device__ __forceinline__ void conv_silu16(const bf16_t* hp, int t, const LAS float* cw, float (&y)[16]) {
#pragma unroll
    for (int c = 0; c < 16; ++c) y[c] = 0.f;
#pragma unroll
    for (int j = 0; j < 4; ++j) {
        if (t - 3 + j >= 0) {
            float x[16];
            const bf16_t* rp = hp + (ptrdiff_t)(j - 3) * GDN_NMAIN;
            { float t8[8]; unpack8(*(const u32x4*)rp, t8);
#pragma unroll
              for (int c = 0; c < 8; ++c) x[c] = t8[c];
              unpack8(*(const u32x4*)(rp + 8), t8);
#pragma unroll
              for (int c = 0; c < 8; ++c) x[8 + c] = t8[c]; }
#pragma unroll
            for (int q = 0; q < 4; ++q) { const f32x4 w = *(const LAS f32x4*)(cw + j * 128 + 4 * q);
#pragma unroll
                for (int e = 0; e < 4; ++e) y[4 * q + e] += w[e] * x[4 * q + e]; }
        }
    }
#pragma unroll
    for (int c = 0; c < 16; ++c) y[c] = silu(y[c]);
}
__device__ __forceinline__ float sumsq16_8lanes(const float (&y)[16]) {
    float s = 0.f;
#pragma unroll
    for (int c = 0; c < 16; ++c) s += y[c] * y[c];
    s += __shfl_xor(s, 1); s += __shfl_xor(s, 2); s += __shfl_xor(s, 4);
    return s;
}
__device__ __forceinline__ void pack16(const float (&y)[16], u32x4& a, u32x4& b) {
    a.x = cvt_pk_bf16(y[0], y[1]); a.y = cvt_pk_bf16(y[2], y[3]); a.z = cvt_pk_bf16(y[4], y[5]); a.w = cvt_pk_bf16(y[6], y[7]);
    b.x = cvt_pk_bf16(y[8], y[9]); b.y = cvt_pk_bf16(y[10], y[11]); b.z = cvt_pk_bf16(y[12], y[13]); b.w = cvt_pk_bf16(y[14], y[15]);
}
__device__ __forceinline__ void unpack16(const u32x4 a, const u32x4 b, float (&y)[16]) {
    float t8[8]; unpack8(a, t8);
#pragma unroll
    for (int c = 0; c < 8; ++c) y[c] = t8[c];
    unpack8(b, t8);
#pragma unroll
    for (int c = 0; c < 8; ++c) y[8 + c] = t8[c];
}
__device__ __forceinline__ bf16x8 lds_frag16(const LAS unsigned char* p) { return *(const LAS bf16x8*)p; }
__device__ __forceinline__ bf16x8 lds_frag8x2(const LAS unsigned char* p0, const LAS unsigned char* p1) {
    const s16x4 a = *(const volatile LAS s16x4*)p0, b = *(const volatile LAS s16x4*)p1; return (bf16x8){a[0], a[1], a[2], a[3], b[0], b[1], b[2], b[3]};
}

constexpr int GA_GC = 0, GA_BT = 256, GA_CW = 512, GA_Q = GA_CW + 3 * 4 * 128 * 4, GA_K = GA_Q + 64 * 272, GA_LT = GA_K + 64 * 272, GA_END = GA_LT + 8 * 8192;
static_assert(GA_END <= 131072 && GA_LT % 16 == 0, "GDN phase A LDS map");
constexpr int GB_GC = 0, GB_BT = 512, GB_Q = 1024,     GB_KB = GB_Q + 64 * 272, GB_VB = GB_KB + 64 * 272, GB_KD = GB_VB + 64 * 272, GB_T = GB_KD + 128 * 144, GB_AT = GB_T + 64 * 144, GB_O = GB_AT + 64 * 144, GB_END = GB_O + 64 * 528;
static_assert(GB_END <= 131072 && GB_O % 16 == 0, "GDN phase B LDS map");

template <int I, int J> __device__ __forceinline__ void inv_row(float& s0, float& s1, const float lr, const float (&t)[64]) {
    if constexpr (J + 8 <= I) {
        int a0, a1, a2, a3, a4, a5, a6, a7;
        asm volatile("v_readlane_b32 %2, %10, %19\n\tv_readlane_b32 %3, %10, %19+1\n\tv_readlane_b32 %4, %10, %19+2\n\tv_readlane_b32 %5, %10, %19+3\n\t"
                     "v_readlane_b32 %6, %10, %19+4\n\tv_readlane_b32 %7, %10, %19+5\n\tv_readlane_b32 %8, %10, %19+6\n\tv_readlane_b32 %9, %10, %19+7\n\t"
                     "v_fma_f32 %0, -%11, %2, %0\n\tv_fma_f32 %1, -%12, %3, %1\n\tv_fma_f32 %0, -%13, %4, %0\n\tv_fma_f32 %1, -%14, %5, %1\n\t"
                     "v_fma_f32 %0, -%15, %6, %0\n\tv_fma_f32 %1, -%16, %7, %1\n\tv_fma_f32 %0, -%17, %8, %0\n\tv_fma_f32 %1, -%18, %9, %1"
                     : "+v"(s0), "+v"(s1), "=&s"(a0), "=&s"(a1), "=&s"(a2), "=&s"(a3), "=&s"(a4), "=&s"(a5), "=&s"(a6), "=&s"(a7)
                     : "v"(lr), "v"(t[J]), "v"(t[J + 1]), "v"(t[J + 2]), "v"(t[J + 3]), "v"(t[J + 4]), "v"(t[J + 5]), "v"(t[J + 6]), "v"(t[J + 7]), "i"(J));
        inv_row<I, J + 8>(s0, s1, lr, t);
    } else {
#pragma unroll
        for (int j = J; j < I; ++j) { const float lj = __int_as_float(__builtin_amdgcn_readlane(__float_as_int(lr), j)); if (j & 1) s1 -= lj * t[j]; else s0 -= lj * t[j]; }
    }
}
template <int I0> __device__ __forceinline__ void inv_rows8(const LAS float* Lp, const float flane, float (&t)[64]) {
    float lr[8];
#pragma unroll
    for (int k = 0; k < 8; ++k) lr[k] = Lp[((I0 + k) * (I0 + k - 1)) / 2];
#define INV_ROW(k) { float s0 = 1.f - fminf(fabsf(flane - (float)(I0 + k)), 1.f), s1 = 0.f; inv_row<I0 + k, 0>(s0, s1, lr[k], t); t[I0 + k] = s0 + s1; }
    INV_ROW(0) INV_ROW(1) INV_ROW(2) INV_ROW(3) INV_ROW(4) INV_ROW(5) INV_ROW(6) INV_ROW(7)
#undef INV_ROW
}

__device__ __forceinline__ void gdn_phase_a(int widk, bf16_t* H, const float* G, const float* BETA, const float* convw  , bf16_t* TG, bf16_t* ATT, LAS unsigned char* lds) {
    MK_IDS();
    LAS float* gcs = (LAS float*)(lds + GA_GC); LAS float* bts = (LAS float*)(lds + GA_BT); LAS float* cwl = (LAS float*)(lds + GA_CW);
    for (int bh = blockIdx.x; bh < 256; bh += gridDim.x) {
        const int b = bh >> 3, h = bh & 7;
        __syncthreads();
        for (int e = tid; e < 3 * 4 * 128; e += NTHR) { const int ten = e / 512, tap = (e >> 7) & 3, c = e & 127; cwl[e] = convw[tap * 3072 + ten * 1024 + h * 128 + c]; }
        __syncthreads();
        float gnext = 0.f, bnext = 0.f;
        if (wid == 0) { gnext = G[(size_t)(b * T + 31 * 64 + lane) * 8 + h]; bnext = BETA[(size_t)(b * T + 31 * 64 + lane) * 8 + h]; }
        for (int sg = 3; sg >= 0; --sg) {
            for (int k = 7; k >= 0; --k) {
                const int n = sg * 8 + k, it = n * 256 + bh, m0 = b * T + n * 64;
                if (wid == 0) { float c = gnext;
#pragma unroll
                    for (int o = 1; o < 64; o <<= 1) { const float t = __shfl_up(c, o); if (lane >= o) c += t; }
                    gcs[lane] = c; bts[lane] = bnext;
                    if (n > 0) { gnext = G[(size_t)(m0 - 64 + lane) * 8 + h]; bnext = BETA[(size_t)(m0 - 64 + lane) * 8 + h]; } }
                const int r = tid >> 3, c0 = (tid & 7) * 16, t = n * 64 + r; bf16_t* hp = H + (size_t)(m0 + r) * GDN_NMAIN + h * 128 + c0;
                u32x4 st[6];
                {   float y[16];
                    conv_silu16(hp, t, cwl + c0, y);
                    { const float rinv = rsqrtf(sumsq16_8lanes(y) + RMS_EPS) * 0.08838834764831845f;
#pragma unroll
                      for (int c = 0; c < 16; ++c) y[c] *= rinv; pack16(y, st[0], st[1]); }
                    conv_silu16(hp + 1024, t, cwl + 512 + c0, y);
                    { const float rinv = rsqrtf(sumsq16_8lanes(y) + RMS_EPS);
#pragma unroll
                      for (int c = 0; c < 16; ++c) y[c] *= rinv; pack16(y, st[2], st[3]); }
                    conv_silu16(hp + 2048, t, cwl + 1024 + c0, y);
                    pack16(y, st[4], st[5]);
                    *(LAS u32x4*)(lds + GA_Q + r * 272 + c0 * 2) = st[0]; *(LAS u32x4*)(lds + GA_Q + r * 272 + c0 * 2 + 16) = st[1];
                    *(LAS u32x4*)(lds + GA_K + r * 272 + c0 * 2) = st[2]; *(LAS u32x4*)(lds + GA_K + r * 272 + c0 * 2 + 16) = st[3];
                }
                __syncthreads();
                *(u32x4*)hp = st[0]; *(u32x4*)(hp + 8) = st[1]; *(u32x4*)(hp + 1024) = st[2]; *(u32x4*)(hp + 1024 + 8) = st[3]; *(u32x4*)(hp + 2048) = st[4]; *(u32x4*)(hp + 2048 + 8) = st[5];
                {
                    const int which = wid >> 2, bi = (wid >> 1) & 1, bj = wid & 1, l31 = lane & 31, hi = lane >> 5;
                    LAS float* Lt = (LAS float*)(lds + GA_LT + k * 8192);
                    f32x16 acc = {};
                    if (!(bi == 0 && bj == 1)) {
                        const LAS unsigned char* ap = lds + (which ? GA_Q : GA_K) + (32 * bi + l31) * 272 + hi * 16;
                        const LAS unsigned char* bp = lds + GA_K + (32 * bj + l31) * 272 + hi * 16;
#pragma unroll
                        for (int ks = 0; ks < 8; ++ks) acc = __builtin_amdgcn_mfma_f32_32x32x16_bf16(lds_frag16(ap + ks * 32), lds_frag16(bp + ks * 32), acc, 0, 0, 0);
                    }
                    const int j = 32 * bj + l31; const float gcj = gcs[j];
#pragma unroll
                    for (int rr = 0; rr < 16; ++rr) { const int i = 32 * bi + crow(rr, hi); const float dec = __expf(fminf(gcs[i] - gcj, 0.f));
                        if (which == 0) { if (i > j) Lt[(i * (i - 1)) / 2 + j] = bts[i] * acc[rr] * dec; }
                        else ATT[((size_t)it * 64 + i) * 64 + j] = f2bf((i >= j) ? acc[rr] * dec : 0.f); }
                }
                __syncthreads();
            }
            {
                float t[64]; const float flane = (float)lane;
                const LAS float* Lp = (const LAS float*)(lds + GA_LT + wid * 8192) + lane; asm volatile("" : "+v"(Lp));
                inv_rows8<0>(Lp, flane, t); inv_rows8<8>(Lp, flane, t); inv_rows8<16>(Lp, flane, t); inv_rows8<24>(Lp, flane, t);
                inv_rows8<32>(Lp, flane, t); inv_rows8<40>(Lp, flane, t); inv_rows8<48>(Lp, flane, t); inv_rows8<56>(Lp, flane, t);
                bf16_t* tp = TG + (size_t)((sg * 8 + wid) * 256 + bh) * 4096 + lane;
#pragma unroll
                for (int i = 0; i < 64; ++i) tp[i * 64] = f2bf(t[i]);
            }
        }
    }
    __syncthreads();
}

__device__ __forceinline__ void gdn_phase_b(int widk, bf16_t* H, const float* G, const float* BETA, const float* normw  , const bf16_t* TG, const bf16_t* ATT, LAS unsigned char* lds) {
    MK_IDS();
    LAS float* gcs = (LAS float*)(lds + GB_GC); LAS float* bts = (LAS float*)(lds + GB_BT);
    const int n16 = lane & 15, q4 = lane >> 4;
    for (int bh = blockIdx.x; bh < 256; bh += gridDim.x) {
        const int b = bh >> 3, h = bh & 7;
        f32x4 S[8];
#pragma unroll
        for (int s = 0; s < 8; ++s) S[s] = (f32x4){0.f, 0.f, 0.f, 0.f};
        const int r = tid >> 3, c0 = (tid & 7) * 16;
        u32x4 q0, q1, k0, k1, v0, v1, tt, aa, ga0, ga1; float gval = 0.f, bval = 0.f;
#define GB_LOAD(n_) do { const int it_ = (n_) * 256 + bh, m_ = b * T + (n_) * 64; const bf16_t* hq = H + (size_t)(m_ + r) * GDN_NMAIN + h * 128 + c0; \
            q0 = *(const u32x4*)hq; q1 = *(const u32x4*)(hq + 8); k0 = *(const u32x4*)(hq + 1024); k1 = *(const u32x4*)(hq + 1024 + 8); v0 = *(const u32x4*)(hq + 2048); v1 = *(const u32x4*)(hq + 2048 + 8); \
            ga0 = *(const u32x4*)(hq + 3072); ga1 = *(const u32x4*)(hq + 3072 + 8); \
            tt = ((const u32x4*)(TG + (size_t)it_ * 4096))[tid]; aa = ((const u32x4*)(ATT + (size_t)it_ * 4096))[tid]; \
            if (wid == 0) { gval = G[(size_t)(m_ + lane) * 8 + h]; bval = BETA[(size_t)(m_ + lane) * 8 + h]; } } while (0)
        GB_LOAD(0);
#define GB_CUMSUM(par_) do { if (wid == 0) { float c = gval; _Pragma("unroll") for (int o = 1; o < 64; o <<= 1) { const float t = __shfl_up(c, o); if (lane >= o) c += t; } \
            gcs[(par_) * 64 + lane] = c; bts[(par_) * 64 + lane] = bval; } } while (0)
        GB_CUMSUM(0);
        __syncthreads();
        for (int n = 0; n < 32; ++n) {
            const int m0 = b * T + n * 64, par = n & 1;
            bf16_t* hp = H + (size_t)(m0 + r) * GDN_NMAIN + h * 128 + c0;
            const float glast = gcs[par * 64 + 63];
            {   const float gcr = gcs[par * 64 + r], btr = bts[par * 64 + r], eg = __expf(gcr), ekd = __expf(glast - gcr);
                float y[16]; u32x4 a, bq;
                unpack16(q0, q1, y);
#pragma unroll
                for (int c = 0; c < 16; ++c) y[c] *= eg;
                pack16(y, a, bq); *(LAS u32x4*)(lds + GB_Q + r * 272 + c0 * 2) = a; *(LAS u32x4*)(lds + GB_Q + r * 272 + c0 * 2 + 16) = bq;
                unpack16(k0, k1, y);
#pragma unroll
                for (int c = 0; c < 16; ++c) *(LAS bf16_t*)(lds + GB_KD + (c0 + c) * 144 + r * 2) = f2bf(y[c] * ekd);
                { const float sc = btr * eg;
#pragma unroll
                  for (int c = 0; c < 16; ++c) y[c] *= sc; }
                pack16(y, a, bq); *(LAS u32x4*)(lds + GB_KB + r * 272 + c0 * 2) = a; *(LAS u32x4*)(lds + GB_KB + r * 272 + c0 * 2 + 16) = bq;
                unpack16(v0, v1, y);
#pragma unroll
                for (int c = 0; c < 16; ++c) y[c] *= btr;
                pack16(y, a, bq); *(LAS u32x4*)(lds + GB_VB + r * 272 + c0 * 2) = a; *(LAS u32x4*)(lds + GB_VB + r * 272 + c0 * 2 + 16) = bq;
                *(LAS u32x4*)(lds + GB_T + (tid >> 3) * 144 + (tid & 7) * 16) = tt;
                *(LAS u32x4*)(lds + GB_AT + (tid >> 3) * 144 + (tid & 7) * 16) = aa;
            }
            const u32x4 gk0 = ga0, gk1 = ga1;
            __syncthreads();
            if (n + 1 < 32) GB_LOAD(n + 1);
            {
                bf16x8 Sf[4];
#pragma unroll
                for (int ks = 0; ks < 4; ++ks) { u32x4 w; w.x = cvt_pk_bf16(S[2 * ks][0], S[2 * ks][1]); w.y = cvt_pk_bf16(S[2 * ks][2], S[2 * ks][3]);
                    w.z = cvt_pk_bf16(S[2 * ks + 1][0], S[2 * ks + 1][1]); w.w = cvt_pk_bf16(S[2 * ks + 1][2], S[2 * ks + 1][3]); Sf[ks] = __builtin_bit_cast(bf16x8, w); }
                f32x4 rr[4];
#pragma unroll
                for (int mt = 0; mt < 4; ++mt) {
                    const LAS unsigned char* vp = lds + GB_VB + (16 * mt + 4 * q4) * 272 + (16 * wid + n16) * 2;
                    rr[mt] = (f32x4){-bf2f(*(const LAS bf16_t*)vp), -bf2f(*(const LAS bf16_t*)(vp + 272)), -bf2f(*(const LAS bf16_t*)(vp + 544)), -bf2f(*(const LAS bf16_t*)(vp + 816))};
                    const LAS unsigned char* ap = lds + GB_KB + (16 * mt + n16) * 272 + 8 * q4;
#pragma unroll
                    for (int ks = 0; ks < 4; ++ks) rr[mt] = __builtin_amdgcn_mfma_f32_16x16x32_bf16(lds_frag8x2(ap + ks * 64, ap + ks * 64 + 32), Sf[ks], rr[mt], 0, 0, 0);
                }
                bf16x8 Rf[2];
#pragma unroll
                for (int kt = 0; kt < 2; ++kt) { u32x4 w; w.x = cvt_pk_bf16(-rr[2 * kt][0], -rr[2 * kt][1]); w.y = cvt_pk_bf16(-rr[2 * kt][2], -rr[2 * kt][3]);
                    w.z = cvt_pk_bf16(-rr[2 * kt + 1][0], -rr[2 * kt + 1][1]); w.w = cvt_pk_bf16(-rr[2 * kt + 1][2], -rr[2 * kt + 1][3]); Rf[kt] = __builtin_bit_cast(bf16x8, w); }
                f32x4 vn[4];
#pragma unroll
                for (int mt = 0; mt < 4; ++mt) { vn[mt] = (f32x4){0.f, 0.f, 0.f, 0.f};
                    const LAS unsigned char* tp = lds + GB_T + (16 * mt + n16) * 144 + 8 * q4;
#pragma unroll
                    for (int kt = 0; kt < 2; ++kt) if (kt == 0 || mt >= 2) vn[mt] = __builtin_amdgcn_mfma_f32_16x16x32_bf16(lds_frag8x2(tp + kt * 64, tp + kt * 64 + 32), Rf[kt], vn[mt], 0, 0, 0); }
                bf16x8 Vf[2];
#pragma unroll
                for (int kt = 0; kt < 2; ++kt) { u32x4 w; w.x = cvt_pk_bf16(vn[2 * kt][0], vn[2 * kt][1]); w.y = cvt_pk_bf16(vn[2 * kt][2], vn[2 * kt][3]);
                    w.z = cvt_pk_bf16(vn[2 * kt + 1][0], vn[2 * kt + 1][1]); w.w = cvt_pk_bf16(vn[2 * kt + 1][2], vn[2 * kt + 1][3]); Vf[kt] = __builtin_bit_cast(bf16x8, w); }
#pragma unroll
                for (int mt = 0; mt < 4; ++mt) {
                    f32x4 o = {0.f, 0.f, 0.f, 0.f};
                    const LAS unsigned char* qp = lds + GB_Q + (16 * mt + n16) * 272 + 8 * q4;
#pragma unroll
                    for (int ks = 0; ks < 4; ++ks) o = __builtin_amdgcn_mfma_f32_16x16x32_bf16(lds_frag8x2(qp + ks * 64, qp + ks * 64 + 32), Sf[ks], o, 0, 0, 0);
                    const LAS unsigned char* atp = lds + GB_AT + (16 * mt + n16) * 144 + 8 * q4;
#pragma unroll
                    for (int kt = 0; kt < 2; ++kt) if (kt == 0 || mt >= 2) o = __builtin_amdgcn_mfma_f32_16x16x32_bf16(lds_frag8x2(atp + kt * 64, atp + kt * 64 + 32), Vf[kt], o, 0, 0, 0);
#pragma unroll
                    for (int i = 0; i < 4; ++i) *(LAS float*)(lds + GB_O + (16 * mt + 4 * q4 + i) * 528 + (16 * wid + n16) * 4) = o[i];
                }
                const float eg = __expf(glast);
#pragma unroll
                for (int st = 0; st < 8; ++st) { S[st] = S[st] * eg;
                    const LAS unsigned char* kp = lds + GB_KD + (16 * st + n16) * 144 + 8 * q4;
#pragma unroll
                    for (int kt = 0; kt < 2; ++kt) S[st] = __builtin_amdgcn_mfma_f32_16x16x32_bf16(lds_frag8x2(kp + kt * 64, kp + kt * 64 + 32), Vf[kt], S[st], 0, 0, 0); }
            }
            if (n + 1 < 32) GB_CUMSUM(par ^ 1);
            __syncthreads();
            {
                float o[16];
#pragma unroll
                for (int q = 0; q < 4; ++q) { const f32x4 v = *(const LAS f32x4*)(lds + GB_O + r * 528 + (c0 + 4 * q) * 4); o[4 * q] = v[0]; o[4 * q + 1] = v[1]; o[4 * q + 2] = v[2]; o[4 * q + 3] = v[3]; }
                const float rstd = rsqrtf(sumsq16_8lanes(o) * (1.f / 128.f) + RMS_EPS);
                float gt[16]; unpack16(gk0, gk1, gt);
                float res[16];
#pragma unroll
                for (int c = 0; c < 16; ++c) res[c] = o[c] * rstd * normw[c0 + c] * silu(gt[c]);
                u32x4 a, bq; pack16(res, a, bq);
                *(u32x4*)(hp + 2048) = a; *(u32x4*)(hp + 2048 + 8) = bq;
            }
        }
        __syncthreads();
    }
}
#undef GB_CUMSUM
#undef GB_LOAD

__device__ __forceinline__ void diff_prep_phase(int widk, bf16_t* H  , const int* positions, bf16_t* VT  , LAS unsigned char* lds) {
    MK_IDS();
    LAS unsigned char* scr = lds + wid * 16384;
    for (int item = gw; item < NB * 32 * 16; item += NGW) {
        const int dvh = item & 1, h = (item >> 1) & 7, tb = (item >> 4) & 31, b = item >> 9;
        const bf16_t* src = H + ((size_t)b * T + tb * 64) * DIFF_N + 2048 + h * 128 + dvh * 64;
#pragma unroll
        for (int i = 0; i < 8; ++i) { const int row = (lane >> 3) + 8 * i, ch = lane & 7; *(LAS u32x4*)(scr + row * 144 + ch * 16) = *(const u32x4*)(src + (size_t)row * DIFF_N + ch * 8); }
        LDS_WAIT();
        bf16_t* dst = VT + (((size_t)b * 8 + h) * 128 + dvh * 64 + lane) * T + tb * 64;
#pragma unroll
        for (int k = 0; k < 8; ++k) { unsigned short v[8];
#pragma unroll
            for (int e = 0; e < 8; ++e) v[e] = *(const LAS bf16_t*)(scr + (8 * k + e) * 144 + lane * 2);
            u32x4 w; w.x = v[0] | ((unsigned)v[1] << 16); w.y = v[2] | ((unsigned)v[3] << 16); w.z = v[4] | ((unsigned)v[5] << 16); w.w = v[6] | ((unsigned)v[7] << 16);
            *(u32x4*)(dst + 8 * k) = w; }
        LDS_WAIT();
    }
}

constexpr int AT_STAGE = 36864, AT_K = 0, AT_V = 64 * 272, AT_OSTG = 2 * AT_STAGE;
static_assert(AT_OSTG + 128 * 272 <= 131072, "attention LDS map");
__device__ __forceinline__ void diff_attn_phase(int widk, const bf16_t* H, const bf16_t* VT, bf16_t* O, const float* lq1, const float* lk1, const float* lq2, const float* lk2, const float* subw, float lambda_init,
                                                LAS unsigned char* lds) {
    MK_IDS();
    const float lam = __expf(wave_sum(lq1[lane] * lk1[lane])) - __expf(wave_sum(lq2[lane] * lk2[lane])) + lambda_init;
    const int c = wid >> 2, rg = wid & 3, l31 = lane & 31, hi = lane >> 5;
    for (int bh = blockIdx.x; bh < 256; bh += gridDim.x) {
        const int b = bh >> 3, h = bh & 7;
        const bf16_t* Kg = H + (size_t)b * T * DIFF_N + 1024 + h * 128;
        const bf16_t* Vg = VT + (size_t)bh * 128 * T;
        for (int ui = 0; ui < 16; ++ui) {
            const int qb = (ui & 1) ? (15 - (ui >> 1)) : (ui >> 1);
            const int q0w = 128 * qb + 32 * rg, nt = 2 * qb + 2;
            bf16x8 qf[4];
            { const bf16_t* qp = H + ((size_t)b * T + q0w + l31) * DIFF_N + h * 128 + c * 64 + 8 * hi;
#pragma unroll
              for (int d0 = 0; d0 < 4; ++d0) qf[d0] = *(const bf16x8*)(qp + 16 * d0); }
            f32x16 o[4];
#pragma unroll
            for (int d = 0; d < 4; ++d) o[d] = (f32x16){};
            float mrun = -1e30f, lrun = 0.f;
            u32x4 pk[2], pv[2];
#define AT_LOAD(j) do { _Pragma("unroll") for (int i_ = 0; i_ < 2; ++i_) { const int ci = tid + 512 * i_; \
                pk[i_] = *(const u32x4*)(Kg + (size_t)((j) * 64 + (ci >> 4)) * DIFF_N + (ci & 15) * 8); \
                pv[i_] = *(const u32x4*)(Vg + (size_t)(ci >> 3) * T + (j) * 64 + (ci & 7) * 8); } } while (0)
            AT_LOAD(0);
            for (int j = 0; j < nt; ++j) {
                LAS unsigned char* st = lds + (j & 1) * AT_STAGE;
#pragma unroll
                for (int i_ = 0; i_ < 2; ++i_) { const int ci = tid + 512 * i_;
                    *(LAS u32x4*)(st + AT_K + (ci >> 4) * 272 + (ci & 15) * 16) = pk[i_];
                    { LAS unsigned char* vd = st + AT_V + (ci >> 3) * 136 + (ci & 7) * 16; *(LAS u32x2*)vd = (u32x2){pv[i_].x, pv[i_].y}; *(LAS u32x2*)(vd + 8) = (u32x2){pv[i_].z, pv[i_].w}; } }
                __syncthreads();
                if (j + 1 < nt) AT_LOAD(j + 1);
                if (64 * j <= q0w + 31) {
                    bf16x8 kf[2][4];
#pragma unroll
                    for (int kb = 0; kb < 2; ++kb) { const LAS unsigned char* kp = st + AT_K + (32 * kb + l31) * 272 + c * 128 + hi * 16;
#pragma unroll
                        for (int d0 = 0; d0 < 4; ++d0) kf[kb][d0] = lds_frag16(kp + d0 * 32); }
                    f32x16 p[2]; p[0] = (f32x16){}; p[1] = (f32x16){};
#pragma unroll
                    for (int d0 = 0; d0 < 4; ++d0) { p[0] = __builtin_amdgcn_mfma_f32_32x32x16_bf16(kf[0][d0], qf[d0], p[0], 0, 0, 0); p[1] = __builtin_amdgcn_mfma_f32_32x32x16_bf16(kf[1][d0], qf[d0], p[1], 0, 0, 0); }
                    const LAS unsigned char* vbase = st + AT_V + l31 * 136 + 8 * hi;
                    bf16x8 va[4], vb[4];
#define AT_LOADV(dst, t_) do { _Pragma("unroll") for (int d = 0; d < 4; ++d) dst[d] = lds_frag8x2(vbase + d * 32 * 136 + (t_) * 32, vbase + d * 32 * 136 + (t_) * 32 + 16); } while (0)
#define AT_MMA(src, pf_) do { _Pragma("unroll") for (int d = 0; d < 4; ++d) o[d] = __builtin_amdgcn_mfma_f32_32x32x16_bf16(src[d], pf_, o[d], 0, 0, 0); } while (0)
                    AT_LOADV(va, 0);
                    asm volatile("" ::: "memory");
                    if (64 * j + 63 > q0w) {
                        const int q = q0w + l31;
#pragma unroll
                        for (int kb = 0; kb < 2; ++kb)
#pragma unroll
                            for (int r = 0; r < 16; ++r) { const int kv = 64 * j + 32 * kb + crow(r, hi); if (kv > q) p[kb][r] = -1e30f; }
                    }
                    float mx0 = fmaxf(p[0][0], p[1][0]), mx1 = fmaxf(p[0][1], p[1][1]);
#pragma unroll
                    for (int r = 2; r < 16; r += 2) { mx0 = fmaxf(mx0, fmaxf(p[0][r], p[1][r])); mx1 = fmaxf(mx1, fmaxf(p[0][r + 1], p[1][r + 1])); }
                    float mx = fmaxf(mx0, mx1);
                    mx = fmaxf(mx, __shfl_xor(mx, 32));
                    const float mnew = fmaxf(mrun, mx);
                    if (__any(mnew > mrun)) {
                        const float al = __builtin_amdgcn_exp2f(mrun - mnew); lrun *= al;
#pragma unroll
                        for (int d = 0; d < 4; ++d) o[d] = o[d] * al;
                    }
                    mrun = mnew;
                    float ls0 = 0.f, ls1 = 0.f, ls2 = 0.f, ls3 = 0.f;
#pragma unroll
                    for (int kb = 0; kb < 2; ++kb)
#pragma unroll
                        for (int r = 0; r < 16; r += 4) { p[kb][r] = __builtin_amdgcn_exp2f(p[kb][r] - mnew); p[kb][r + 1] = __builtin_amdgcn_exp2f(p[kb][r + 1] - mnew);
                            p[kb][r + 2] = __builtin_amdgcn_exp2f(p[kb][r + 2] - mnew); p[kb][r + 3] = __builtin_amdgcn_exp2f(p[kb][r + 3] - mnew);
                            ls0 += p[kb][r]; ls1 += p[kb][r + 1]; ls2 += p[kb][r + 2]; ls3 += p[kb][r + 3]; }
                    lrun += (ls0 + ls1) + (ls2 + ls3);
                    bf16x8 pf[4];
#pragma unroll
                    for (int t = 0; t < 4; ++t) { const int kb = t >> 1, s8 = (t & 1) * 8;
                        u32x4 w; w.x = cvt_pk_bf16(p[kb][s8], p[kb][s8 + 1]); w.y = cvt_pk_bf16(p[kb][s8 + 2], p[kb][s8 + 3]);
                        w.z = cvt_pk_bf16(p[kb][s8 + 4], p[kb][s8 + 5]); w.w = cvt_pk_bf16(p[kb][s8 + 6], p[kb][s8 + 7]); pf[t] = __builtin_bit_cast(bf16x8, w); }
                    asm volatile("" ::: "memory");
                    AT_LOADV(vb, 1); asm volatile("" ::: "memory"); AT_MMA(va, pf[0]);
                    AT_LOADV(va, 2); asm volatile("" ::: "memory"); AT_MMA(vb, pf[1]);
                    AT_LOADV(vb, 3); asm volatile("" ::: "memory"); AT_MMA(va, pf[2]);
                    AT_MMA(vb, pf[3]);
#undef AT_LOADV
#undef AT_MMA
                }
            }
#undef AT_LOAD
            const float ltot = lrun + __shfl_xor(lrun, 32);
            const float inv = (c ? lam : 1.f) / ltot;
            __syncthreads();
            LAS float* xch = (LAS float*)lds + rg * 4096;
            if (c == 1) {
#pragma unroll
                for (int d = 0; d < 4; ++d)
#pragma unroll
                    for (int r = 0; r < 16; ++r) xch[(d * 16 + r) * 64 + lane] = o[d][r] * inv;
            }
            __syncthreads();
            if (c == 0) {
                float ss = 0.f;
#pragma unroll
                for (int d = 0; d < 4; ++d)
#pragma unroll
                    for (int r = 0; r < 16; ++r) { const float v = o[d][r] * inv - xch[(d * 16 + r) * 64 + lane]; o[d][r] = v; ss += v * v; }
                ss += __shfl_xor(ss, 32);
                const float rstd = rsqrtf(ss * (1.f / 128.f) + RMS_EPS) * (1.f - lambda_init);
                LAS unsigned char* op = lds + AT_OSTG + (rg * 32 + l31) * 272 + 8 * hi;
#pragma unroll
                for (int d = 0; d < 4; ++d)
#pragma unroll
                    for (int g = 0; g < 4; ++g) { const int dv = 32 * d + 8 * g + 4 * hi; const f32x4 sw = *(const f32x4*)(subw + dv);
                        u32x2 w; w.x = cvt_pk_bf16(o[d][4 * g] * rstd * sw[0], o[d][4 * g + 1] * rstd * sw[1]); w.y = cvt_pk_bf16(o[d][4 * g + 2] * rstd * sw[2], o[d][4 * g + 3] * rstd * sw[3]);
                        *(LAS u32x2*)(op + (32 * d + 8 * g) * 2) = w; }
            }
            __syncthreads();
            {
                const LAS unsigned char* sp = lds + AT_OSTG + (rg * 32 + c * 16) * 272;
                bf16_t* gp = O + ((size_t)b * T + 128 * qb + rg * 32 + c * 16) * D + h * 128;
#pragma unroll
                for (int i = 0; i < 4; ++i) { const int idx = i * 64 + lane, row = idx >> 4, ch = idx & 15;
                    *(u32x4*)(gp + (size_t)row * D + ch * 8) = *(const LAS u32x4*)(sp + row * 272 + ch * 16); }
            }
        }
    }
}

template <bool FUSED_LN> __global__ void __launch_bounds__(NTHR, 2) fwd_megakernel(Params p) {
    extern __shared__ __attribute__((aligned(16))) unsigned char lds_raw[];
    LAS unsigned char* lds = (LAS unsigned char*)lds_raw;
    cg::grid_group grid = cg::this_grid();
    const int widk = __builtin_amdgcn_readfirstlane((int)threadIdx.x >> 6);
    volatile LAS unsigned* bst = (volatile LAS unsigned*)(lds + 131072 + 1024);
    if (threadIdx.x < 2) bst[threadIdx.x] = 0u;
    if (blockIdx.x == 0) { for (unsigned i = threadIdx.x; i < WS_CTL_BYTES / 4; i += NTHR) ((unsigned*)p.ws)[i] = 0u; }
    __syncthreads();
    const int G = gridDim.x;
    constexpr bool fused_ln = FUSED_LN;
    unsigned char* ws = p.ws; unsigned char* wsw = ws + WS_W;
    bf16_t* XN = (bf16_t*)(ws + WS_XN); bf16_t* Hb = (bf16_t*)(ws + WS_H);
    float* Gb = (float*)(ws + WS_GB); float* BETAb = Gb + (size_t)M * 8;

    unsigned long long pt0 = 0, pticks = 0; (void)pt0;
    TBEG(4);
#ifndef NO_PRO
    REPS(4) prologue(widk, p, lds);
#endif
    grid.sync(); TEND(4);
    const XcdBarrier xbar = xcd_barrier_post((unsigned*)p.ws, bst);
    for (int layer = 0; layer < DEPTH; ++layer) {
        const int j = layer >> 1;
        const float* resid = (layer == 0) ? p.in[0] : p.out;
        if ((layer & 1) == 0) {
            TBEG(1);
            {   pg8::Gemm g{XN, (const bf16_t*)(wsw + W_GWIN) + (size_t)j * 4096 * 1024, M, GDN_NMAIN, D, D}; pg8::StaticOrder S; S.init(M, GDN_NMAIN, G, (int)blockIdx.x);
                pg8::EpiBf16 E{Hb, GDN_NMAIN};
                REPS(1) PH_GEMMB pg8::gemm_phase<pg8::EpiBf16, pg8::StaticOrder, true, true, D, D, true>(widk, lds, g, S, E); }
#ifndef NO_AB
            REPS(4) gdn_ab_phase(widk, XN, (const bf16_t*)(wsw + W_GWAB) + (size_t)j * 16 * 1024, p.in[4] + j * 8, p.in[5] + j * 8, Gb, BETAb);
#endif
            xcd_barrier(xbar, widk); TEND(1); TBEG(2);
#ifndef NO_GA
            gdn_phase_a(widk, Hb, Gb, BETAb, p.in[3] + (size_t)j * 4 * 3072, (bf16_t*)(ws + WS_UT) + (size_t)32 * 1024 * 1024, (bf16_t*)(ws + WS_UT), lds);
#endif
            xcd_barrier(xbar, widk);
#ifndef NO_GB
            gdn_phase_b(widk, Hb, Gb, BETAb, p.in[6] + j * 128, (const bf16_t*)(ws + WS_UT) + (size_t)32 * 1024 * 1024, (const bf16_t*)(ws + WS_UT), lds);
#endif
            xcd_barrier(xbar, widk); TEND(2); TBEG(5);
            {   pg8::Gemm g{Hb + 2048, (const bf16_t*)(wsw + W_GWOUT) + (size_t)j * 1024 * 1024, M, D, D, GDN_NMAIN}; pg8::StaticOrder S; S.init(M, D, G, (int)blockIdx.x);
                if constexpr (fused_ln) {
                    if (layer == 0) { pg8::EpiResidLn<false, false> E{p.in[0], p.out, XN, p.in[19] + layer * D, p.in[20] + layer * D, ALPHA, LN_EPS, (unsigned*)(ws + WS_XBUF), (unsigned*)(ws + WS_CNT) + (size_t)(2 * layer) * 4096, (LAS float*)(lds + 131072 + 2048)};
                        pg8::gemm_phase<pg8::EpiResidLn<false, false>, pg8::StaticOrder, true, true, D, GDN_NMAIN>(widk, lds, g, S, E); }
                    else { pg8::EpiResidLn<true, false> E{nullptr, p.out, XN, p.in[19] + layer * D, p.in[20] + layer * D, ALPHA, LN_EPS, (unsigned*)(ws + WS_XBUF), (unsigned*)(ws + WS_CNT) + (size_t)(2 * layer) * 4096, (LAS float*)(lds + 131072 + 2048)};
                        pg8::gemm_phase<pg8::EpiResidLn<true, false>, pg8::StaticOrder, true, true, D, GDN_NMAIN>(widk, lds, g, S, E); } }
                else { pg8::EpiResid E{resid, p.out, D, ALPHA};
                    PH_GEMMR pg8::gemm_phase<pg8::EpiResid, pg8::StaticOrder, true, true, D, GDN_NMAIN>(widk, lds, g, S, E); } }
        } else {
            const float lambda_init = 0.8f - 0.6f * expf(-0.3f * (float)layer);
            TBEG(1);
            {   pg8::Gemm g{XN, (const bf16_t*)(wsw + W_DWIN) + (size_t)j * 3072 * 1024, M, DIFF_N, D, D}; pg8::StaticOrder S; S.init(M, DIFF_N, G, (int)blockIdx.x);
                pg8::EpiRope E{Hb, (const unsigned*)(ws + WS_ROPE), 0.125f * LOG2E, (bf16_t*)(ws + WS_VT)};
                pg8::gemm_phase<pg8::EpiRope, pg8::StaticOrder, true, true, D, D, true>(widk, lds, g, S, E); }
            xcd_barrier(xbar, widk); TEND(1); TBEG(4);
#ifndef NO_ATT
            REPS(3) diff_attn_phase(widk, Hb, (const bf16_t*)(ws + WS_VT), (bf16_t*)(ws + WS_O), p.in[9] + j * 64, p.in[10] + j * 64, p.in[11] + j * 64, p.in[12] + j * 64, p.in[13] + j * 128, lambda_init, lds);
#endif
            xcd_barrier(xbar, widk); TEND(3); TBEG(5);
            {   pg8::Gemm g{(const bf16_t*)(ws + WS_O), (const bf16_t*)(wsw + W_DWOUT) + (size_t)j * 1024 * 1024, M, D, D, D}; pg8::StaticOrder S; S.init(M, D, G, (int)blockIdx.x);
                if constexpr (fused_ln) { pg8::EpiResidLn<true, false> E{nullptr, p.out, XN, p.in[19] + layer * D, p.in[20] + layer * D, ALPHA, LN_EPS, (unsigned*)(ws + WS_XBUF), (unsigned*)(ws + WS_CNT) + (size_t)(2 * layer) * 4096, (LAS float*)(lds + 131072 + 2048)};
                    pg8::gemm_phase<pg8::EpiResidLn<true, false>, pg8::StaticOrder, true, true, D, D>(widk, lds, g, S, E); }
                else { pg8::EpiResid E{resid, p.out, D, ALPHA};
                    PH_GEMMR pg8::gemm_phase<pg8::EpiResid, pg8::StaticOrder, true, true, D, D>(widk, lds, g, S, E); } }
        }
        xcd_barrier(xbar, widk); TEND(5);
        if constexpr (!fused_ln) { ln_phase(widk, p.out, XN, p.in[19] + layer * D, p.in[20] + layer * D); xcd_barrier(xbar, widk); }
        {
            bf16_t* ACT = (bf16_t*)(ws + WS_ACT); float* HALO = (float*)(ws + WS_HALO); float* HALO2 = (float*)(ws + WS_HALO2);
            const float* fcw = p.in[16] + (size_t)layer * 3 * FFN_N; const float* fcb = p.in[17] + (size_t)layer * FFN_N;
            TBEG(6);
            {   pg8::Gemm g{XN, (const bf16_t*)(wsw + W_FUP) + (size_t)layer * 5632 * 1024, M, FFN_N, D, D}; pg8::StaticOrder S; S.init(M, FFN_N, G, (int)blockIdx.x);
                pg8::EpiFfnAct E{ACT, fcw, fcb, HALO, HALO2, (LAS float*)(lds + 131072 + 2048)};
                pg8::gemm_phase<pg8::EpiFfnAct, pg8::StaticOrder, true, true, D, D, true>(widk, lds, g, S, E); }
            xcd_barrier(xbar, widk); TEND(6); TBEG(4);
            ffn_fixup_phase(widk, ACT, HALO, HALO2, fcw, fcb);
            xcd_barrier(xbar, widk); TEND(4); TBEG(7);
            {   pg8::Gemm g{ACT, (const bf16_t*)(wsw + W_FDOWN) + (size_t)layer * 1024 * 2816, M, D, FFN_H, FFN_H}; pg8::StaticOrder S; S.init(M, D, G, (int)blockIdx.x);
                if constexpr (fused_ln) {
                    if (layer == DEPTH - 1) { pg8::EpiResidLn<true, true> E{nullptr, p.out, XN, p.in[21] + layer * D, p.in[22] + layer * D, ALPHA, LN_EPS, (unsigned*)(ws + WS_XBUF), (unsigned*)(ws + WS_CNT) + (size_t)(2 * layer + 1) * 4096, (LAS float*)(lds + 131072 + 2048)};
                        pg8::gemm_phase<pg8::EpiResidLn<true, true>, pg8::StaticOrder, true, true, FFN_H, FFN_H>(widk, lds, g, S, E); }
                    else { pg8::EpiResidLn<true, false> E{nullptr, p.out, XN, p.in[21] + layer * D, p.in[22] + layer * D, ALPHA, LN_EPS, (unsigned*)(ws + WS_XBUF), (unsigned*)(ws + WS_CNT) + (size_t)(2 * layer + 1) * 4096, (LAS float*)(lds + 131072 + 2048)};
                        pg8::gemm_phase<pg8::EpiResidLn<true, false>, pg8::StaticOrder, true, true, FFN_H, FFN_H>(widk, lds, g, S, E); } }
                else { pg8::EpiResid E{p.out, p.out, D, ALPHA};
                    pg8::gemm_phase<pg8::EpiResid, pg8::StaticOrder, true, true, FFN_H, FFN_H>(widk, lds, g, S, E); } }
        }
        xcd_barrier(xbar, widk); TEND(7);
        if constexpr (!fused_ln) { ln_phase(widk, p.out, XN, p.in[21] + layer * D, p.in[22] + layer * D); xcd_barrier(xbar, widk); }
    }
    if (PROBE_T) { const unsigned long long ts = __builtin_amdgcn_s_memrealtime(); while (__builtin_amdgcn_s_memrealtime() - ts < pticks) __builtin_amdgcn_s_sleep(8); }
}
}

extern "C" void kernel_launch(void* const* d_in, const int* in_sizes, int n_in, void* d_out, int out_size, void* d_ws, size_t ws_size, hipStream_t stream) {
    static int grid = 0;
    if (grid == 0) {
        if (n_in != 23 || ws_size < mk::WS_END) { fprintf(stderr, "kernel_launch: unexpected n_in %d / ws_size %zu (need %zu)\n", n_in, ws_size, (size_t)mk::WS_END); grid = -1; return; }
        int dev = 0, cus = 0, per_cu = 0;
        (void)hipGetDevice(&dev); (void)hipDeviceGetAttribute(&cus, hipDeviceAttributeMultiprocessorCount, dev);
        const void* kfn = (const void*)mk::fwd_megakernel<true>; const void* kfn2 = (const void*)mk::fwd_megakernel<false>;
        if (hipFuncSetAttribute(kfn, hipFuncAttributeMaxDynamicSharedMemorySize, mk::LDS_BYTES) != hipSuccess || hipFuncSetAttribute(kfn2, hipFuncAttributeMaxDynamicSharedMemorySize, mk::LDS_BYTES) != hipSuccess) { fprintf(stderr, "kernel_launch: hipFuncSetAttribute failed\n"); grid = -1; return; }
        if (hipOccupancyMaxActiveBlocksPerMultiprocessor(&per_cu, kfn, mk::NTHR, mk::LDS_BYTES) != hipSuccess || per_cu < 1) { fprintf(stderr, "kernel_launch: occupancy query gave %d\n", per_cu); per_cu = 1; }
        (void)hipGetLastError();
        grid = cus * per_cu;
        fprintf(stderr, "kernel_launch: grid %d (cus %d x %d)\n", grid, cus, per_cu);
    }
    if (grid < 0) return;
    mk::Params p{};
    for (int i = 0; i < 23; ++i) p.in[i] = (const float*)d_in[i];
    p.positions = (const int*)d_in[1]; p.out = (float*)d_out; p.ws = (unsigned char*)d_ws;
    void* args[] = {&p};
    hipError_t e = hipLaunchCooperativeKernel(grid == 256 ? (const void*)mk::fwd_megakernel<true> : (const void*)mk::fwd_megakernel<false>, dim3(grid), dim3(mk::NTHR), args, mk::LDS_BYTES, stream);
    if (e != hipSuccess) fprintf(stderr, "cooperative launch failed: %s (grid %d)\n", hipGetErrorString(e), grid);
}
```

```cpp
#include <hip/hip_runtime.h>
#include <hip/hip_cooperative_groups.h>
#include <cstdio>
#include <cstdint>
namespace cg = cooperative_groups;
#ifndef PROBE_REP
#define PROBE_REP 0
#endif
#define REPS(k) for (int rep_ = 0; rep_ < ((PROBE_REP) == (k) ? 2 : 1); ++rep_)
#ifndef PROBE_T
#define PROBE_T 0
#endif
#define TBEG(k) if (PROBE_T == (k)) pt0 = __builtin_amdgcn_s_memrealtime()
#define TEND(k) if (PROBE_T == (k)) pticks += __builtin_amdgcn_s_memrealtime() - pt0
namespace pg8 {
#define PG8_LAS __attribute__((address_space(3)))
typedef unsigned short bf16_t;
typedef short bf16x8 __attribute__((ext_vector_type(8)));
typedef float f32x4 __attribute__((ext_vector_type(4)));
typedef unsigned u32x4 __attribute__((ext_vector_type(4)));
constexpr int BM = 256, BK = 64, HALF = 128, HTB = HALF * BK * 2  , STAGE_BYTES = 8 * HTB, NXCD = 8, WGM = 8;

__host__ __device__ __forceinline__ int lds_byte(int r, int c) { const int st = (r >> 4) * 2 + (c >> 5), rr = r & 15, cc = c & 31, ob = rr * 64 + cc * 2; return st * 1024 + (ob ^ (((ob >> 9) & 1) << 5)); }
__host__ __device__ __forceinline__ void stage_rc(int b, int& R, int& C) { const int st = b / 1024, sb = b % 1024, swz = sb ^ (((sb >> 9) & 1) << 5); R = (st >> 1) * 16 + swz / 64; C = (st & 1) * 32 + (swz % 64) / 2; }
__host__ __device__ __forceinline__ int perm32(int rho) { const int n = rho >> 4, i = rho & 15; return 8 * (i >> 2) + 4 * n + (i & 3); }

struct Unit { int pm, pn; };
struct Gemm { const bf16_t* A; const bf16_t* Bt; int M, N, K, lda; };

struct StaticOrder {
    int nM, nN, nwg, G, c;
    __host__ __device__ void init(int M, int N, int G_, int c_) { nM = M / BM; nN = N / BM; nwg = nM * nN; G = G_; c = c_; }
    __host__ __device__ bool next(int i, Unit& u) const {
        const long L = (long)i * G + c; if (L >= nwg) return false;
        int wgid = (int)L; { const int q = nwg / NXCD, r = nwg % NXCD, xcd = wgid % NXCD, off = wgid / NXCD; wgid = (xcd < r ? xcd * (q + 1) : r * (q + 1) + (xcd - r) * q) + off; }
        const int nig = WGM * nN, gid = wgid / nig, fm = gid * WGM, gsz = (nM - fm) < WGM ? (nM - fm) : WGM;
        u.pm = fm + ((wgid % nig) % gsz); u.pn = (wgid % nig) / gsz; return true;
    }
    __device__ __forceinline__ void a_ready(const Unit&) const {}
    __device__ __forceinline__ void done(const Unit&) const {}
};
typedef float f32x2 __attribute__((ext_vector_type(2)));
typedef __bf16 bf16x2v __attribute__((ext_vector_type(2)));
typedef _Float16 f16x2v __attribute__((ext_vector_type(2)));
typedef _Float16 f16x8 __attribute__((ext_vector_type(8)));
__device__ __forceinline__ unsigned cvt_pk_f16(float lo, float hi) { f32x2 v = {lo, hi}; f16x2v b = __builtin_convertvector(v, f16x2v); return __builtin_bit_cast(unsigned, b); }
__device__ __forceinline__ f32x2 unpk_f16(unsigned w) { const f16x2v h = __builtin_bit_cast(f16x2v, w); return __builtin_convertvector(h, f32x2); }
template <bool F16> __device__ __forceinline__ f32x4 mma16(const bf16x8 a, const bf16x8 b, const f32x4 c) {
    if constexpr (F16) return __builtin_amdgcn_mfma_f32_16x16x32_f16(__builtin_bit_cast(f16x8, a), __builtin_bit_cast(f16x8, b), c, 0, 0, 0);
    else return __builtin_amdgcn_mfma_f32_16x16x32_bf16(a, b, c, 0, 0, 0);
}
__device__ __forceinline__ unsigned cvt_pk_bf16(float lo, float hi) { f32x2 v = {lo, hi}; bf16x2v b = __builtin_convertvector(v, bf16x2v); return __builtin_bit_cast(unsigned, b); }

struct EpiBf16 {
    static constexpr bool PERM = true, AFTER_DRAIN = false;
    bf16_t* O; int ldc;
    __device__ __forceinline__ void operator()(const f32x4 (&acc)[2][2][4][2], const Unit& u, int wr, int wc, int fr, int fq) const {
        const int row0 = u.pm * BM + wr * 64 + fr; const int col0 = u.pn * BM + wc * 32 + 8 * fq;
#pragma unroll
        for (int ai = 0; ai < 2; ++ai)
#pragma unroll
            for (int m = 0; m < 4; ++m) { bf16_t* rowp = O + (size_t)(row0 + ai * HALF + m * 16) * ldc + col0;
#pragma unroll
                for (int bj = 0; bj < 2; ++bj) { const f32x4 v0 = acc[ai][bj][m][0], v1 = acc[ai][bj][m][1];
                    u32x4 w; w.x = cvt_pk_bf16(v0[0], v0[1]); w.y = cvt_pk_bf16(v0[2], v0[3]); w.z = cvt_pk_bf16(v1[0], v1[1]); w.w = cvt_pk_bf16(v1[2], v1[3]);
                    *(u32x4*)(rowp + bj * HALF) = w; } }
    }
};
struct EpiResid {
    static constexpr bool PERM = false, AFTER_DRAIN = false;
    const float* base; float* out; int ldc; float alpha;
    __device__ __forceinline__ void operator()(const f32x4 (&acc)[2][2][4][2], const Unit& u, int wr, int wc, int fr, int fq) const {
        const int col0 = u.pn * BM + wc * 32 + 4 * fq;
#pragma unroll
        for (int ai = 0; ai < 2; ++ai)
#pragma unroll
            for (int m = 0; m < 4; ++m) { const int r = ai * HALF + wr * 64 + m * 16 + fr; const size_t off = (size_t)(u.pm * BM + r) * ldc + col0;
#pragma unroll
                for (int bj = 0; bj < 2; ++bj)
#pragma unroll
                    for (int n = 0; n < 2; ++n) { const f32x4 bs = *(const f32x4*)(base + off + bj * HALF + n * 16); const f32x4 o = bs * alpha + acc[ai][bj][m][n];
                        *(f32x4*)(out + off + bj * HALF + n * 16) = o; }
                asm volatile("" ::: "memory"); }
    }
};

struct EpiRope {
    static constexpr bool PERM = true, AFTER_DRAIN = false;
    bf16_t* O; const unsigned* CS; float qscale; bf16_t* VT;
    __device__ __forceinline__ void operator()(const f32x4 (&acc)[2][2][4][2], const Unit& u, int wr, int wc, int fr_, int fq_) const {
        int fr = fr_, fq = fq_; asm volatile("" : "+v"(fr), "+v"(fq));
        const int row0 = u.pm * BM + wr * 64 + fr;
        if (u.pn >= 8) {
            const int t0 = (u.pm * BM) & 2047, bb = (u.pm * BM) >> 11;
#pragma unroll
            for (int bj = 0; bj < 2; ++bj) {
                bf16_t* vt = VT + ((size_t)(bb * 8 + 2 * (u.pn - 8) + bj) * 128 + wc * 32 + 8 * fq) * 2048 + t0 + wr * 64 + fr;
#pragma unroll
                for (int n = 0; n < 2; ++n)
#pragma unroll
                    for (int e = 0; e < 4; ++e)
#pragma unroll
                        for (int ai = 0; ai < 2; ++ai)
#pragma unroll
                            for (int m = 0; m < 4; ++m) vt[(size_t)(4 * n + e) * 2048 + ai * HALF + m * 16] = (bf16_t)(cvt_pk_bf16(acc[ai][bj][m][n][e], 0.f) & 0xffffu);
            }
        } else {
            const float sc = (u.pn < 4) ? qscale : 1.f;
            const int col1 = u.pn * BM + wc * 64 + 8 * fq;
#pragma unroll
            for (int ai = 0; ai < 2; ++ai)
#pragma unroll
                for (int m = 0; m < 4; ++m) { const int row = row0 + ai * HALF + m * 16;
                    const u32x4 t0 = *(const u32x4*)(CS + (size_t)row * 32 + 8 * fq), t1 = *(const u32x4*)(CS + (size_t)row * 32 + 8 * fq + 4);
                    const f32x2 e0 = unpk_f16(t0.x), e1 = unpk_f16(t0.y), e2 = unpk_f16(t0.z), e3 = unpk_f16(t0.w), e4 = unpk_f16(t1.x), e5 = unpk_f16(t1.y), e6 = unpk_f16(t1.z), e7 = unpk_f16(t1.w);
                    const f32x4 c0 = {e0[0], e1[0], e2[0], e3[0]}, c1 = {e4[0], e5[0], e6[0], e7[0]}, s0 = {e0[1], e1[1], e2[1], e3[1]}, s1 = {e4[1], e5[1], e6[1], e7[1]};
                    const f32x4 a0 = acc[ai][0][m][0], a1 = acc[ai][0][m][1], b0 = acc[ai][1][m][0], b1 = acc[ai][1][m][1];
                    const f32x4 y10 = (a0 * c0 - b0 * s0) * sc, y11 = (a1 * c1 - b1 * s1) * sc, y20 = (b0 * c0 + a0 * s0) * sc, y21 = (b1 * c1 + a1 * s1) * sc;
                    u32x4 w1, w2; w1.x = cvt_pk_bf16(y10[0], y10[1]); w1.y = cvt_pk_bf16(y10[2], y10[3]); w1.z = cvt_pk_bf16(y11[0], y11[1]); w1.w = cvt_pk_bf16(y11[2], y11[3]);
                    w2.x = cvt_pk_bf16(y20[0], y20[1]); w2.y = cvt_pk_bf16(y20[2], y20[3]); w2.z = cvt_pk_bf16(y21[0], y21[1]); w2.w = cvt_pk_bf16(y21[2], y21[3]);
                    bf16_t* rowp = O + (size_t)row * 3072 + col1;
                    *(u32x4*)rowp = w1; *(u32x4*)(rowp + 32) = w2;
                    if (m & 1) asm volatile("" ::: "memory"); }
        }
    }
};

template <bool BASE_BF16, bool WRITE_F32> struct EpiResidLn {
    static constexpr bool PERM = true, AFTER_DRAIN = false;
    const float* base; float* out; bf16_t* xn; const float* g; const float* b; float alpha, eps;
    unsigned* xbuf;
    unsigned* cnt;
    PG8_LAS float* sl;
    __device__ __forceinline__ void operator()(f32x4 (&acc)[2][2][4][2], const Unit& u, int wr, int wc, int fr_, int fq_) const {
        typedef unsigned u32x2 __attribute__((ext_vector_type(2)));
        int fr = fr_, fq = fq_; asm volatile("" : "+v"(fr), "+v"(fq));
        const int col0 = u.pn * BM + wc * 32 + 8 * fq;
        const int lane = fq * 16 + fr, wid = wr * 4 + wc, tid = wid * 64 + lane;
#pragma unroll
        for (int ai = 0; ai < 2; ++ai)
#pragma unroll
            for (int m = 0; m < 4; ++m) { const int r = ai * HALF + wr * 64 + m * 16 + fr; const size_t off = (size_t)(u.pm * BM + r) * 1024 + col0;
                float s = 0.f, q = 0.f;
#pragma unroll
                for (int bj = 0; bj < 2; ++bj) { f32x4 bs0, bs1;
                    if constexpr (BASE_BF16) { const u32x4 rb = *(const u32x4*)(xn + off + bj * HALF); const f32x2 a0 = unpk_f16(rb.x), a1 = unpk_f16(rb.y), a2 = unpk_f16(rb.z), a3 = unpk_f16(rb.w);
                        bs0 = (f32x4){a0[0], a0[1], a1[0], a1[1]}; bs1 = (f32x4){a2[0], a2[1], a3[0], a3[1]}; }
                    else { bs0 = *(const f32x4*)(base + off + bj * HALF); bs1 = *(const f32x4*)(base + off + bj * HALF + 4); }
                    const f32x4 y0 = bs0 * alpha + acc[ai][bj][m][0], y1 = bs1 * alpha + acc[ai][bj][m][1]; acc[ai][bj][m][0] = y0; acc[ai][bj][m][1] = y1;
                    s += ((y0[0] + y0[1]) + (y0[2] + y0[3])) + ((y1[0] + y1[1]) + (y1[2] + y1[3]));
                    q += ((y0[0] * y0[0] + y0[1] * y0[1]) + (y0[2] * y0[2] + y0[3] * y0[3])) + ((y1[0] * y1[0] + y1[1] * y1[1]) + (y1[2] * y1[2] + y1[3] * y1[3])); }
                s += __shfl_xor(s, 16); s += __shfl_xor(s, 32); q += __shfl_xor(q, 16); q += __shfl_xor(q, 32);
                if (fq == 0) { sl[(r * 4 + wc) * 2] = s; sl[(r * 4 + wc) * 2 + 1] = q; }
                asm volatile("" ::: "memory"); }
        asm volatile("s_waitcnt lgkmcnt(0)" ::: "memory"); __builtin_amdgcn_s_barrier(); asm volatile("" ::: "memory");
        if (tid < 256) {
            const PG8_LAS f32x4* pp = (const PG8_LAS f32x4*)(sl + tid * 8); const f32x4 p0 = pp[0], p1 = pp[1];
            const float S = (p0[0] + p0[2]) + (p1[0] + p1[2]), Q = (p0[1] + p0[3]) + (p1[1] + p1[3]);
            unsigned* xp = xbuf + (((size_t)u.pm * 4 + u.pn) * 256 + tid) * 2;
            __hip_atomic_store(xp, __float_as_uint(S), __ATOMIC_RELAXED, __HIP_MEMORY_SCOPE_AGENT); __hip_atomic_store(xp + 1, __float_as_uint(Q), __ATOMIC_RELAXED, __HIP_MEMORY_SCOPE_AGENT);
            asm volatile("s_waitcnt vmcnt(0)" ::: "memory");
            if (lane == 0) __hip_atomic_fetch_add(cnt + 16 * u.pm, 1u, __ATOMIC_RELAXED, __HIP_MEMORY_SCOPE_AGENT);
        }
        if (wid == 0) {
            unsigned sp = 0;
            while ((unsigned)__builtin_amdgcn_readfirstlane(__hip_atomic_load(cnt + 16 * u.pm, __ATOMIC_RELAXED, __HIP_MEMORY_SCOPE_AGENT)) < 16u) { __builtin_amdgcn_s_sleep(2); if (++sp > (1u << 22)) break; }
            __builtin_amdgcn_fence(__ATOMIC_ACQUIRE, "agent");
        }
        asm volatile("s_waitcnt vmcnt(0) lgkmcnt(0)" ::: "memory"); __builtin_amdgcn_s_barrier(); asm volatile("" ::: "memory");
        if (tid < 256) {
            float S = 0.f, Q = 0.f;
#pragma unroll
            for (int t = 0; t < 4; ++t) { unsigned* xp = xbuf + (((size_t)u.pm * 4 + t) * 256 + tid) * 2;
                S += __uint_as_float(__hip_atomic_load(xp, __ATOMIC_RELAXED, __HIP_MEMORY_SCOPE_AGENT)); Q += __uint_as_float(__hip_atomic_load(xp + 1, __ATOMIC_RELAXED, __HIP_MEMORY_SCOPE_AGENT)); }
            const float mean = S * (1.f / 1024.f), var = fmaxf(Q * (1.f / 1024.f) - mean * mean, 0.f);
            sl[2048 + tid * 2] = mean; sl[2048 + tid * 2 + 1] = 1.f / sqrtf(var + eps);
        }
        asm volatile("s_waitcnt lgkmcnt(0)" ::: "memory"); __builtin_amdgcn_s_barrier(); asm volatile("" ::: "memory");
#pragma unroll
        for (int bj = 0; bj < 2; ++bj) {
            const f32x4 gv0 = *(const f32x4*)(g + col0 + bj * HALF), gv1 = *(const f32x4*)(g + col0 + bj * HALF + 4), bv0 = *(const f32x4*)(b + col0 + bj * HALF), bv1 = *(const f32x4*)(b + col0 + bj * HALF + 4);
#pragma unroll
            for (int ai = 0; ai < 2; ++ai)
#pragma unroll
                for (int m = 0; m < 4; ++m) { const int r = ai * HALF + wr * 64 + m * 16 + fr; const size_t off = (size_t)(u.pm * BM + r) * 1024 + col0 + bj * HALF;
                    const float mean = sl[2048 + r * 2], rstd = sl[2048 + r * 2 + 1];
                    const f32x4 o0 = (acc[ai][bj][m][0] - mean) * rstd * gv0 + bv0, o1 = (acc[ai][bj][m][1] - mean) * rstd * gv1 + bv1;
                    if constexpr (WRITE_F32) { *(f32x4*)(out + off) = o0; *(f32x4*)(out + off + 4) = o1; }
                    u32x4 w; w.x = cvt_pk_f16(o0[0], o0[1]); w.y = cvt_pk_f16(o0[2], o0[3]); w.z = cvt_pk_f16(o1[0], o1[1]); w.w = cvt_pk_f16(o1[2], o1[3]); *(u32x4*)(xn + off) = w; }
            asm volatile("" ::: "memory");
        }
    }
};

__device__ __forceinline__ float dpp_ror1(float v) { float r; asm volatile("s_nop 1\n\tv_mov_b32_dpp %0, %1 row_ror:1 row_mask:0xf bank_mask:0xf" : "=&v"(r) : "v"(v)); return r; }
__device__ __forceinline__ float dpp_ror2(float v) { float r; asm volatile("s_nop 1\n\tv_mov_b32_dpp %0, %1 row_ror:2 row_mask:0xf bank_mask:0xf" : "=&v"(r) : "v"(v)); return r; }
__device__ __forceinline__ float silu_f(float x) { return x * __builtin_amdgcn_rcpf(1.f + __expf(-x)); }
struct EpiFfnAct {
    static constexpr bool PERM = true, AFTER_DRAIN = false;
    bf16_t* ACT; const float* cw; const float* cb; float* HALO; float* HALO2; PG8_LAS float* hl;
    __device__ __forceinline__ void operator()(const f32x4 (&acc)[2][2][4][2], const Unit& u, int wr, int wc, int fr_, int fq_) const {
        int fr = fr_, fq = fq_; asm volatile("" : "+v"(fr), "+v"(fq));
        const int cc0 = wc * 32 + 8 * fq, colA = u.pn * 128 + cc0;
        if (fr >= 14) {
#pragma unroll
            for (int ai = 0; ai < 2; ++ai) { PG8_LAS float* hp = hl + ((2 * ai + wr) * 2 + (fr - 14)) * 256 + cc0;
#pragma unroll
                for (int bj = 0; bj < 2; ++bj)
#pragma unroll
                    for (int n = 0; n < 2; ++n) *(PG8_LAS f32x4*)(hp + bj * 128 + 4 * n) = acc[ai][bj][3][n]; }
            if (wr == 1) { float* gp = HALO + ((size_t)u.pm * 2 + (fr - 14)) * 5632 + colA;
#pragma unroll
                for (int bj = 0; bj < 2; ++bj)
#pragma unroll
                    for (int n = 0; n < 2; ++n) *(f32x4*)(gp + bj * 2816 + 4 * n) = acc[1][bj][3][n]; }
        }
        if (fr < 2 && wr == 0) { float* gp = HALO2 + ((size_t)u.pm * 2 + fr) * 5632 + colA;
#pragma unroll
            for (int bj = 0; bj < 2; ++bj)
#pragma unroll
                for (int n = 0; n < 2; ++n) *(f32x4*)(gp + bj * 2816 + 4 * n) = acc[0][bj][0][n]; }
        asm volatile("s_waitcnt lgkmcnt(0)" ::: "memory"); __builtin_amdgcn_s_barrier(); asm volatile("" ::: "memory");
#pragma unroll
        for (int ai = 0; ai < 2; ++ai) {
            const int strip = 2 * ai + wr;
            unsigned kx[4], ky[4];
#pragma unroll
            for (int n = 0; n < 2; ++n) {
                f32x4 wa[3], wb[3];
#pragma unroll
                for (int j = 0; j < 3; ++j) { wa[j] = *(const f32x4*)(cw + j * 5632 + colA + 4 * n); wb[j] = *(const f32x4*)(cw + j * 5632 + 2816 + colA + 4 * n); }
                const f32x4 ba = *(const f32x4*)(cb + colA + 4 * n), bb = *(const f32x4*)(cb + 2816 + colA + 4 * n);
                f32x4 h1a = {0.f, 0.f, 0.f, 0.f}, h2a = h1a, h1b = h1a, h2b = h1a;
                if (strip > 0) { const PG8_LAS float* hp = hl + ((strip - 1) * 2) * 256 + cc0 + 4 * n;
                    h2a = *(const PG8_LAS f32x4*)hp; h1a = *(const PG8_LAS f32x4*)(hp + 256); h2b = *(const PG8_LAS f32x4*)(hp + 128); h1b = *(const PG8_LAS f32x4*)(hp + 256 + 128); }
                f32x4 pr1a = h1a, pr2a = h2a, pr1b = h1b, pr2b = h2b;
#pragma unroll
                for (int m = 0; m < 4; ++m) {
                    const f32x4 ca = acc[ai][0][m][n], cbv = acc[ai][1][m][n];
                    f32x4 c1a, c2a, c1b, c2b;
#pragma unroll
                    for (int e = 0; e < 4; ++e) { c1a[e] = dpp_ror1(ca[e]); c2a[e] = dpp_ror2(ca[e]); c1b[e] = dpp_ror1(cbv[e]); c2b[e] = dpp_ror2(cbv[e]); }
                    float o[4];
#pragma unroll
                    for (int e = 0; e < 4; ++e) {
                        float x1a, x2a, x1b, x2b;
                        if (m > 0) { x1a = pr1a[e]; x2a = pr2a[e]; x1b = pr1b[e]; x2b = pr2b[e]; }
                        else { x1a = h1a[e]; x2a = (fr == 0) ? h2a[e] : h1a[e]; x1b = h1b[e]; x2b = (fr == 0) ? h2b[e] : h1b[e]; }
                        const float p1a = (fr == 0) ? x1a : c1a[e], p2a = (fr < 2) ? x2a : c2a[e];
                        const float p1b = (fr == 0) ? x1b : c1b[e], p2b = (fr < 2) ? x2b : c2b[e];
                        const float ya = wa[0][e] * p2a + wa[1][e] * p1a + wa[2][e] * ca[e] + ba[e];
                        const float yb = wb[0][e] * p2b + wb[1][e] * p1b + wb[2][e] * cbv[e] + bb[e];
                        o[e] = silu_f(ya) * yb;
                    }
                    pr1a = c1a; pr2a = c2a; pr1b = c1b; pr2b = c2b;
                    const unsigned w0 = cvt_pk_bf16(o[0], o[1]), w1 = cvt_pk_bf16(o[2], o[3]);
                    asm volatile("" :: "v"(w0), "v"(w1));
                    if (n == 0) { kx[m] = w0; ky[m] = w1; }
                    else { u32x4 w; w.x = kx[m]; w.y = ky[m]; w.z = w0; w.w = w1; *(u32x4*)(ACT + (size_t)(u.pm * BM + ai * HALF + wr * 64 + m * 16 + fr) * 2816 + colA) = w; }
                }
                asm volatile("" ::: "memory");
            }
        }
    }
};

template <class Epi, class Sched, bool ALIGN_EPI, bool SP2, int KC, int LDAC, bool F16 = false>
__device__ __forceinline__ void gemm_phase(int widk, PG8_LAS unsigned char* lds, const Gemm g, const Sched& S, const Epi& E) {
    int lane_; asm volatile("v_mbcnt_lo_u32_b32 %0, -1, 0\n\tv_mbcnt_hi_u32_b32 %0, -1, %0" : "=v"(lane_));
    int wid_ = widk; asm volatile("" : "+s"(wid_));
    const int wid = wid_, lane = lane_, tid = wid * 64 + lane, wr = wid >> 2, wc = wid & 3, fr = lane & 15, fq = lane >> 4;
    constexpr int K = KC, nt = K / BK;
    unsigned voffA[2], voffB[2];
#pragma unroll
    for (int i = 0; i < 2; ++i) { int R, C; stage_rc(tid * 16 + i * 8192, R, C); const int Rb = Epi::PERM ? ((R & ~31) + perm32(R & 31)) : R;
        voffA[i] = (unsigned)(R * LDAC + C) * 2u; voffB[i] = (unsigned)(Rb * K + C) * 2u; }
    const size_t kstep = (size_t)(BK * 2);
    const size_t hstepA = (size_t)HALF * LDAC * 2, hstepB = (size_t)HALF * K * 2;
    const size_t tstepA = 2 * hstepA, tstepB = 2 * hstepB;
    const unsigned ldsw = (unsigned)wid * 1024u;
    const int aoff = lds_byte(wr * 64 + fr, fq * 8), boff = lds_byte(wc * 32 + fr, fq * 8);
#define PG8_SA(b, h) (((b) * 2 + (h)) * HTB)
#define PG8_SB(b, h) ((4 + (b) * 2 + (h)) * HTB)
#define PG8_STAGE(bufoff, gbase, voff) do { _Pragma("unroll") for (int _i = 0; _i < 2; ++_i) \
        __builtin_amdgcn_global_load_lds((const unsigned*)((const char*)(gbase) + (voff)[_i]), (PG8_LAS unsigned*)(lds + (bufoff) + ldsw + _i * 8192), 16, 0, 0); } while (0)
#define PG8_LDA(dst, b, h) do { _Pragma("unroll") for (int m = 0; m < 4; ++m) _Pragma("unroll") for (int k = 0; k < 2; ++k) dst[m][k] = *(const PG8_LAS bf16x8*)(lds + PG8_SA(b, h) + aoff + m * 2048 + k * 1024); } while (0)
#define PG8_LDB(dst, b, h) do { _Pragma("unroll") for (int n = 0; n < 2; ++n) _Pragma("unroll") for (int k = 0; k < 2; ++k) dst[n][k] = *(const PG8_LAS bf16x8*)(lds + PG8_SB(b, h) + boff + n * 2048 + k * 1024); } while (0)
#define PG8_MMA(ai, bj, At, Bt) do { __builtin_amdgcn_s_setprio(1); _Pragma("unroll") for (int m = 0; m < 4; ++m) _Pragma("unroll") for (int n = 0; n < 2; ++n) _Pragma("unroll") for (int k = 0; k < 2; ++k) \
        acc[ai][bj][m][n] = mma16<F16>(Bt[n][k], At[m][k], acc[ai][bj][m][n]); __builtin_amdgcn_s_setprio(0); } while (0)
#define PG8_WAIT_V(n) asm volatile("s_waitcnt vmcnt(" #n ")" ::: "memory")
#define PG8_WAIT_L(n) asm volatile("s_waitcnt lgkmcnt(" #n ")" ::: "memory")
#define PG8_BAR __builtin_amdgcn_s_barrier()
#define PG8_SCHED __builtin_amdgcn_sched_barrier(0)
    Unit cur, nxt; int ui = 0;
    if (!S.next(0, cur)) return;
    f32x4 acc[2][2][4][2];
#pragma unroll
    for (int a = 0; a < 2; ++a)
#pragma unroll
        for (int b = 0; b < 2; ++b)
#pragma unroll
            for (int m = 0; m < 4; ++m)
#pragma unroll
                for (int n = 0; n < 2; ++n) acc[a][b][m][n] = (f32x4){0.f, 0.f, 0.f, 0.f};
    bf16x8 At[4][2], B0[2][2], B1[2][2];
    const char* cA = (const char*)g.A + (size_t)cur.pm * tstepA; const char* cB = (const char*)g.Bt + (size_t)cur.pn * tstepB;
    S.a_ready(cur);
    if constexpr (SP2) {
        PG8_STAGE(PG8_SB(0, 0), cB, voffB); PG8_STAGE(PG8_SB(0, 1), cB + hstepB, voffB); PG8_STAGE(PG8_SA(0, 0), cA, voffA); PG8_STAGE(PG8_SA(0, 1), cA + hstepA, voffA);
        if (wr == 1) PG8_BAR;
        PG8_WAIT_V(2); PG8_BAR;
        PG8_STAGE(PG8_SB(1, 0), cB + kstep, voffB); PG8_STAGE(PG8_SA(1, 0), cA + kstep, voffA); PG8_STAGE(PG8_SB(1, 1), cB + hstepB + kstep, voffB);
        PG8_WAIT_V(6); PG8_BAR;
    } else {
        PG8_STAGE(PG8_SB(0, 0), cB, voffB); PG8_STAGE(PG8_SA(0, 0), cA, voffA); PG8_STAGE(PG8_SB(0, 1), cB + hstepB, voffB); PG8_STAGE(PG8_SA(0, 1), cA + hstepA, voffA);
        if (wr == 1) PG8_BAR;
        PG8_WAIT_V(4); PG8_BAR;
        PG8_STAGE(PG8_SB(1, 0), cB + kstep, voffB); PG8_STAGE(PG8_SA(1, 0), cA + kstep, voffA); PG8_STAGE(PG8_SB(1, 1), cB + hstepB + kstep, voffB);
        PG8_WAIT_V(6); PG8_BAR;
    }
    for (;;) {
        const bool has_next = S.next(ui + 1, nxt);
        const char* nA = has_next ? (const char*)g.A + (size_t)nxt.pm * tstepA : cA; const char* nB = has_next ? (const char*)g.Bt + (size_t)nxt.pn * tstepB : cB;
        for (int t = 0; t < nt; t += 2) {
            const bool last = (t == nt - 2);
            const char* a1 = cA + (size_t)(t + 1) * kstep;
            const char* a2 = last ? nA : cA + (size_t)(t + 2) * kstep; const char* b2 = last ? nB : cB + (size_t)(t + 2) * kstep;
            const char* a3 = a2 + kstep; const char* b3 = b2 + kstep;
            if (last && has_next) S.a_ready(nxt);
            if constexpr (SP2) {
            PG8_LDB(B0, 0, 0); PG8_LDB(B1, 0, 1); PG8_SCHED; PG8_LDA(At, 0, 0); PG8_STAGE(PG8_SA(1, 1), a1 + hstepA, voffA);
            PG8_WAIT_V(8); PG8_WAIT_L(0); PG8_BAR; PG8_MMA(0, 0, At, B0); PG8_MMA(0, 1, At, B1); PG8_BAR; PG8_SCHED;
            PG8_LDA(At, 0, 1); PG8_STAGE(PG8_SB(0, 0), b2, voffB); PG8_STAGE(PG8_SB(0, 1), b2 + hstepB, voffB); PG8_STAGE(PG8_SA(0, 0), a2, voffA);
            PG8_WAIT_V(8); PG8_WAIT_L(0); PG8_BAR; PG8_MMA(1, 0, At, B0); PG8_MMA(1, 1, At, B1); PG8_BAR; PG8_SCHED;
            PG8_LDB(B0, 1, 0); PG8_LDB(B1, 1, 1); PG8_SCHED; PG8_LDA(At, 1, 0); PG8_STAGE(PG8_SA(0, 1), a2 + hstepA, voffA);
            PG8_WAIT_V(8); PG8_WAIT_L(0); PG8_BAR; PG8_MMA(0, 0, At, B0); PG8_MMA(0, 1, At, B1); PG8_BAR; PG8_SCHED;
            PG8_LDA(At, 1, 1); PG8_STAGE(PG8_SB(1, 0), b3, voffB); PG8_STAGE(PG8_SB(1, 1), b3 + hstepB, voffB); PG8_STAGE(PG8_SA(1, 0), a3, voffA);
            PG8_WAIT_V(8); PG8_WAIT_L(0); PG8_BAR; PG8_MMA(1, 0, At, B0); PG8_MMA(1, 1, At, B1); PG8_BAR; PG8_SCHED;
            } else {
            PG8_LDB(B0, 0, 0); PG8_SCHED; PG8_LDA(At, 0, 0); PG8_STAGE(PG8_SA(1, 1), a1 + hstepA, voffA);
            PG8_WAIT_L(8); PG8_BAR; PG8_WAIT_L(0); PG8_MMA(0, 0, At, B0); PG8_BAR; PG8_SCHED;
            PG8_LDB(B1, 0, 1); PG8_STAGE(PG8_SB(0, 0), b2, voffB);
            PG8_BAR; PG8_WAIT_L(0); PG8_MMA(0, 1, At, B1); PG8_BAR;
            PG8_LDA(At, 0, 1); PG8_STAGE(PG8_SA(0, 0), a2, voffA);
            PG8_BAR; PG8_WAIT_L(0); PG8_MMA(1, 0, At, B0); PG8_BAR; PG8_SCHED;
            PG8_STAGE(PG8_SB(0, 1), b2 + hstepB, voffB);
            PG8_WAIT_V(6); PG8_BAR; PG8_MMA(1, 1, At, B1); PG8_BAR;
            PG8_LDB(B0, 1, 0); PG8_SCHED; PG8_LDA(At, 1, 0); PG8_STAGE(PG8_SA(0, 1), a2 + hstepA, voffA);
            PG8_WAIT_L(8); PG8_BAR; PG8_WAIT_L(0); PG8_MMA(0, 0, At, B0); PG8_BAR; PG8_SCHED;
            PG8_LDB(B1, 1, 1); PG8_STAGE(PG8_SB(1, 0), b3, voffB);
            PG8_BAR; PG8_WAIT_L(0); PG8_MMA(0, 1, At, B1); PG8_BAR;
            PG8_LDA(At, 1, 1); PG8_STAGE(PG8_SA(1, 0), a3, voffA);
            PG8_BAR; PG8_WAIT_L(0); PG8_MMA(1, 0, At, B0); PG8_BAR; PG8_SCHED;
            PG8_STAGE(PG8_SB(1, 1), b3 + hstepB, voffB);
            PG8_WAIT_V(6); PG8_BAR; PG8_MMA(1, 1, At, B1); PG8_BAR;
            }
        }
        if constexpr (ALIGN_EPI) { if (wr == 0) PG8_BAR; }
        if constexpr (!Epi::AFTER_DRAIN) { E(acc, cur, wr, wc, fr, fq); S.done(cur); }
        if (!has_next) break;
#pragma unroll
        for (int a = 0; a < 2; ++a)
#pragma unroll
            for (int b = 0; b < 2; ++b)
#pragma unroll
                for (int m = 0; m < 4; ++m)
#pragma unroll
                    for (int n = 0; n < 2; ++n) acc[a][b][m][n] = (f32x4){0.f, 0.f, 0.f, 0.f};
        cur = nxt; cA = nA; cB = nB; ++ui;
        if constexpr (ALIGN_EPI) { if (wr == 1) PG8_BAR; }
    }
    PG8_WAIT_V(0);
    if constexpr (!ALIGN_EPI) { if (wr == 0) PG8_BAR; }
    PG8_BAR;
    if constexpr (Epi::AFTER_DRAIN) { E.fused(acc, cur, wr, wc, fr, fq, lds, wid, lane); S.done(cur); }
#undef PG8_SA
#undef PG8_SB
#undef PG8_STAGE
#undef PG8_LDA
#undef PG8_LDB
#undef PG8_MMA
#undef PG8_WAIT_V
#undef PG8_WAIT_L
#undef PG8_BAR
#undef PG8_SCHED
}
}

#ifdef NO_GEMMB
#define PH_GEMMB if (0)
#else
#define PH_GEMMB
#endif
#ifdef NO_GEMMR
#define PH_GEMMR if (0)
#else
#define PH_GEMMR
#endif
namespace mk {
#define LAS __attribute__((address_space(3)))
typedef unsigned short bf16_t;
typedef short bf16x8 __attribute__((ext_vector_type(8)));
typedef short s16x4 __attribute__((ext_vector_type(4)));
typedef float f32x4 __attribute__((ext_vector_type(4)));
typedef float f32x16 __attribute__((ext_vector_type(16)));
typedef unsigned u32x4 __attribute__((ext_vector_type(4)));
typedef unsigned u32x2 __attribute__((ext_vector_type(2)));
using pg8::cvt_pk_bf16;

constexpr int NB = 32, T = 2048, D = 1024, M = NB * T, DEPTH = 4;
constexpr int NWAVES = 8, NTHR = 512;
constexpr int GDN_N = 4112, GDN_NMAIN = 4096, DIFF_N = 3072, FFN_H = 2816, FFN_N = 5632;
constexpr float LN_EPS = 1e-5f, RMS_EPS = 1e-6f;
constexpr float ALPHA = 1.6817928305074290f;
constexpr float LOG2E = 1.4426950408889634f;
constexpr int MH = M / 2;

constexpr size_t MiB = 1u << 20;
constexpr size_t WS_W = 2 * MiB;
constexpr size_t W_GWIN = 0, W_GWAB = W_GWIN + 2ull * 4096 * 1024 * 2, W_GWOUT = W_GWAB + 2ull * 16 * 1024 * 2, W_DWIN = W_GWOUT + 2ull * 1024 * 1024 * 2,
                 W_DWOUT = W_DWIN + 2ull * 3072 * 1024 * 2, W_FUP = W_DWOUT + 2ull * 1024 * 1024 * 2, W_FDOWN = W_FUP + 4ull * 5632 * 1024 * 2, W_END = W_FDOWN + 4ull * 1024 * 2816 * 2;
static_assert(WS_W + W_END <= 106 * MiB, "weights region");
constexpr size_t WS_CNT = 16384;
constexpr size_t WS_CTL_BYTES = 16384 + 8 * 256 * 16 * 4;
constexpr size_t WS_XBUF = 110 * MiB;
constexpr size_t WS_GB = 106 * MiB;
constexpr size_t WS_XN = 112 * MiB;
static_assert(WS_CTL_BYTES <= WS_W && WS_XBUF + 256ull * 4 * 256 * 2 * 4 <= WS_XN && WS_GB + 2ull * 65536 * 8 * 4 <= WS_XBUF, "small-buffer map");
constexpr size_t WS_H = 240 * MiB;
constexpr size_t WS_ACT = WS_H;
constexpr size_t WS_HALO = WS_H + 352 * MiB;
constexpr size_t WS_HALO2 = WS_HALO + 12 * MiB;
constexpr size_t WS_UT = WS_H + 512 * MiB;
constexpr size_t WS_WN = WS_UT + 128 * MiB;
constexpr size_t WS_VT = WS_H + 384 * MiB;
constexpr size_t WS_O = WS_VT + 128 * MiB;
constexpr size_t WS_ROPE = WS_WN + 128 * MiB;
constexpr size_t WS_END = WS_ROPE + 16 * MiB;
static_assert(WS_END <= 1024 * MiB, "workspace map");
constexpr int LDS_BYTES = 131072 + 2048 + 10240;

__device__ __forceinline__ float bf2f(unsigned short h) { return __uint_as_float((unsigned)h << 16); }
__device__ __forceinline__ unsigned short f2bf(float f) { return (unsigned short)(cvt_pk_bf16(f, 0.f) & 0xffffu); }
__device__ __forceinline__ float wave_sum(float v) {
#pragma unroll
    for (int o = 1; o < 64; o <<= 1) v += __shfl_xor(v, o);
    return v;
}
__device__ __forceinline__ float silu(float x) { return x * __builtin_amdgcn_rcpf(1.f + __expf(-x)); }
__device__ __forceinline__ void unpack8(const u32x4 v, float (&o)[8]) {
    o[0] = __uint_as_float(v.x << 16); o[1] = __uint_as_float(v.x & 0xffff0000u); o[2] = __uint_as_float(v.y << 16); o[3] = __uint_as_float(v.y & 0xffff0000u);
    o[4] = __uint_as_float(v.z << 16); o[5] = __uint_as_float(v.z & 0xffff0000u); o[6] = __uint_as_float(v.w << 16); o[7] = __uint_as_float(v.w & 0xffff0000u);
}
__device__ __forceinline__ u32x4 pack8(const float (&o)[8]) { u32x4 w; w.x = cvt_pk_bf16(o[0], o[1]); w.y = cvt_pk_bf16(o[2], o[3]); w.z = cvt_pk_bf16(o[4], o[5]); w.w = cvt_pk_bf16(o[6], o[7]); return w; }
__device__ __forceinline__ int crow(int r, int hi) { return (r & 3) + 8 * (r >> 2) + 4 * hi; }
#define LDS_WAIT() asm volatile("s_waitcnt lgkmcnt(0)" ::: "memory")
#define MK_IDS() int lane_; asm volatile("v_mbcnt_lo_u32_b32 %0, -1, 0\n\tv_mbcnt_hi_u32_b32 %0, -1, %0" : "=v"(lane_));   \
      \
    int wid_ = widk; asm volatile("" : "+s"(wid_)); const int lane = lane_, wid = wid_, tid = wid * 64 + lane; const int G_ = gridDim.x, gw = blockIdx.x * NWAVES + wid, NGW = G_ * NWAVES, gt = blockIdx.x * NTHR + tid, NGT = G_ * NTHR; \
    (void)lane; (void)wid; (void)gw; (void)NGW; (void)gt; (void)NGT

template <int UPPERM = 0, bool F16OUT = false> __device__ __forceinline__ void transpose_item(const float* W, int ldw, int K, int nblk, bf16_t* WT, LAS float* scr, int item, int lane) {
    const int kb = item / nblk, nb = item % nblk, k0 = 64 * kb, n0 = 32 * nb;
    const int r0 = UPPERM == 1 ? (n0 < FFN_H ? 256 * (n0 >> 7) + (n0 & 127) : 256 * ((n0 - FFN_H) >> 7) + 128 + ((n0 - FFN_H) & 127))
                 : UPPERM == 2 ? (n0 < 2048 ? (n0 & ~255) + 128 * ((n0 >> 5) & 1) + 32 * ((n0 >> 6) & 3) : n0) : n0;
#pragma unroll 8
    for (int i = 0; i < 32; ++i) { const int kk = 2 * i + (lane >> 5); scr[kk * 33 + (lane & 31)] = W[(size_t)(k0 + kk) * ldw + n0 + (lane & 31)]; }
    LDS_WAIT();
    const int c = lane & 7;
#pragma unroll
    for (int j = 0; j < 4; ++j) { const int n = (lane >> 3) + 8 * j; const LAS float* s = scr + (8 * c) * 33 + n;
        u32x4 o;
        if constexpr (F16OUT) { o.x = pg8::cvt_pk_f16(s[0 * 33], s[1 * 33]); o.y = pg8::cvt_pk_f16(s[2 * 33], s[3 * 33]); o.z = pg8::cvt_pk_f16(s[4 * 33], s[5 * 33]); o.w = pg8::cvt_pk_f16(s[6 * 33], s[7 * 33]); }
        else { o.x = cvt_pk_bf16(s[0 * 33], s[1 * 33]); o.y = cvt_pk_bf16(s[2 * 33], s[3 * 33]); o.z = cvt_pk_bf16(s[4 * 33], s[5 * 33]); o.w = cvt_pk_bf16(s[6 * 33], s[7 * 33]); }
        *(u32x4*)(WT + (size_t)(r0 + n) * K + k0 + 8 * c) = o; }
    LDS_WAIT();
}

#define XB_TMO      128
#define XB_XCNT(j)  (256  + 64 * (j))
#define XB_XSUB(j)  (1280 + 64 * (j))
#define XB_XGEN(j)  (2304 + 64 * (j))
#define XB_TOP      3328
#define XB_TOPGEN   3392
#define XCD_BAR_WORDS 3456
#define XB_SPIN_CAP (1u << 18)

__device__ __forceinline__ unsigned xb_ld(unsigned* p)              { return __hip_atomic_load(p, __ATOMIC_RELAXED, __HIP_MEMORY_SCOPE_AGENT); }
__device__ __forceinline__ unsigned xb_add(unsigned* p, unsigned v) { return __hip_atomic_fetch_add(p, v, __ATOMIC_RELAXED, __HIP_MEMORY_SCOPE_AGENT); }
__device__ __forceinline__ unsigned xb_xcc_id() { return (unsigned)__builtin_amdgcn_s_getreg((3 << 11) | 20) & 0xFu; }
#define XB_SPIN(cond, bar) do { unsigned _sp = 0; while (cond) { __builtin_amdgcn_s_sleep(1); \
    if ((++_sp & 255u) == 0u) { if (xb_ld(&(bar)[XB_TMO])) break; if (_sp > XB_SPIN_CAP) { atomicAdd(&(bar)[XB_TMO], 1u); break; } } } } while (0)

struct XcdBarrier {
    unsigned* bar; unsigned x;
    volatile LAS unsigned* st;
};

__device__ __forceinline__ XcdBarrier xcd_barrier_post(unsigned* bar, volatile LAS unsigned* st) {
    XcdBarrier b; b.bar = bar; b.x = xb_xcc_id(); b.st = st;
    if (threadIdx.x == 0) (void)xb_add(&bar[XB_XCNT(b.x)], 1u);
    return b;
}
__device__ __forceinline__ void xcd_barrier_complete(unsigned* bar, unsigned x, unsigned& nloc, unsigned& nx) {
    const unsigned G = gridDim.x * gridDim.y * gridDim.z;
    unsigned sum, cnt, mine, sp = 0u;
    for (;;) {
        sum = 0u; cnt = 0u; mine = 0u;
#pragma unroll
        for (unsigned j = 0; j < 16; ++j) { const unsigned c = xb_ld(&bar[XB_XCNT(j)]); sum += c; cnt += (c > 0u) ? 1u : 0u; mine = (j == x) ? c : mine; }
        if (sum == G) break;
        __builtin_amdgcn_s_sleep(1);
        if ((++sp & 255u) == 0u) { if (xb_ld(&bar[XB_TMO])) break; if (sp > XB_SPIN_CAP) { atomicAdd(&bar[XB_TMO], 1u); break; } }
    }
    nloc = mine > 0u ? mine : 1u; nx = cnt > 0u ? cnt : 1u;
}

__device__ __forceinline__ void xcd_barrier(const XcdBarrier& b, int widk) {
    asm volatile("s_waitcnt vmcnt(0)" ::: "memory");
    __syncthreads();
    int xl_; asm volatile("v_mbcnt_lo_u32_b32 %0, -1, 0\n\tv_mbcnt_hi_u32_b32 %0, -1, %0" : "=v"(xl_));
    if (widk == 0 && xl_ == 0) {
        unsigned* bar = b.bar;
        __builtin_amdgcn_s_waitcnt(0);
        unsigned nloc = b.st[0], nx = b.st[1];
        if (nloc == 0u) { xcd_barrier_complete(bar, b.x, nloc, nx); b.st[0] = nloc; b.st[1] = nx; }
        const unsigned old = xb_add(&bar[XB_XSUB(b.x)], 1u);
        const unsigned gen = old / nloc;
        if (old + 1u == (gen + 1u) * nloc) {
            __builtin_amdgcn_fence(__ATOMIC_RELEASE, "agent");
            asm volatile("s_waitcnt vmcnt(0)" ::: "memory");
            const unsigned og = xb_add(&bar[XB_TOP], 1u);
            const unsigned tg = og / nx;
            if (og + 1u == (tg + 1u) * nx) xb_add(&bar[XB_TOPGEN], 1u);
            else XB_SPIN(xb_ld(&bar[XB_TOPGEN]) == tg, bar);
            __builtin_amdgcn_fence(__ATOMIC_ACQUIRE, "agent");
            xb_add(&bar[XB_XGEN(b.x)], 1u);
            asm volatile("s_waitcnt vmcnt(0)" ::: "memory");
        } else {
            XB_SPIN(xb_ld(&bar[XB_XGEN(b.x)]) == gen, bar);
            __builtin_amdgcn_fence(__ATOMIC_ACQUIRE, "agent");
            asm volatile("s_waitcnt vmcnt(0)" ::: "memory");
        }
    }
    __syncthreads();
}

struct Params {
    const float* in[23];
    const int* positions;
    float* out;
    unsigned char* ws;
};

__device__ __forceinline__ void prologue(int widk, const Params& p, LAS unsigned char* lds) {
    MK_IDS(); const int wave = wid;
    LAS float* scr = (LAS float*)(lds + wave * 16384);
    unsigned char* wsw = p.ws + WS_W;
    constexpr int I_GWIN = 16 * 128, I_SQ = 16 * 32, I_DWIN = 16 * 96, I_FUP = 16 * 176, I_FDN = 44 * 32;
    constexpr int NITEMS = 2 * I_GWIN + 2 * I_SQ + 2 * I_DWIN + 2 * I_SQ + 4 * I_FUP + 4 * I_FDN;
    for (int it = gw; it < NITEMS; it += NGW) {
        int r = it;
        if (r < 2 * I_GWIN) { const int j = r / I_GWIN; r %= I_GWIN; transpose_item<0, true>(p.in[2] + (size_t)j * 1024 * GDN_N, GDN_N, 1024, 128, (bf16_t*)(wsw + W_GWIN) + (size_t)j * 4096 * 1024, scr, r, lane); continue; } r -= 2 * I_GWIN;
        if (r < 2 * I_SQ) { const int j = r / I_SQ; r %= I_SQ; transpose_item(p.in[7] + (size_t)j * 1024 * 1024, 1024, 1024, 32, (bf16_t*)(wsw + W_GWOUT) + (size_t)j * 1024 * 1024, scr, r, lane); continue; } r -= 2 * I_SQ;
        if (r < 2 * I_DWIN) { const int j = r / I_DWIN; r %= I_DWIN; transpose_item<2, true>(p.in[8] + (size_t)j * 1024 * DIFF_N, DIFF_N, 1024, 96, (bf16_t*)(wsw + W_DWIN) + (size_t)j * 3072 * 1024, scr, r, lane); continue; } r -= 2 * I_DWIN;
        if (r < 2 * I_SQ) { const int j = r / I_SQ; r %= I_SQ; transpose_item(p.in[14] + (size_t)j * 1024 * 1024, 1024, 1024, 32, (bf16_t*)(wsw + W_DWOUT) + (size_t)j * 1024 * 1024, scr, r, lane); continue; } r -= 2 * I_SQ;
        if (r < 4 * I_FUP) { const int j = r / I_FUP; r %= I_FUP; transpose_item<1, true>(p.in[15] + (size_t)j * 1024 * FFN_N, FFN_N, 1024, 176, (bf16_t*)(wsw + W_FUP) + (size_t)j * 5632 * 1024, scr, r, lane); continue; } r -= 4 * I_FUP;
        { const int j = r / I_FDN; r %= I_FDN; transpose_item(p.in[18] + (size_t)j * 2816 * 1024, 1024, 2816, 32, (bf16_t*)(wsw + W_FDOWN) + (size_t)j * 1024 * 2816, scr, r, lane); }
    }
    for (int e = gt; e < 2 * 16 * 1024; e += NGT) { const int j = e >> 14, n = (e >> 10) & 15, k = e & 1023;
        ((bf16_t*)(wsw + W_GWAB))[e] = (unsigned short)(pg8::cvt_pk_f16(p.in[2][(size_t)j * 1024 * GDN_N + (size_t)k * GDN_N + GDN_NMAIN + n], 0.f) & 0xffffu); }
    { unsigned* CS = (unsigned*)(p.ws + WS_ROPE);
      for (int e = gt; e < M * 32; e += NGT) { const int m = e >> 5, f = e & 31; const float inv = exp2f(-(float)f * (13.287712379549449f / 32.f)); float sn, cs; sincosf((float)p.positions[m] * inv, &sn, &cs); CS[e] = pg8::cvt_pk_f16(cs, sn); } }
    const f32x4* x4 = (const f32x4*)p.in[0]; u32x4* xn = (u32x4*)(p.ws + WS_XN);
    for (int e = gt; e < M * D / 8; e += NGT) { const f32x4 a = x4[2 * e], b = x4[2 * e + 1]; u32x4 w; w.x = pg8::cvt_pk_f16(a[0], a[1]); w.y = pg8::cvt_pk_f16(a[2], a[3]); w.z = pg8::cvt_pk_f16(b[0], b[1]); w.w = pg8::cvt_pk_f16(b[2], b[3]); xn[e] = w; }
}

__device__ __forceinline__ void ln_phase(int widk, float* X, bf16_t* XN, const float* g, const float* b) {
    MK_IDS();
    f32x4 gv[4], bv[4];
#pragma unroll
    for (int j = 0; j < 4; ++j) { gv[j] = ((const f32x4*)g)[lane + 64 * j]; bv[j] = ((const f32x4*)b)[lane + 64 * j]; }
    for (int m = gw; m < M; m += NGW) {
        f32x4* xr = (f32x4*)(X + (size_t)m * D) + lane;
        f32x4 v[4]; float s = 0.f;
#pragma unroll
        for (int j = 0; j < 4; ++j) { v[j] = xr[64 * j]; s += (v[j][0] + v[j][1]) + (v[j][2] + v[j][3]); }
        const float mean = wave_sum(s) * (1.f / D); float s2 = 0.f;
#pragma unroll
        for (int j = 0; j < 4; ++j) { v[j] = v[j] - mean; s2 += (v[j][0] * v[j][0] + v[j][1] * v[j][1]) + (v[j][2] * v[j][2] + v[j][3] * v[j][3]); }
        const float rstd = 1.f / sqrtf(wave_sum(s2) * (1.f / D) + LN_EPS);
        u32x2* o8 = (u32x2*)(XN + (size_t)m * D) + lane;
#pragma unroll
        for (int j = 0; j < 4; ++j) { const f32x4 o = v[j] * rstd * gv[j] + bv[j]; xr[64 * j] = o; u32x2 w; w.x = pg8::cvt_pk_f16(o[0], o[1]); w.y = pg8::cvt_pk_f16(o[2], o[3]); o8[64 * j] = w; }
    }
}

__device__ __forceinline__ void ffn_fixup_phase(int widk, bf16_t* ACT, const float* HALO, const float* HALO2, const float* cw, const float* cb) {
    MK_IDS();
    constexpr int NCG = FFN_H / 4;
    for (int item = gt; item < (M / 256) * NCG; item += NGT) {
        const int pm = item / NCG, col = (item % NCG) * 4;
        if ((pm & 7) == 0) continue;
        f32x4 wa[3], wb[3];
#pragma unroll
        for (int j = 0; j < 3; ++j) { wa[j] = *(const f32x4*)(cw + j * FFN_N + col); wb[j] = *(const f32x4*)(cw + j * FFN_N + FFN_H + col); }
        const f32x4 ba = *(const f32x4*)(cb + col), bb = *(const f32x4*)(cb + FFN_H + col);
        const float* hp = HALO + (size_t)(pm - 1) * 2 * FFN_N + col; const float* h2 = HALO2 + (size_t)pm * 2 * FFN_N + col;
        const f32x4 am2 = *(const f32x4*)hp, am1 = *(const f32x4*)(hp + FFN_N), a0 = *(const f32x4*)h2, a1 = *(const f32x4*)(h2 + FFN_N);
        const f32x4 bm2 = *(const f32x4*)(hp + FFN_H), bm1 = *(const f32x4*)(hp + FFN_N + FFN_H), b0 = *(const f32x4*)(h2 + FFN_H), b1 = *(const f32x4*)(h2 + FFN_N + FFN_H);
        float o0[4], o1[4];
#pragma unroll
        for (int e = 0; e < 4; ++e) {
            o0[e] = silu(wa[0][e] * am2[e] + wa[1][e] * am1[e] + wa[2][e] * a0[e] + ba[e]) * (wb[0][e] * bm2[e] + wb[1][e] * bm1[e] + wb[2][e] * b0[e] + bb[e]);
            o1[e] = silu(wa[0][e] * am1[e] + wa[1][e] * a0[e] + wa[2][e] * a1[e] + ba[e]) * (wb[0][e] * bm1[e] + wb[1][e] * b0[e] + wb[2][e] * b1[e] + bb[e]);
        }
        u32x2 w; w.x = cvt_pk_bf16(o0[0], o0[1]); w.y = cvt_pk_bf16(o0[2], o0[3]); *(u32x2*)(ACT + (size_t)(pm * 256) * FFN_H + col) = w;
        w.x = cvt_pk_bf16(o1[0], o1[1]); w.y = cvt_pk_bf16(o1[2], o1[3]); *(u32x2*)(ACT + (size_t)(pm * 256 + 1) * FFN_H + col) = w;
    }
}

__device__ __forceinline__ void gdn_ab_phase(int widk, const bf16_t* XN, const bf16_t* wabT  , const float* a_log, const float* dt_bias, float* G, float* BETA) {
    MK_IDS();
    const int n = lane & 15, q4 = lane >> 4, h = n & 7;
    const float al = -__expf(a_log[h]), db = dt_bias[h];
    for (int it = gw; it < M / 16; it += NGW) {
        const int m0 = it * 16;
        f32x4 acc = {0.f, 0.f, 0.f, 0.f};
        const bf16_t* ap = XN + (size_t)(m0 + n) * D + 8 * q4;
        const bf16_t* bp = wabT + (size_t)n * D + 8 * q4;
#pragma unroll 8
        for (int ks = 0; ks < 32; ++ks) { const bf16x8 a = *(const bf16x8*)(ap + 32 * ks), b = *(const bf16x8*)(bp + 32 * ks); acc = pg8::mma16<true>(a, b, acc); }
#pragma unroll
        for (int i = 0; i < 4; ++i) { const int m = m0 + 4 * q4 + i; const float v = acc[i];
            if (n < 8) { const float x = v + db; const float sp = x > 20.f ? x : log1pf(__expf(x)); G[(size_t)m * 8 + h] = al * sp; }
            else BETA[(size_t)m * 8 + h] = 1.f / (1.f + __expf(-v)); }
    }
}

__device__ __forceinline__ void conv_silu16(const bf16_t* hp, int t, const LAS float* cw, float (&y)[16]) {
#pragma unroll
    for (int c = 0; c < 16; ++c) y[c] = 0.f;
#pragma unroll
    for (int j = 0; j < 4; ++j) {
        if (t - 3 + j >= 0) {
            float x[16];
            const bf16_t* rp = hp + (ptrdiff_t)(j - 3) * GDN_NMAIN;
            { float t8[8]; unpack8(*(const u32x4*)rp, t8);
#pragma unroll
              for (int c = 0; c < 8; ++c) x[c] = t8[c];
              unpack8(*(const u32x4*)(rp + 8), t8);
#pragma unroll
              for (int c = 0; c < 8; ++c) x[8 + c] = t8[c]; }
#pragma unroll
            for (int q = 0; q < 4; ++q) { const f32x4 w = *(const LAS f32x4*)(cw + j * 128 + 4 * q);
#pragma unroll
                for (int e = 0; e < 4; ++e) y[4 * q + e] += w[e] * x[4 * q + e]; }
        }
    }
#pragma unroll
    for (int c = 0; c < 16; ++c) y[c] = silu(y[c]);
}
__device__ __forceinline__ float sumsq16_8lanes(const float (&y)[16]) {
    float s = 0.f;
#pragma unroll
    for (int c = 0; c < 16; ++c) s += y[c] * y[c];
    s += __shfl_xor(s, 1); s += __shfl_xor(s, 2); s += __shfl_xor(s, 4);
    return s;
}
__device__ __forceinline__ void pack16(const float (&y)[16], u32x4& a, u32x4& b) {
    a.x = cvt_pk_bf16(y[0], y[1]); a.y = cvt_pk_bf16(y[2], y[3]); a.z = cvt_pk_bf16(y[4], y[5]); a.w = cvt_pk_bf16(y[6], y[7]);
    b.x = cvt_pk_bf16(y[8], y[9]); b.y = cvt_pk_bf16(y[10], y[11]); b.z = cvt_pk_bf16(y[12], y[13]); b.w = cvt_pk_bf16(y[14], y[15]);
}
__device__ __forceinline__ void unpack16(const u32x4 a, const u32x4 b, float (&y)[16]) {
    float t8[8]; unpack8(a, t8);
#pragma unroll
    for (int c = 0; c < 8; ++c) y[c] = t8[c];
    unpack8(b, t8);
#pragma unroll
    for (int c = 0; c < 8; ++c) y[8 + c] = t8[c];
}
__device__ __forceinline__ bf16x8 lds_frag16(const LAS unsigned char* p) { return *(const LAS bf16x8*)p; }
__device__ __forceinline__ bf16x8 lds_frag8x2(const LAS unsigned char* p0, const LAS unsigned char* p1) {
    const s16x4 a = *(const volatile LAS s16x4*)p0, b = *(const volatile LAS s16x4*)p1; return (bf16x8){a[0], a[1], a[2], a[3], b[0], b[1], b[2], b[3]};
}

constexpr int GA_GC = 0, GA_BT = 256, GA_CW = 512, GA_Q = GA_CW + 3 * 4 * 128 * 4, GA_K = GA_Q + 64 * 272, GA_LT = GA_K + 64 * 272, GA_END = GA_LT + 8 * 8192;
static_assert(GA_END <= 131072 && GA_LT % 16 == 0, "GDN phase A LDS map");
constexpr int GB_GC = 0, GB_BT = 512, GB_Q = 1024,     GB_KB = GB_Q + 64 * 272, GB_VB = GB_KB + 64 * 272, GB_KD = GB_VB + 64 * 272, GB_T = GB_KD + 128 * 144, GB_AT = GB_T + 64 * 144, GB_O = GB_AT + 64 * 144, GB_END = GB_O + 64 * 528;
static_assert(GB_END <= 131072 && GB_O % 16 == 0, "GDN phase B LDS map");

template <int I, int J> __device__ __forceinline__ void inv_row(float& s0, float& s1, const float lr, const float (&t)[64]) {
    if constexpr (J + 8 <= I) {
        int a0, a1, a2, a3, a4, a5, a6, a7;
        asm volatile("v_readlane_b32 %2, %10, %19\n\tv_readlane_b32 %3, %10, %19+1\n\tv_readlane_b32 %4, %10, %19+2\n\tv_readlane_b32 %5, %10, %19+3\n\t"
                     "v_readlane_b32 %6, %10, %19+4\n\tv_readlane_b32 %7, %10, %19+5\n\tv_readlane_b32 %8, %10, %19+6\n\tv_readlane_b32 %9, %10, %19+7\n\t"
                     "v_fma_f32 %0, -%11, %2, %0\n\tv_fma_f32 %1, -%12, %3, %1\n\tv_fma_f32 %0, -%13, %4, %0\n\tv_fma_f32 %1, -%14, %5, %1\n\t"
                     "v_fma_f32 %0, -%15, %6, %0\n\tv_fma_f32 %1, -%16, %7, %1\n\tv_fma_f32 %0, -%17, %8, %0\n\tv_fma_f32 %1, -%18, %9, %1"
                     : "+v"(s0), "+v"(s1), "=&s"(a0), "=&s"(a1), "=&s"(a2), "=&s"(a3), "=&s"(a4), "=&s"(a5), "=&s"(a6), "=&s"(a7)
                     : "v"(lr), "v"(t[J]), "v"(t[J + 1]), "v"(t[J + 2]), "v"(t[J + 3]), "v"(t[J + 4]), "v"(t[J + 5]), "v"(t[J + 6]), "v"(t[J + 7]), "i"(J));
        inv_row<I, J + 8>(s0, s1, lr, t);
    } else {
#pragma unroll
        for (int j = J; j < I; ++j) { const float lj = __int_as_float(__builtin_amdgcn_readlane(__float_as_int(lr), j)); if (j & 1) s1 -= lj * t[j]; else s0 -= lj * t[j]; }
    }
}
template <int I0> __device__ __forceinline__ void inv_rows8(const LAS float* Lp, const float flane, float (&t)[64]) {
    float lr[8];
#pragma unroll
    for (int k = 0; k < 8; ++k) lr[k] = Lp[((I0 + k) * (I0 + k - 1)) / 2];
#define INV_ROW(k) { float s0 = 1.f - fminf(fabsf(flane - (float)(I0 + k)), 1.f), s1 = 0.f; inv_row<I0 + k, 0>(s0, s1, lr[k], t); t[I0 + k] = s0 + s1; }
    INV_ROW(0) INV_ROW(1) INV_ROW(2) INV_ROW(3) INV_ROW(4) INV_ROW(5) INV_ROW(6) INV_ROW(7)
#undef INV_ROW
}

__device__ __forceinline__ void gdn_phase_a(int widk, bf16_t* H, const float* G, const float* BETA, const float* convw  , bf16_t* TG, bf16_t* ATT, LAS unsigned char* lds) {
    MK_IDS();
    LAS float* gcs = (LAS float*)(lds + GA_GC); LAS float* bts = (LAS float*)(lds + GA_BT); LAS float* cwl = (LAS float*)(lds + GA_CW);
    for (int bh = blockIdx.x; bh < 256; bh += gridDim.x) {
        const int b = bh >> 3, h = bh & 7;
        __syncthreads();
        for (int e = tid; e < 3 * 4 * 128; e += NTHR) { const int ten = e / 512, tap = (e >> 7) & 3, c = e & 127; cwl[e] = convw[tap * 3072 + ten * 1024 + h * 128 + c]; }
        __syncthreads();
        float gnext = 0.f, bnext = 0.f;
        if (wid == 0) { gnext = G[(size_t)(b * T + 31 * 64 + lane) * 8 + h]; bnext = BETA[(size_t)(b * T + 31 * 64 + lane) * 8 + h]; }
        for (int sg = 3; sg >= 0; --sg) {
            for (int k = 7; k >= 0; --k) {
                const int n = sg * 8 + k, it = n * 256 + bh, m0 = b * T + n * 64;
                if (wid == 0) { float c = gnext;
#pragma unroll
                    for (int o = 1; o < 64; o <<= 1) { const float t = __shfl_up(c, o); if (lane >= o) c += t; }
                    gcs[lane] = c; bts[lane] = bnext;
                    if (n > 0) { gnext = G[(size_t)(m0 - 64 + lane) * 8 + h]; bnext = BETA[(size_t)(m0 - 64 + lane) * 8 + h]; } }
                const int r = tid >> 3, c0 = (tid & 7) * 16, t = n * 64 + r; bf16_t* hp = H + (size_t)(m0 + r) * GDN_NMAIN + h * 128 + c0;
                u32x4 st[6];
                {   float y[16];
                    conv_silu16(hp, t, cwl + c0, y);
                    { const float rinv = rsqrtf(sumsq16_8lanes(y) + RMS_EPS) * 0.08838834764831845f;
#pragma unroll
                      for (int c = 0; c < 16; ++c) y[c] *= rinv; pack16(y, st[0], st[1]); }
                    conv_silu16(hp + 1024, t, cwl + 512 + c0, y);
                    { const float rinv = rsqrtf(sumsq16_8lanes(y) + RMS_EPS);
#pragma unroll
                      for (int c = 0; c < 16; ++c) y[c] *= rinv; pack16(y, st[2], st[3]); }
                    conv_silu16(hp + 2048, t, cwl + 1024 + c0, y);
                    pack16(y, st[4], st[5]);
                    *(LAS u32x4*)(lds + GA_Q + r * 272 + c0 * 2) = st[0]; *(LAS u32x4*)(lds + GA_Q + r * 272 + c0 * 2 + 16) = st[1];
                    *(LAS u32x4*)(lds + GA_K + r * 272 + c0 * 2) = st[2]; *(LAS u32x4*)(lds + GA_K + r * 272 + c0 * 2 + 16) = st[3];
                }
                __syncthreads();
                *(u32x4*)hp = st[0]; *(u32x4*)(hp + 8) = st[1]; *(u32x4*)(hp + 1024) = st[2]; *(u32x4*)(hp + 1024 + 8) = st[3]; *(u32x4*)(hp + 2048) = st[4]; *(u32x4*)(hp + 2048 + 8) = st[5];
                {
                    const int which = wid >> 2, bi = (wid >> 1) & 1, bj = wid & 1, l31 = lane & 31, hi = lane >> 5;
                    LAS float* Lt = (LAS float*)(lds + GA_LT + k * 8192);
                    f32x16 acc = {};
                    if (!(bi == 0 && bj == 1)) {
                        const LAS unsigned char* ap = lds + (which ? GA_Q : GA_K) + (32 * bi + l31) * 272 + hi * 16;
                        const LAS unsigned char* bp = lds + GA_K + (32 * bj + l31) * 272 + hi * 16;
#pragma unroll
                        for (int ks = 0; ks < 8; ++ks) acc = __builtin_amdgcn_mfma_f32_32x32x16_bf16(lds_frag16(ap + ks * 32), lds_frag16(bp + ks * 32), acc, 0, 0, 0);
                    }
                    const int j = 32 * bj + l31; const float gcj = gcs[j];
#pragma unroll
                    for (int rr = 0; rr < 16; ++rr) { const int i = 32 * bi + crow(rr, hi); const float dec = __expf(fminf(gcs[i] - gcj, 0.f));
                        if (which == 0) { if (i > j) Lt[(i * (i - 1)) / 2 + j] = bts[i] * acc[rr] * dec; }
                        else ATT[((size_t)it * 64 + i) * 64 + j] = f2bf((i >= j) ? acc[rr] * dec : 0.f); }
                }
                __syncthreads();
            }
            {
                float t[64]; const float flane = (float)lane;
                const LAS float* Lp = (const LAS float*)(lds + GA_LT + wid * 8192) + lane; asm volatile("" : "+v"(Lp));
                inv_rows8<0>(Lp, flane, t); inv_rows8<8>(Lp, flane, t); inv_rows8<16>(Lp, flane, t); inv_rows8<24>(Lp, flane, t);
                inv_rows8<32>(Lp, flane, t); inv_rows8<40>(Lp, flane, t); inv_rows8<48>(Lp, flane, t); inv_rows8<56>(Lp, flane, t);
                bf16_t* tp = TG + (size_t)((sg * 8 + wid) * 256 + bh) * 4096 + lane;
#pragma unroll
                for (int i = 0; i < 64; ++i) tp[i * 64] = f2bf(t[i]);
            }
        }
    }
    __syncthreads();
}

__device__ __forceinline__ void gdn_phase_b(int widk, bf16_t* H, const float* G, const float* BETA, const float* normw  , const bf16_t* TG, const bf16_t* ATT, LAS unsigned char* lds) {
    MK_IDS();
    LAS float* gcs = (LAS float*)(lds + GB_GC); LAS float* bts = (LAS float*)(lds + GB_BT);
    const int n16 = lane & 15, q4 = lane >> 4;
    for (int bh = blockIdx.x; bh < 256; bh += gridDim.x) {
        const int b = bh >> 3, h = bh & 7;
        f32x4 S[8];
#pragma unroll
        for (int s = 0; s < 8; ++s) S[s] = (f32x4){0.f, 0.f, 0.f, 0.f};
        const int r = tid >> 3, c0 = (tid & 7) * 16;
        u32x4 q0, q1, k0, k1, v0, v1, tt, aa, ga0, ga1; float gval = 0.f, bval = 0.f;
#define GB_LOAD(n_) do { const int it_ = (n_) * 256 + bh, m_ = b * T + (n_) * 64; const bf16_t* hq = H + (size_t)(m_ + r) * GDN_NMAIN + h * 128 + c0; \
            q0 = *(const u32x4*)hq; q1 = *(const u32x4*)(hq + 8); k0 = *(const u32x4*)(hq + 1024); k1 = *(const u32x4*)(hq + 1024 + 8); v0 = *(const u32x4*)(hq + 2048); v1 = *(const u32x4*)(hq + 2048 + 8); \
            ga0 = *(const u32x4*)(hq + 3072); ga1 = *(const u32x4*)(hq + 3072 + 8); \
            tt = ((const u32x4*)(TG + (size_t)it_ * 4096))[tid]; aa = ((const u32x4*)(ATT + (size_t)it_ * 4096))[tid]; \
            if (wid == 0) { gval = G[(size_t)(m_ + lane) * 8 + h]; bval = BETA[(size_t)(m_ + lane) * 8 + h]; } } while (0)
        GB_LOAD(0);
#define GB_CUMSUM(par_) do { if (wid == 0) { float c = gval; _Pragma("unroll") for (int o = 1; o < 64; o <<= 1) { const float t = __shfl_up(c, o); if (lane >= o) c += t; } \
            gcs[(par_) * 64 + lane] = c; bts[(par_) * 64 + lane] = bval; } } while (0)
        GB_CUMSUM(0);
        __syncthreads();
        for (int n = 0; n < 32; ++n) {
            const int m0 = b * T + n * 64, par = n & 1;
            bf16_t* hp = H + (size_t)(m0 + r) * GDN_NMAIN + h * 128 + c0;
            const float glast = gcs[par * 64 + 63];
            {   const float gcr = gcs[par * 64 + r], btr = bts[par * 64 + r], eg = __expf(gcr), ekd = __expf(glast - gcr);
                float y[16]; u32x4 a, bq;
                unpack16(q0, q1, y);
#pragma unroll
                for (int c = 0; c < 16; ++c) y[c] *= eg;
                pack16(y, a, bq); *(LAS u32x4*)(lds + GB_Q + r * 272 + c0 * 2) = a; *(LAS u32x4*)(lds + GB_Q + r * 272 + c0 * 2 + 16) = bq;
                unpack16(k0, k1, y);
#pragma unroll
                for (int c = 0; c < 16; ++c) *(LAS bf16_t*)(lds + GB_KD + (c0 + c) * 144 + r * 2) = f2bf(y[c] * ekd);
                { const float sc = btr * eg;
#pragma unroll
                  for (int c = 0; c < 16; ++c) y[c] *= sc; }
                pack16(y, a, bq); *(LAS u32x4*)(lds + GB_KB + r * 272 + c0 * 2) = a; *(LAS u32x4*)(lds + GB_KB + r * 272 + c0 * 2 + 16) = bq;
                unpack16(v0, v1, y);
#pragma unroll
                for (int c = 0; c < 16; ++c) y[c] *= btr;
                pack16(y, a, bq); *(LAS u32x4*)(lds + GB_VB + r * 272 + c0 * 2) = a; *(LAS u32x4*)(lds + GB_VB + r * 272 + c0 * 2 + 16) = bq;
                *(LAS u32x4*)(lds + GB_T + (tid >> 3) * 144 + (tid & 7) * 16) = tt;
                *(LAS u32x4*)(lds + GB_AT + (tid >> 3) * 144 + (tid & 7) * 16) = aa;
            }
            const u32x4 gk0 = ga0, gk1 = ga1;
            __syncthreads();
            if (n + 1 < 32) GB_LOAD(n + 1);
            {
                bf16x8 Sf[4];
#pragma unroll
                for (int ks = 0; ks < 4; ++ks) { u32x4 w; w.x = cvt_pk_bf16(S[2 * ks][0], S[2 * ks][1]); w.y = cvt_pk_bf16(S[2 * ks][2], S[2 * ks][3]);
                    w.z = cvt_pk_bf16(S[2 * ks + 1][0], S[2 * ks + 1][1]); w.w = cvt_pk_bf16(S[2 * ks + 1][2], S[2 * ks + 1][3]); Sf[ks] = __builtin_bit_cast(bf16x8, w); }
                f32x4 rr[4];
#pragma unroll
                for (int mt = 0; mt < 4; ++mt) {
                    const LAS unsigned char* vp = lds + GB_VB + (16 * mt + 4 * q4) * 272 + (16 * wid + n16) * 2;
                    rr[mt] = (f32x4){-bf2f(*(const LAS bf16_t*)vp), -bf2f(*(const LAS bf16_t*)(vp + 272)), -bf2f(*(const LAS bf16_t*)(vp + 544)), -bf2f(*(const LAS bf16_t*)(vp + 816))};
                    const LAS unsigned char* ap = lds + GB_KB + (16 * mt + n16) * 272 + 8 * q4;
#pragma unroll
                    for (int ks = 0; ks < 4; ++ks) rr[mt] = __builtin_amdgcn_mfma_f32_16x16x32_bf16(lds_frag8x2(ap + ks * 64, ap + ks * 64 + 32), Sf[ks], rr[mt], 0, 0, 0);
                }
                bf16x8 Rf[2];
#pragma unroll
                for (int kt = 0; kt < 2; ++kt) { u32x4 w; w.x = cvt_pk_bf16(-rr[2 * kt][0], -rr[2 * kt][1]); w.y = cvt_pk_bf16(-rr[2 * kt][2], -rr[2 * kt][3]);
                    w.z = cvt_pk_bf16(-rr[2 * kt + 1][0], -rr[2 * kt + 1][1]); w.w = cvt_pk_bf16(-rr[2 * kt + 1][2], -rr[2 * kt + 1][3]); Rf[kt] = __builtin_bit_cast(bf16x8, w); }
                f32x4 vn[4];
#pragma unroll
                for (int mt = 0; mt < 4; ++mt) { vn[mt] = (f32x4){0.f, 0.f, 0.f, 0.f};
                    const LAS unsigned char* tp = lds + GB_T + (16 * mt + n16) * 144 + 8 * q4;
#pragma unroll
                    for (int kt = 0; kt < 2; ++kt) if (kt == 0 || mt >= 2) vn[mt] = __builtin_amdgcn_mfma_f32_16x16x32_bf16(lds_frag8x2(tp + kt * 64, tp + kt * 64 + 32), Rf[kt], vn[mt], 0, 0, 0); }
                bf16x8 Vf[2];
#pragma unroll
                for (int kt = 0; kt < 2; ++kt) { u32x4 w; w.x = cvt_pk_bf16(vn[2 * kt][0], vn[2 * kt][1]); w.y = cvt_pk_bf16(vn[2 * kt][2], vn[2 * kt][3]);
                    w.z = cvt_pk_bf16(vn[2 * kt + 1][0], vn[2 * kt + 1][1]); w.w = cvt_pk_bf16(vn[2 * kt + 1][2], vn[2 * kt + 1][3]); Vf[kt] = __builtin_bit_cast(bf16x8, w); }
#pragma unroll
                for (int mt = 0; mt < 4; ++mt) {
                    f32x4 o = {0.f, 0.f, 0.f, 0.f};
                    const LAS unsigned char* qp = lds + GB_Q + (16 * mt + n16) * 272 + 8 * q4;
#pragma unroll
                    for (int ks = 0; ks < 4; ++ks) o = __builtin_amdgcn_mfma_f32_16x16x32_bf16(lds_frag8x2(qp + ks * 64, qp + ks * 64 + 32), Sf[ks], o, 0, 0, 0);
                    const LAS unsigned char* atp = lds + GB_AT + (16 * mt + n16) * 144 + 8 * q4;
#pragma unroll
                    for (int kt = 0; kt < 2; ++kt) if (kt == 0 || mt >= 2) o = __builtin_amdgcn_mfma_f32_16x16x32_bf16(lds_frag8x2(atp + kt * 64, atp + kt * 64 + 32), Vf[kt], o, 0, 0, 0);
#pragma unroll
                    for (int i = 0; i < 4; ++i) *(LAS float*)(lds + GB_O + (16 * mt + 4 * q4 + i) * 528 + (16 * wid + n16) * 4) = o[i];
                }
                const float eg = __expf(glast);
#pragma unroll
                for (int st = 0; st < 8; ++st) { S[st] = S[st] * eg;
                    const LAS unsigned char* kp = lds + GB_KD + (16 * st + n16) * 144 + 8 * q4;
#pragma unroll
                    for (int kt = 0; kt < 2; ++kt) S[st] = __builtin_amdgcn_mfma_f32_16x16x32_bf16(lds_frag8x2(kp + kt * 64, kp + kt * 64 + 32), Vf[kt], S[st], 0, 0, 0); }
            }
            if (n + 1 < 32) GB_CUMSUM(par ^ 1);
            __syncthreads();
            {
                float o[16];
#pragma unroll
                for (int q = 0; q < 4; ++q) { const f32x4 v = *(const LAS f32x4*)(lds + GB_O + r * 528 + (c0 + 4 * q) * 4); o[4 * q] = v[0]; o[4 * q + 1] = v[1]; o[4 * q + 2] = v[2]; o[4 * q + 3] = v[3]; }
                const float rstd = rsqrtf(sumsq16_8lanes(o) * (1.f / 128.f) + RMS_EPS);
                float gt[16]; unpack16(gk0, gk1, gt);
                float res[16];
#pragma unroll
                for (int c = 0; c < 16; ++c) res[c] = o[c] * rstd * normw[c0 + c] * silu(gt[c]);
                u32x4 a, bq; pack16(res, a, bq);
                *(u32x4*)(hp + 2048) = a; *(u32x4*)(hp + 2048 + 8) = bq;
            }
        }
        __syncthreads();
    }
}
#undef GB_CUMSUM
#undef GB_LOAD

__device__ __forceinline__ void diff_prep_phase(int widk, bf16_t* H  , const int* positions, bf16_t* VT  , LAS unsigned char* lds) {
    MK_IDS();
    LAS unsigned char* scr = lds + wid * 16384;
    for (int item = gw; item < NB * 32 * 16; item += NGW) {
        const int dvh = item & 1, h = (item >> 1) & 7, tb = (item >> 4) & 31, b = item >> 9;
        const bf16_t* src = H + ((size_t)b * T + tb * 64) * DIFF_N + 2048 + h * 128 + dvh * 64;
#pragma unroll
        for (int i = 0; i < 8; ++i) { const int row = (lane >> 3) + 8 * i, ch = lane & 7; *(LAS u32x4*)(scr + row * 144 + ch * 16) = *(const u32x4*)(src + (size_t)row * DIFF_N + ch * 8); }
        LDS_WAIT();
        bf16_t* dst = VT + (((size_t)b * 8 + h) * 128 + dvh * 64 + lane) * T + tb * 64;
#pragma unroll
        for (int k = 0; k < 8; ++k) { unsigned short v[8];
#pragma unroll
            for (int e = 0; e < 8; ++e) v[e] = *(const LAS bf16_t*)(scr + (8 * k + e) * 144 + lane * 2);
            u32x4 w; w.x = v[0] | ((unsigned)v[1] << 16); w.y = v[2] | ((unsigned)v[3] << 16); w.z = v[4] | ((unsigned)v[5] << 16); w.w = v[6] | ((unsigned)v[7] << 16);
            *(u32x4*)(dst + 8 * k) = w; }
        LDS_WAIT();
    }
}

constexpr int AT_STAGE = 36864, AT_K = 0, AT_V = 64 * 272, AT_OSTG = 2 * AT_STAGE;
static_assert(AT_OSTG + 128 * 272 <= 131072, "attention LDS map");
__device__ __forceinline__ void diff_attn_phase(int widk, const bf16_t* H, const bf16_t* VT, bf16_t* O, const float* lq1, const float* lk1, const float* lq2, const float* lk2, const float* subw, float lambda_init,
                                                LAS unsigned char* lds) {
    MK_IDS();
    const float lam = __expf(wave_sum(lq1[lane] * lk1[lane])) - __expf(wave_sum(lq2[lane] * lk2[lane])) + lambda_init;
    const int c = wid >> 2, rg = wid & 3, l31 = lane & 31, hi = lane >> 5;
    for (int bh = blockIdx.x; bh < 256; bh += gridDim.x) {
        const int b = bh >> 3, h = bh & 7;
        const bf16_t* Kg = H + (size_t)b * T * DIFF_N + 1024 + h * 128;
        const bf16_t* Vg = VT + (size_t)bh * 128 * T;
        for (int ui = 0; ui < 16; ++ui) {
            const int qb = (ui & 1) ? (15 - (ui >> 1)) : (ui >> 1);
            const int q0w = 128 * qb + 32 * rg, nt = 2 * qb + 2;
            bf16x8 qf[4];
            { const bf16_t* qp = H + ((size_t)b * T + q0w + l31) * DIFF_N + h * 128 + c * 64 + 8 * hi;
#pragma unroll
              for (int d0 = 0; d0 < 4; ++d0) qf[d0] = *(const bf16x8*)(qp + 16 * d0); }
            f32x16 o[4];
#pragma unroll
            for (int d = 0; d < 4; ++d) o[d] = (f32x16){};
            float mrun = -1e30f, lrun = 0.f;
            u32x4 pk[2], pv[2];
#define AT_LOAD(j) do { _Pragma("unroll") for (int i_ = 0; i_ < 2; ++i_) { const int ci = tid + 512 * i_; \
                pk[i_] = *(const u32x4*)(Kg + (size_t)((j) * 64 + (ci >> 4)) * DIFF_N + (ci & 15) * 8); \
                pv[i_] = *(const u32x4*)(Vg + (size_t)(ci >> 3) * T + (j) * 64 + (ci & 7) * 8); } } while (0)
            AT_LOAD(0);
            for (int j = 0; j < nt; ++j) {
                LAS unsigned char* st = lds + (j & 1) * AT_STAGE;
#pragma unroll
                for (int i_ = 0; i_ < 2; ++i_) { const int ci = tid + 512 * i_;
                    *(LAS u32x4*)(st + AT_K + (ci >> 4) * 272 + (ci & 15) * 16) = pk[i_];
                    { LAS unsigned char* vd = st + AT_V + (ci >> 3) * 136 + (ci & 7) * 16; *(LAS u32x2*)vd = (u32x2){pv[i_].x, pv[i_].y}; *(LAS u32x2*)(vd + 8) = (u32x2){pv[i_].z, pv[i_].w}; } }
                __syncthreads();
                if (j + 1 < nt) AT_LOAD(j + 1);
                if (64 * j <= q0w + 31) {
                    bf16x8 kf[2][4];
#pragma unroll
                    for (int kb = 0; kb < 2; ++kb) { const LAS unsigned char* kp = st + AT_K + (32 * kb + l31) * 272 + c * 128 + hi * 16;
#pragma unroll
                        for (int d0 = 0; d0 < 4; ++d0) kf[kb][d0] = lds_frag16(kp + d0 * 32); }
                    f32x16 p[2]; p[0] = (f32x16){}; p[1] = (f32x16){};
#pragma unroll
                    for (int d0 = 0; d0 < 4; ++d0) { p[0] = __builtin_amdgcn_mfma_f32_32x32x16_bf16(kf[0][d0], qf[d0], p[0], 0, 0, 0); p[1] = __builtin_amdgcn_mfma_f32_32x32x16_bf16(kf[1][d0], qf[d0], p[1], 0, 0, 0); }
                    const LAS unsigned char* vbase = st + AT_V + l31 * 136 + 8 * hi;
                    bf16x8 va[4], vb[4];
#define AT_LOADV(dst, t_) do { _Pragma("unroll") for (int d = 0; d < 4; ++d) dst[d] = lds_frag8x2(vbase + d * 32 * 136 + (t_) * 32, vbase + d * 32 * 136 + (t_) * 32 + 16); } while (0)
#define AT_MMA(src, pf_) do { _Pragma("unroll") for (int d = 0; d < 4; ++d) o[d] = __builtin_amdgcn_mfma_f32_32x32x16_bf16(src[d], pf_, o[d], 0, 0, 0); } while (0)
                    AT_LOADV(va, 0);
                    asm volatile("" ::: "memory");
                    if (64 * j + 63 > q0w) {
                        const int q = q0w + l31;
#pragma unroll
                        for (int kb = 0; kb < 2; ++kb)
#pragma unroll
                            for (int r = 0; r < 16; ++r) { const int kv = 64 * j + 32 * kb + crow(r, hi); if (kv > q) p[kb][r] = -1e30f; }
                    }
                    float mx0 = fmaxf(p[0][0], p[1][0]), mx1 = fmaxf(p[0][1], p[1][1]);
#pragma unroll
                    for (int r = 2; r < 16; r += 2) { mx0 = fmaxf(mx0, fmaxf(p[0][r], p[1][r])); mx1 = fmaxf(mx1, fmaxf(p[0][r + 1], p[1][r + 1])); }
                    float mx = fmaxf(mx0, mx1);
                    mx = fmaxf(mx, __shfl_xor(mx, 32));
                    const float mnew = fmaxf(mrun, mx);
                    if (__any(mnew > mrun)) {
                        const float al = __builtin_amdgcn_exp2f(mrun - mnew); lrun *= al;
#pragma unroll
                        for (int d = 0; d < 4; ++d) o[d] = o[d] * al;
                    }
                    mrun = mnew;
                    float ls0 = 0.f, ls1 = 0.f, ls2 = 0.f, ls3 = 0.f;
#pragma unroll
                    for (int kb = 0; kb < 2; ++kb)
#pragma unroll
                        for (int r = 0; r < 16; r += 4) { p[kb][r] = __builtin_amdgcn_exp2f(p[kb][r] - mnew); p[kb][r + 1] = __builtin_amdgcn_exp2f(p[kb][r + 1] - mnew);
                            p[kb][r + 2] = __builtin_amdgcn_exp2f(p[kb][r + 2] - mnew); p[kb][r + 3] = __builtin_amdgcn_exp2f(p[kb][r + 3] - mnew);
                            ls0 += p[kb][r]; ls1 += p[kb][r + 1]; ls2 += p[kb][r + 2]; ls3 += p[kb][r + 3]; }
                    lrun += (ls0 + ls1) + (ls2 + ls3);
                    bf16x8 pf[4];
#pragma unroll
                    for (int t = 0; t < 4; ++t) { const int kb = t >> 1, s8 = (t & 1) * 8;
                        u32x4 w; w.x = cvt_pk_bf16(p[kb][s8], p[kb][s8 + 1]); w.y = cvt_pk_bf16(p[kb][s8 + 2], p[kb][s8 + 3]);
                        w.z = cvt_pk_bf16(p[kb][s8 + 4], p[kb][s8 + 5]); w.w = cvt_pk_bf16(p[kb][s8 + 6], p[kb][s8 + 7]); pf[t] = __builtin_bit_cast(bf16x8, w); }
                    asm volatile("" ::: "memory");
                    AT_LOADV(vb, 1); asm volatile("" ::: "memory"); AT_MMA(va, pf[0]);
                    AT_LOADV(va, 2); asm volatile("" ::: "memory"); AT_MMA(vb, pf[1]);
                    AT_LOADV(vb, 3); asm volatile("" ::: "memory"); AT_MMA(va, pf[2]);
                    AT_MMA(vb, pf[3]);
#undef AT_LOADV
#undef AT_MMA
                }
            }
#undef AT_LOAD
            const float ltot = lrun + __shfl_xor(lrun, 32);
            const float inv = (c ? lam : 1.f) / ltot;
            __syncthreads();
            LAS float* xch = (LAS float*)lds + rg * 4096;
            if (c == 1) {
#pragma unroll
                for (int d = 0; d < 4; ++d)
#pragma unroll
                    for (int r = 0; r < 16; ++r) xch[(d * 16 + r) * 64 + lane] = o[d][r] * inv;
            }
            __syncthreads();
            if (c == 0) {
                float ss = 0.f;
#pragma unroll
                for (int d = 0; d < 4; ++d)
#pragma unroll
                    for (int r = 0; r < 16; ++r) { const float v = o[d][r] * inv - xch[(d * 16 + r) * 64 + lane]; o[d][r] = v; ss += v * v; }
                ss += __shfl_xor(ss, 32);
                const float rstd = rsqrtf(ss * (1.f / 128.f) + RMS_EPS) * (1.f - lambda_init);
                LAS unsigned char* op = lds + AT_OSTG + (rg * 32 + l31) * 272 + 8 * hi;
#pragma unroll
                for (int d = 0; d < 4; ++d)
#pragma unroll
                    for (int g = 0; g < 4; ++g) { const int dv = 32 * d + 8 * g + 4 * hi; const f32x4 sw = *(const f32x4*)(subw + dv);
                        u32x2 w; w.x = cvt_pk_bf16(o[d][4 * g] * rstd * sw[0], o[d][4 * g + 1] * rstd * sw[1]); w.y = cvt_pk_bf16(o[d][4 * g + 2] * rstd * sw[2], o[d][4 * g + 3] * rstd * sw[3]);
                        *(LAS u32x2*)(op + (32 * d + 8 * g) * 2) = w; }
            }
            __syncthreads();
            {
                const LAS unsigned char* sp = lds + AT_OSTG + (rg * 32 + c * 16) * 272;
                bf16_t* gp = O + ((size_t)b * T + 128 * qb + rg * 32 + c * 16) * D + h * 128;
#pragma unroll
                for (int i = 0; i < 4; ++i) { const int idx = i * 64 + lane, row = idx >> 4, ch = idx & 15;
                    *(u32x4*)(gp + (size_t)row * D + ch * 8) = *(const LAS u32x4*)(sp + row * 272 + ch * 16); }
            }
        }
    }
}

template <bool FUSED_LN> __global__ void __launch_bounds__(NTHR, 2) fwd_megakernel(Params p) {
    extern __shared__ __attribute__((aligned(16))) unsigned char lds_raw[];
    LAS unsigned char* lds = (LAS unsigned char*)lds_raw;
    cg::grid_group grid = cg::this_grid();
    const int widk = __builtin_amdgcn_readfirstlane((int)threadIdx.x >> 6);
    volatile LAS unsigned* bst = (volatile LAS unsigned*)(lds + 131072 + 1024);
    if (threadIdx.x < 2) bst[threadIdx.x] = 0u;
    if (blockIdx.x == 0) { for (unsigned i = threadIdx.x; i < WS_CTL_BYTES / 4; i += NTHR) ((unsigned*)p.ws)[i] = 0u; }
    __syncthreads();
    const int G = gridDim.x;
    constexpr bool fused_ln = FUSED_LN;
    unsigned char* ws = p.ws; unsigned char* wsw = ws + WS_W;
    bf16_t* XN = (bf16_t*)(ws + WS_XN); bf16_t* Hb = (bf16_t*)(ws + WS_H);
    float* Gb = (float*)(ws + WS_GB); float* BETAb = Gb + (size_t)M * 8;

    unsigned long long pt0 = 0, pticks = 0; (void)pt0;
    TBEG(4);
#ifndef NO_PRO
    REPS(4) prologue(widk, p, lds);
#endif
    grid.sync(); TEND(4);
    const XcdBarrier xbar = xcd_barrier_post((unsigned*)p.ws, bst);
    for (int layer = 0; layer < DEPTH; ++layer) {
        const int j = layer >> 1;
        const float* resid = (layer == 0) ? p.in[0] : p.out;
        if ((layer & 1) == 0) {
            TBEG(1);
            {   pg8::Gemm g{XN, (const bf16_t*)(wsw + W_GWIN) + (size_t)j * 4096 * 1024, M, GDN_NMAIN, D, D}; pg8::StaticOrder S; S.init(M, GDN_NMAIN, G, (int)blockIdx.x);
                pg8::EpiBf16 E{Hb, GDN_NMAIN};
                REPS(1) PH_GEMMB pg8::gemm_phase<pg8::EpiBf16, pg8::StaticOrder, true, true, D, D, true>(widk, lds, g, S, E); }
#ifndef NO_AB
            REPS(4) gdn_ab_phase(widk, XN, (const bf16_t*)(wsw + W_GWAB) + (size_t)j * 16 * 1024, p.in[4] + j * 8, p.in[5] + j * 8, Gb, BETAb);
#endif
            xcd_barrier(xbar, widk); TEND(1); TBEG(2);
#ifndef NO_GA
            gdn_phase_a(widk, Hb, Gb, BETAb, p.in[3] + (size_t)j * 4 * 3072, (bf16_t*)(ws + WS_UT) + (size_t)32 * 1024 * 1024, (bf16_t*)(ws + WS_UT), lds);
#endif
            xcd_barrier(xbar, widk);
#ifndef NO_GB
            gdn_phase_b(widk, Hb, Gb, BETAb, p.in[6] + j * 128, (const bf16_t*)(ws + WS_UT) + (size_t)32 * 1024 * 1024, (const bf16_t*)(ws + WS_UT), lds);
#endif
            xcd_barrier(xbar, widk); TEND(2); TBEG(5);
            {   pg8::Gemm g{Hb + 2048, (const bf16_t*)(wsw + W_GWOUT) + (size_t)j * 1024 * 1024, M, D, D, GDN_NMAIN}; pg8::StaticOrder S; S.init(M, D, G, (int)blockIdx.x);
                if constexpr (fused_ln) {
                    if (layer == 0) { pg8::EpiResidLn<false, false> E{p.in[0], p.out, XN, p.in[19] + layer * D, p.in[20] + layer * D, ALPHA, LN_EPS, (unsigned*)(ws + WS_XBUF), (unsigned*)(ws + WS_CNT) + (size_t)(2 * layer) * 4096, (LAS float*)(lds + 131072 + 2048)};
                        pg8::gemm_phase<pg8::EpiResidLn<false, false>, pg8::StaticOrder, true, true, D, GDN_NMAIN>(widk, lds, g, S, E); }
                    else { pg8::EpiResidLn<true, false> E{nullptr, p.out, XN, p.in[19] + layer * D, p.in[20] + layer * D, ALPHA, LN_EPS, (unsigned*)(ws + WS_XBUF), (unsigned*)(ws + WS_CNT) + (size_t)(2 * layer) * 4096, (LAS float*)(lds + 131072 + 2048)};
                        pg8::gemm_phase<pg8::EpiResidLn<true, false>, pg8::StaticOrder, true, true, D, GDN_NMAIN>(widk, lds, g, S, E); } }
                else { pg8::EpiResid E{resid, p.out, D, ALPHA};
                    PH_GEMMR pg8::gemm_phase<pg8::EpiResid, pg8::StaticOrder, true, true, D, GDN_NMAIN>(widk, lds, g, S, E); } }
        } else {
            const float lambda_init = 0.8f - 0.6f * expf(-0.3f * (float)layer);
            TBEG(1);
            {   pg8::Gemm g{XN, (const bf16_t*)(wsw + W_DWIN) + (size_t)j * 3072 * 1024, M, DIFF_N, D, D}; pg8::StaticOrder S; S.init(M, DIFF_N, G, (int)blockIdx.x);
                pg8::EpiRope E{Hb, (const unsigned*)(ws + WS_ROPE), 0.125f * LOG2E, (bf16_t*)(ws + WS_VT)};
                pg8::gemm_phase<pg8::EpiRope, pg8::StaticOrder, true, true, D, D, true>(widk, lds, g, S, E); }
            xcd_barrier(xbar, widk); TEND(1); TBEG(4);
#ifndef NO_ATT
            REPS(3) diff_attn_phase(widk, Hb, (const bf16_t*)(ws + WS_VT), (bf16_t*)(ws + WS_O), p.in[9] + j * 64, p.in[10] + j * 64, p.in[11] + j * 64, p.in[12] + j * 64, p.in[13] + j * 128, lambda_init, lds);
#endif
            xcd_barrier(xbar, widk); TEND(3); TBEG(5);
            {   pg8::Gemm g{(const bf16_t*)(ws + WS_O), (const bf16_t*)(wsw + W_DWOUT) + (size_t)j * 1024 * 1024, M, D, D, D}; pg8::StaticOrder S; S.init(M, D, G, (int)blockIdx.x);
                if constexpr (fused_ln) { pg8::EpiResidLn<true, false> E{nullptr, p.out, XN, p.in[19] + layer * D, p.in[20] + layer * D, ALPHA, LN_EPS, (unsigned*)(ws + WS_XBUF), (unsigned*)(ws + WS_CNT) + (size_t)(2 * layer) * 4096, (LAS float*)(lds + 131072 + 2048)};
                    pg8::gemm_phase<pg8::EpiResidLn<true, false>, pg8::StaticOrder, true, true, D, D>(widk, lds, g, S, E); }
                else { pg8::EpiResid E{resid, p.out, D, ALPHA};
                    PH_GEMMR pg8::gemm_phase<pg8::EpiResid, pg8::StaticOrder, true, true, D, D>(widk, lds, g, S, E); } }
        }
        xcd_barrier(xbar, widk); TEND(5);
        if constexpr (!fused_ln) { ln_phase(widk, p.out, XN, p.in[19] + layer * D, p.in[20] + layer * D); xcd_barrier(xbar, widk); }
        {
            bf16_t* ACT = (bf16_t*)(ws + WS_ACT); float* HALO = (float*)(ws + WS_HALO); float* HALO2 = (float*)(ws + WS_HALO2);
            const float* fcw = p.in[16] + (size_t)layer * 3 * FFN_N; const float* fcb = p.in[17] + (size_t)layer * FFN_N;
            TBEG(6);
            {   pg8::Gemm g{XN, (const bf16_t*)(wsw + W_FUP) + (size_t)layer * 5632 * 1024, M, FFN_N, D, D}; pg8::StaticOrder S; S.init(M, FFN_N, G, (int)blockIdx.x);
                pg8::EpiFfnAct E{ACT, fcw, fcb, HALO, HALO2, (LAS float*)(lds + 131072 + 2048)};
                pg8::gemm_phase<pg8::EpiFfnAct, pg8::StaticOrder, true, true, D, D, true>(widk, lds, g, S, E); }
            xcd_barrier(xbar, widk); TEND(6); TBEG(4);
            ffn_fixup_phase(widk, ACT, HALO, HALO2, fcw, fcb);
            xcd_barrier(xbar, widk); TEND(4); TBEG(7);
            {   pg8::Gemm g{ACT, (const bf16_t*)(wsw + W_FDOWN) + (size_t)layer * 1024 * 2816, M, D, FFN_H, FFN_H}; pg8::StaticOrder S; S.init(M, D, G, (int)blockIdx.x);
                if constexpr (fused_ln) {
                    if (layer == DEPTH - 1) { pg8::EpiResidLn<true, true> E{nullptr, p.out, XN, p.in[21] + layer * D, p.in[22] + layer * D, ALPHA, LN_EPS, (unsigned*)(ws + WS_XBUF), (unsigned*)(ws + WS_CNT) + (size_t)(2 * layer + 1) * 4096, (LAS float*)(lds + 131072 + 2048)};
                        pg8::gemm_phase<pg8::EpiResidLn<true, true>, pg8::StaticOrder, true, true, FFN_H, FFN_H>(widk, lds, g, S, E); }
                    else { pg8::EpiResidLn<true, false> E{nullptr, p.out, XN, p.in[21] + layer * D, p.in[22] + layer * D, ALPHA, LN_EPS, (unsigned*)(ws + WS_XBUF), (unsigned*)(ws + WS_CNT) + (size_t)(2 * layer + 1) * 4096, (LAS float*)(lds + 131072 + 2048)};
                        pg8::gemm_phase<pg8::EpiResidLn<true, false>, pg8::StaticOrder, true, true, FFN_H, FFN_H>(widk, lds, g, S, E); } }
                else { pg8::EpiResid E{p.out, p.out, D, ALPHA};
                    pg8::gemm_phase<pg8::EpiResid, pg8::StaticOrder, true, true, FFN_H, FFN_H>(widk, lds, g, S, E); } }
        }
        xcd_barrier(xbar, widk); TEND(7);
        if constexpr (!fused_ln) { ln_phase(widk, p.out, XN, p.in[21] + layer * D, p.in[22] + layer * D); xcd_barrier(xbar, widk); }
    }
    if (PROBE_T) { const unsigned long long ts = __builtin_amdgcn_s_memrealtime(); while (__builtin_amdgcn_s_memrealtime() - ts < pticks) __builtin_amdgcn_s_sleep(8); }
}
}

extern "C" void kernel_launch(void* const* d_in, const int* in_sizes, int n_in, void* d_out, int out_size, void* d_ws, size_t ws_size, hipStream_t stream) {
    static int grid = 0;
    if (grid == 0) {
        if (n_in != 23 || ws_size < mk::WS_END) { fprintf(stderr, "kernel_launch: unexpected n_in %d / ws_size %zu (need %zu)\n", n_in, ws_size, (size_t)mk::WS_END); grid = -1; return; }
        int dev = 0, cus = 0, per_cu = 0;
        (void)hipGetDevice(&dev); (void)hipDeviceGetAttribute(&cus, hipDeviceAttributeMultiprocessorCount, dev);
        const void* kfn = (const void*)mk::fwd_megakernel<true>; const void* kfn2 = (const void*)mk::fwd_megakernel<false>;
        if (hipFuncSetAttribute(kfn, hipFuncAttributeMaxDynamicSharedMemorySize, mk::LDS_BYTES) != hipSuccess || hipFuncSetAttribute(kfn2, hipFuncAttributeMaxDynamicSharedMemorySize, mk::LDS_BYTES) != hipSuccess) { fprintf(stderr, "kernel_launch: hipFuncSetAttribute failed\n"); grid = -1; return; }
        if (hipOccupancyMaxActiveBlocksPerMultiprocessor(&per_cu, kfn, mk::NTHR, mk::LDS_BYTES) != hipSuccess || per_cu < 1) { fprintf(stderr, "kernel_launch: occupancy query gave %d\n", per_cu); per_cu = 1; }
        (void)hipGetLastError();
        grid = cus * per_cu;
        fprintf(stderr, "kernel_launch: grid %d (cus %d x %d)\n", grid, cus, per_cu);
    }
    if (grid < 0) return;
    mk::Params p{};
    for (int i = 0; i < 23; ++i) p.in[i] = (const float*)d_in[i];
    p.positions = (const int*)d_in[1]; p.out = (float*)d_out; p.ws = (unsigned char*)d_ws;
    void* args[] = {&p};
    hipError_t e = hipLaunchCooperativeKernel(grid == 256 ? (const void*)mk::fwd_megakernel<true> : (const void*)mk::fwd_megakernel<false>, dim3(grid), dim3(mk::NTHR), args, mk::LDS_BYTES, stream);
    if (e != hipSuccess) fprintf(stderr, "cooperative launch failed: %s (grid %d)\n", hipGetErrorString(e), grid);
}
```

```cpp
#include <hip/hip_runtime.h>
#include <hip/hip_cooperative_groups.h>
#include <cstdio>
#include <cstdint>
namespace cg = cooperative_groups;
#ifndef PROBE_REP
#define PROBE_REP 0
#endif
#define REPS(k) for (int rep_ = 0; rep_ < ((PROBE_REP) == (k) ? 2 : 1); ++rep_)
#ifndef PROBE_T
#define PROBE_T 0
#endif
#define TBEG(k) if (PROBE_T == (k)) pt0 = __builtin_amdgcn_s_memrealtime()
#define TEND(k) if (PROBE_T == (k)) pticks += __builtin_amdgcn_s_memrealtime() - pt0
namespace pg8 {
#define PG8_LAS __attribute__((address_space(3)))
typedef unsigned short bf16_t;
typedef short bf16x8 __attribute__((ext_vector_type(8)));
typedef float f32x4 __attribute__((ext_vector_type(4)));
typedef unsigned u32x4 __attribute__((ext_vector_type(4)));
constexpr int BM = 256, BK = 64, HALF = 128, HTB = HALF * BK * 2  , STAGE_BYTES = 8 * HTB, NXCD = 8, WGM = 8;

__host__ __device__ __forceinline__ int lds_byte(int r, int c) { const int st = (r >> 4) * 2 + (c >> 5), rr = r & 15, cc = c & 31, ob = rr * 64 + cc * 2; return st * 1024 + (ob ^ (((ob >> 9) & 1) << 5)); }
__host__ __device__ __forceinline__ void stage_rc(int b, int& R, int& C) { const int st = b / 1024, sb = b % 1024, swz = sb ^ (((sb >> 9) & 1) << 5); R = (st >> 1) * 16 + swz / 64; C = (st & 1) * 32 + (swz % 64) / 2; }
__host__ __device__ __forceinline__ int perm32(int rho) { const int n = rho >> 4, i = rho & 15; return 8 * (i >> 2) + 4 * n + (i & 3); }

struct Unit { int pm, pn; };
struct Gemm { const bf16_t* A; const bf16_t* Bt; int M, N, K, lda; };

struct StaticOrder {
    int nM, nN, nwg, G, c;
    __host__ __device__ void init(int M, int N, int G_, int c_) { nM = M / BM; nN = N / BM; nwg = nM * nN; G = G_; c = c_; }
    __host__ __device__ bool next(int i, Unit& u) const {
        const long L = (long)i * G + c; if (L >= nwg) return false;
        int wgid = (int)L; { const int q = nwg / NXCD, r = nwg % NXCD, xcd = wgid % NXCD, off = wgid / NXCD; wgid = (xcd < r ? xcd * (q + 1) : r * (q + 1) + (xcd - r) * q) + off; }
        const int nig = WGM * nN, gid = wgid / nig, fm = gid * WGM, gsz = (nM - fm) < WGM ? (nM - fm) : WGM;
        u.pm = fm + ((wgid % nig) % gsz); u.pn = (wgid % nig) / gsz; return true;
    }
    __device__ __forceinline__ void a_ready(const Unit&) const {}
    __device__ __forceinline__ void done(const Unit&) const {}
};
typedef float f32x2 __attribute__((ext_vector_type(2)));
typedef __bf16 bf16x2v __attribute__((ext_vector_type(2)));
typedef _Float16 f16x2v __attribute__((ext_vector_type(2)));
typedef _Float16 f16x8 __attribute__((ext_vector_type(8)));
__device__ __forceinline__ unsigned cvt_pk_f16(float lo, float hi) { f32x2 v = {lo, hi}; f16x2v b = __builtin_convertvector(v, f16x2v); return __builtin_bit_cast(unsigned, b); }
__device__ __forceinline__ f32x2 unpk_f16(unsigned w) { const f16x2v h = __builtin_bit_cast(f16x2v, w); return __builtin_convertvector(h, f32x2); }
template <bool F16> __device__ __forceinline__ f32x4 mma16(const bf16x8 a, const bf16x8 b, const f32x4 c) {
    if constexpr (F16) return __builtin_amdgcn_mfma_f32_16x16x32_f16(__builtin_bit_cast(f16x8, a), __builtin_bit_cast(f16x8, b), c, 0, 0, 0);
    else return __builtin_amdgcn_mfma_f32_16x16x32_bf16(a, b, c, 0, 0, 0);
}
__device__ __forceinline__ unsigned cvt_pk_bf16(float lo, float hi) { f32x2 v = {lo, hi}; bf16x2v b = __builtin_convertvector(v, bf16x2v); return __builtin_bit_cast(unsigned, b); }

struct EpiBf16 {
    static constexpr bool PERM = true, AFTER_DRAIN = false;
    bf16_t* O; int ldc;
    __device__ __forceinline__ void operator()(const f32x4 (&acc)[2][2][4][2], const Unit& u, int wr, int wc, int fr, int fq) const {
        const int row0 = u.pm * BM + wr * 64 + fr; const int col0 = u.pn * BM + wc * 32 + 8 * fq;
#pragma unroll
        for (int ai = 0; ai < 2; ++ai)
#pragma unroll
            for (int m = 0; m < 4; ++m) { bf16_t* rowp = O + (size_t)(row0 + ai * HALF + m * 16) * ldc + col0;
#pragma unroll
                for (int bj = 0; bj < 2; ++bj) { const f32x4 v0 = acc[ai][bj][m][0], v1 = acc[ai][bj][m][1];
                    u32x4 w; w.x = cvt_pk_bf16(v0[0], v0[1]); w.y = cvt_pk_bf16(v0[2], v0[3]); w.z = cvt_pk_bf16(v1[0], v1[1]); w.w = cvt_pk_bf16(v1[2], v1[3]);
                    *(u32x4*)(rowp + bj * HALF) = w; } }
    }
};
struct EpiResid {
    static constexpr bool PERM = false, AFTER_DRAIN = false;
    const float* base; float* out; int ldc; float alpha;
    __device__ __forceinline__ void operator()(const f32x4 (&acc)[2][2][4][2], const Unit& u, int wr, int wc, int fr, int fq) const {
        const int col0 = u.pn * BM + wc * 32 + 4 * fq;
#pragma unroll
        for (int ai = 0; ai < 2; ++ai)
#pragma unroll
            for (int m = 0; m < 4; ++m) { const int r = ai * HALF + wr * 64 + m * 16 + fr; const size_t off = (size_t)(u.pm * BM + r) * ldc + col0;
#pragma unroll
                for (int bj = 0; bj < 2; ++bj)
#pragma unroll
                    for (int n = 0; n < 2; ++n) { const f32x4 bs = *(const f32x4*)(base + off + bj * HALF + n * 16); const f32x4 o = bs * alpha + acc[ai][bj][m][n];
                        *(f32x4*)(out + off + bj * HALF + n * 16) = o; }
                asm volatile("" ::: "memory"); }
    }
};

struct EpiRope {
    static constexpr bool PERM = true, AFTER_DRAIN = false;
    bf16_t* O; const unsigned* CS; float qscale; bf16_t* VT;
    __device__ __forceinline__ void operator()(const f32x4 (&acc)[2][2][4][2], const Unit& u, int wr, int wc, int fr_, int fq_) const {
        int fr = fr_, fq = fq_; asm volatile("" : "+v"(fr), "+v"(fq));
        const int row0 = u.pm * BM + wr * 64 + fr;
        if (u.pn >= 8) {
            const int t0 = (u.pm * BM) & 2047, bb = (u.pm * BM) >> 11;
#pragma unroll
            for (int bj = 0; bj < 2; ++bj) {
                bf16_t* vt = VT + ((size_t)(bb * 8 + 2 * (u.pn - 8) + bj) * 128 + wc * 32 + 8 * fq) * 2048 + t0 + wr * 64 + fr;
#pragma unroll
                for (int n = 0; n < 2; ++n)
#pragma unroll
                    for (int e = 0; e < 4; ++e)
#pragma unroll
                        for (int ai = 0; ai < 2; ++ai)
#pragma unroll
                            for (int m = 0; m < 4; ++m) vt[(size_t)(4 * n + e) * 2048 + ai * HALF + m * 16] = (bf16_t)(cvt_pk_bf16(acc[ai][bj][m][n][e], 0.f) & 0xffffu);
            }
        } else {
            const float sc = (u.pn < 4) ? qscale : 1.f;
            const int col1 = u.pn * BM + wc * 64 + 8 * fq;
#pragma unroll
            for (int ai = 0; ai < 2; ++ai)
#pragma unroll
                for (int m = 0; m < 4; ++m) { const int row = row0 + ai * HALF + m * 16;
                    const u32x4 t0 = *(const u32x4*)(CS + (size_t)row * 32 + 8 * fq), t1 = *(const u32x4*)(CS + (size_t)row * 32 + 8 * fq + 4);
                    const f32x2 e0 = unpk_f16(t0.x), e1 = unpk_f16(t0.y), e2 = unpk_f16(t0.z), e3 = unpk_f16(t0.w), e4 = unpk_f16(t1.x), e5 = unpk_f16(t1.y), e6 = unpk_f16(t1.z), e7 = unpk_f16(t1.w);
                    const f32x4 c0 = {e0[0], e1[0], e2[0], e3[0]}, c1 = {e4[0], e5[0], e6[0], e7[0]}, s0 = {e0[1], e1[1], e2[1], e3[1]}, s1 = {e4[1], e5[1], e6[1], e7[1]};
                    const f32x4 a0 = acc[ai][0][m][0], a1 = acc[ai][0][m][1], b0 = acc[ai][1][m][0], b1 = acc[ai][1][m][1];
                    const f32x4 y10 = (a0 * c0 - b0 * s0) * sc, y11 = (a1 * c1 - b1 * s1) * sc, y20 = (b0 * c0 + a0 * s0) * sc, y21 = (b1 * c1 + a1 * s1) * sc;
                    u32x4 w1, w2; w1.x = cvt_pk_bf16(y10[0], y10[1]); w1.y = cvt_pk_bf16(y10[2], y10[3]); w1.z = cvt_pk_bf16(y11[0], y11[1]); w1.w = cvt_pk_bf16(y11[2], y11[3]);
                    w2.x = cvt_pk_bf16(y20[0], y20[1]); w2.y = cvt_pk_bf16(y20[2], y20[3]); w2.z = cvt_pk_bf16(y21[0], y21[1]); w2.w = cvt_pk_bf16(y21[2], y21[3]);
                    bf16_t* rowp = O + (size_t)row * 3072 + col1;
                    *(u32x4*)rowp = w1; *(u32x4*)(rowp + 32) = w2;
                    if (m & 1) asm volatile("" ::: "memory"); }
        }
    }
};

template <bool BASE_BF16, bool WRITE_F32> struct EpiResidLn {
    static constexpr bool PERM = true, AFTER_DRAIN = false;
    const float* base; float* out; bf16_t* xn; const float* g; const float* b; float alpha, eps;
    unsigned* xbuf;
    unsigned* cnt;
    PG8_LAS float* sl;
    __device__ __forceinline__ void operator()(f32x4 (&acc)[2][2][4][2], const Unit& u, int wr, int wc, int fr_, int fq_) const {
        typedef unsigned u32x2 __attribute__((ext_vector_type(2)));
        int fr = fr_, fq = fq_; asm volatile("" : "+v"(fr), "+v"(fq));
        const int col0 = u.pn * BM + wc * 32 + 8 * fq;
        const int lane = fq * 16 + fr, wid = wr * 4 + wc, tid = wid * 64 + lane;
#pragma unroll
        for (int ai = 0; ai < 2; ++ai)
#pragma unroll
            for (int m = 0; m < 4; ++m) { const int r = ai * HALF + wr * 64 + m * 16 + fr; const size_t off = (size_t)(u.pm * BM + r) * 1024 + col0;
                float s = 0.f, q = 0.f;
#pragma unroll
                for (int bj = 0; bj < 2; ++bj) { f32x4 bs0, bs1;
                    if constexpr (BASE_BF16) { const u32x4 rb = *(const u32x4*)(xn + off + bj * HALF); const f32x2 a0 = unpk_f16(rb.x), a1 = unpk_f16(rb.y), a2 = unpk_f16(rb.z), a3 = unpk_f16(rb.w);
                        bs0 = (f32x4){a0[0], a0[1], a1[0], a1[1]}; bs1 = (f32x4){a2[0], a2[1], a3[0], a3[1]}; }
                    else { bs0 = *(const f32x4*)(base + off + bj * HALF); bs1 = *(const f32x4*)(base + off + bj * HALF + 4); }
                    const f32x4 y0 = bs0 * alpha + acc[ai][bj][m][0], y1 = bs1 * alpha + acc[ai][bj][m][1]; acc[ai][bj][m][0] = y0; acc[ai][bj][m][1] = y1;
                    s += ((y0[0] + y0[1]) + (y0[2] + y0[3])) + ((y1[0] + y1[1]) + (y1[2] + y1[3]));
                    q += ((y0[0] * y0[0] + y0[1] * y0[1]) + (y0[2] * y0[2] + y0[3] * y0[3])) + ((y1[0] * y1[0] + y1[1] * y1[1]) + (y1[2] * y1[2] + y1[3] * y1[3])); }
                s += __shfl_xor(s, 16); s += __shfl_xor(s, 32); q += __shfl_xor(q, 16); q += __shfl_xor(q, 32);
                if (fq == 0) { sl[(r * 4 + wc) * 2] = s; sl[(r * 4 + wc) * 2 + 1] = q; }
                asm volatile("" ::: "memory"); }
        asm volatile("s_waitcnt lgkmcnt(0)" ::: "memory"); __builtin_amdgcn_s_barrier(); asm volatile("" ::: "memory");
        if (tid < 256) {
            const PG8_LAS f32x4* pp = (const PG8_LAS f32x4*)(sl + tid * 8); const f32x4 p0 = pp[0], p1 = pp[1];
            const float S = (p0[0] + p0[2]) + (p1[0] + p1[2]), Q = (p0[1] + p0[3]) + (p1[1] + p1[3]);
            unsigned* xp = xbuf + (((size_t)u.pm * 4 + u.pn) * 256 + tid) * 2;
            __hip_atomic_store(xp, __float_as_uint(S), __ATOMIC_RELAXED, __HIP_MEMORY_SCOPE_AGENT); __hip_atomic_store(xp + 1, __float_as_uint(Q), __ATOMIC_RELAXED, __HIP_MEMORY_SCOPE_AGENT);
            asm volatile("s_waitcnt vmcnt(0)" ::: "memory");
            if (lane == 0) __hip_atomic_fetch_add(cnt + 16 * u.pm, 1u, __ATOMIC_RELAXED, __HIP_MEMORY_SCOPE_AGENT);
        }
        if (wid == 0) {
            unsigned sp = 0;
            while ((unsigned)__builtin_amdgcn_readfirstlane(__hip_atomic_load(cnt + 16 * u.pm, __ATOMIC_RELAXED, __HIP_MEMORY_SCOPE_AGENT)) < 16u) { __builtin_amdgcn_s_sleep(2); if (++sp > (1u << 22)) break; }
            __builtin_amdgcn_fence(__ATOMIC_ACQUIRE, "agent");
        }
        asm volatile("s_waitcnt vmcnt(0) lgkmcnt(0)" ::: "memory"); __builtin_amdgcn_s_barrier(); asm volatile("" ::: "memory");
        if (tid < 256) {
            float S = 0.f, Q = 0.f;
#pragma unroll
            for (int t = 0; t < 4; ++t) { unsigned* xp = xbuf + (((size_t)u.pm * 4 + t) * 256 + tid) * 2;
                S += __uint_as_float(__hip_atomic_load(xp, __ATOMIC_RELAXED, __HIP_MEMORY_SCOPE_AGENT)); Q += __uint_as_float(__hip_atomic_load(xp + 1, __ATOMIC_RELAXED, __HIP_MEMORY_SCOPE_AGENT)); }
            const float mean = S * (1.f / 1024.f), var = fmaxf(Q * (1.f / 1024.f) - mean * mean, 0.f);
            sl[2048 + tid * 2] = mean; sl[2048 + tid * 2 + 1] = 1.f / sqrtf(var + eps);
        }
        asm volatile("s_waitcnt lgkmcnt(0)" ::: "memory"); __builtin_amdgcn_s_barrier(); asm volatile("" ::: "memory");
#pragma unroll
        for (int bj = 0; bj < 2; ++bj) {
            const f32x4 gv0 = *(const f32x4*)(g + col0 + bj * HALF), gv1 = *(const f32x4*)(g + col0 + bj * HALF + 4), bv0 = *(const f32x4*)(b + col0 + bj * HALF), bv1 = *(const f32x4*)(b + col0 + bj * HALF + 4);
#pragma unroll
            for (int ai = 0; ai < 2; ++ai)
#pragma unroll
                for (int m = 0; m < 4; ++m) { const int r = ai * HALF + wr * 64 + m * 16 + fr; const size_t off = (size_t)(u.pm * BM + r) * 1024 + col0 + bj * HALF;
                    const float mean = sl[2048 + r * 2], rstd = sl[2048 + r * 2 + 1];
                    const f32x4 o0 = (acc[ai][bj][m][0] - mean) * rstd * gv0 + bv0, o1 = (acc[ai][bj][m][1] - mean) * rstd * gv1 + bv1;
                    if constexpr (WRITE_F32) { *(f32x4*)(out + off) = o0; *(f32x4*)(out + off + 4) = o1; }
                    u32x4 w; w.x = cvt_pk_f16(o0[0], o0[1]); w.y = cvt_pk_f16(o0[2], o0[3]); w.z = cvt_pk_f16(o1[0], o1[1]); w.w = cvt_pk_f16(o1[2], o1[3]); *(u32x4*)(xn + off) = w; }
            asm volatile("" ::: "memory");
        }
    }
};

__device__ __forceinline__ float dpp_ror1(float v) { float r; asm volatile("v_mov_b32_dpp %0, %1 row_ror:1 row_mask:0xf bank_mask:0xf" : "=&v"(r) : "v"(v)); return r; }
__device__ __forceinline__ float dpp_ror2(float v) { float r; asm volatile("v_mov_b32_dpp %0, %1 row_ror:2 row_mask:0xf bank_mask:0xf" : "=&v"(r) : "v"(v)); return r; }
__device__ __forceinline__ float silu_f(float x) { return x * __builtin_amdgcn_rcpf(1.f + __expf(-x)); }
struct EpiFfnAct {
    static constexpr bool PERM = true, AFTER_DRAIN = false;
    bf16_t* ACT; const float* cw; const float* cb; float* HALO; float* HALO2; PG8_LAS float* hl;
    __device__ __forceinline__ void operator()(const f32x4 (&acc)[2][2][4][2], const Unit& u, int wr, int wc, int fr_, int fq_) const {
        int fr = fr_, fq = fq_; asm volatile("" : "+v"(fr), "+v"(fq));
        const int cc0 = wc * 32 + 8 * fq, colA = u.pn * 128 + cc0;
        if (fr >= 14) {
#pragma unroll
            for (int ai = 0; ai < 2; ++ai) { PG8_LAS float* hp = hl + ((2 * ai + wr) * 2 + (fr - 14)) * 256 + cc0;
#pragma unroll
                for (int bj = 0; bj < 2; ++bj)
#pragma unroll
                    for (int n = 0; n < 2; ++n) *(PG8_LAS f32x4*)(hp + bj * 128 + 4 * n) = acc[ai][bj][3][n]; }
            if (wr == 1) { float* gp = HALO + ((size_t)u.pm * 2 + (fr - 14)) * 5632 + colA;
#pragma unroll
                for (int bj = 0; bj < 2; ++bj)
#pragma unroll
                    for (int n = 0; n < 2; ++n) *(f32x4*)(gp + bj * 2816 + 4 * n) = acc[1][bj][3][n]; }
        }
        if (fr < 2 && wr == 0) { float* gp = HALO2 + ((size_t)u.pm * 2 + fr) * 5632 + colA;
#pragma unroll
            for (int bj = 0; bj < 2; ++bj)
#pragma unroll
                for (int n = 0; n < 2; ++n) *(f32x4*)(gp + bj * 2816 + 4 * n) = acc[0][bj][0][n]; }
        asm volatile("s_waitcnt lgkmcnt(0)" ::: "memory"); __builtin_amdgcn_s_barrier(); asm volatile("" ::: "memory");
#pragma unroll
        for (int ai = 0; ai < 2; ++ai) {
            const int strip = 2 * ai + wr;
            unsigned kx[4], ky[4];
#pragma unroll
            for (int n = 0; n < 2; ++n) {
                f32x4 wa[3], wb[3];
#pragma unroll
                for (int j = 0; j < 3; ++j) { wa[j] = *(const f32x4*)(cw + j * 5632 + colA + 4 * n); wb[j] = *(const f32x4*)(cw + j * 5632 + 2816 + colA + 4 * n); }
                const f32x4 ba = *(const f32x4*)(cb + colA + 4 * n), bb = *(const f32x4*)(cb + 2816 + colA + 4 * n);
                f32x4 h1a = {0.f, 0.f, 0.f, 0.f}, h2a = h1a, h1b = h1a, h2b = h1a;
                if (strip > 0) { const PG8_LAS float* hp = hl + ((strip - 1) * 2) * 256 + cc0 + 4 * n;
                    h2a = *(const PG8_LAS f32x4*)hp; h1a = *(const PG8_LAS f32x4*)(hp + 256); h2b = *(const PG8_LAS f32x4*)(hp + 128); h1b = *(const PG8_LAS f32x4*)(hp + 256 + 128); }
                f32x4 pr1a = h1a, pr2a = h2a, pr1b = h1b, pr2b = h2b;
#pragma unroll
                for (int m = 0; m < 4; ++m) {
                    const f32x4 ca = acc[ai][0][m][n], cbv = acc[ai][1][m][n];
                    f32x4 c1a, c2a, c1b, c2b;
#pragma unroll
                    for (int e = 0; e < 4; ++e) { c1a[e] = dpp_ror1(ca[e]); c2a[e] = dpp_ror2(ca[e]); c1b[e] = dpp_ror1(cbv[e]); c2b[e] = dpp_ror2(cbv[e]); }
                    float o[4];
#pragma unroll
                    for (int e = 0; e < 4; ++e) {
                        float x1a, x2a, x1b, x2b;
                        if (m > 0) { x1a = pr1a[e]; x2a = pr2a[e]; x1b = pr1b[e]; x2b = pr2b[e]; }
                        else { x1a = h1a[e]; x2a = (fr == 0) ? h2a[e] : h1a[e]; x1b = h1b[e]; x2b = (fr == 0) ? h2b[e] : h1b[e]; }
                        const float p1a = (fr == 0) ? x1a : c1a[e], p2a = (fr < 2) ? x2a : c2a[e];
                        const float p1b = (fr == 0) ? x1b : c1b[e], p2b = (fr < 2) ? x2b : c2b[e];
                        const float ya = wa[0][e] * p2a + wa[1][e] * p1a + wa[2][e] * ca[e] + ba[e];
                        const float yb = wb[0][e] * p2b + wb[1][e] * p1b + wb[2][e] * cbv[e] + bb[e];
                        o[e] = silu_f(ya) * yb;
                    }
                    pr1a = c1a; pr2a = c2a; pr1b = c1b; pr2b = c2b;
                    const unsigned w0 = cvt_pk_bf16(o[0], o[1]), w1 = cvt_pk_bf16(o[2], o[3]);
                    asm volatile("" :: "v"(w0), "v"(w1));
                    if (n == 0) { kx[m] = w0; ky[m] = w1; }
                    else { u32x4 w; w.x = kx[m]; w.y = ky[m]; w.z = w0; w.w = w1; *(u32x4*)(ACT + (size_t)(u.pm * BM + ai * HALF + wr * 64 + m * 16 + fr) * 2816 + colA) = w; }
                }
                asm volatile("" ::: "memory");
            }
        }
    }
};

template <class Epi, class Sched, bool ALIGN_EPI, bool SP2, int KC, int LDAC, bool F16 = false>
__device__ __forceinline__ void gemm_phase(int widk, PG8_LAS unsigned char* lds, const Gemm g, const Sched& S, const Epi& E) {
    int lane_; asm volatile("v_mbcnt_lo_u32_b32 %0, -1, 0\n\tv_mbcnt_hi_u32_b32 %0, -1, %0" : "=v"(lane_));
    int wid_ = widk; asm volatile("" : "+s"(wid_));
    const int wid = wid_, lane = lane_, tid = wid * 64 + lane, wr = wid >> 2, wc = wid & 3, fr = lane & 15, fq = lane >> 4;
    constexpr int K = KC, nt = K / BK;
    unsigned voffA[2], voffB[2];
#pragma unroll
    for (int i = 0; i < 2; ++i) { int R, C; stage_rc(tid * 16 + i * 8192, R, C); const int Rb = Epi::PERM ? ((R & ~31) + perm32(R & 31)) : R;
        voffA[i] = (unsigned)(R * LDAC + C) * 2u; voffB[i] = (unsigned)(Rb * K + C) * 2u; }
    const size_t kstep = (size_t)(BK * 2);
    const size_t hstepA = (size_t)HALF * LDAC * 2, hstepB = (size_t)HALF * K * 2;
    const size_t tstepA = 2 * hstepA, tstepB = 2 * hstepB;
    const unsigned ldsw = (unsigned)wid * 1024u;
    const int aoff = lds_byte(wr * 64 + fr, fq * 8), boff = lds_byte(wc * 32 + fr, fq * 8);
#define PG8_SA(b, h) (((b) * 2 + (h)) * HTB)
#define PG8_SB(b, h) ((4 + (b) * 2 + (h)) * HTB)
#define PG8_STAGE(bufoff, gbase, voff) do { _Pragma("unroll") for (int _i = 0; _i < 2; ++_i) \
        __builtin_amdgcn_global_load_lds((const unsigned*)((const char*)(gbase) + (voff)[_i]), (PG8_LAS unsigned*)(lds + (bufoff) + ldsw + _i * 8192), 16, 0, 0); } while (0)
#define PG8_LDA(dst, b, h) do { _Pragma("unroll") for (int m = 0; m < 4; ++m) _Pragma("unroll") for (int k = 0; k < 2; ++k) dst[m][k] = *(const PG8_LAS bf16x8*)(lds + PG8_SA(b, h) + aoff + m * 2048 + k * 1024); } while (0)
#define PG8_LDB(dst, b, h) do { _Pragma("unroll") for (int n = 0; n < 2; ++n) _Pragma("unroll") for (int k = 0; k < 2; ++k) dst[n][k] = *(const PG8_LAS bf16x8*)(lds + PG8_SB(b, h) + boff + n * 2048 + k * 1024); } while (0)
#define PG8_MMA(ai, bj, At, Bt) do { __builtin_amdgcn_s_setprio(1); _Pragma("unroll") for (int m = 0; m < 4; ++m) _Pragma("unroll") for (int n = 0; n < 2; ++n) _Pragma("unroll") for (int k = 0; k < 2; ++k) \
        acc[ai][bj][m][n] = mma16<F16>(Bt[n][k], At[m][k], acc[ai][bj][m][n]); __builtin_amdgcn_s_setprio(0); } while (0)
#define PG8_WAIT_V(n) asm volatile("s_waitcnt vmcnt(" #n ")" ::: "memory")
#define PG8_WAIT_L(n) asm volatile("s_waitcnt lgkmcnt(" #n ")" ::: "memory")
#define PG8_BAR __builtin_amdgcn_s_barrier()
#define PG8_SCHED __builtin_amdgcn_sched_barrier(0)
    Unit cur, nxt; int ui = 0;
    if (!S.next(0, cur)) return;
    f32x4 acc[2][2][4][2];
#pragma unroll
    for (int a = 0; a < 2; ++a)
#pragma unroll
        for (int b = 0; b < 2; ++b)
#pragma unroll
            for (int m = 0; m < 4; ++m)
#pragma unroll
                for (int n = 0; n < 2; ++n) acc[a][b][m][n] = (f32x4){0.f, 0.f, 0.f, 0.f};
    bf16x8 At[4][2], B0[2][2], B1[2][2];
    const char* cA = (const char*)g.A + (size_t)cur.pm * tstepA; const char* cB = (const char*)g.Bt + (size_t)cur.pn * tstepB;
    S.a_ready(cur);
    if constexpr (SP2) {
        PG8_STAGE(PG8_SB(0, 0), cB, voffB); PG8_STAGE(PG8_SB(0, 1), cB + hstepB, voffB); PG8_STAGE(PG8_SA(0, 0), cA, voffA); PG8_STAGE(PG8_SA(0, 1), cA + hstepA, voffA);
        if (wr == 1) PG8_BAR;
        PG8_WAIT_V(2); PG8_BAR;
        PG8_STAGE(PG8_SB(1, 0), cB + kstep, voffB); PG8_STAGE(PG8_SA(1, 0), cA + kstep, voffA); PG8_STAGE(PG8_SB(1, 1), cB + hstepB + kstep, voffB);
        PG8_WAIT_V(6); PG8_BAR;
    } else {
        PG8_STAGE(PG8_SB(0, 0), cB, voffB); PG8_STAGE(PG8_SA(0, 0), cA, voffA); PG8_STAGE(PG8_SB(0, 1), cB + hstepB, voffB); PG8_STAGE(PG8_SA(0, 1), cA + hstepA, voffA);
        if (wr == 1) PG8_BAR;
        PG8_WAIT_V(4); PG8_BAR;
        PG8_STAGE(PG8_SB(1, 0), cB + kstep, voffB); PG8_STAGE(PG8_SA(1, 0), cA + kstep, voffA); PG8_STAGE(PG8_SB(1, 1), cB + hstepB + kstep, voffB);
        PG8_WAIT_V(6); PG8_BAR;
    }
    for (;;) {
        const bool has_next = S.next(ui + 1, nxt);
        const char* nA = has_next ? (const char*)g.A + (size_t)nxt.pm * tstepA : cA; const char* nB = has_next ? (const char*)g.Bt + (size_t)nxt.pn * tstepB : cB;
        for (int t = 0; t < nt; t += 2) {
            const bool last = (t == nt - 2);
            const char* a1 = cA + (size_t)(t + 1) * kstep;
            const char* a2 = last ? nA : cA + (size_t)(t + 2) * kstep; const char* b2 = last ? nB : cB + (size_t)(t + 2) * kstep;
            const char* a3 = a2 + kstep; const char* b3 = b2 + kstep;
            if (last && has_next) S.a_ready(nxt);
            if constexpr (SP2) {
            PG8_LDB(B0, 0, 0); PG8_LDB(B1, 0, 1); PG8_SCHED; PG8_LDA(At, 0, 0); PG8_STAGE(PG8_SA(1, 1), a1 + hstepA, voffA);
            PG8_WAIT_V(8); PG8_WAIT_L(0); PG8_BAR; PG8_MMA(0, 0, At, B0); PG8_MMA(0, 1, At, B1); PG8_BAR; PG8_SCHED;
            PG8_LDA(At, 0, 1); PG8_STAGE(PG8_SB(0, 0), b2, voffB); PG8_STAGE(PG8_SB(0, 1), b2 + hstepB, voffB); PG8_STAGE(PG8_SA(0, 0), a2, voffA);
            PG8_WAIT_V(8); PG8_WAIT_L(0); PG8_BAR; PG8_MMA(1, 0, At, B0); PG8_MMA(1, 1, At, B1); PG8_BAR; PG8_SCHED;
            PG8_LDB(B0, 1, 0); PG8_LDB(B1, 1, 1); PG8_SCHED; PG8_LDA(At, 1, 0); PG8_STAGE(PG8_SA(0, 1), a2 + hstepA, voffA);
            PG8_WAIT_V(8); PG8_WAIT_L(0); PG8_BAR; PG8_MMA(0, 0, At, B0); PG8_MMA(0, 1, At, B1); PG8_BAR; PG8_SCHED;
            PG8_LDA(At, 1, 1); PG8_STAGE(PG8_SB(1, 0), b3, voffB); PG8_STAGE(PG8_SB(1, 1), b3 + hstepB, voffB); PG8_STAGE(PG8_SA(1, 0), a3, voffA);
            PG8_WAIT_V(8); PG8_WAIT_L(0); PG8_BAR; PG8_MMA(1, 0, At, B0); PG8_MMA(1, 1, At, B1); PG8_BAR; PG8_SCHED;
            } else {
            PG8_LDB(B0, 0, 0); PG8_SCHED; PG8_LDA(At, 0, 0); PG8_STAGE(PG8_SA(1, 1), a1 + hstepA, voffA);
            PG8_WAIT_L(8); PG8_BAR; PG8_WAIT_L(0); PG8_MMA(0, 0, At, B0); PG8_BAR; PG8_SCHED;
            PG8_LDB(B1, 0, 1); PG8_STAGE(PG8_SB(0, 0), b2, voffB);
            PG8_BAR; PG8_WAIT_L(0); PG8_MMA(0, 1, At, B1); PG8_BAR;
            PG8_LDA(At, 0, 1); PG8_STAGE(PG8_SA(0, 0), a2, voffA);
            PG8_BAR; PG8_WAIT_L(0); PG8_MMA(1, 0, At, B0); PG8_BAR; PG8_SCHED;
            PG8_STAGE(PG8_SB(0, 1), b2 + hstepB, voffB);
            PG8_WAIT_V(6); PG8_BAR; PG8_MMA(1, 1, At, B1); PG8_BAR;
            PG8_LDB(B0, 1, 0); PG8_SCHED; PG8_LDA(At, 1, 0); PG8_STAGE(PG8_SA(0, 1), a2 + hstepA, voffA);
            PG8_WAIT_L(8); PG8_BAR; PG8_WAIT_L(0); PG8_MMA(0, 0, At, B0); PG8_BAR; PG8_SCHED;
            PG8_LDB(B1, 1, 1); PG8_STAGE(PG8_SB(1, 0), b3, voffB);
            PG8_BAR; PG8_WAIT_L(0); PG8_MMA(0, 1, At, B1); PG8_BAR;
            PG8_LDA(At, 1, 1); PG8_STAGE(PG8_SA(1, 0), a3, voffA);
            PG8_BAR; PG8_WAIT_L(0); PG8_MMA(1, 0, At, B0); PG8_BAR; PG8_SCHED;
            PG8_STAGE(PG8_SB(1, 1), b3 + hstepB, voffB);
            PG8_WAIT_V(6); PG8_BAR; PG8_MMA(1, 1, At, B1); PG8_BAR;
            }
        }
        if constexpr (ALIGN_EPI) { if (wr == 0) PG8_BAR; }
        if constexpr (!Epi::AFTER_DRAIN) { E(acc, cur, wr, wc, fr, fq); S.done(cur); }
        if (!has_next) break;
#pragma unroll
        for (int a = 0; a < 2; ++a)
#pragma unroll
            for (int b = 0; b < 2; ++b)
#pragma unroll
                for (int m = 0; m < 4; ++m)
#pragma unroll
                    for (int n = 0; n < 2; ++n) acc[a][b][m][n] = (f32x4){0.f, 0.f, 0.f, 0.f};
        cur = nxt; cA = nA; cB = nB; ++ui;
        if constexpr (ALIGN_EPI) { if (wr == 1) PG8_BAR; }
    }
    PG8_WAIT_V(0);
    if constexpr (!ALIGN_EPI) { if (wr == 0) PG8_BAR; }
    PG8_BAR;
    if constexpr (Epi::AFTER_DRAIN) { E.fused(acc, cur, wr, wc, fr, fq, lds, wid, lane); S.done(cur); }
#undef PG8_SA
#undef PG8_SB
#undef PG8_STAGE
#undef PG8_LDA
#undef PG8_LDB
#undef PG8_MMA
#undef PG8_WAIT_V
#undef PG8_WAIT_L
#undef PG8_BAR
#undef PG8_SCHED
}
}

#ifdef NO_GEMMB
#define PH_GEMMB if (0)
#else
#define PH_GEMMB
#endif
#ifdef NO_GEMMR
#define PH_GEMMR if (0)
#else
#define PH_GEMMR
#endif
namespace mk {
#define LAS __attribute__((address_space(3)))
typedef unsigned short bf16_t;
typedef short bf16x8 __attribute__((ext_vector_type(8)));
typedef short s16x4 __attribute__((ext_vector_type(4)));
typedef float f32x4 __attribute__((ext_vector_type(4)));
typedef float f32x16 __attribute__((ext_vector_type(16)));
typedef unsigned u32x4 __attribute__((ext_vector_type(4)));
typedef unsigned u32x2 __attribute__((ext_vector_type(2)));
using pg8::cvt_pk_bf16;

constexpr int NB = 32, T = 2048, D = 1024, M = NB * T, DEPTH = 4;
constexpr int NWAVES = 8, NTHR = 512;
constexpr int GDN_N = 4112, GDN_NMAIN = 4096, DIFF_N = 3072, FFN_H = 2816, FFN_N = 5632;
constexpr float LN_EPS = 1e-5f, RMS_EPS = 1e-6f;
constexpr float ALPHA = 1.6817928305074290f;
constexpr float LOG2E = 1.4426950408889634f;
constexpr int MH = M / 2;

constexpr size_t MiB = 1u << 20;
constexpr size_t WS_W = 2 * MiB;
constexpr size_t W_GWIN = 0, W_GWAB = W_GWIN + 2ull * 4096 * 1024 * 2, W_GWOUT = W_GWAB + 2ull * 16 * 1024 * 2, W_DWIN = W_GWOUT + 2ull * 1024 * 1024 * 2,
                 W_DWOUT = W_DWIN + 2ull * 3072 * 1024 * 2, W_FUP = W_DWOUT + 2ull * 1024 * 1024 * 2, W_FDOWN = W_FUP + 4ull * 5632 * 1024 * 2, W_END = W_FDOWN + 4ull * 1024 * 2816 * 2;
static_assert(WS_W + W_END <= 106 * MiB, "weights region");
constexpr size_t WS_CNT = 16384;
constexpr size_t WS_CTL_BYTES = 16384 + 8 * 256 * 16 * 4;
constexpr size_t WS_XBUF = 110 * MiB;
constexpr size_t WS_GB = 106 * MiB;
constexpr size_t WS_XN = 112 * MiB;
static_assert(WS_CTL_BYTES <= WS_W && WS_XBUF + 256ull * 4 * 256 * 2 * 4 <= WS_XN && WS_GB + 2ull * 65536 * 8 * 4 <= WS_XBUF, "small-buffer map");
constexpr size_t WS_H = 240 * MiB;
constexpr size_t WS_ACT = WS_H;
constexpr size_t WS_HALO = WS_H + 352 * MiB;
constexpr size_t WS_HALO2 = WS_HALO + 12 * MiB;
constexpr size_t WS_UT = WS_H + 512 * MiB;
constexpr size_t WS_WN = WS_UT + 128 * MiB;
constexpr size_t WS_VT = WS_H + 384 * MiB;
constexpr size_t WS_O = WS_VT + 128 * MiB;
constexpr size_t WS_ROPE = WS_WN + 128 * MiB;
constexpr size_t WS_END = WS_ROPE + 16 * MiB;
static_assert(WS_END <= 1024 * MiB, "workspace map");
constexpr int LDS_BYTES = 131072 + 2048 + 10240;

__device__ __forceinline__ float bf2f(unsigned short h) { return __uint_as_float((unsigned)h << 16); }
__device__ __forceinline__ unsigned short f2bf(float f) { return (unsigned short)(cvt_pk_bf16(f, 0.f) & 0xffffu); }
__device__ __forceinline__ float wave_sum(float v) {
#pragma unroll
    for (int o = 1; o < 64; o <<= 1) v += __shfl_xor(v, o);
    return v;
}
__device__ __forceinline__ float silu(float x) { return x * __builtin_amdgcn_rcpf(1.f + __expf(-x)); }
__device__ __forceinline__ void unpack8(const u32x4 v, float (&o)[8]) {
    o[0] = __uint_as_float(v.x << 16); o[1] = __uint_as_float(v.x & 0xffff0000u); o[2] = __uint_as_float(v.y << 16); o[3] = __uint_as_float(v.y & 0xffff0000u);
    o[4] = __uint_as_float(v.z << 16); o[5] = __uint_as_float(v.z & 0xffff0000u); o[6] = __uint_as_float(v.w << 16); o[7] = __uint_as_float(v.w & 0xffff0000u);
}
__device__ __forceinline__ u32x4 pack8(const float (&o)[8]) { u32x4 w; w.x = cvt_pk_bf16(o[0], o[1]); w.y = cvt_pk_bf16(o[2], o[3]); w.z = cvt_pk_bf16(o[4], o[5]); w.w = cvt_pk_bf16(o[6], o[7]); return w; }
__device__ __forceinline__ int crow(int r, int hi) { return (r & 3) + 8 * (r >> 2) + 4 * hi; }
#define LDS_WAIT() asm volatile("s_waitcnt lgkmcnt(0)" ::: "memory")
#define MK_IDS() int lane_; asm volatile("v_mbcnt_lo_u32_b32 %0, -1, 0\n\tv_mbcnt_hi_u32_b32 %0, -1, %0" : "=v"(lane_));   \
      \
    int wid_ = widk; asm volatile("" : "+s"(wid_)); const int lane = lane_, wid = wid_, tid = wid * 64 + lane; const int G_ = gridDim.x, gw = blockIdx.x * NWAVES + wid, NGW = G_ * NWAVES, gt = blockIdx.x * NTHR + tid, NGT = G_ * NTHR; \
    (void)lane; (void)wid; (void)gw; (void)NGW; (void)gt; (void)NGT

template <int UPPERM = 0, bool F16OUT = false> __device__ __forceinline__ void transpose_item(const float* W, int ldw, int K, int nblk, bf16_t* WT, LAS float* scr, int item, int lane) {
    const int kb = item / nblk, nb = item % nblk, k0 = 64 * kb, n0 = 32 * nb;
    const int r0 = UPPERM == 1 ? (n0 < FFN_H ? 256 * (n0 >> 7) + (n0 & 127) : 256 * ((n0 - FFN_H) >> 7) + 128 + ((n0 - FFN_H) & 127))
                 : UPPERM == 2 ? (n0 < 2048 ? (n0 & ~255) + 128 * ((n0 >> 5) & 1) + 32 * ((n0 >> 6) & 3) : n0) : n0;
#pragma unroll 8
    for (int i = 0; i < 32; ++i) { const int kk = 2 * i + (lane >> 5); scr[kk * 33 + (lane & 31)] = W[(size_t)(k0 + kk) * ldw + n0 + (lane & 31)]; }
    LDS_WAIT();
    const int c = lane & 7;
#pragma unroll
    for (int j = 0; j < 4; ++j) { const int n = (lane >> 3) + 8 * j; const LAS float* s = scr + (8 * c) * 33 + n;
        u32x4 o;
        if constexpr (F16OUT) { o.x = pg8::cvt_pk_f16(s[0 * 33], s[1 * 33]); o.y = pg8::cvt_pk_f16(s[2 * 33], s[3 * 33]); o.z = pg8::cvt_pk_f16(s[4 * 33], s[5 * 33]); o.w = pg8::cvt_pk_f16(s[6 * 33], s[7 * 33]); }
        else { o.x = cvt_pk_bf16(s[0 * 33], s[1 * 33]); o.y = cvt_pk_bf16(s[2 * 33], s[3 * 33]); o.z = cvt_pk_bf16(s[4 * 33], s[5 * 33]); o.w = cvt_pk_bf16(s[6 * 33], s[7 * 33]); }
        *(u32x4*)(WT + (size_t)(r0 + n) * K + k0 + 8 * c) = o; }
    LDS_WAIT();
}

#define XB_TMO      128
#define XB_XCNT(j)  (256  + 64 * (j))
#define XB_XSUB(j)  (1280 + 64 * (j))
#define XB_XGEN(j)  (2304 + 64 * (j))
#define XB_TOP      3328
#define XB_TOPGEN   3392
#define XCD_BAR_WORDS 3456
#define XB_SPIN_CAP (1u << 18)

__device__ __forceinline__ unsigned xb_ld(unsigned* p)              { return __hip_atomic_load(p, __ATOMIC_RELAXED, __HIP_MEMORY_SCOPE_AGENT); }
__device__ __forceinline__ unsigned xb_add(unsigned* p, unsigned v) { return __hip_atomic_fetch_add(p, v, __ATOMIC_RELAXED, __HIP_MEMORY_SCOPE_AGENT); }
__device__ __forceinline__ unsigned xb_xcc_id() { return (unsigned)__builtin_amdgcn_s_getreg((3 << 11) | 20) & 0xFu; }
#define XB_SPIN(cond, bar) do { unsigned _sp = 0; while (cond) { __builtin_amdgcn_s_sleep(1); \
    if ((++_sp & 255u) == 0u) { if (xb_ld(&(bar)[XB_TMO])) break; if (_sp > XB_SPIN_CAP) { atomicAdd(&(bar)[XB_TMO], 1u); break; } } } } while (0)

struct XcdBarrier {
    unsigned* bar; unsigned x;
    volatile LAS unsigned* st;
};

__device__ __forceinline__ XcdBarrier xcd_barrier_post(unsigned* bar, volatile LAS unsigned* st) {
    XcdBarrier b; b.bar = bar; b.x = xb_xcc_id(); b.st = st;
    if (threadIdx.x == 0) (void)xb_add(&bar[XB_XCNT(b.x)], 1u);
    return b;
}
__device__ __forceinline__ void xcd_barrier_complete(unsigned* bar, unsigned x, unsigned& nloc, unsigned& nx) {
    const unsigned G = gridDim.x * gridDim.y * gridDim.z;
    unsigned sum, cnt, mine, sp = 0u;
    for (;;) {
        sum = 0u; cnt = 0u; mine = 0u;
#pragma unroll
        for (unsigned j = 0; j < 16; ++j) { const unsigned c = xb_ld(&bar[XB_XCNT(j)]); sum += c; cnt += (c > 0u) ? 1u : 0u; mine = (j == x) ? c : mine; }
        if (sum == G) break;
        __builtin_amdgcn_s_sleep(1);
        if ((++sp & 255u) == 0u) { if (xb_ld(&bar[XB_TMO])) break; if (sp > XB_SPIN_CAP) { atomicAdd(&bar[XB_TMO], 1u); break; } }
    }
    nloc = mine > 0u ? mine : 1u; nx = cnt > 0u ? cnt : 1u;
}

__device__ __forceinline__ void xcd_barrier(const XcdBarrier& b, int widk) {
    asm volatile("s_waitcnt vmcnt(0)" ::: "memory");
    __syncthreads();
    int xl_; asm volatile("v_mbcnt_lo_u32_b32 %0, -1, 0\n\tv_mbcnt_hi_u32_b32 %0, -1, %0" : "=v"(xl_));
    if (widk == 0 && xl_ == 0) {
        unsigned* bar = b.bar;
        __builtin_amdgcn_s_waitcnt(0);
        unsigned nloc = b.st[0], nx = b.st[1];
        if (nloc == 0u) { xcd_barrier_complete(bar, b.x, nloc, nx); b.st[0] = nloc; b.st[1] = nx; }
        const unsigned old = xb_add(&bar[XB_XSUB(b.x)], 1u);
        const unsigned gen = old / nloc;
        if (old + 1u == (gen + 1u) * nloc) {
            __builtin_amdgcn_fence(__ATOMIC_RELEASE, "agent");
            asm volatile("s_waitcnt vmcnt(0)" ::: "memory");
            const unsigned og = xb_add(&bar[XB_TOP], 1u);
            const unsigned tg = og / nx;
            if (og + 1u == (tg + 1u) * nx) xb_add(&bar[XB_TOPGEN], 1u);
            else XB_SPIN(xb_ld(&bar[XB_TOPGEN]) == tg, bar);
            __builtin_amdgcn_fence(__ATOMIC_ACQUIRE, "agent");
            xb_add(&bar[XB_XGEN(b.x)], 1u);
            asm volatile("s_waitcnt vmcnt(0)" ::: "memory");
        } else {
            XB_SPIN(xb_ld(&bar[XB_XGEN(b.x)]) == gen, bar);
            __builtin_amdgcn_fence(__ATOMIC_ACQUIRE, "agent");
            asm volatile("s_waitcnt vmcnt(0)" ::: "memory");
        }
    }
    __syncthreads();
}

struct Params {
    const float* in[23];
    const int* positions;
    float* out;
    unsigned char* ws;
};

__device__ __forceinline__ void prologue(int widk, const Params& p, LAS unsigned char* lds) {
    MK_IDS(); const int wave = wid;
    LAS float* scr = (LAS float*)(lds + wave * 16384);
    unsigned char* wsw = p.ws + WS_W;
    constexpr int I_GWIN = 16 * 128, I_SQ = 16 * 32, I_DWIN = 16 * 96, I_FUP = 16 * 176, I_FDN = 44 * 32;
    constexpr int NITEMS = 2 * I_GWIN + 2 * I_SQ + 2 * I_DWIN + 2 * I_SQ + 4 * I_FUP + 4 * I_FDN;
    for (int it = gw; it < NITEMS; it += NGW) {
        int r = it;
        if (r < 2 * I_GWIN) { const int j = r / I_GWIN; r %= I_GWIN; transpose_item<0, true>(p.in[2] + (size_t)j * 1024 * GDN_N, GDN_N, 1024, 128, (bf16_t*)(wsw + W_GWIN) + (size_t)j * 4096 * 1024, scr, r, lane); continue; } r -= 2 * I_GWIN;
        if (r < 2 * I_SQ) { const int j = r / I_SQ; r %= I_SQ; transpose_item(p.in[7] + (size_t)j * 1024 * 1024, 1024, 1024, 32, (bf16_t*)(wsw + W_GWOUT) + (size_t)j * 1024 * 1024, scr, r, lane); continue; } r -= 2 * I_SQ;
        if (r < 2 * I_DWIN) { const int j = r / I_DWIN; r %= I_DWIN; transpose_item<2, true>(p.in[8] + (size_t)j * 1024 * DIFF_N, DIFF_N, 1024, 96, (bf16_t*)(wsw + W_DWIN) + (size_t)j * 3072 * 1024, scr, r, lane); continue; } r -= 2 * I_DWIN;
        if (r < 2 * I_SQ) { const int j = r / I_SQ; r %= I_SQ; transpose_item(p.in[14] + (size_t)j * 1024 * 1024, 1024, 1024, 32, (bf16_t*)(wsw + W_DWOUT) + (size_t)j * 1024 * 1024, scr, r, lane); continue; } r -= 2 * I_SQ;
        if (r < 4 * I_FUP) { const int j = r / I_FUP; r %= I_FUP; transpose_item<1, true>(p.in[15] + (size_t)j * 1024 * FFN_N, FFN_N, 1024, 176, (bf16_t*)(wsw + W_FUP) + (size_t)j * 5632 * 1024, scr, r, lane); continue; } r -= 4 * I_FUP;
        { const int j = r / I_FDN; r %= I_FDN; transpose_item(p.in[18] + (size_t)j * 2816 * 1024, 1024, 2816, 32, (bf16_t*)(wsw + W_FDOWN) + (size_t)j * 1024 * 2816, scr, r, lane); }
    }
    for (int e = gt; e < 2 * 16 * 1024; e += NGT) { const int j = e >> 14, n = (e >> 10) & 15, k = e & 1023;
        ((bf16_t*)(wsw + W_GWAB))[e] = (unsigned short)(pg8::cvt_pk_f16(p.in[2][(size_t)j * 1024 * GDN_N + (size_t)k * GDN_N + GDN_NMAIN + n], 0.f) & 0xffffu); }
    { unsigned* CS = (unsigned*)(p.ws + WS_ROPE);
      for (int e = gt; e < M * 32; e += NGT) { const int m = e >> 5, f = e & 31; const float inv = exp2f(-(float)f * (13.287712379549449f / 32.f)); float sn, cs; sincosf((float)p.positions[m] * inv, &sn, &cs); CS[e] = pg8::cvt_pk_f16(cs, sn); } }
    const f32x4* x4 = (const f32x4*)p.in[0]; u32x4* xn = (u32x4*)(p.ws + WS_XN);
    for (int e = gt; e < M * D / 8; e += NGT) { const f32x4 a = x4[2 * e], b = x4[2 * e + 1]; u32x4 w; w.x = pg8::cvt_pk_f16(a[0], a[1]); w.y = pg8::cvt_pk_f16(a[2], a[3]); w.z = pg8::cvt_pk_f16(b[0], b[1]); w.w = pg8::cvt_pk_f16(b[2], b[3]); xn[e] = w; }
}

__device__ __forceinline__ void ln_phase(int widk, float* X, bf16_t* XN, const float* g, const float* b) {
    MK_IDS();
    f32x4 gv[4], bv[4];
#pragma unroll
    for (int j = 0; j < 4; ++j) { gv[j] = ((const f32x4*)g)[lane + 64 * j]; bv[j] = ((const f32x4*)b)[lane + 64 * j]; }
    for (int m = gw; m < M; m += NGW) {
        f32x4* xr = (f32x4*)(X + (size_t)m * D) + lane;
        f32x4 v[4]; float s = 0.f;
#pragma unroll
        for (int j = 0; j < 4; ++j) { v[j] = xr[64 * j]; s += (v[j][0] + v[j][1]) + (v[j][2] + v[j][3]); }
        const float mean = wave_sum(s) * (1.f / D); float s2 = 0.f;
#pragma unroll
        for (int j = 0; j < 4; ++j) { v[j] = v[j] - mean; s2 += (v[j][0] * v[j][0] + v[j][1] * v[j][1]) + (v[j][2] * v[j][2] + v[j][3] * v[j][3]); }
        const float rstd = 1.f / sqrtf(wave_sum(s2) * (1.f / D) + LN_EPS);
        u32x2* o8 = (u32x2*)(XN + (size_t)m * D) + lane;
#pragma unroll
        for (int j = 0; j < 4; ++j) { const f32x4 o = v[j] * rstd * gv[j] + bv[j]; xr[64 * j] = o; u32x2 w; w.x = pg8::cvt_pk_f16(o[0], o[1]); w.y = pg8::cvt_pk_f16(o[2], o[3]); o8[64 * j] = w; }
    }
}

__device__ __forceinline__ void ffn_fixup_phase(int widk, bf16_t* ACT, const float* HALO, const float* HALO2, const float* cw, const float* cb) {
    MK_IDS();
    constexpr int NCG = FFN_H / 4;
    for (int item = gt; item < (M / 256) * NCG; item += NGT) {
        const int pm = item / NCG, col = (item % NCG) * 4;
        if ((pm & 7) == 0) continue;
        f32x4 wa[3], wb[3];
#pragma unroll
        for (int j = 0; j < 3; ++j) { wa[j] = *(const f32x4*)(cw + j * FFN_N + col); wb[j] = *(const f32x4*)(cw + j * FFN_N + FFN_H + col); }
        const f32x4 ba = *(const f32x4*)(cb + col), bb = *(const f32x4*)(cb + FFN_H + col);
        const float* hp = HALO + (size_t)(pm - 1) * 2 * FFN_N + col; const float* h2 = HALO2 + (size_t)pm * 2 * FFN_N + col;
        const f32x4 am2 = *(const f32x4*)hp, am1 = *(const f32x4*)(hp + FFN_N), a0 = *(const f32x4*)h2, a1 = *(const f32x4*)(h2 + FFN_N);
        const f32x4 bm2 = *(const f32x4*)(hp + FFN_H), bm1 = *(const f32x4*)(hp + FFN_N + FFN_H), b0 = *(const f32x4*)(h2 + FFN_H), b1 = *(const f32x4*)(h2 + FFN_N + FFN_H);
        float o0[4], o1[4];
#pragma unroll
        for (int e = 0; e < 4; ++e) {
            o0[e] = silu(wa[0][e] * am2[e] + wa[1][e] * am1[e] + wa[2][e] * a0[e] + ba[e]) * (wb[0][e] * bm2[e] + wb[1][e] * bm1[e] + wb[2][e] * b0[e] + bb[e]);
            o1[e] = silu(wa[0][e] * am1[e] + wa[1][e] * a0[e] + wa[2][e] * a1[e] + ba[e]) * (wb[0][e] * bm1[e] + wb[1][e] * b0[e] + wb[2][e] * b1[e] + bb[e]);
        }
        u32x2 w; w.x = cvt_pk_bf16(o0[0], o0[1]); w.y = cvt_pk_bf16(o0[2], o0[3]); *(u32x2*)(ACT + (size_t)(pm * 256) * FFN_H + col) = w;
        w.x = cvt_pk_bf16(o1[0], o1[1]); w.y = cvt_pk_bf16(o1[2], o1[3]); *(u32x2*)(ACT + (size_t)(pm * 256 + 1) * FFN_H + col) = w;
    }
}

__device__ __forceinline__ void gdn_ab_phase(int widk, const bf16_t* XN, const bf16_t* wabT  , const float* a_log, const float* dt_bias, float* G, float* BETA) {
    MK_IDS();
    const int n = lane & 15, q4 = lane >> 4, h = n & 7;
    const float al = -__expf(a_log[h]), db = dt_bias[h];
    for (int it = gw; it < M / 16; it += NGW) {
        const int m0 = it * 16;
        f32x4 acc = {0.f, 0.f, 0.f, 0.f};
        const bf16_t* ap = XN + (size_t)(m0 + n) * D + 8 * q4;
        const bf16_t* bp = wabT + (size_t)n * D + 8 * q4;
#pragma unroll 8
        for (int ks = 0; ks < 32; ++ks) { const bf16x8 a = *(const bf16x8*)(ap + 32 * ks), b = *(const bf16x8*)(bp + 32 * ks); acc = pg8::mma16<true>(a, b, acc); }
#pragma unroll
        for (int i = 0; i < 4; ++i) { const int m = m0 + 4 * q4 + i; const float v = acc[i];
            if (n < 8) { const float x = v + db; const float sp = x > 20.f ? x : log1pf(__expf(x)); G[(size_t)m * 8 + h] = al * sp; }
            else BETA[(size_t)m * 8 + h] = 1.f / (1.f + __expf(-v)); }
    }
}

__device__ __forceinline__ void conv_silu16(const bf16_t* hp, int t, const LAS float* cw, float (&y)[16]) {
#pragma unroll
    for (int c = 0; c < 16; ++c) y[c] = 0.f;
#pragma unroll
    for (int j = 0; j < 4; ++j) {
        if (t - 3 + j >= 0) {
            float x[16];
            const bf16_t* rp = hp + (ptrdiff_t)(j - 3) * GDN_NMAIN;
            { float t8[8]; unpack8(*(const u32x4*)rp, t8);
#pragma unroll
              for (int c = 0; c < 8; ++c) x[c] = t8[c];
              unpack8(*(const u32x4*)(rp + 8), t8);
#pragma unroll
              for (int c = 0; c < 8; ++c) x[8 + c] = t8[c]; }
#pragma unroll
            for (int q = 0; q < 4; ++q) { const f32x4 w = *(const LAS f32x4*)(cw + j * 128 + 4 * q);
#pragma unroll
                for (int e = 0; e < 4; ++e) y[4 * q + e] += w[e] * x[4 * q + e]; }
        }
    }
#pragma unroll
    for (int c = 0; c < 16; ++c) y[c] = silu(y[c]);
}
__device__ __forceinline__ float sumsq16_8lanes(const float (&y)[16]) {
    float s = 0.f;
#pragma unroll
    for (int c = 0; c < 16; ++c) s += y[c] * y[c];
    s += __shfl_xor(s, 1); s += __shfl_xor(s, 2); s += __shfl_xor(s, 4);
    return s;
}
__device__ __forceinline__ void pack16(const float (&y)[16], u32x4& a, u32x4& b) {
    a.x = cvt_pk_bf16(y[0], y[1]); a.y = cvt_pk_bf16(y[2], y[3]); a.z = cvt_pk_bf16(y[4], y[5]); a.w = cvt_pk_bf16(y[6], y[7]);
    b.x = cvt_pk_bf16(y[8], y[9]); b.y = cvt_pk_bf16(y[10], y[11]); b.z = cvt_pk_bf16(y[12], y[13]); b.w = cvt_pk_bf16(y[14], y[15]);
}
__device__ __forceinline__ void unpack16(const u32x4 a, const u32x4 b, float (&y)[16]) {
    float t8[8]; unpack8(a, t8);
#pragma unroll
    for (int c = 0; c < 8; ++c) y[c] = t8[c];
    unpack8(b, t8);
#pragma unroll
    for (int c = 0; c < 8; ++c) y[8 + c] = t8[c];
}
__device__ __forceinline__ bf16x8 lds_frag16(const LAS unsigned char* p) { return *(const LAS bf16x8*)p; }
__device__ __forceinline__ bf16x8 lds_frag8x2(const LAS unsigned char* p0, const LAS unsigned char* p1) {
    const s16x4 a = *(const volatile LAS s16x4*)p0, b = *(const volatile LAS s16x4*)p1; return (bf16x8){a[0], a[1], a[2], a[3], b[0], b[1], b[2], b[3]};
}

constexpr int GA_GC = 0, GA_BT = 256, GA_CW = 512, GA_Q = GA_CW + 3 * 4 * 128 * 4, GA_K = GA_Q + 64 * 272, GA_LT = GA_K + 64 * 272, GA_END = GA_LT + 8 * 8192;
static_assert(GA_END <= 131072 && GA_LT % 16 == 0, "GDN phase A LDS map");
constexpr int GB_GC = 0, GB_BT = 512, GB_Q = 1024,     GB_KB = GB_Q + 64 * 272, GB_VB = GB_KB + 64 * 272, GB_KD = GB_VB + 64 * 272, GB_T = GB_KD + 128 * 144, GB_AT = GB_T + 64 * 144, GB_O = GB_AT + 64 * 144, GB_END = GB_O + 64 * 528;
static_assert(GB_END <= 131072 && GB_O % 16 == 0, "GDN phase B LDS map");

template <int I, int J> __device__ __forceinline__ void inv_row(float& s0, float& s1, const float lr, const float (&t)[64]) {
    if constexpr (J + 8 <= I) {
        int a0, a1, a2, a3, a4, a5, a6, a7;
        asm volatile("v_readlane_b32 %2, %10, %19\n\tv_readlane_b32 %3, %10, %19+1\n\tv_readlane_b32 %4, %10, %19+2\n\tv_readlane_b32 %5, %10, %19+3\n\t"
                     "v_readlane_b32 %6, %10, %19+4\n\tv_readlane_b32 %7, %10, %19+5\n\tv_readlane_b32 %8, %10, %19+6\n\tv_readlane_b32 %9, %10, %19+7\n\t"
                     "v_fma_f32 %0, -%11, %2, %0\n\tv_fma_f32 %1, -%12, %3, %1\n\tv_fma_f32 %0, -%13, %4, %0\n\tv_fma_f32 %1, -%14, %5, %1\n\t"
                     "v_fma_f32 %0, -%15, %6, %0\n\tv_fma_f32 %1, -%16, %7, %1\n\tv_fma_f32 %0, -%17, %8, %0\n\tv_fma_f32 %1, -%18, %9, %1"
                     : "+v"(s0), "+v"(s1), "=&s"(a0), "=&s"(a1), "=&s"(a2), "=&s"(a3), "=&s"(a4), "=&s"(a5), "=&s"(a6), "=&s"(a7)
                     : "v"(lr), "v"(t[J]), "v"(t[J + 1]), "v"(t[J + 2]), "v"(t[J + 3]), "v"(t[J + 4]), "v"(t[J + 5]), "v"(t[J + 6]), "v"(t[J + 7]), "i"(J));
        inv_row<I, J + 8>(s0, s1, lr, t);
    } else {
#pragma unroll
        for (int j = J; j < I; ++j) { const float lj = __int_as_float(__builtin_amdgcn_readlane(__float_as_int(lr), j)); if (j & 1) s1 -= lj * t[j]; else s0 -= lj * t[j]; }
    }
}
template <int I0> __device__ __forceinline__ void inv_rows8(const LAS float* Lp, const float flane, float (&t)[64]) {
    float lr[8];
#pragma unroll
    for (int k = 0; k < 8; ++k) lr[k] = Lp[((I0 + k) * (I0 + k - 1)) / 2];
#define INV_ROW(k) { float s0 = 1.f - fminf(fabsf(flane - (float)(I0 + k)), 1.f), s1 = 0.f; inv_row<I0 + k, 0>(s0, s1, lr[k], t); t[I0 + k] = s0 + s1; }
    INV_ROW(0) INV_ROW(1) INV_ROW(2) INV_ROW(3) INV_ROW(4) INV_ROW(5) INV_ROW(6) INV_ROW(7)
#undef INV_ROW
}

__device__ __forceinline__ void gdn_phase_a(int widk, bf16_t* H, const float* G, const float* BETA, const float* convw  , bf16_t* TG, bf16_t* ATT, LAS unsigned char* lds) {
    MK_IDS();
    LAS float* gcs = (LAS float*)(lds + GA_GC); LAS float* bts = (LAS float*)(lds + GA_BT); LAS float* cwl = (LAS float*)(lds + GA_CW);
    for (int bh = blockIdx.x; bh < 256; bh += gridDim.x) {
        const int b = bh >> 3, h = bh & 7;
        __syncthreads();
        for (int e = tid; e < 3 * 4 * 128; e += NTHR) { const int ten = e / 512, tap = (e >> 7) & 3, c = e & 127; cwl[e] = convw[tap * 3072 + ten * 1024 + h * 128 + c]; }
        __syncthreads();
        float gnext = 0.f, bnext = 0.f;
        if (wid == 0) { gnext = G[(size_t)(b * T + 31 * 64 + lane) * 8 + h]; bnext = BETA[(size_t)(b * T + 31 * 64 + lane) * 8 + h]; }
        for (int sg = 3; sg >= 0; --sg) {
            for (int k = 7; k >= 0; --k) {
                const int n = sg * 8 + k, it = n * 256 + bh, m0 = b * T + n * 64;
                if (wid == 0) { float c = gnext;
#pragma unroll
                    for (int o = 1; o < 64; o <<= 1) { const float t = __shfl_up(c, o); if (lane >= o) c += t; }
                    gcs[lane] = c; bts[lane] = bnext;
                    if (n > 0) { gnext = G[(size_t)(m0 - 64 + lane) * 8 + h]; bnext = BETA[(size_t)(m0 - 64 + lane) * 8 + h]; } }
                const int r = tid >> 3, c0 = (tid & 7) * 16, t = n * 64 + r; bf16_t* hp = H + (size_t)(m0 + r) * GDN_NMAIN + h * 128 + c0;
                u32x4 st[6];
                {   float y[16];
                    conv_silu16(hp, t, cwl + c0, y);
                    { const float rinv = rsqrtf(sumsq16_8lanes(y) + RMS_EPS) * 0.08838834764831845f;
#pragma unroll
                      for (int c = 0; c < 16; ++c) y[c] *= rinv; pack16(y, st[0], st[1]); }
                    conv_silu16(hp + 1024, t, cwl + 512 + c0, y);
                    { const float rinv = rsqrtf(sumsq16_8lanes(y) + RMS_EPS);
#pragma unroll
                      for (int c = 0; c < 16; ++c) y[c] *= rinv; pack16(y, st[2], st[3]); }
                    conv_silu16(hp + 2048, t, cwl + 1024 + c0, y);
                    pack16(y, st[4], st[5]);
                    *(LAS u32x4*)(lds + GA_Q + r * 272 + c0 * 2) = st[0]; *(LAS u32x4*)(lds + GA_Q + r * 272 + c0 * 2 + 16) = st[1];
                    *(LAS u32x4*)(lds + GA_K + r * 272 + c0 * 2) = st[2]; *(LAS u32x4*)(lds + GA_K + r * 272 + c0 * 2 + 16) = st[3];
                }
                __syncthreads();
                *(u32x4*)hp = st[0]; *(u32x4*)(hp + 8) = st[1]; *(u32x4*)(hp + 1024) = st[2]; *(u32x4*)(hp + 1024 + 8) = st[3]; *(u32x4*)(hp + 2048) = st[4]; *(u32x4*)(hp + 2048 + 8) = st[5];
                {
                    const int which = wid >> 2, bi = (wid >> 1) & 1, bj = wid & 1, l31 = lane & 31, hi = lane >> 5;
                    LAS float* Lt = (LAS float*)(lds + GA_LT + k * 8192);
                    f32x16 acc = {};
                    if (!(bi == 0 && bj == 1)) {
                        const LAS unsigned char* ap = lds + (which ? GA_Q : GA_K) + (32 * bi + l31) * 272 + hi * 16;
                        const LAS unsigned char* bp = lds + GA_K + (32 * bj + l31) * 272 + hi * 16;
#pragma unroll
                        for (int ks = 0; ks < 8; ++ks) acc = __builtin_amdgcn_mfma_f32_32x32x16_bf16(lds_frag16(ap + ks * 32), lds_frag16(bp + ks * 32), acc, 0, 0, 0);
                    }
                    const int j = 32 * bj + l31; const float gcj = gcs[j];
#pragma unroll
                    for (int rr = 0; rr < 16; ++rr) { const int i = 32 * bi + crow(rr, hi); const float dec = __expf(fminf(gcs[i] - gcj, 0.f));
                        if (which == 0) { if (i > j) Lt[(i * (i - 1)) / 2 + j] = bts[i] * acc[rr] * dec; }
                        else ATT[((size_t)it * 64 + i) * 64 + j] = f2bf((i >= j) ? acc[rr] * dec : 0.f); }
                }
                __syncthreads();
            }
            {
                float t[64]; const float flane = (float)lane;
                const LAS float* Lp = (const LAS float*)(lds + GA_LT + wid * 8192) + lane; asm volatile("" : "+v"(Lp));
                inv_rows8<0>(Lp, flane, t); inv_rows8<8>(Lp, flane, t); inv_rows8<16>(Lp, flane, t); inv_rows8<24>(Lp, flane, t);
                inv_rows8<32>(Lp, flane, t); inv_rows8<40>(Lp, flane, t); inv_rows8<48>(Lp, flane, t); inv_rows8<56>(Lp, flane, t);
                bf16_t* tp = TG + (size_t)((sg * 8 + wid) * 256 + bh) * 4096 + lane;
#pragma unroll
                for (int i = 0; i < 64; ++i) tp[i * 64] = f2bf(t[i]);
            }
        }
    }
    __syncthreads();
}

__device__ __forceinline__ void gdn_phase_b(int widk, bf16_t* H, const float* G, const float* BETA, const float* normw  , const bf16_t* TG, const bf16_t* ATT, LAS unsigned char* lds) {
    MK_IDS();
    LAS float* gcs = (LAS float*)(lds + GB_GC); LAS float* bts = (LAS float*)(lds + GB_BT);
    const int n16 = lane & 15, q4 = lane >> 4;
    for (int bh = blockIdx.x; bh < 256; bh += gridDim.x) {
        const int b = bh >> 3, h = bh & 7;
        f32x4 S[8];
#pragma unroll
        for (int s = 0; s < 8; ++s) S[s] = (f32x4){0.f, 0.f, 0.f, 0.f};
        const int r = tid >> 3, c0 = (tid & 7) * 16;
        u32x4 q0, q1, k0, k1, v0, v1, tt, aa, ga0, ga1; float gval = 0.f, bval = 0.f;
#define GB_LOAD(n_) do { const int it_ = (n_) * 256 + bh, m_ = b * T + (n_) * 64; const bf16_t* hq = H + (size_t)(m_ + r) * GDN_NMAIN + h * 128 + c0; \
            q0 = *(const u32x4*)hq; q1 = *(const u32x4*)(hq + 8); k0 = *(const u32x4*)(hq + 1024); k1 = *(const u32x4*)(hq + 1024 + 8); v0 = *(const u32x4*)(hq + 2048); v1 = *(const u32x4*)(hq + 2048 + 8); \
            ga0 = *(const u32x4*)(hq + 3072); ga1 = *(const u32x4*)(hq + 3072 + 8); \
            tt = ((const u32x4*)(TG + (size_t)it_ * 4096))[tid]; aa = ((const u32x4*)(ATT + (size_t)it_ * 4096))[tid]; \
            if (wid == 0) { gval = G[(size_t)(m_ + lane) * 8 + h]; bval = BETA[(size_t)(m_ + lane) * 8 + h]; } } while (0)
        GB_LOAD(0);
#define GB_CUMSUM(par_) do { if (wid == 0) { float c = gval; _Pragma("unroll") for (int o = 1; o < 64; o <<= 1) { const float t = __shfl_up(c, o); if (lane >= o) c += t; } \
            gcs[(par_) * 64 + lane] = c; bts[(par_) * 64 + lane] = bval; } } while (0)
        GB_CUMSUM(0);
        __syncthreads();
        for (int n = 0; n < 32; ++n) {
            const int m0 = b * T + n * 64, par = n & 1;
            bf16_t* hp = H + (size_t)(m0 + r) * GDN_NMAIN + h * 128 + c0;
            const float glast = gcs[par * 64 + 63];
            {   const float gcr = gcs[par * 64 + r], btr = bts[par * 64 + r], eg = __expf(gcr), ekd = __expf(glast - gcr);
                float y[16]; u32x4 a, bq;
                unpack16(q0, q1, y);
#pragma unroll
                for (int c = 0; c < 16; ++c) y[c] *= eg;
                pack16(y, a, bq); *(LAS u32x4*)(lds + GB_Q + r * 272 + c0 * 2) = a; *(LAS u32x4*)(lds + GB_Q + r * 272 + c0 * 2 + 16) = bq;
                unpack16(k0, k1, y);
#pragma unroll
                for (int c = 0; c < 16; ++c) *(LAS bf16_t*)(lds + GB_KD + (c0 + c) * 144 + r * 2) = f2bf(y[c] * ekd);
                { const float sc = btr * eg;
#pragma unroll
                  for (int c = 0; c < 16; ++c) y[c] *= sc; }
                pack16(y, a, bq); *(LAS u32x4*)(lds + GB_KB + r * 272 + c0 * 2) = a; *(LAS u32x4*)(lds + GB_KB + r * 272 + c0 * 2 + 16) = bq;
                unpack16(v0, v1, y);
#pragma unroll
                for (int c = 0; c < 16; ++c) y[c] *= btr;
                pack16(y, a, bq); *(LAS u32x4*)(lds + GB_VB + r * 272 + c0 * 2) = a; *(LAS u32x4*)(lds + GB_VB + r * 272 + c0 * 2 + 16) = bq;
                *(LAS u32x4*)(lds + GB_T + (tid >> 3) * 144 + (tid & 7) * 16) = tt;
                *(LAS u32x4*)(lds + GB_AT + (tid >> 3) * 144 + (tid & 7) * 16) = aa;
            }
            const u32x4 gk0 = ga0, gk1 = ga1;
            __syncthreads();
            if (n + 1 < 32) GB_LOAD(n + 1);
            {
                bf16x8 Sf[4];
#pragma unroll
                for (int ks = 0; ks < 4; ++ks) { u32x4 w; w.x = cvt_pk_bf16(S[2 * ks][0], S[2 * ks][1]); w.y = cvt_pk_bf16(S[2 * ks][2], S[2 * ks][3]);
                    w.z = cvt_pk_bf16(S[2 * ks + 1][0], S[2 * ks + 1][1]); w.w = cvt_pk_bf16(S[2 * ks + 1][2], S[2 * ks + 1][3]); Sf[ks] = __builtin_bit_cast(bf16x8, w); }
                f32x4 rr[4];
#pragma unroll
                for (int mt = 0; mt < 4; ++mt) {
                    const LAS unsigned char* vp = lds + GB_VB + (16 * mt + 4 * q4) * 272 + (16 * wid + n16) * 2;
                    rr[mt] = (f32x4){-bf2f(*(const LAS bf16_t*)vp), -bf2f(*(const LAS bf16_t*)(vp + 272)), -bf2f(*(const LAS bf16_t*)(vp + 544)), -bf2f(*(const LAS bf16_t*)(vp + 816))};
                    const LAS unsigned char* ap = lds + GB_KB + (16 * mt + n16) * 272 + 8 * q4;
#pragma unroll
                    for (int ks = 0; ks < 4; ++ks) rr[mt] = __builtin_amdgcn_mfma_f32_16x16x32_bf16(lds_frag8x2(ap + ks * 64, ap + ks * 64 + 32), Sf[ks], rr[mt], 0, 0, 0);
                }
                bf16x8 Rf[2];
#pragma unroll
                for (int kt = 0; kt < 2; ++kt) { u32x4 w; w.x = cvt_pk_bf16(-rr[2 * kt][0], -rr[2 * kt][1]); w.y = cvt_pk_bf16(-rr[2 * kt][2], -rr[2 * kt][3]);
                    w.z = cvt_pk_bf16(-rr[2 * kt + 1][0], -rr[2 * kt + 1][1]); w.w = cvt_pk_bf16(-rr[2 * kt + 1][2], -rr[2 * kt + 1][3]); Rf[kt] = __builtin_bit_cast(bf16x8, w); }
                f32x4 vn[4];
#pragma unroll
                for (int mt = 0; mt < 4; ++mt) { vn[mt] = (f32x4){0.f, 0.f, 0.f, 0.f};
                    const LAS unsigned char* tp = lds + GB_T + (16 * mt + n16) * 144 + 8 * q4;
#pragma unroll
                    for (int kt = 0; kt < 2; ++kt) if (kt == 0 || mt >= 2) vn[mt] = __builtin_amdgcn_mfma_f32_16x16x32_bf16(lds_frag8x2(tp + kt * 64, tp + kt * 64 + 32), Rf[kt], vn[mt], 0, 0, 0); }
                bf16x8 Vf[2];
#pragma unroll
                for (int kt = 0; kt < 2; ++kt) { u32x4 w; w.x = cvt_pk_bf16(vn[2 * kt][0], vn[2 * kt][1]); w.y = cvt_pk_bf16(vn[2 * kt][2], vn[2 * kt][3]);
                    w.z = cvt_pk_bf16(vn[2 * kt + 1][0], vn[2 * kt + 1][1]); w.w = cvt_pk_bf16(vn[2 * kt + 1][2], vn[2 * kt + 1][3]); Vf[kt] = __builtin_bit_cast(bf16x8, w); }
#pragma unroll
                for (int mt = 0; mt < 4; ++mt) {
                    f32x4 o = {0.f, 0.f, 0.f, 0.f};
                    const LAS unsigned char* qp = lds + GB_Q + (16 * mt + n16) * 272 + 8 * q4;
#pragma unroll
                    for (int ks = 0; ks < 4; ++ks) o = __builtin_amdgcn_mfma_f32_16x16x32_bf16(lds_frag8x2(qp + ks * 64, qp + ks * 64 + 32), Sf[ks], o, 0, 0, 0);
                    const LAS unsigned char* atp = lds + GB_AT + (16 * mt + n16) * 144 + 8 * q4;
#pragma unroll
                    for (int kt = 0; kt < 2; ++kt) if (kt == 0 || mt >= 2) o = __builtin_amdgcn_mfma_f32_16x16x32_bf16(lds_frag8x2(atp + kt * 64, atp + kt * 64 + 32), Vf[kt], o, 0, 0, 0);
#pragma unroll
                    for (int i = 0; i < 4; ++i) *(LAS float*)(lds + GB_O + (16 * mt + 4 * q4 + i) * 528 + (16 * wid + n16) * 4) = o[i];
                }
                const float eg = __expf(glast);
#pragma unroll
                for (int st = 0; st < 8; ++st) { S[st] = S[st] * eg;
                    const LAS unsigned char* kp = lds + GB_KD + (16 * st + n16) * 144 + 8 * q4;
#pragma unroll
                    for (int kt = 0; kt < 2; ++kt) S[st] = __builtin_amdgcn_mfma_f32_16x16x32_bf16(lds_frag8x2(kp + kt * 64, kp + kt * 64 + 32), Vf[kt], S[st], 0, 0, 0); }
            }
            if (n + 1 < 32) GB_CUMSUM(par ^ 1);
            __syncthreads();
            {
                float o[16];
#pragma unroll
                for (int q = 0; q < 4; ++q) { const f32x4 v = *(const LAS f32x4*)(lds + GB_O + r * 528 + (c0 + 4 * q) * 4); o[4 * q] = v[0]; o[4 * q + 1] = v[1]; o[4 * q + 2] = v[2]; o[4 * q + 3] = v[3]; }
                const float rstd = rsqrtf(sumsq16_8lanes(o) * (1.f / 128.f) + RMS_EPS);
                float gt[16]; unpack16(gk0, gk1, gt);
                float res[16];
#pragma unroll
                for (int c = 0; c < 16; ++c) res[c] = o[c] * rstd * normw[c0 + c] * silu(gt[c]);
                u32x4 a, bq; pack16(res, a, bq);
                *(u32x4*)(hp + 2048) = a; *(u32x4*)(hp + 2048 + 8) = bq;
            }
        }
        __syncthreads();
    }
}
#undef GB_CUMSUM
#undef GB_LOAD

__device__ __forceinline__ void diff_prep_phase(int widk, bf16_t* H  , const int* positions, bf16_t* VT  , LAS unsigned char* lds) {
    MK_IDS();
    LAS unsigned char* scr = lds + wid * 16384;
    for (int item = gw; item < NB * 32 * 16; item += NGW) {
        const int dvh = item & 1, h = (item >> 1) & 7, tb = (item >> 4) & 31, b = item >> 9;
        const bf16_t* src = H + ((size_t)b * T + tb * 64) * DIFF_N + 2048 + h * 128 + dvh * 64;
#pragma unroll
        for (int i = 0; i < 8; ++i) { const int row = (lane >> 3) + 8 * i, ch = lane & 7; *(LAS u32x4*)(scr + row * 144 + ch * 16) = *(const u32x4*)(src + (size_t)row * DIFF_N + ch * 8); }
        LDS_WAIT();
        bf16_t* dst = VT + (((size_t)b * 8 + h) * 128 + dvh * 64 + lane) * T + tb * 64;
#pragma unroll
        for (int k = 0; k < 8; ++k) { unsigned short v[8];
#pragma unroll
            for (int e = 0; e < 8; ++e) v[e] = *(const LAS bf16_t*)(scr + (8 * k + e) * 144 + lane * 2);
            u32x4 w; w.x = v[0] | ((unsigned)v[1] << 16); w.y = v[2] | ((unsigned)v[3] << 16); w.z = v[4] | ((unsigned)v[5] << 16); w.w = v[6] | ((unsigned)v[7] << 16);
            *(u32x4*)(dst + 8 * k) = w; }
        LDS_WAIT();
    }
}

constexpr int AT_STAGE = 36864, AT_K = 0, AT_V = 64 * 272, AT_OSTG = 2 * AT_STAGE;
static_assert(AT_OSTG + 128 * 272 <= 131072, "attention LDS map");
__device__ __forceinline__ void diff_attn_phase(int widk, const bf16_t* H, const bf16_t* VT, bf16_t* O, const float* lq1, const float* lk1, const float* lq2, const float* lk2, const float* subw, float lambda_init,
                                                LAS unsigned char* lds) {
    MK_IDS();
    const float lam = __expf(wave_sum(lq1[lane] * lk1[lane])) - __expf(wave_sum(lq2[lane] * lk2[lane])) + lambda_init;
    const int c = wid >> 2, rg = wid & 3, l31 = lane & 31, hi = lane >> 5;
    for (int bh = blockIdx.x; bh < 256; bh += gridDim.x) {
        const int b = bh >> 3, h = bh & 7;
        const bf16_t* Kg = H + (size_t)b * T * DIFF_N + 1024 + h * 128;
        const bf16_t* Vg = VT + (size_t)bh * 128 * T;
        for (int ui = 0; ui < 16; ++ui) {
            const int qb = (ui & 1) ? (15 - (ui >> 1)) : (ui >> 1);
            const int q0w = 128 * qb + 32 * rg, nt = 2 * qb + 2;
            bf16x8 qf[4];
            { const bf16_t* qp = H + ((size_t)b * T + q0w + l31) * DIFF_N + h * 128 + c * 64 + 8 * hi;
#pragma unroll
              for (int d0 = 0; d0 < 4; ++d0) qf[d0] = *(const bf16x8*)(qp + 16 * d0); }
            f32x16 o[4];
#pragma unroll
            for (int d = 0; d < 4; ++d) o[d] = (f32x16){};
            float mrun = -1e30f, lrun = 0.f;
            u32x4 pk[2], pv[2];
#define AT_LOAD(j) do { _Pragma("unroll") for (int i_ = 0; i_ < 2; ++i_) { const int ci = tid + 512 * i_; \
                pk[i_] = *(const u32x4*)(Kg + (size_t)((j) * 64 + (ci >> 4)) * DIFF_N + (ci & 15) * 8); \
                pv[i_] = *(const u32x4*)(Vg + (size_t)(ci >> 3) * T + (j) * 64 + (ci & 7) * 8); } } while (0)
            AT_LOAD(0);
            for (int j = 0; j < nt; ++j) {
                LAS unsigned char* st = lds + (j & 1) * AT_STAGE;
#pragma unroll
                for (int i_ = 0; i_ < 2; ++i_) { const int ci = tid + 512 * i_;
                    *(LAS u32x4*)(st + AT_K + (ci >> 4) * 272 + (ci & 15) * 16) = pk[i_];
                    { LAS unsigned char* vd = st + AT_V + (ci >> 3) * 136 + (ci & 7) * 16; *(LAS u32x2*)vd = (u32x2){pv[i_].x, pv[i_].y}; *(LAS u32x2*)(vd + 8) = (u32x2){pv[i_].z, pv[i_].w}; } }
                __syncthreads();
                if (j + 1 < nt) AT_LOAD(j + 1);
                if (64 * j <= q0w + 31) {
                    bf16x8 kf[2][4];
#pragma unroll
                    for (int kb = 0; kb < 2; ++kb) { const LAS unsigned char* kp = st + AT_K + (32 * kb + l31) * 272 + c * 128 + hi * 16;
#pragma unroll
                        for (int d0 = 0; d0 < 4; ++d0) kf[kb][d0] = lds_frag16(kp + d0 * 32); }
                    f32x16 p[2]; p[0] = (f32x16){}; p[1] = (f32x16){};
#pragma unroll
                    for (int d0 = 0; d0 < 4; ++d0) { p[0] = __builtin_amdgcn_mfma_f32_32x32x16_bf16(kf[0][d0], qf[d0], p[0], 0, 0, 0); p[1] = __builtin_amdgcn_mfma_f32_32x32x16_bf16(kf[1][d0], qf[d0], p[1], 0, 0, 0); }
                    const LAS unsigned char* vbase = st + AT_V + l31 * 136 + 8 * hi;
                    bf16x8 va[4], vb[4];
#define AT_LOADV(dst, t_) do { _Pragma("unroll") for (int d = 0; d < 4; ++d) dst[d] = lds_frag8x2(vbase + d * 32 * 136 + (t_) * 32, vbase + d * 32 * 136 + (t_) * 32 + 16); } while (0)
#define AT_MMA(src, pf_) do { _Pragma("unroll") for (int d = 0; d < 4; ++d) o[d] = __builtin_amdgcn_mfma_f32_32x32x16_bf16(src[d], pf_, o[d], 0, 0, 0); } while (0)
                    AT_LOADV(va, 0);
                    asm volatile("" ::: "memory");
                    if (64 * j + 63 > q0w) {
                        const int q = q0w + l31;
#pragma unroll
                        for (int kb = 0; kb < 2; ++kb)
#pragma unroll
                            for (int r = 0; r < 16; ++r) { const int kv = 64 * j + 32 * kb + crow(r, hi); if (kv > q) p[kb][r] = -1e30f; }
                    }
                    float mx0 = fmaxf(p[0][0], p[1][0]), mx1 = fmaxf(p[0][1], p[1][1]);
#pragma unroll
                    for (int r = 2; r < 16; r += 2) { mx0 = fmaxf(mx0, fmaxf(p[0][r], p[1][r])); mx1 = fmaxf(mx1, fmaxf(p[0][r + 1], p[1][r + 1])); }
                    float mx = fmaxf(mx0, mx1);
                    mx = fmaxf(mx, __shfl_xor(mx, 32));
                    const float mnew = fmaxf(mrun, mx);
                    if (__any(mnew > mrun)) {
                        const float al = __builtin_amdgcn_exp2f(mrun - mnew); lrun *= al;
#pragma unroll
                        for (int d = 0; d < 4; ++d) o[d] = o[d] * al;
                    }
                    mrun = mnew;
                    float ls0 = 0.f, ls1 = 0.f, ls2 = 0.f, ls3 = 0.f;
#pragma unroll
                    for (int kb = 0; kb < 2; ++kb)
#pragma unroll
                        for (int r = 0; r < 16; r += 4) { p[kb][r] = __builtin_amdgcn_exp2f(p[kb][r] - mnew); p[kb][r + 1] = __builtin_amdgcn_exp2f(p[kb][r + 1] - mnew);
                            p[kb][r + 2] = __builtin_amdgcn_exp2f(p[kb][r + 2] - mnew); p[kb][r + 3] = __builtin_amdgcn_exp2f(p[kb][r + 3] - mnew);
                            ls0 += p[kb][r]; ls1 += p[kb][r + 1]; ls2 += p[kb][r + 2]; ls3 += p[kb][r + 3]; }
                    lrun += (ls0 + ls1) + (ls2 + ls3);
                    bf16x8 pf[4];
#pragma unroll
                    for (int t = 0; t < 4; ++t) { const int kb = t >> 1, s8 = (t & 1) * 8;
                        u32x4 w; w.x = cvt_pk_bf16(p[kb][s8], p[kb][s8 + 1]); w.y = cvt_pk_bf16(p[kb][s8 + 2], p[kb][s8 + 3]);
                        w.z = cvt_pk_bf16(p[kb][s8 + 4], p[kb][s8 + 5]); w.w = cvt_pk_bf16(p[kb][s8 + 6], p[kb][s8 + 7]); pf[t] = __builtin_bit_cast(bf16x8, w); }
                    asm volatile("" ::: "memory");
                    AT_LOADV(vb, 1); asm volatile("" ::: "memory"); AT_MMA(va, pf[0]);
                    AT_LOADV(va, 2); asm volatile("" ::: "memory"); AT_MMA(vb, pf[1]);
                    AT_LOADV(vb, 3); asm volatile("" ::: "memory"); AT_MMA(va, pf[2]);
                    AT_MMA(vb, pf[3]);
#undef AT_LOADV
#undef AT_MMA
                }
            }
#undef AT_LOAD
            const float ltot = lrun + __shfl_xor(lrun, 32);
            const float inv = (c ? lam : 1.f) / ltot;
            __syncthreads();
            LAS float* xch = (LAS float*)lds + rg * 4096;
            if (c == 1) {
#pragma unroll
                for (int d = 0; d < 4; ++d)
#pragma unroll
                    for (int r = 0; r < 16; ++r) xch[(d * 16 + r) * 64 + lane] = o[d][r] * inv;
            }
            __syncthreads();
            if (c == 0) {
                float ss = 0.f;
#pragma unroll
                for (int d = 0; d < 4; ++d)
#pragma unroll
                    for (int r = 0; r < 16; ++r) { const float v = o[d][r] * inv - xch[(d * 16 + r) * 64 + lane]; o[d][r] = v; ss += v * v; }
                ss += __shfl_xor(ss, 32);
                const float rstd = rsqrtf(ss * (1.f / 128.f) + RMS_EPS) * (1.f - lambda_init);
                LAS unsigned char* op = lds + AT_OSTG + (rg * 32 + l31) * 272 + 8 * hi;
#pragma unroll
                for (int d = 0; d < 4; ++d)
#pragma unroll
                    for (int g = 0; g < 4; ++g) { const int dv = 32 * d + 8 * g + 4 * hi; const f32x4 sw = *(const f32x4*)(subw + dv);
                        u32x2 w; w.x = cvt_pk_bf16(o[d][4 * g] * rstd * sw[0], o[d][4 * g + 1] * rstd * sw[1]); w.y = cvt_pk_bf16(o[d][4 * g + 2] * rstd * sw[2], o[d][4 * g + 3] * rstd * sw[3]);
                        *(LAS u32x2*)(op + (32 * d + 8 * g) * 2) = w; }
            }
            __syncthreads();
            {
                const LAS unsigned char* sp = lds + AT_OSTG + (rg * 32 + c * 16) * 272;
                bf16_t* gp = O + ((size_t)b * T + 128 * qb + rg * 32 + c * 16) * D + h * 128;
#pragma unroll
                for (int i = 0; i < 4; ++i) { const int idx = i * 64 + lane, row = idx >> 4, ch = idx & 15;
                    *(u32x4*)(gp + (size_t)row * D + ch * 8) = *(const LAS u32x4*)(sp + row * 272 + ch * 16); }
            }
        }
    }
}

template <bool FUSED_LN> __global__ void __launch_bounds__(NTHR, 2) fwd_megakernel(Params p) {
    extern __shared__ __attribute__((aligned(16))) unsigned char lds_raw[];
    LAS unsigned char* lds = (LAS unsigned char*)lds_raw;
    cg::grid_group grid = cg::this_grid();
    const int widk = __builtin_amdgcn_readfirstlane((int)threadIdx.x >> 6);
    volatile LAS unsigned* bst = (volatile LAS unsigned*)(lds + 131072 + 1024);
    if (threadIdx.x < 2) bst[threadIdx.x] = 0u;
    if (blockIdx.x == 0) { for (unsigned i = threadIdx.x; i < WS_CTL_BYTES / 4; i += NTHR) ((unsigned*)p.ws)[i] = 0u; }
    __syncthreads();
    const int G = gridDim.x;
    constexpr bool fused_ln = FUSED_LN;
    unsigned char* ws = p.ws; unsigned char* wsw = ws + WS_W;
    bf16_t* XN = (bf16_t*)(ws + WS_XN); bf16_t* Hb = (bf16_t*)(ws + WS_H);
    float* Gb = (float*)(ws + WS_GB); float* BETAb = Gb + (size_t)M * 8;

    unsigned long long pt0 = 0, pticks = 0; (void)pt0;
    TBEG(4);
#ifndef NO_PRO
    REPS(4) prologue(widk, p, lds);
#endif
    grid.sync(); TEND(4);
    const XcdBarrier xbar = xcd_barrier_post((unsigned*)p.ws, bst);
    for (int layer = 0; layer < DEPTH; ++layer) {
        const int j = layer >> 1;
        const float* resid = (layer == 0) ? p.in[0] : p.out;
        if ((layer & 1) == 0) {
            TBEG(1);
            {   pg8::Gemm g{XN, (const bf16_t*)(wsw + W_GWIN) + (size_t)j * 4096 * 1024, M, GDN_NMAIN, D, D}; pg8::StaticOrder S; S.init(M, GDN_NMAIN, G, (int)blockIdx.x);
                pg8::EpiBf16 E{Hb, GDN_NMAIN};
                REPS(1) PH_GEMMB pg8::gemm_phase<pg8::EpiBf16, pg8::StaticOrder, true, true, D, D, true>(widk, lds, g, S, E); }
#ifndef NO_AB
            REPS(4) gdn_ab_phase(widk, XN, (const bf16_t*)(wsw + W_GWAB) + (size_t)j * 16 * 1024, p.in[4] + j * 8, p.in[5] + j * 8, Gb, BETAb);
#endif
            xcd_barrier(xbar, widk); TEND(1); TBEG(2);
#ifndef NO_GA
            gdn_phase_a(widk, Hb, Gb, BETAb, p.in[3] + (size_t)j * 4 * 3072, (bf16_t*)(ws + WS_UT) + (size_t)32 * 1024 * 1024, (bf16_t*)(ws + WS_UT), lds);
#endif
            xcd_barrier(xbar, widk);
#ifndef NO_GB
            gdn_phase_b(widk, Hb, Gb, BETAb, p.in[6] + j * 128, (const bf16_t*)(ws + WS_UT) + (size_t)32 * 1024 * 1024, (const bf16_t*)(ws + WS_UT), lds);
#endif
            xcd_barrier(xbar, widk); TEND(2); TBEG(5);
            {   pg8::Gemm g{Hb + 2048, (const bf16_t*)(wsw + W_GWOUT) + (size_t)j * 1024 * 1024, M, D, D, GDN_NMAIN}; pg8::StaticOrder S; S.init(M, D, G, (int)blockIdx.x);
                if constexpr (fused_ln) {
                    if (layer == 0) { pg8::EpiResidLn<false, false> E{p.in[0], p.out, XN, p.in[19] + layer * D, p.in[20] + layer * D, ALPHA, LN_EPS, (unsigned*)(ws + WS_XBUF), (unsigned*)(ws + WS_CNT) + (size_t)(2 * layer) * 4096, (LAS float*)(lds + 131072 + 2048)};
                        pg8::gemm_phase<pg8::EpiResidLn<false, false>, pg8::StaticOrder, true, true, D, GDN_NMAIN>(widk, lds, g, S, E); }
                    else { pg8::EpiResidLn<true, false> E{nullptr, p.out, XN, p.in[19] + layer * D, p.in[20] + layer * D, ALPHA, LN_EPS, (unsigned*)(ws + WS_XBUF), (unsigned*)(ws + WS_CNT) + (size_t)(2 * layer) * 4096, (LAS float*)(lds + 131072 + 2048)};
                        pg8::gemm_phase<pg8::EpiResidLn<true, false>, pg8::StaticOrder, true, true, D, GDN_NMAIN>(widk, lds, g, S, E); } }
                else { pg8::EpiResid E{resid, p.out, D, ALPHA};
                    PH_GEMMR pg8::gemm_phase<pg8::EpiResid, pg8::StaticOrder, true, true, D, GDN_NMAIN>(widk, lds, g, S, E); } }
        } else {
            const float lambda_init = 0.8f - 0.6f * expf(-0.3f * (float)layer);
            TBEG(1);
            {   pg8::Gemm g{XN, (const bf16_t*)(wsw + W_DWIN) + (size_t)j * 3072 * 1024, M, DIFF_N, D, D}; pg8::StaticOrder S; S.init(M, DIFF_N, G, (int)blockIdx.x);
                pg8::EpiRope E{Hb, (const unsigned*)(ws + WS_ROPE), 0.125f * LOG2E, (bf16_t*)(ws + WS_VT)};
                pg8::gemm_phase<pg8::EpiRope, pg8::StaticOrder, true, true, D, D, true>(widk, lds, g, S, E); }
            xcd_barrier(xbar, widk); TEND(1); TBEG(4);
#ifndef NO_ATT
            REPS(3) diff_attn_phase(widk, Hb, (const bf16_t*)(ws + WS_VT), (bf16_t*)(ws + WS_O), p.in[9] + j * 64, p.in[10] + j * 64, p.in[11] + j * 64, p.in[12] + j * 64, p.in[13] + j * 128, lambda_init, lds);
#endif
            xcd_barrier(xbar, widk); TEND(3); TBEG(5);
            {   pg8::Gemm g{(const bf16_t*)(ws + WS_O), (const bf16_t*)(wsw + W_DWOUT) + (size_t)j * 1024 * 1024, M, D, D, D}; pg8::StaticOrder S; S.init(M, D, G, (int)blockIdx.x);
                if constexpr (fused_ln) { pg8::EpiResidLn<true, false> E{nullptr, p.out, XN, p.in[19] + layer * D, p.in[20] + layer * D, ALPHA, LN_EPS, (unsigned*)(ws + WS_XBUF), (unsigned*)(ws + WS_CNT) + (size_t)(2 * layer) * 4096, (LAS float*)(lds + 131072 + 2048)};
                    pg8::gemm_phase<pg8::EpiResidLn<true, false>, pg8::StaticOrder, true, true, D, D>(widk, lds, g, S, E); }
                else { pg8::EpiResid E{resid, p.out, D, ALPHA};
                    PH_GEMMR pg8::gemm_phase<pg8::EpiResid, pg8::StaticOrder, true, true, D, D>(widk, lds, g, S, E); } }
        }
        xcd_barrier(xbar, widk); TEND(5);
        if constexpr (!fused_ln) { ln_phase(widk, p.out, XN, p.in[19] + layer * D, p.in[20] + layer * D); xcd_barrier(xbar, widk); }
        {
            bf16_t* ACT = (bf16_t*)(ws + WS_ACT); float* HALO = (float*)(ws + WS_HALO); float* HALO2 = (float*)(ws + WS_HALO2);
            const float* fcw = p.in[16] + (size_t)layer * 3 * FFN_N; const float* fcb = p.in[17] + (size_t)layer * FFN_N;
            TBEG(6);
            {   pg8::Gemm g{XN, (const bf16_t*)(wsw + W_FUP) + (size_t)layer * 5632 * 1024, M, FFN_N, D, D}; pg8::StaticOrder S; S.init(M, FFN_N, G, (int)blockIdx.x);
                pg8::EpiFfnAct E{ACT, fcw, fcb, HALO, HALO2, (LAS float*)(lds + 131072 + 2048)};
                pg8::gemm_phase<pg8::EpiFfnAct, pg8::StaticOrder, true, true, D, D, true>(widk, lds, g, S, E); }
            xcd_barrier(xbar, widk); TEND(6); TBEG(4);
            ffn_fixup_phase(widk, ACT, HALO, HALO2, fcw, fcb);
            xcd_barrier(xbar, widk); TEND(4); TBEG(7);
            {   pg8::Gemm g{ACT, (const bf16_t*)(wsw + W_FDOWN) + (size_t)layer * 1024 * 2816, M, D, FFN_H, FFN_H}; pg8::StaticOrder S; S.init(M, D, G, (int)blockIdx.x);
                if constexpr (fused_ln) {
                    if (layer == DEPTH - 1) { pg8::EpiResidLn<true, true> E{nullptr, p.out, XN, p.in[21] + layer * D, p.in[22] + layer * D, ALPHA, LN_EPS, (unsigned*)(ws + WS_XBUF), (unsigned*)(ws + WS_CNT) + (size_t)(2 * layer + 1) * 4096, (LAS float*)(lds + 131072 + 2048)};
                        pg8::gemm_phase<pg8::EpiResidLn<true, true>, pg8::StaticOrder, true, true, FFN_H, FFN_H>(widk, lds, g, S, E); }
                    else { pg8::EpiResidLn<true, false> E{nullptr, p.out, XN, p.in[21] + layer * D, p.in[22] + layer * D, ALPHA, LN_EPS, (unsigned*)(ws + WS_XBUF), (unsigned*)(ws + WS_CNT) + (size_t)(2 * layer + 1) * 4096, (LAS float*)(lds + 131072 + 2048)};
                        pg8::gemm_phase<pg8::EpiResidLn<true, false>, pg8::StaticOrder, true, true, FFN_H, FFN_H>(widk, lds, g, S, E); } }
                else { pg8::EpiResid E{p.out, p.out, D, ALPHA};
                    pg8::gemm_phase<pg8::EpiResid, pg8::StaticOrder, true, true, FFN_H, FFN_H>(widk, lds, g, S, E); } }
        }
        xcd_barrier(xbar, widk); TEND(7);
        if constexpr (!fused_ln) { ln_phase(widk, p.out, XN, p.in[21] + layer * D, p.in[22] + layer * D); xcd_barrier(xbar, widk); }
    }
    if (PROBE_T) { const unsigned long long ts = __builtin_amdgcn_s_memrealtime(); while (__builtin_amdgcn_s_memrealtime() - ts < pticks) __builtin_amdgcn_s_sleep(8); }
}
}

extern "C" void kernel_launch(void* const* d_in, const int* in_sizes, int n_in, void* d_out, int out_size, void* d_ws, size_t ws_size, hipStream_t stream) {
    static int grid = 0;
    if (grid == 0) {
        if (n_in != 23 || ws_size < mk::WS_END) { fprintf(stderr, "kernel_launch: unexpected n_in %d / ws_size %zu (need %zu)\n", n_in, ws_size, (size_t)mk::WS_END); grid = -1; return; }
        int dev = 0, cus = 0, per_cu = 0;
        (void)hipGetDevice(&dev); (void)hipDeviceGetAttribute(&cus, hipDeviceAttributeMultiprocessorCount, dev);
        const void* kfn = (const void*)mk::fwd_megakernel<true>; const void* kfn2 = (const void*)mk::fwd_megakernel<false>;
        if (hipFuncSetAttribute(kfn, hipFuncAttributeMaxDynamicSharedMemorySize, mk::LDS_BYTES) != hipSuccess || hipFuncSetAttribute(kfn2, hipFuncAttributeMaxDynamicSharedMemorySize, mk::LDS_BYTES) != hipSuccess) { fprintf(stderr, "kernel_launch: hipFuncSetAttribute failed\n"); grid = -1; return; }
        if (hipOccupancyMaxActiveBlocksPerMultiprocessor(&per_cu, kfn, mk::NTHR, mk::LDS_BYTES) != hipSuccess || per_cu < 1) { fprintf(stderr, "kernel_launch: occupancy query gave %d\n", per_cu); per_cu = 1; }
        (void)hipGetLastError();
        grid = cus * per_cu;
        fprintf(stderr, "kernel_launch: grid %d (cus %d x %d)\n", grid, cus, per_cu);
    }
    if (grid < 0) return;
    mk::Params p{};
    for (int i = 0; i < 23; ++i) p.in[i] = (const float*)d_in[i];
    p.positions = (const int*)d_in[1]; p.out = (float*)d_out; p.ws = (unsigned char*)d_ws;
    void* args[] = {&p};
    hipError_t e = hipLaunchCooperativeKernel(grid == 256 ? (const void*)mk::fwd_megakernel<true> : (const void*)mk::fwd_megakernel<false>, dim3(grid), dim3(mk::NTHR), args, mk::LDS_BYTES, stream);
    if (e != hipSuccess) fprintf(stderr, "cooperative launch failed: %s (grid %d)\n", hipGetErrorString(e), grid);
}
```

```cpp
#include <hip/hip_runtime.h>
#include <hip/hip_cooperative_groups.h>
#include <cstdio>
#include <cstdint>
namespace cg = cooperative_groups;
#ifndef PROBE_REP
#define PROBE_REP 0
#endif
#define REPS(k) for (int rep_ = 0; rep_ < ((PROBE_REP) == (k) ? 2 : 1); ++rep_)
#ifndef PROBE_T
#define PROBE_T 0
#endif
#define TBEG(k) if (PROBE_T == (k)) pt0 = __builtin_amdgcn_s_memrealtime()
#define TEND(k) if (PROBE_T == (k)) pticks += __builtin_amdgcn_s_memrealtime() - pt0
namespace pg8 {
#define PG8_LAS __attribute__((address_space(3)))
typedef unsigned short bf16_t;
typedef short bf16x8 __attribute__((ext_vector_type(8)));
typedef float f32x4 __attribute__((ext_vector_type(4)));
typedef unsigned u32x4 __attribute__((ext_vector_type(4)));
constexpr int BM = 256, BK = 64, HALF = 128, HTB = HALF * BK * 2  , STAGE_BYTES = 8 * HTB, NXCD = 8, WGM = 8;

__host__ __device__ __forceinline__ int lds_byte(int r, int c) { const int st = (r >> 4) * 2 + (c >> 5), rr = r & 15, cc = c & 31, ob = rr * 64 + cc * 2; return st * 1024 + (ob ^ (((ob >> 9) & 1) << 5)); }
__host__ __device__ __forceinline__ void stage_rc(int b, int& R, int& C) { const int st = b / 1024, sb = b % 1024, swz = sb ^ (((sb >> 9) & 1) << 5); R = (st >> 1) * 16 + swz / 64; C = (st & 1) * 32 + (swz % 64) / 2; }
__host__ __device__ __forceinline__ int perm32(int rho) { const int n = rho >> 4, i = rho & 15; return 8 * (i >> 2) + 4 * n + (i & 3); }

struct Unit { int pm, pn; };
struct Gemm { const bf16_t* A; const bf16_t* Bt; int M, N, K, lda; };

struct StaticOrder {
    int nM, nN, nwg, G, c;
    __host__ __device__ void init(int M, int N, int G_, int c_) { nM = M / BM; nN = N / BM; nwg = nM * nN; G = G_; c = c_; }
    __host__ __device__ bool next(int i, Unit& u) const {
        const long L = (long)i * G + c; if (L >= nwg) return false;
        int wgid = (int)L; { const int q = nwg / NXCD, r = nwg % NXCD, xcd = wgid % NXCD, off = wgid / NXCD; wgid = (xcd < r ? xcd * (q + 1) : r * (q + 1) + (xcd - r) * q) + off; }
        const int nig = WGM * nN, gid = wgid / nig, fm = gid * WGM, gsz = (nM - fm) < WGM ? (nM - fm) : WGM;
        u.pm = fm + ((wgid % nig) % gsz); u.pn = (wgid % nig) / gsz; return true;
    }
    __device__ __forceinline__ void a_ready(const Unit&) const {}
    __device__ __forceinline__ void done(const Unit&) const {}
};
typedef float f32x2 __attribute__((ext_vector_type(2)));
typedef __bf16 bf16x2v __attribute__((ext_vector_type(2)));
typedef _Float16 f16x2v __attribute__((ext_vector_type(2)));
typedef _Float16 f16x8 __attribute__((ext_vector_type(8)));
__device__ __forceinline__ unsigned cvt_pk_f16(float lo, float hi) { f32x2 v = {lo, hi}; f16x2v b = __builtin_convertvector(v, f16x2v); return __builtin_bit_cast(unsigned, b); }
__device__ __forceinline__ f32x2 unpk_f16(unsigned w) { const f16x2v h = __builtin_bit_cast(f16x2v, w); return __builtin_convertvector(h, f32x2); }
template <bool F16> __device__ __forceinline__ f32x4 mma16(const bf16x8 a, const bf16x8 b, const f32x4 c) {
    if constexpr (F16) return __builtin_amdgcn_mfma_f32_16x16x32_f16(__builtin_bit_cast(f16x8, a), __builtin_bit_cast(f16x8, b), c, 0, 0, 0);
    else return __builtin_amdgcn_mfma_f32_16x16x32_bf16(a, b, c, 0, 0, 0);
}
__device__ __forceinline__ unsigned cvt_pk_bf16(float lo, float hi) { f32x2 v = {lo, hi}; bf16x2v b = __builtin_convertvector(v, bf16x2v); return __builtin_bit_cast(unsigned, b); }

struct EpiBf16 {
    static constexpr bool PERM = true, AFTER_DRAIN = false;
    bf16_t* O; int ldc;
    __device__ __forceinline__ void operator()(const f32x4 (&acc)[2][2][4][2], const Unit& u, int wr, int wc, int fr, int fq) const {
        const int row0 = u.pm * BM + wr * 64 + fr; const int col0 = u.pn * BM + wc * 32 + 8 * fq;
#pragma unroll
        for (int ai = 0; ai < 2; ++ai)
#pragma unroll
            for (int m = 0; m < 4; ++m) { bf16_t* rowp = O + (size_t)(row0 + ai * HALF + m * 16) * ldc + col0;
#pragma unroll
                for (int bj = 0; bj < 2; ++bj) { const f32x4 v0 = acc[ai][bj][m][0], v1 = acc[ai][bj][m][1];
                    u32x4 w; w.x = cvt_pk_bf16(v0[0], v0[1]); w.y = cvt_pk_bf16(v0[2], v0[3]); w.z = cvt_pk_bf16(v1[0], v1[1]); w.w = cvt_pk_bf16(v1[2], v1[3]);
                    __builtin_nontemporal_store(w, (u32x4*)(rowp + bj * HALF)); } }
    }
};
struct EpiResid {
    static constexpr bool PERM = false, AFTER_DRAIN = false;
    const float* base; float* out; int ldc; float alpha;
    __device__ __forceinline__ void operator()(const f32x4 (&acc)[2][2][4][2], const Unit& u, int wr, int wc, int fr, int fq) const {
        const int col0 = u.pn * BM + wc * 32 + 4 * fq;
#pragma unroll
        for (int ai = 0; ai < 2; ++ai)
#pragma unroll
            for (int m = 0; m < 4; ++m) { const int r = ai * HALF + wr * 64 + m * 16 + fr; const size_t off = (size_t)(u.pm * BM + r) * ldc + col0;
#pragma unroll
                for (int bj = 0; bj < 2; ++bj)
#pragma unroll
                    for (int n = 0; n < 2; ++n) { const f32x4 bs = *(const f32x4*)(base + off + bj * HALF + n * 16); const f32x4 o = bs * alpha + acc[ai][bj][m][n];
                        *(f32x4*)(out + off + bj * HALF + n * 16) = o; }
                asm volatile("" ::: "memory"); }
    }
};

struct EpiRope {
    static constexpr bool PERM = true, AFTER_DRAIN = false;
    bf16_t* O; const unsigned* CS; float qscale; bf16_t* VT;
    __device__ __forceinline__ void operator()(const f32x4 (&acc)[2][2][4][2], const Unit& u, int wr, int wc, int fr_, int fq_) const {
        int fr = fr_, fq = fq_; asm volatile("" : "+v"(fr), "+v"(fq));
        const int row0 = u.pm * BM + wr * 64 + fr;
        if (u.pn >= 8) {
            const int t0 = (u.pm * BM) & 2047, bb = (u.pm * BM) >> 11;
#pragma unroll
            for (int bj = 0; bj < 2; ++bj) {
                bf16_t* vt = VT + ((size_t)(bb * 8 + 2 * (u.pn - 8) + bj) * 128 + wc * 32 + 8 * fq) * 2048 + t0 + wr * 64 + fr;
#pragma unroll
                for (int n = 0; n < 2; ++n)
#pragma unroll
                    for (int e = 0; e < 4; ++e)
#pragma unroll
                        for (int ai = 0; ai < 2; ++ai)
#pragma unroll
                            for (int m = 0; m < 4; ++m) vt[(size_t)(4 * n + e) * 2048 + ai * HALF + m * 16] = (bf16_t)(cvt_pk_bf16(acc[ai][bj][m][n][e], 0.f) & 0xffffu);
            }
        } else {
            const float sc = (u.pn < 4) ? qscale : 1.f;
            const int col1 = u.pn * BM + wc * 64 + 8 * fq;
#pragma unroll
            for (int ai = 0; ai < 2; ++ai)
#pragma unroll
                for (int m = 0; m < 4; ++m) { const int row = row0 + ai * HALF + m * 16;
                    const u32x4 t0 = *(const u32x4*)(CS + (size_t)row * 32 + 8 * fq), t1 = *(const u32x4*)(CS + (size_t)row * 32 + 8 * fq + 4);
                    const f32x2 e0 = unpk_f16(t0.x), e1 = unpk_f16(t0.y), e2 = unpk_f16(t0.z), e3 = unpk_f16(t0.w), e4 = unpk_f16(t1.x), e5 = unpk_f16(t1.y), e6 = unpk_f16(t1.z), e7 = unpk_f16(t1.w);
                    const f32x4 c0 = {e0[0], e1[0], e2[0], e3[0]}, c1 = {e4[0], e5[0], e6[0], e7[0]}, s0 = {e0[1], e1[1], e2[1], e3[1]}, s1 = {e4[1], e5[1], e6[1], e7[1]};
                    const f32x4 a0 = acc[ai][0][m][0], a1 = acc[ai][0][m][1], b0 = acc[ai][1][m][0], b1 = acc[ai][1][m][1];
                    const f32x4 y10 = (a0 * c0 - b0 * s0) * sc, y11 = (a1 * c1 - b1 * s1) * sc, y20 = (b0 * c0 + a0 * s0) * sc, y21 = (b1 * c1 + a1 * s1) * sc;
                    u32x4 w1, w2; w1.x = cvt_pk_bf16(y10[0], y10[1]); w1.y = cvt_pk_bf16(y10[2], y10[3]); w1.z = cvt_pk_bf16(y11[0], y11[1]); w1.w = cvt_pk_bf16(y11[2], y11[3]);
                    w2.x = cvt_pk_bf16(y20[0], y20[1]); w2.y = cvt_pk_bf16(y20[2], y20[3]); w2.z = cvt_pk_bf16(y21[0], y21[1]); w2.w = cvt_pk_bf16(y21[2], y21[3]);
                    bf16_t* rowp = O + (size_t)row * 3072 + col1;
                    *(u32x4*)rowp = w1; *(u32x4*)(rowp + 32) = w2;
                    if (m & 1) asm volatile("" ::: "memory"); }
        }
    }
};

template <bool BASE_BF16, bool WRITE_F32> struct EpiResidLn {
    static constexpr bool PERM = true, AFTER_DRAIN = false;
    const float* base; float* out; bf16_t* xn; const float* g; const float* b; float alpha, eps;
    unsigned* xbuf;
    unsigned* cnt;
    PG8_LAS float* sl;
    __device__ __forceinline__ void operator()(f32x4 (&acc)[2][2][4][2], const Unit& u, int wr, int wc, int fr_, int fq_) const {
        typedef unsigned u32x2 __attribute__((ext_vector_type(2)));
        int fr = fr_, fq = fq_; asm volatile("" : "+v"(fr), "+v"(fq));
        const int col0 = u.pn * BM + wc * 32 + 8 * fq;
        const int lane = fq * 16 + fr, wid = wr * 4 + wc, tid = wid * 64 + lane;
#pragma unroll
        for (int ai = 0; ai < 2; ++ai)
#pragma unroll
            for (int m = 0; m < 4; ++m) { const int r = ai * HALF + wr * 64 + m * 16 + fr; const size_t off = (size_t)(u.pm * BM + r) * 1024 + col0;
                float s = 0.f, q = 0.f;
#pragma unroll
                for (int bj = 0; bj < 2; ++bj) { f32x4 bs0, bs1;
                    if constexpr (BASE_BF16) { const u32x4 rb = *(const u32x4*)(xn + off + bj * HALF); const f32x2 a0 = unpk_f16(rb.x), a1 = unpk_f16(rb.y), a2 = unpk_f16(rb.z), a3 = unpk_f16(rb.w);
                        bs0 = (f32x4){a0[0], a0[1], a1[0], a1[1]}; bs1 = (f32x4){a2[0], a2[1], a3[0], a3[1]}; }
                    else { bs0 = *(const f32x4*)(base + off + bj * HALF); bs1 = *(const f32x4*)(base + off + bj * HALF + 4); }
                    const f32x4 y0 = bs0 * alpha + acc[ai][bj][m][0], y1 = bs1 * alpha + acc[ai][bj][m][1]; acc[ai][bj][m][0] = y0; acc[ai][bj][m][1] = y1;
                    s += ((y0[0] + y0[1]) + (y0[2] + y0[3])) + ((y1[0] + y1[1]) + (y1[2] + y1[3]));
                    q += ((y0[0] * y0[0] + y0[1] * y0[1]) + (y0[2] * y0[2] + y0[3] * y0[3])) + ((y1[0] * y1[0] + y1[1] * y1[1]) + (y1[2] * y1[2] + y1[3] * y1[3])); }
                s += __shfl_xor(s, 16); s += __shfl_xor(s, 32); q += __shfl_xor(q, 16); q += __shfl_xor(q, 32);
                if (fq == 0) { sl[(r * 4 + wc) * 2] = s; sl[(r * 4 + wc) * 2 + 1] = q; }
                asm volatile("" ::: "memory"); }
        asm volatile("s_waitcnt lgkmcnt(0)" ::: "memory"); __builtin_amdgcn_s_barrier(); asm volatile("" ::: "memory");
        if (tid < 256) {
            const PG8_LAS f32x4* pp = (const PG8_LAS f32x4*)(sl + tid * 8); const f32x4 p0 = pp[0], p1 = pp[1];
            const float S = (p0[0] + p0[2]) + (p1[0] + p1[2]), Q = (p0[1] + p0[3]) + (p1[1] + p1[3]);
            unsigned* xp = xbuf + (((size_t)u.pm * 4 + u.pn) * 256 + tid) * 2;
            __hip_atomic_store(xp, __float_as_uint(S), __ATOMIC_RELAXED, __HIP_MEMORY_SCOPE_AGENT); __hip_atomic_store(xp + 1, __float_as_uint(Q), __ATOMIC_RELAXED, __HIP_MEMORY_SCOPE_AGENT);
            asm volatile("s_waitcnt vmcnt(0)" ::: "memory");
            if (lane == 0) __hip_atomic_fetch_add(cnt + 16 * u.pm, 1u, __ATOMIC_RELAXED, __HIP_MEMORY_SCOPE_AGENT);
        }
        if (wid == 0) {
            unsigned sp = 0;
            while ((unsigned)__builtin_amdgcn_readfirstlane(__hip_atomic_load(cnt + 16 * u.pm, __ATOMIC_RELAXED, __HIP_MEMORY_SCOPE_AGENT)) < 16u) { __builtin_amdgcn_s_sleep(2); if (++sp > (1u << 22)) break; }
            __builtin_amdgcn_fence(__ATOMIC_ACQUIRE, "agent");
        }
        asm volatile("s_waitcnt vmcnt(0) lgkmcnt(0)" ::: "memory"); __builtin_amdgcn_s_barrier(); asm volatile("" ::: "memory");
        if (tid < 256) {
            float S = 0.f, Q = 0.f;
#pragma unroll
            for (int t = 0; t < 4; ++t) { unsigned* xp = xbuf + (((size_t)u.pm * 4 + t) * 256 + tid) * 2;
                S += __uint_as_float(__hip_atomic_load(xp, __ATOMIC_RELAXED, __HIP_MEMORY_SCOPE_AGENT)); Q += __uint_as_float(__hip_atomic_load(xp + 1, __ATOMIC_RELAXED, __HIP_MEMORY_SCOPE_AGENT)); }
            const float mean = S * (1.f / 1024.f), var = fmaxf(Q * (1.f / 1024.f) - mean * mean, 0.f);
            sl[2048 + tid * 2] = mean; sl[2048 + tid * 2 + 1] = 1.f / sqrtf(var + eps);
        }
        asm volatile("s_waitcnt lgkmcnt(0)" ::: "memory"); __builtin_amdgcn_s_barrier(); asm volatile("" ::: "memory");
#pragma unroll
        for (int bj = 0; bj < 2; ++bj) {
            const f32x4 gv0 = *(const f32x4*)(g + col0 + bj * HALF), gv1 = *(const f32x4*)(g + col0 + bj * HALF + 4), bv0 = *(const f32x4*)(b + col0 + bj * HALF), bv1 = *(const f32x4*)(b + col0 + bj * HALF + 4);
#pragma unroll
            for (int ai = 0; ai < 2; ++ai)
#pragma unroll
                for (int m = 0; m < 4; ++m) { const int r = ai * HALF + wr * 64 + m * 16 + fr; const size_t off = (size_t)(u.pm * BM + r) * 1024 + col0 + bj * HALF;
                    const float mean = sl[2048 + r * 2], rstd = sl[2048 + r * 2 + 1];
                    const f32x4 o0 = (acc[ai][bj][m][0] - mean) * rstd * gv0 + bv0, o1 = (acc[ai][bj][m][1] - mean) * rstd * gv1 + bv1;
                    if constexpr (WRITE_F32) { *(f32x4*)(out + off) = o0; *(f32x4*)(out + off + 4) = o1; }
                    u32x4 w; w.x = cvt_pk_f16(o0[0], o0[1]); w.y = cvt_pk_f16(o0[2], o0[3]); w.z = cvt_pk_f16(o1[0], o1[1]); w.w = cvt_pk_f16(o1[2], o1[3]); *(u32x4*)(xn + off) = w; }
            asm volatile("" ::: "memory");
        }
    }
};

__device__ __forceinline__ float dpp_ror1(float v) { float r; asm volatile("v_mov_b32_dpp %0, %1 row_ror:1 row_mask:0xf bank_mask:0xf" : "=&v"(r) : "v"(v)); return r; }
__device__ __forceinline__ float dpp_ror2(float v) { float r; asm volatile("v_mov_b32_dpp %0, %1 row_ror:2 row_mask:0xf bank_mask:0xf" : "=&v"(r) : "v"(v)); return r; }
__device__ __forceinline__ float silu_f(float x) { return x * __builtin_amdgcn_rcpf(1.f + __expf(-x)); }
struct EpiFfnAct {
    static constexpr bool PERM = true, AFTER_DRAIN = false;
    bf16_t* ACT; const float* cw; const float* cb; float* HALO; float* HALO2; PG8_LAS float* hl;
    __device__ __forceinline__ void operator()(const f32x4 (&acc)[2][2][4][2], const Unit& u, int wr, int wc, int fr_, int fq_) const {
        int fr = fr_, fq = fq_; asm volatile("" : "+v"(fr), "+v"(fq));
        const int cc0 = wc * 32 + 8 * fq, colA = u.pn * 128 + cc0;
        if (fr >= 14) {
#pragma unroll
            for (int ai = 0; ai < 2; ++ai) { PG8_LAS float* hp = hl + ((2 * ai + wr) * 2 + (fr - 14)) * 256 + cc0;
#pragma unroll
                for (int bj = 0; bj < 2; ++bj)
#pragma unroll
                    for (int n = 0; n < 2; ++n) *(PG8_LAS f32x4*)(hp + bj * 128 + 4 * n) = acc[ai][bj][3][n]; }
            if (wr == 1) { float* gp = HALO + ((size_t)u.pm * 2 + (fr - 14)) * 5632 + colA;
#pragma unroll
                for (int bj = 0; bj < 2; ++bj)
#pragma unroll
                    for (int n = 0; n < 2; ++n) *(f32x4*)(gp + bj * 2816 + 4 * n) = acc[1][bj][3][n]; }
        }
        if (fr < 2 && wr == 0) { float* gp = HALO2 + ((size_t)u.pm * 2 + fr) * 5632 + colA;
#pragma unroll
            for (int bj = 0; bj < 2; ++bj)
#pragma unroll
                for (int n = 0; n < 2; ++n) *(f32x4*)(gp + bj * 2816 + 4 * n) = acc[0][bj][0][n]; }
        asm volatile("s_waitcnt lgkmcnt(0)" ::: "memory"); __builtin_amdgcn_s_barrier(); asm volatile("" ::: "memory");
#pragma unroll
        for (int ai = 0; ai < 2; ++ai) {
            const int strip = 2 * ai + wr;
            unsigned kx[4], ky[4];
#pragma unroll
            for (int n = 0; n < 2; ++n) {
                f32x4 wa[3], wb[3];
#pragma unroll
                for (int j = 0; j < 3; ++j) { wa[j] = *(const f32x4*)(cw + j * 5632 + colA + 4 * n); wb[j] = *(const f32x4*)(cw + j * 5632 + 2816 + colA + 4 * n); }
                const f32x4 ba = *(const f32x4*)(cb + colA + 4 * n), bb = *(const f32x4*)(cb + 2816 + colA + 4 * n);
                f32x4 h1a = {0.f, 0.f, 0.f, 0.f}, h2a = h1a, h1b = h1a, h2b = h1a;
                if (strip > 0) { const PG8_LAS float* hp = hl + ((strip - 1) * 2) * 256 + cc0 + 4 * n;
                    h2a = *(const PG8_LAS f32x4*)hp; h1a = *(const PG8_LAS f32x4*)(hp + 256); h2b = *(const PG8_LAS f32x4*)(hp + 128); h1b = *(const PG8_LAS f32x4*)(hp + 256 + 128); }
                f32x4 pr1a = h1a, pr2a = h2a, pr1b = h1b, pr2b = h2b;
#pragma unroll
                for (int m = 0; m < 4; ++m) {
                    const f32x4 ca = acc[ai][0][m][n], cbv = acc[ai][1][m][n];
                    f32x4 c1a, c2a, c1b, c2b;
#pragma unroll
                    for (int e = 0; e < 4; ++e) { c1a[e] = dpp_ror1(ca[e]); c2a[e] = dpp_ror2(ca[e]); c1b[e] = dpp_ror1(cbv[e]); c2b[e] = dpp_ror2(cbv[e]); }
                    float o[4];
#pragma unroll
                    for (int e = 0; e < 4; ++e) {
                        float x1a, x2a, x1b, x2b;
                        if (m > 0) { x1a = pr1a[e]; x2a = pr2a[e]; x1b = pr1b[e]; x2b = pr2b[e]; }
                        else { x1a = h1a[e]; x2a = (fr == 0) ? h2a[e] : h1a[e]; x1b = h1b[e]; x2b = (fr == 0) ? h2b[e] : h1b[e]; }
                        const float p1a = (fr == 0) ? x1a : c1a[e], p2a = (fr < 2) ? x2a : c2a[e];
                        const float p1b = (fr == 0) ? x1b : c1b[e], p2b = (fr < 2) ? x2b : c2b[e];
                        const float ya = wa[0][e] * p2a + wa[1][e] * p1a + wa[2][e] * ca[e] + ba[e];
                        const float yb = wb[0][e] * p2b + wb[1][e] * p1b + wb[2][e] * cbv[e] + bb[e];
                        o[e] = silu_f(ya) * yb;
                    }
                    pr1a = c1a; pr2a = c2a; pr1b = c1b; pr2b = c2b;
                    const unsigned w0 = cvt_pk_bf16(o[0], o[1]), w1 = cvt_pk_bf16(o[2], o[3]);
                    asm volatile("" :: "v"(w0), "v"(w1));
                    if (n == 0) { kx[m] = w0; ky[m] = w1; }
                    else { u32x4 w; w.x = kx[m]; w.y = ky[m]; w.z = w0; w.w = w1; __builtin_nontemporal_store(w, (u32x4*)(ACT + (size_t)(u.pm * BM + ai * HALF + wr * 64 + m * 16 + fr) * 2816 + colA)); }
                }
                asm volatile("" ::: "memory");
            }
        }
    }
};

template <class Epi, class Sched, bool ALIGN_EPI, bool SP2, int KC, int LDAC, bool F16 = false>
__device__ __forceinline__ void gemm_phase(int widk, PG8_LAS unsigned char* lds, const Gemm g, const Sched& S, const Epi& E) {
    int lane_; asm volatile("v_mbcnt_lo_u32_b32 %0, -1, 0\n\tv_mbcnt_hi_u32_b32 %0, -1, %0" : "=v"(lane_));
    int wid_ = widk; asm volatile("" : "+s"(wid_));
    const int wid = wid_, lane = lane_, tid = wid * 64 + lane, wr = wid >> 2, wc = wid & 3, fr = lane & 15, fq = lane >> 4;
    constexpr int K = KC, nt = K / BK;
    unsigned voffA[2], voffB[2];
#pragma unroll
    for (int i = 0; i < 2; ++i) { int R, C; stage_rc(tid * 16 + i * 8192, R, C); const int Rb = Epi::PERM ? ((R & ~31) + perm32(R & 31)) : R;
        voffA[i] = (unsigned)(R * LDAC + C) * 2u; voffB[i] = (unsigned)(Rb * K + C) * 2u; }
    const size_t kstep = (size_t)(BK * 2);
    const size_t hstepA = (size_t)HALF * LDAC * 2, hstepB = (size_t)HALF * K * 2;
    const size_t tstepA = 2 * hstepA, tstepB = 2 * hstepB;
    const unsigned ldsw = (unsigned)wid * 1024u;
    const int aoff = lds_byte(wr * 64 + fr, fq * 8), boff = lds_byte(wc * 32 + fr, fq * 8);
#define PG8_SA(b, h) (((b) * 2 + (h)) * HTB)
#define PG8_SB(b, h) ((4 + (b) * 2 + (h)) * HTB)
#define PG8_STAGE(bufoff, gbase, voff) do { _Pragma("unroll") for (int _i = 0; _i < 2; ++_i) \
        __builtin_amdgcn_global_load_lds((const unsigned*)((const char*)(gbase) + (voff)[_i]), (PG8_LAS unsigned*)(lds + (bufoff) + ldsw + _i * 8192), 16, 0, 0); } while (0)
#define PG8_LDA(dst, b, h) do { _Pragma("unroll") for (int m = 0; m < 4; ++m) _Pragma("unroll") for (int k = 0; k < 2; ++k) dst[m][k] = *(const PG8_LAS bf16x8*)(lds + PG8_SA(b, h) + aoff + m * 2048 + k * 1024); } while (0)
#define PG8_LDB(dst, b, h) do { _Pragma("unroll") for (int n = 0; n < 2; ++n) _Pragma("unroll") for (int k = 0; k < 2; ++k) dst[n][k] = *(const PG8_LAS bf16x8*)(lds + PG8_SB(b, h) + boff + n * 2048 + k * 1024); } while (0)
#define PG8_MMA(ai, bj, At, Bt) do { __builtin_amdgcn_s_setprio(1); _Pragma("unroll") for (int m = 0; m < 4; ++m) _Pragma("unroll") for (int n = 0; n < 2; ++n) _Pragma("unroll") for (int k = 0; k < 2; ++k) \
        acc[ai][bj][m][n] = mma16<F16>(Bt[n][k], At[m][k], acc[ai][bj][m][n]); __builtin_amdgcn_s_setprio(0); } while (0)
#define PG8_WAIT_V(n) asm volatile("s_waitcnt vmcnt(" #n ")" ::: "memory")
#define PG8_WAIT_L(n) asm volatile("s_waitcnt lgkmcnt(" #n ")" ::: "memory")
#define PG8_BAR __builtin_amdgcn_s_barrier()
#define PG8_SCHED __builtin_amdgcn_sched_barrier(0)
    Unit cur, nxt; int ui = 0;
    if (!S.next(0, cur)) return;
    f32x4 acc[2][2][4][2];
#pragma unroll
    for (int a = 0; a < 2; ++a)
#pragma unroll
        for (int b = 0; b < 2; ++b)
#pragma unroll
            for (int m = 0; m < 4; ++m)
#pragma unroll
                for (int n = 0; n < 2; ++n) acc[a][b][m][n] = (f32x4){0.f, 0.f, 0.f, 0.f};
    bf16x8 At[4][2], B0[2][2], B1[2][2];
    const char* cA = (const char*)g.A + (size_t)cur.pm * tstepA; const char* cB = (const char*)g.Bt + (size_t)cur.pn * tstepB;
    S.a_ready(cur);
    if constexpr (SP2) {
        PG8_STAGE(PG8_SB(0, 0), cB, voffB); PG8_STAGE(PG8_SB(0, 1), cB + hstepB, voffB); PG8_STAGE(PG8_SA(0, 0), cA, voffA); PG8_STAGE(PG8_SA(0, 1), cA + hstepA, voffA);
        if (wr == 1) PG8_BAR;
        PG8_WAIT_V(2); PG8_BAR;
        PG8_STAGE(PG8_SB(1, 0), cB + kstep, voffB); PG8_STAGE(PG8_SA(1, 0), cA + kstep, voffA); PG8_STAGE(PG8_SB(1, 1), cB + hstepB + kstep, voffB);
        PG8_WAIT_V(6); PG8_BAR;
    } else {
        PG8_STAGE(PG8_SB(0, 0), cB, voffB); PG8_STAGE(PG8_SA(0, 0), cA, voffA); PG8_STAGE(PG8_SB(0, 1), cB + hstepB, voffB); PG8_STAGE(PG8_SA(0, 1), cA + hstepA, voffA);
        if (wr == 1) PG8_BAR;
        PG8_WAIT_V(4); PG8_BAR;
        PG8_STAGE(PG8_SB(1, 0), cB + kstep, voffB); PG8_STAGE(PG8_SA(1, 0), cA + kstep, voffA); PG8_STAGE(PG8_SB(1, 1), cB + hstepB + kstep, voffB);
        PG8_WAIT_V(6); PG8_BAR;
    }
    for (;;) {
        const bool has_next = S.next(ui + 1, nxt);
        const char* nA = has_next ? (const char*)g.A + (size_t)nxt.pm * tstepA : cA; const char* nB = has_next ? (const char*)g.Bt + (size_t)nxt.pn * tstepB : cB;
        for (int t = 0; t < nt; t += 2) {
            const bool last = (t == nt - 2);
            const char* a1 = cA + (size_t)(t + 1) * kstep;
            const char* a2 = last ? nA : cA + (size_t)(t + 2) * kstep; const char* b2 = last ? nB : cB + (size_t)(t + 2) * kstep;
            const char* a3 = a2 + kstep; const char* b3 = b2 + kstep;
            if (last && has_next) S.a_ready(nxt);
            if constexpr (SP2) {
            PG8_LDB(B0, 0, 0); PG8_LDB(B1, 0, 1); PG8_SCHED; PG8_LDA(At, 0, 0); PG8_STAGE(PG8_SA(1, 1), a1 + hstepA, voffA);
            PG8_WAIT_V(8); PG8_WAIT_L(0); PG8_BAR; PG8_MMA(0, 0, At, B0); PG8_MMA(0, 1, At, B1); PG8_BAR; PG8_SCHED;
            PG8_LDA(At, 0, 1); PG8_STAGE(PG8_SB(0, 0), b2, voffB); PG8_STAGE(PG8_SB(0, 1), b2 + hstepB, voffB); PG8_STAGE(PG8_SA(0, 0), a2, voffA);
            PG8_WAIT_V(8); PG8_WAIT_L(0); PG8_BAR; PG8_MMA(1, 0, At, B0); PG8_MMA(1, 1, At, B1); PG8_BAR; PG8_SCHED;
            PG8_LDB(B0, 1, 0); PG8_LDB(B1, 1, 1); PG8_SCHED; PG8_LDA(At, 1, 0); PG8_STAGE(PG8_SA(0, 1), a2 + hstepA, voffA);
            PG8_WAIT_V(8); PG8_WAIT_L(0); PG8_BAR; PG8_MMA(0, 0, At, B0); PG8_MMA(0, 1, At, B1); PG8_BAR; PG8_SCHED;
            PG8_LDA(At, 1, 1); PG8_STAGE(PG8_SB(1, 0), b3, voffB); PG8_STAGE(PG8_SB(1, 1), b3 + hstepB, voffB); PG8_STAGE(PG8_SA(1, 0), a3, voffA);
            PG8_WAIT_V(8); PG8_WAIT_L(0); PG8_BAR; PG8_MMA(1, 0, At, B0); PG8_MMA(1, 1, At, B1); PG8_BAR; PG8_SCHED;
            } else {
            PG8_LDB(B0, 0, 0); PG8_SCHED; PG8_LDA(At, 0, 0); PG8_STAGE(PG8_SA(1, 1), a1 + hstepA, voffA);
            PG8_WAIT_L(8); PG8_BAR; PG8_WAIT_L(0); PG8_MMA(0, 0, At, B0); PG8_BAR; PG8_SCHED;
            PG8_LDB(B1, 0, 1); PG8_STAGE(PG8_SB(0, 0), b2, voffB);
            PG8_BAR; PG8_WAIT_L(0); PG8_MMA(0, 1, At, B1); PG8_BAR;
            PG8_LDA(At, 0, 1); PG8_STAGE(PG8_SA(0, 0), a2, voffA);
            PG8_BAR; PG8_WAIT_L(0); PG8_MMA(1, 0, At, B0); PG8_BAR; PG8_SCHED;
            PG8_STAGE(PG8_SB(0, 1), b2 + hstepB, voffB);
            PG8_WAIT_V(6); PG8_BAR; PG8_MMA(1, 1, At, B1); PG8_BAR;
            PG8_LDB(B0, 1, 0); PG8_SCHED; PG8_LDA(At, 1, 0); PG8_STAGE(PG8_SA(0, 1), a2 + hstepA, voffA);
            PG8_WAIT_L(8); PG8_BAR; PG8_WAIT_L(0); PG8_MMA(0, 0, At, B0); PG8_BAR; PG8_SCHED;
            PG8_LDB(B1, 1, 1); PG8_STAGE(PG8_SB(1, 0), b3, voffB);
            PG8_BAR; PG8_WAIT_L(0); PG8_MMA(0, 1, At, B1); PG8_BAR;
            PG8_LDA(At, 1, 1); PG8_STAGE(PG8_SA(1, 0), a3, voffA);
            PG8_BAR; PG8_WAIT_L(0); PG8_MMA(1, 0, At, B0); PG8_BAR; PG8_SCHED;
            PG8_STAGE(PG8_SB(1, 1), b3 + hstepB, voffB);
            PG8_WAIT_V(6); PG8_BAR; PG8_MMA(1, 1, At, B1); PG8_BAR;
            }
        }
        if constexpr (ALIGN_EPI) { if (wr == 0) PG8_BAR; }
        if constexpr (!Epi::AFTER_DRAIN) { E(acc, cur, wr, wc, fr, fq); S.done(cur); }
        if (!has_next) break;
#pragma unroll
        for (int a = 0; a < 2; ++a)
#pragma unroll
            for (int b = 0; b < 2; ++b)
#pragma unroll
                for (int m = 0; m < 4; ++m)
#pragma unroll
                    for (int n = 0; n < 2; ++n) acc[a][b][m][n] = (f32x4){0.f, 0.f, 0.f, 0.f};
        cur = nxt; cA = nA; cB = nB; ++ui;
        if constexpr (ALIGN_EPI) { if (wr == 1) PG8_BAR; }
    }
    PG8_WAIT_V(0);
    if constexpr (!ALIGN_EPI) { if (wr == 0) PG8_BAR; }
    PG8_BAR;
    if constexpr (Epi::AFTER_DRAIN) { E.fused(acc, cur, wr, wc, fr, fq, lds, wid, lane); S.done(cur); }
#undef PG8_SA
#undef PG8_SB
#undef PG8_STAGE
#undef PG8_LDA
#undef PG8_LDB
#undef PG8_MMA
#undef PG8_WAIT_V
#undef PG8_WAIT_L
#undef PG8_BAR
#undef PG8_SCHED
}
}

#ifdef NO_GEMMB
#define PH_GEMMB if (0)
#else
#define PH_GEMMB
#endif
#ifdef NO_GEMMR
#define PH_GEMMR if (0)
#else
#define PH_GEMMR
#endif
namespace mk {
#define LAS __attribute__((address_space(3)))
typedef unsigned short bf16_t;
typedef short bf16x8 __attribute__((ext_vector_type(8)));
typedef short s16x4 __attribute__((ext_vector_type(4)));
typedef float f32x4 __attribute__((ext_vector_type(4)));
typedef float f32x16 __attribute__((ext_vector_type(16)));
typedef unsigned u32x4 __attribute__((ext_vector_type(4)));
typedef unsigned u32x2 __attribute__((ext_vector_type(2)));
using pg8::cvt_pk_bf16;

constexpr int NB = 32, T = 2048, D = 1024, M = NB * T, DEPTH = 4;
constexpr int NWAVES = 8, NTHR = 512;
constexpr int GDN_N = 4112, GDN_NMAIN = 4096, DIFF_N = 3072, FFN_H = 2816, FFN_N = 5632;
constexpr float LN_EPS = 1e-5f, RMS_EPS = 1e-6f;
constexpr float ALPHA = 1.6817928305074290f;
constexpr float LOG2E = 1.4426950408889634f;
constexpr int MH = M / 2;

constexpr size_t MiB = 1u << 20;
constexpr size_t WS_W = 2 * MiB;
constexpr size_t W_GWIN = 0, W_GWAB = W_GWIN + 2ull * 4096 * 1024 * 2, W_GWOUT = W_GWAB + 2ull * 16 * 1024 * 2, W_DWIN = W_GWOUT + 2ull * 1024 * 1024 * 2,
                 W_DWOUT = W_DWIN + 2ull * 3072 * 1024 * 2, W_FUP = W_DWOUT + 2ull * 1024 * 1024 * 2, W_FDOWN = W_FUP + 4ull * 5632 * 1024 * 2, W_END = W_FDOWN + 4ull * 1024 * 2816 * 2;
static_assert(WS_W + W_END <= 106 * MiB, "weights region");
constexpr size_t WS_CNT = 16384;
constexpr size_t WS_CTL_BYTES = 16384 + 8 * 256 * 16 * 4;
constexpr size_t WS_XBUF = 110 * MiB;
constexpr size_t WS_GB = 106 * MiB;
constexpr size_t WS_XN = 112 * MiB;
static_assert(WS_CTL_BYTES <= WS_W && WS_XBUF + 256ull * 4 * 256 * 2 * 4 <= WS_XN && WS_GB + 2ull * 65536 * 8 * 4 <= WS_XBUF, "small-buffer map");
constexpr size_t WS_H = 240 * MiB;
constexpr size_t WS_ACT = WS_H;
constexpr size_t WS_HALO = WS_H + 352 * MiB;
constexpr size_t WS_HALO2 = WS_HALO + 12 * MiB;
constexpr size_t WS_UT = WS_H + 512 * MiB;
constexpr size_t WS_WN = WS_UT + 128 * MiB;
constexpr size_t WS_VT = WS_H + 384 * MiB;
constexpr size_t WS_O = WS_VT + 128 * MiB;
constexpr size_t WS_ROPE = WS_WN + 128 * MiB;
constexpr size_t WS_END = WS_ROPE + 16 * MiB;
static_assert(WS_END <= 1024 * MiB, "workspace map");
constexpr int LDS_BYTES = 131072 + 2048 + 10240;

__device__ __forceinline__ float bf2f(unsigned short h) { return __uint_as_float((unsigned)h << 16); }
__device__ __forceinline__ unsigned short f2bf(float f) { return (unsigned short)(cvt_pk_bf16(f, 0.f) & 0xffffu); }
__device__ __forceinline__ float wave_sum(float v) {
#pragma unroll
    for (int o = 1; o < 64; o <<= 1) v += __shfl_xor(v, o);
    return v;
}
__device__ __forceinline__ float silu(float x) { return x * __builtin_amdgcn_rcpf(1.f + __expf(-x)); }
__device__ __forceinline__ void unpack8(const u32x4 v, float (&o)[8]) {
    o[0] = __uint_as_float(v.x << 16); o[1] = __uint_as_float(v.x & 0xffff0000u); o[2] = __uint_as_float(v.y << 16); o[3] = __uint_as_float(v.y & 0xffff0000u);
    o[4] = __uint_as_float(v.z << 16); o[5] = __uint_as_float(v.z & 0xffff0000u); o[6] = __uint_as_float(v.w << 16); o[7] = __uint_as_float(v.w & 0xffff0000u);
}
__device__ __forceinline__ u32x4 pack8(const float (&o)[8]) { u32x4 w; w.x = cvt_pk_bf16(o[0], o[1]); w.y = cvt_pk_bf16(o[2], o[3]); w.z = cvt_pk_bf16(o[4], o[5]); w.w = cvt_pk_bf16(o[6], o[7]); return w; }
__device__ __forceinline__ int crow(int r, int hi) { return (r & 3) + 8 * (r >> 2) + 4 * hi; }
#define LDS_WAIT() asm volatile("s_waitcnt lgkmcnt(0)" ::: "memory")
#define MK_IDS() int lane_; asm volatile("v_mbcnt_lo_u32_b32 %0, -1, 0\n\tv_mbcnt_hi_u32_b32 %0, -1, %0" : "=v"(lane_));   \
      \
    int wid_ = widk; asm volatile("" : "+s"(wid_)); const int lane = lane_, wid = wid_, tid = wid * 64 + lane; const int G_ = gridDim.x, gw = blockIdx.x * NWAVES + wid, NGW = G_ * NWAVES, gt = blockIdx.x * NTHR + tid, NGT = G_ * NTHR; \
    (void)lane; (void)wid; (void)gw; (void)NGW; (void)gt; (void)NGT

template <int UPPERM = 0, bool F16OUT = false> __device__ __forceinline__ void transpose_item(const float* W, int ldw, int K, int nblk, bf16_t* WT, LAS float* scr, int item, int lane) {
    const int kb = item / nblk, nb = item % nblk, k0 = 64 * kb, n0 = 32 * nb;
    const int r0 = UPPERM == 1 ? (n0 < FFN_H ? 256 * (n0 >> 7) + (n0 & 127) : 256 * ((n0 - FFN_H) >> 7) + 128 + ((n0 - FFN_H) & 127))
                 : UPPERM == 2 ? (n0 < 2048 ? (n0 & ~255) + 128 * ((n0 >> 5) & 1) + 32 * ((n0 >> 6) & 3) : n0) : n0;
#pragma unroll 8
    for (int i = 0; i < 32; ++i) { const int kk = 2 * i + (lane >> 5); scr[kk * 33 + (lane & 31)] = W[(size_t)(k0 + kk) * ldw + n0 + (lane & 31)]; }
    LDS_WAIT();
    const int c = lane & 7;
#pragma unroll
    for (int j = 0; j < 4; ++j) { const int n = (lane >> 3) + 8 * j; const LAS float* s = scr + (8 * c) * 33 + n;
        u32x4 o;
        if constexpr (F16OUT) { o.x = pg8::cvt_pk_f16(s[0 * 33], s[1 * 33]); o.y = pg8::cvt_pk_f16(s[2 * 33], s[3 * 33]); o.z = pg8::cvt_pk_f16(s[4 * 33], s[5 * 33]); o.w = pg8::cvt_pk_f16(s[6 * 33], s[7 * 33]); }
        else { o.x = cvt_pk_bf16(s[0 * 33], s[1 * 33]); o.y = cvt_pk_bf16(s[2 * 33], s[3 * 33]); o.z = cvt_pk_bf16(s[4 * 33], s[5 * 33]); o.w = cvt_pk_bf16(s[6 * 33], s[7 * 33]); }
        *(u32x4*)(WT + (size_t)(r0 + n) * K + k0 + 8 * c) = o; }
    LDS_WAIT();
}

#define XB_TMO      128
#define XB_XCNT(j)  (256  + 64 * (j))
#define XB_XSUB(j)  (1280 + 64 * (j))
#define XB_XGEN(j)  (2304 + 64 * (j))
#define XB_TOP      3328
#define XB_TOPGEN   3392
#define XCD_BAR_WORDS 3456
#define XB_SPIN_CAP (1u << 18)

__device__ __forceinline__ unsigned xb_ld(unsigned* p)              { return __hip_atomic_load(p, __ATOMIC_RELAXED, __HIP_MEMORY_SCOPE_AGENT); }
__device__ __forceinline__ unsigned xb_add(unsigned* p, unsigned v) { return __hip_atomic_fetch_add(p, v, __ATOMIC_RELAXED, __HIP_MEMORY_SCOPE_AGENT); }
__device__ __forceinline__ unsigned xb_xcc_id() { return (unsigned)__builtin_amdgcn_s_getreg((3 << 11) | 20) & 0xFu; }
#define XB_SPIN(cond, bar) do { unsigned _sp = 0; while (cond) { __builtin_amdgcn_s_sleep(1); \
    if ((++_sp & 255u) == 0u) { if (xb_ld(&(bar)[XB_TMO])) break; if (_sp > XB_SPIN_CAP) { atomicAdd(&(bar)[XB_TMO], 1u); break; } } } } while (0)

struct XcdBarrier {
    unsigned* bar; unsigned x;
    volatile LAS unsigned* st;
};

__device__ __forceinline__ XcdBarrier xcd_barrier_post(unsigned* bar, volatile LAS unsigned* st) {
    XcdBarrier b; b.bar = bar; b.x = xb_xcc_id(); b.st = st;
    if (threadIdx.x == 0) (void)xb_add(&bar[XB_XCNT(b.x)], 1u);
    return b;
}
__device__ __forceinline__ void xcd_barrier_complete(unsigned* bar, unsigned x, unsigned& nloc, unsigned& nx) {
    const unsigned G = gridDim.x * gridDim.y * gridDim.z;
    unsigned sum, cnt, mine, sp = 0u;
    for (;;) {
        sum = 0u; cnt = 0u; mine = 0u;
#pragma unroll
        for (unsigned j = 0; j < 16; ++j) { const unsigned c = xb_ld(&bar[XB_XCNT(j)]); sum += c; cnt += (c > 0u) ? 1u : 0u; mine = (j == x) ? c : mine; }
        if (sum == G) break;
        __builtin_amdgcn_s_sleep(1);
        if ((++sp & 255u) == 0u) { if (xb_ld(&bar[XB_TMO])) break; if (sp > XB_SPIN_CAP) { atomicAdd(&bar[XB_TMO], 1u); break; } }
    }
    nloc = mine > 0u ? mine : 1u; nx = cnt > 0u ? cnt : 1u;
}

__device__ __forceinline__ void xcd_barrier(const XcdBarrier& b, int widk) {
    asm volatile("s_waitcnt vmcnt(0)" ::: "memory");
    __syncthreads();
    int xl_; asm volatile("v_mbcnt_lo_u32_b32 %0, -1, 0\n\tv_mbcnt_hi_u32_b32 %0, -1, %0" : "=v"(xl_));
    if (widk == 0 && xl_ == 0) {
        unsigned* bar = b.bar;
        __builtin_amdgcn_s_waitcnt(0);
        unsigned nloc = b.st[0], nx = b.st[1];
        if (nloc == 0u) { xcd_barrier_complete(bar, b.x, nloc, nx); b.st[0] = nloc; b.st[1] = nx; }
        const unsigned old = xb_add(&bar[XB_XSUB(b.x)], 1u);
        const unsigned gen = old / nloc;
        if (old + 1u == (gen + 1u) * nloc) {
            __builtin_amdgcn_fence(__ATOMIC_RELEASE, "agent");
            asm volatile("s_waitcnt vmcnt(0)" ::: "memory");
            const unsigned og = xb_add(&bar[XB_TOP], 1u);
            const unsigned tg = og / nx;
            if (og + 1u == (tg + 1u) * nx) xb_add(&bar[XB_TOPGEN], 1u);
            else XB_SPIN(xb_ld(&bar[XB_TOPGEN]) == tg, bar);
            __builtin_amdgcn_fence(__ATOMIC_ACQUIRE, "agent");
            xb_add(&bar[XB_XGEN(b.x)], 1u);
            asm volatile("s_waitcnt vmcnt(0)" ::: "memory");
        } else {
            XB_SPIN(xb_ld(&bar[XB_XGEN(b.x)]) == gen, bar);
            __builtin_amdgcn_fence(__ATOMIC_ACQUIRE, "agent");
            asm volatile("s_waitcnt vmcnt(0)" ::: "memory");
        }
    }
    __syncthreads();
}

struct Params {
    const float* in[23];
    const int* positions;
    float* out;
    unsigned char* ws;
};

__device__ __forceinline__ void prologue(int widk, const Params& p, LAS unsigned char* lds) {
    MK_IDS(); const int wave = wid;
    LAS float* scr = (LAS float*)(lds + wave * 16384);
    unsigned char* wsw = p.ws + WS_W;
    constexpr int I_GWIN = 16 * 128, I_SQ = 16 * 32, I_DWIN = 16 * 96, I_FUP = 16 * 176, I_FDN = 44 * 32;
    constexpr int NITEMS = 2 * I_GWIN + 2 * I_SQ + 2 * I_DWIN + 2 * I_SQ + 4 * I_FUP + 4 * I_FDN;
    for (int it = gw; it < NITEMS; it += NGW) {
        int r = it;
        if (r < 2 * I_GWIN) { const int j = r / I_GWIN; r %= I_GWIN; transpose_item<0, true>(p.in[2] + (size_t)j * 1024 * GDN_N, GDN_N, 1024, 128, (bf16_t*)(wsw + W_GWIN) + (size_t)j * 4096 * 1024, scr, r, lane); continue; } r -= 2 * I_GWIN;
        if (r < 2 * I_SQ) { const int j = r / I_SQ; r %= I_SQ; transpose_item(p.in[7] + (size_t)j * 1024 * 1024, 1024, 1024, 32, (bf16_t*)(wsw + W_GWOUT) + (size_t)j * 1024 * 1024, scr, r, lane); continue; } r -= 2 * I_SQ;
        if (r < 2 * I_DWIN) { const int j = r / I_DWIN; r %= I_DWIN; transpose_item<2, true>(p.in[8] + (size_t)j * 1024 * DIFF_N, DIFF_N, 1024, 96, (bf16_t*)(wsw + W_DWIN) + (size_t)j * 3072 * 1024, scr, r, lane); continue; } r -= 2 * I_DWIN;
        if (r < 2 * I_SQ) { const int j = r / I_SQ; r %= I_SQ; transpose_item(p.in[14] + (size_t)j * 1024 * 1024, 1024, 1024, 32, (bf16_t*)(wsw + W_DWOUT) + (size_t)j * 1024 * 1024, scr, r, lane); continue; } r -= 2 * I_SQ;
        if (r < 4 * I_FUP) { const int j = r / I_FUP; r %= I_FUP; transpose_item<1, true>(p.in[15] + (size_t)j * 1024 * FFN_N, FFN_N, 1024, 176, (bf16_t*)(wsw + W_FUP) + (size_t)j * 5632 * 1024, scr, r, lane); continue; } r -= 4 * I_FUP;
        { const int j = r / I_FDN; r %= I_FDN; transpose_item(p.in[18] + (size_t)j * 2816 * 1024, 1024, 2816, 32, (bf16_t*)(wsw + W_FDOWN) + (size_t)j * 1024 * 2816, scr, r, lane); }
    }
    for (int e = gt; e < 2 * 16 * 1024; e += NGT) { const int j = e >> 14, n = (e >> 10) & 15, k = e & 1023;
        ((bf16_t*)(wsw + W_GWAB))[e] = (unsigned short)(pg8::cvt_pk_f16(p.in[2][(size_t)j * 1024 * GDN_N + (size_t)k * GDN_N + GDN_NMAIN + n], 0.f) & 0xffffu); }
    { unsigned* CS = (unsigned*)(p.ws + WS_ROPE);
      for (int e = gt; e < M * 32; e += NGT) { const int m = e >> 5, f = e & 31; const float inv = exp2f(-(float)f * (13.287712379549449f / 32.f)); float sn, cs; sincosf((float)p.positions[m] * inv, &sn, &cs); CS[e] = pg8::cvt_pk_f16(cs, sn); } }
    const f32x4* x4 = (const f32x4*)p.in[0]; u32x4* xn = (u32x4*)(p.ws + WS_XN);
    for (int e = gt; e < M * D / 8; e += NGT) { const f32x4 a = x4[2 * e], b = x4[2 * e + 1]; u32x4 w; w.x = pg8::cvt_pk_f16(a[0], a[1]); w.y = pg8::cvt_pk_f16(a[2], a[3]); w.z = pg8::cvt_pk_f16(b[0], b[1]); w.w = pg8::cvt_pk_f16(b[2], b[3]); xn[e] = w; }
}

__device__ __forceinline__ void ln_phase(int widk, float* X, bf16_t* XN, const float* g, const float* b) {
    MK_IDS();
    f32x4 gv[4], bv[4];
#pragma unroll
    for (int j = 0; j < 4; ++j) { gv[j] = ((const f32x4*)g)[lane + 64 * j]; bv[j] = ((const f32x4*)b)[lane + 64 * j]; }
    for (int m = gw; m < M; m += NGW) {
        f32x4* xr = (f32x4*)(X + (size_t)m * D) + lane;
        f32x4 v[4]; float s = 0.f;
#pragma unroll
        for (int j = 0; j < 4; ++j) { v[j] = xr[64 * j]; s += (v[j][0] + v[j][1]) + (v[j][2] + v[j][3]); }
        const float mean = wave_sum(s) * (1.f / D); float s2 = 0.f;
#pragma unroll
        for (int j = 0; j < 4; ++j) { v[j] = v[j] - mean; s2 += (v[j][0] * v[j][0] + v[j][1] * v[j][1]) + (v[j][2] * v[j][2] + v[j][3] * v[j][3]); }
        const float rstd = 1.f / sqrtf(wave_sum(s2) * (1.f / D) + LN_EPS);
        u32x2* o8 = (u32x2*)(XN + (size_t)m * D) + lane;
#pragma unroll
        for (int j = 0; j < 4; ++j) { const f32x4 o = v[j] * rstd * gv[j] + bv[j]; xr[64 * j] = o; u32x2 w; w.x = pg8::cvt_pk_f16(o[0], o[1]); w.y = pg8::cvt_pk_f16(o[2], o[3]); o8[64 * j] = w; }
    }
}

__device__ __forceinline__ void ffn_fixup_phase(int widk, bf16_t* ACT, const float* HALO, const float* HALO2, const float* cw, const float* cb) {
    MK_IDS();
    constexpr int NCG = FFN_H / 4;
    for (int item = gt; item < (M / 256) * NCG; item += NGT) {
        const int pm = item / NCG, col = (item % NCG) * 4;
        if ((pm & 7) == 0) continue;
        f32x4 wa[3], wb[3];
#pragma unroll
        for (int j = 0; j < 3; ++j) { wa[j] = *(const f32x4*)(cw + j * FFN_N + col); wb[j] = *(const f32x4*)(cw + j * FFN_N + FFN_H + col); }
        const f32x4 ba = *(const f32x4*)(cb + col), bb = *(const f32x4*)(cb + FFN_H + col);
        const float* hp = HALO + (size_t)(pm - 1) * 2 * FFN_N + col; const float* h2 = HALO2 + (size_t)pm * 2 * FFN_N + col;
        const f32x4 am2 = *(const f32x4*)hp, am1 = *(const f32x4*)(hp + FFN_N), a0 = *(const f32x4*)h2, a1 = *(const f32x4*)(h2 + FFN_N);
        const f32x4 bm2 = *(const f32x4*)(hp + FFN_H), bm1 = *(const f32x4*)(hp + FFN_N + FFN_H), b0 = *(const f32x4*)(h2 + FFN_H), b1 = *(const f32x4*)(h2 + FFN_N + FFN_H);
        float o0[4], o1[4];
#pragma unroll
        for (int e = 0; e < 4; ++e) {
            o0[e] = silu(wa[0][e] * am2[e] + wa[1][e] * am1[e] + wa[2][e] * a0[e] + ba[e]) * (wb[0][e] * bm2[e] + wb[1][e] * bm1[e] + wb[2][e] * b0[e] + bb[e]);
            o1[e] = silu(wa[0][e] * am1[e] + wa[1][e] * a0[e] + wa[2][e] * a1[e] + ba[e]) * (wb[0][e] * bm1[e] + wb[1][e] * b0[e] + wb[2][e] * b1[e] + bb[e]);
        }
        u32x2 w; w.x = cvt_pk_bf16(o0[0], o0[1]); w.y = cvt_pk_bf16(o0[2], o0[3]); *(u32x2*)(ACT + (size_t)(pm * 256) * FFN_H + col) = w;
        w.x = cvt_pk_bf16(o1[0], o1[1]); w.y = cvt_pk_bf16(o1[2], o1[3]); *(u32x2*)(ACT + (size_t)(pm * 256 + 1) * FFN_H + col) = w;
    }
}

__device__ __forceinline__ void gdn_ab_phase(int widk, const bf16_t* XN, const bf16_t* wabT  , const float* a_log, const float* dt_bias, float* G, float* BETA) {
    MK_IDS();
    const int n = lane & 15, q4 = lane >> 4, h = n & 7;
    const float al = -__expf(a_log[h]), db = dt_bias[h];
    for (int it = gw; it < M / 16; it += NGW) {
        const int m0 = it * 16;
        f32x4 acc = {0.f, 0.f, 0.f, 0.f};
        const bf16_t* ap = XN + (size_t)(m0 + n) * D + 8 * q4;
        const bf16_t* bp = wabT + (size_t)n * D + 8 * q4;
#pragma unroll 8
        for (int ks = 0; ks < 32; ++ks) { const bf16x8 a = *(const bf16x8*)(ap + 32 * ks), b = *(const bf16x8*)(bp + 32 * ks); acc = pg8::mma16<true>(a, b, acc); }
#pragma unroll
        for (int i = 0; i < 4; ++i) { const int m = m0 + 4 * q4 + i; const float v = acc[i];
            if (n < 8) { const float x = v + db; const float sp = x > 20.f ? x : log1pf(__expf(x)); G[(size_t)m * 8 + h] = al * sp; }
            else BETA[(size_t)m * 8 + h] = 1.f / (1.f + __expf(-v)); }
    }
}

__device__ __forceinline__ void conv_silu16(const bf16_t* hp, int t, const LAS float* cw, float (&y)[16]) {
#pragma unroll
    for (int c = 0; c < 16; ++c) y[c] = 0.f;
#pragma unroll
    for (int j = 0; j < 4; ++j) {
        if (t - 3 + j >= 0) {
            float x[16];
            const bf16_t* rp = hp + (ptrdiff_t)(j - 3) * GDN_NMAIN;
            { float t8[8]; unpack8(*(const u32x4*)rp, t8);
#pragma unroll
              for (int c = 0; c < 8; ++c) x[c] = t8[c];
              unpack8(*(const u32x4*)(rp + 8), t8);
#pragma unroll
              for (int c = 0; c < 8; ++c) x[8 + c] = t8[c]; }
#pragma unroll
            for (int q = 0; q < 4; ++q) { const f32x4 w = *(const LAS f32x4*)(cw + j * 128 + 4 * q);
#pragma unroll
                for (int e = 0; e < 4; ++e) y[4 * q + e] += w[e] * x[4 * q + e]; }
        }
    }
#pragma unroll
    for (int c = 0; c < 16; ++c) y[c] = silu(y[c]);
}
__device__ __forceinline__ float sumsq16_8lanes(const float (&y)[16]) {
    float s = 0.f;
#pragma unroll
    for (int c = 0; c < 16; ++c) s += y[c] * y[c];
    s += __shfl_xor(s, 1); s += __shfl_xor(s, 2); s += __shfl_xor(s, 4);
    return s;
}
__device__ __forceinline__ void pack16(const float (&y)[16], u32x4& a, u32x4& b) {
    a.x = cvt_pk_bf16(y[0], y[1]); a.y = cvt_pk_bf16(y[2], y[3]); a.z = cvt_pk_bf16(y[4], y[5]); a.w = cvt_pk_bf16(y[6], y[7]);
    b.x = cvt_pk_bf16(y[8], y[9]); b.y = cvt_pk_bf16(y[10], y[11]); b.z = cvt_pk_bf16(y[12], y[13]); b.w = cvt_pk_bf16(y[14], y[15]);
}
__device__ __forceinline__ void unpack16(const u32x4 a, const u32x4 b, float (&y)[16]) {
    float t8[8]; unpack8(a, t8);
#pragma unroll
    for (int c = 0; c < 8; ++c) y[c] = t8[c];
    unpack8(b, t8);
#pragma unroll
    for (int c = 0; c < 8; ++c) y[8 + c] = t8[c];
}
__device__ __forceinline__ bf16x8 lds_frag16(const LAS unsigned char* p) { return *(const LAS bf16x8*)p; }
__device__ __forceinline__ bf16x8 lds_frag8x2(const LAS unsigned char* p0, const LAS unsigned char* p1) {
    const s16x4 a = *(const volatile LAS s16x4*)p0, b = *(const volatile LAS s16x4*)p1; return (bf16x8){a[0], a[1], a[2], a[3], b[0], b[1], b[2], b[3]};
}

constexpr int GA_GC = 0, GA_BT = 256, GA_CW = 512, GA_Q = GA_CW + 3 * 4 * 128 * 4, GA_K = GA_Q + 64 * 272, GA_LT = GA_K + 64 * 272, GA_END = GA_LT + 8 * 8192;
static_assert(GA_END <= 131072 && GA_LT % 16 == 0, "GDN phase A LDS map");
constexpr int GB_GC = 0, GB_BT = 512, GB_Q = 1024,     GB_KB = GB_Q + 64 * 272, GB_VB = GB_KB + 64 * 272, GB_KD = GB_VB + 64 * 272, GB_T = GB_KD + 128 * 144, GB_AT = GB_T + 64 * 144, GB_O = GB_AT + 64 * 144, GB_END = GB_O + 64 * 528;
static_assert(GB_END <= 131072 && GB_O % 16 == 0, "GDN phase B LDS map");

template <int I, int J> __device__ __forceinline__ void inv_row(float& s0, float& s1, const float lr, const float (&t)[64]) {
    if constexpr (J + 8 <= I) {
        int a0, a1, a2, a3, a4, a5, a6, a7;
        asm volatile("v_readlane_b32 %2, %10, %19\n\tv_readlane_b32 %3, %10, %19+1\n\tv_readlane_b32 %4, %10, %19+2\n\tv_readlane_b32 %5, %10, %19+3\n\t"
                     "v_readlane_b32 %6, %10, %19+4\n\tv_readlane_b32 %7, %10, %19+5\n\tv_readlane_b32 %8, %10, %19+6\n\tv_readlane_b32 %9, %10, %19+7\n\t"
                     "v_fma_f32 %0, -%11, %2, %0\n\tv_fma_f32 %1, -%12, %3, %1\n\tv_fma_f32 %0, -%13, %4, %0\n\tv_fma_f32 %1, -%14, %5, %1\n\t"
                     "v_fma_f32 %0, -%15, %6, %0\n\tv_fma_f32 %1, -%16, %7, %1\n\tv_fma_f32 %0, -%17, %8, %0\n\tv_fma_f32 %1, -%18, %9, %1"
                     : "+v"(s0), "+v"(s1), "=&s"(a0), "=&s"(a1), "=&s"(a2), "=&s"(a3), "=&s"(a4), "=&s"(a5), "=&s"(a6), "=&s"(a7)
                     : "v"(lr), "v"(t[J]), "v"(t[J + 1]), "v"(t[J + 2]), "v"(t[J + 3]), "v"(t[J + 4]), "v"(t[J + 5]), "v"(t[J + 6]), "v"(t[J + 7]), "i"(J));
        inv_row<I, J + 8>(s0, s1, lr, t);
    } else {
#pragma unroll
        for (int j = J; j < I; ++j) { const float lj = __int_as_float(__builtin_amdgcn_readlane(__float_as_int(lr), j)); if (j & 1) s1 -= lj * t[j]; else s0 -= lj * t[j]; }
    }
}
template <int I0> __device__ __forceinline__ void inv_rows8(const LAS float* Lp, const float flane, float (&t)[64]) {
    float lr[8];
#pragma unroll
    for (int k = 0; k < 8; ++k) lr[k] = Lp[((I0 + k) * (I0 + k - 1)) / 2];
#define INV_ROW(k) { float s0 = 1.f - fminf(fabsf(flane - (float)(I0 + k)), 1.f), s1 = 0.f; inv_row<I0 + k, 0>(s0, s1, lr[k], t); t[I0 + k] = s0 + s1; }
    INV_ROW(0) INV_ROW(1) INV_ROW(2) INV_ROW(3) INV_ROW(4) INV_ROW(5) INV_ROW(6) INV_ROW(7)
#undef INV_ROW
}

__device__ __forceinline__ void gdn_phase_a(int widk, bf16_t* H, const float* G, const float* BETA, const float* convw  , bf16_t* TG, bf16_t* ATT, LAS unsigned char* lds) {
    MK_IDS();
    LAS float* gcs = (LAS float*)(lds + GA_GC); LAS float* bts = (LAS float*)(lds + GA_BT); LAS float* cwl = (LAS float*)(lds + GA_CW);
    for (int bh = blockIdx.x; bh < 256; bh += gridDim.x) {
        const int b = bh >> 3, h = bh & 7;
        __syncthreads();
        for (int e = tid; e < 3 * 4 * 128; e += NTHR) { const int ten = e / 512, tap = (e >> 7) & 3, c = e & 127; cwl[e] = convw[tap * 3072 + ten * 1024 + h * 128 + c]; }
        __syncthreads();
        float gnext = 0.f, bnext = 0.f;
        if (wid == 0) { gnext = G[(size_t)(b * T + 31 * 64 + lane) * 8 + h]; bnext = BETA[(size_t)(b * T + 31 * 64 + lane) * 8 + h]; }
        for (int sg = 3; sg >= 0; --sg) {
            for (int k = 7; k >= 0; --k) {
                const int n = sg * 8 + k, it = n * 256 + bh, m0 = b * T + n * 64;
                if (wid == 0) { float c = gnext;
#pragma unroll
                    for (int o = 1; o < 64; o <<= 1) { const float t = __shfl_up(c, o); if (lane >= o) c += t; }
                    gcs[lane] = c; bts[lane] = bnext;
                    if (n > 0) { gnext = G[(size_t)(m0 - 64 + lane) * 8 + h]; bnext = BETA[(size_t)(m0 - 64 + lane) * 8 + h]; } }
                const int r = tid >> 3, c0 = (tid & 7) * 16, t = n * 64 + r; bf16_t* hp = H + (size_t)(m0 + r) * GDN_NMAIN + h * 128 + c0;
                u32x4 st[6];
                {   float y[16];
                    conv_silu16(hp, t, cwl + c0, y);
                    { const float rinv = rsqrtf(sumsq16_8lanes(y) + RMS_EPS) * 0.08838834764831845f;
#pragma unroll
                      for (int c = 0; c < 16; ++c) y[c] *= rinv; pack16(y, st[0], st[1]); }
                    conv_silu16(hp + 1024, t, cwl + 512 + c0, y);
                    { const float rinv = rsqrtf(sumsq16_8lanes(y) + RMS_EPS);
#pragma unroll
                      for (int c = 0; c < 16; ++c) y[c] *= rinv; pack16(y, st[2], st[3]); }
                    conv_silu16(hp + 2048, t, cwl + 1024 + c0, y);
                    pack16(y, st[4], st[5]);
                    *(LAS u32x4*)(lds + GA_Q + r * 272 + c0 * 2) = st[0]; *(LAS u32x4*)(lds + GA_Q + r * 272 + c0 * 2 + 16) = st[1];
                    *(LAS u32x4*)(lds + GA_K + r * 272 + c0 * 2) = st[2]; *(LAS u32x4*)(lds + GA_K + r * 272 + c0 * 2 + 16) = st[3];
                }
                __syncthreads();
                *(u32x4*)hp = st[0]; *(u32x4*)(hp + 8) = st[1]; *(u32x4*)(hp + 1024) = st[2]; *(u32x4*)(hp + 1024 + 8) = st[3]; *(u32x4*)(hp + 2048) = st[4]; *(u32x4*)(hp + 2048 + 8) = st[5];
                {
                    const int which = wid >> 2, bi = (wid >> 1) & 1, bj = wid & 1, l31 = lane & 31, hi = lane >> 5;
                    LAS float* Lt = (LAS float*)(lds + GA_LT + k * 8192);
                    f32x16 acc = {};
                    if (!(bi == 0 && bj == 1)) {
                        const LAS unsigned char* ap = lds + (which ? GA_Q : GA_K) + (32 * bi + l31) * 272 + hi * 16;
                        const LAS unsigned char* bp = lds + GA_K + (32 * bj + l31) * 272 + hi * 16;
#pragma unroll
                        for (int ks = 0; ks < 8; ++ks) acc = __builtin_amdgcn_mfma_f32_32x32x16_bf16(lds_frag16(ap + ks * 32), lds_frag16(bp + ks * 32), acc, 0, 0, 0);
                    }
                    const int j = 32 * bj + l31; const float gcj = gcs[j];
#pragma unroll
                    for (int rr = 0; rr < 16; ++rr) { const int i = 32 * bi + crow(rr, hi); const float dec = __expf(fminf(gcs[i] - gcj, 0.f));
                        if (which == 0) { if (i > j) Lt[(i * (i - 1)) / 2 + j] = bts[i] * acc[rr] * dec; }
                        else ATT[((size_t)it * 64 + i) * 64 + j] = f2bf((i >= j) ? acc[rr] * dec : 0.f); }
                }
                __syncthreads();
            }
            {
                float t[64]; const float flane = (float)lane;
                const LAS float* Lp = (const LAS float*)(lds + GA_LT + wid * 8192) + lane; asm volatile("" : "+v"(Lp));
                inv_rows8<0>(Lp, flane, t); inv_rows8<8>(Lp, flane, t); inv_rows8<16>(Lp, flane, t); inv_rows8<24>(Lp, flane, t);
                inv_rows8<32>(Lp, flane, t); inv_rows8<40>(Lp, flane, t); inv_rows8<48>(Lp, flane, t); inv_rows8<56>(Lp, flane, t);
                bf16_t* tp = TG + (size_t)((sg * 8 + wid) * 256 + bh) * 4096 + lane;
#pragma unroll
                for (int i = 0; i < 64; ++i) tp[i * 64] = f2bf(t[i]);
            }
        }
    }
    __syncthreads();
}

__device__ __forceinline__ void gdn_phase_b(int widk, bf16_t* H, const float* G, const float* BETA, const float* normw  , const bf16_t* TG, const bf16_t* ATT, LAS unsigned char* lds) {
    MK_IDS();
    LAS float* gcs = (LAS float*)(lds + GB_GC); LAS float* bts = (LAS float*)(lds + GB_BT);
    const int n16 = lane & 15, q4 = lane >> 4;
    for (int bh = blockIdx.x; bh < 256; bh += gridDim.x) {
        const int b = bh >> 3, h = bh & 7;
        f32x4 S[8];
#pragma unroll
        for (int s = 0; s < 8; ++s) S[s] = (f32x4){0.f, 0.f, 0.f, 0.f};
        const int r = tid >> 3, c0 = (tid & 7) * 16;
        u32x4 q0, q1, k0, k1, v0, v1, tt, aa, ga0, ga1; float gval = 0.f, bval = 0.f;
#define GB_LOAD(n_) do { const int it_ = (n_) * 256 + bh, m_ = b * T + (n_) * 64; const bf16_t* hq = H + (size_t)(m_ + r) * GDN_NMAIN + h * 128 + c0; \
            q0 = *(const u32x4*)hq; q1 = *(const u32x4*)(hq + 8); k0 = *(const u32x4*)(hq + 1024); k1 = *(const u32x4*)(hq + 1024 + 8); v0 = *(const u32x4*)(hq + 2048); v1 = *(const u32x4*)(hq + 2048 + 8); \
            ga0 = *(const u32x4*)(hq + 3072); ga1 = *(const u32x4*)(hq + 3072 + 8); \
            tt = __builtin_nontemporal_load((const u32x4*)(TG + (size_t)it_ * 4096) + tid); aa = __builtin_nontemporal_load((const u32x4*)(ATT + (size_t)it_ * 4096) + tid);   \
            if (wid == 0) { gval = G[(size_t)(m_ + lane) * 8 + h]; bval = BETA[(size_t)(m_ + lane) * 8 + h]; } } while (0)
        GB_LOAD(0);
#define GB_CUMSUM(par_) do { if (wid == 0) { float c = gval; _Pragma("unroll") for (int o = 1; o < 64; o <<= 1) { const float t = __shfl_up(c, o); if (lane >= o) c += t; } \
            gcs[(par_) * 64 + lane] = c; bts[(par_) * 64 + lane] = bval; } } while (0)
        GB_CUMSUM(0);
        __syncthreads();
        for (int n = 0; n < 32; ++n) {
            const int m0 = b * T + n * 64, par = n & 1;
            bf16_t* hp = H + (size_t)(m0 + r) * GDN_NMAIN + h * 128 + c0;
            const float glast = gcs[par * 64 + 63];
            {   const float gcr = gcs[par * 64 + r], btr = bts[par * 64 + r], eg = __expf(gcr), ekd = __expf(glast - gcr);
                float y[16]; u32x4 a, bq;
                unpack16(q0, q1, y);
#pragma unroll
                for (int c = 0; c < 16; ++c) y[c] *= eg;
                pack16(y, a, bq); *(LAS u32x4*)(lds + GB_Q + r * 272 + c0 * 2) = a; *(LAS u32x4*)(lds + GB_Q + r * 272 + c0 * 2 + 16) = bq;
                unpack16(k0, k1, y);
#pragma unroll
                for (int c = 0; c < 16; ++c) *(LAS bf16_t*)(lds + GB_KD + (c0 + c) * 144 + r * 2) = f2bf(y[c] * ekd);
                { const float sc = btr * eg;
#pragma unroll
                  for (int c = 0; c < 16; ++c) y[c] *= sc; }
                pack16(y, a, bq); *(LAS u32x4*)(lds + GB_KB + r * 272 + c0 * 2) = a; *(LAS u32x4*)(lds + GB_KB + r * 272 + c0 * 2 + 16) = bq;
                unpack16(v0, v1, y);
#pragma unroll
                for (int c = 0; c < 16; ++c) y[c] *= btr;
                pack16(y, a, bq); *(LAS u32x4*)(lds + GB_VB + r * 272 + c0 * 2) = a; *(LAS u32x4*)(lds + GB_VB + r * 272 + c0 * 2 + 16) = bq;
                *(LAS u32x4*)(lds + GB_T + (tid >> 3) * 144 + (tid & 7) * 16) = tt;
                *(LAS u32x4*)(lds + GB_AT + (tid >> 3) * 144 + (tid & 7) * 16) = aa;
            }
            const u32x4 gk0 = ga0, gk1 = ga1;
            __syncthreads();
            if (n + 1 < 32) GB_LOAD(n + 1);
            {
                bf16x8 Sf[4];
#pragma unroll
                for (int ks = 0; ks < 4; ++ks) { u32x4 w; w.x = cvt_pk_bf16(S[2 * ks][0], S[2 * ks][1]); w.y = cvt_pk_bf16(S[2 * ks][2], S[2 * ks][3]);
                    w.z = cvt_pk_bf16(S[2 * ks + 1][0], S[2 * ks + 1][1]); w.w = cvt_pk_bf16(S[2 * ks + 1][2], S[2 * ks + 1][3]); Sf[ks] = __builtin_bit_cast(bf16x8, w); }
                f32x4 rr[4];
#pragma unroll
                for (int mt = 0; mt < 4; ++mt) {
                    const LAS unsigned char* vp = lds + GB_VB + (16 * mt + 4 * q4) * 272 + (16 * wid + n16) * 2;
                    rr[mt] = (f32x4){-bf2f(*(const LAS bf16_t*)vp), -bf2f(*(const LAS bf16_t*)(vp + 272)), -bf2f(*(const LAS bf16_t*)(vp + 544)), -bf2f(*(const LAS bf16_t*)(vp + 816))};
                    const LAS unsigned char* ap = lds + GB_KB + (16 * mt + n16) * 272 + 8 * q4;
#pragma unroll
                    for (int ks = 0; ks < 4; ++ks) rr[mt] = __builtin_amdgcn_mfma_f32_16x16x32_bf16(lds_frag8x2(ap + ks * 64, ap + ks * 64 + 32), Sf[ks], rr[mt], 0, 0, 0);
                }
                bf16x8 Rf[2];
#pragma unroll
                for (int kt = 0; kt < 2; ++kt) { u32x4 w; w.x = cvt_pk_bf16(-rr[2 * kt][0], -rr[2 * kt][1]); w.y = cvt_pk_bf16(-rr[2 * kt][2], -rr[2 * kt][3]);
                    w.z = cvt_pk_bf16(-rr[2 * kt + 1][0], -rr[2 * kt + 1][1]); w.w = cvt_pk_bf16(-rr[2 * kt + 1][2], -rr[2 * kt + 1][3]); Rf[kt] = __builtin_bit_cast(bf16x8, w); }
                f32x4 vn[4];
#pragma unroll
                for (int mt = 0; mt < 4; ++mt) { vn[mt] = (f32x4){0.f, 0.f, 0.f, 0.f};
                    const LAS unsigned char* tp = lds + GB_T + (16 * mt + n16) * 144 + 8 * q4;
#pragma unroll
                    for (int kt = 0; kt < 2; ++kt) if (kt == 0 || mt >= 2) vn[mt] = __builtin_amdgcn_mfma_f32_16x16x32_bf16(lds_frag8x2(tp + kt * 64, tp + kt * 64 + 32), Rf[kt], vn[mt], 0, 0, 0); }
                bf16x8 Vf[2];
#pragma unroll
                for (int kt = 0; kt < 2; ++kt) { u32x4 w; w.x = cvt_pk_bf16(vn[2 * kt][0], vn[2 * kt][1]); w.y = cvt_pk_bf16(vn[2 * kt][2], vn[2 * kt][3]);
                    w.z = cvt_pk_bf16(vn[2 * kt + 1][0], vn[2 * kt + 1][1]); w.w = cvt_pk_bf16(vn[2 * kt + 1][2], vn[2 * kt + 1][3]); Vf[kt] = __builtin_bit_cast(bf16x8, w); }
#pragma unroll
                for (int mt = 0; mt < 4; ++mt) {
                    f32x4 o = {0.f, 0.f, 0.f, 0.f};
                    const LAS unsigned char* qp = lds + GB_Q + (16 * mt + n16) * 272 + 8 * q4;
#pragma unroll
                    for (int ks = 0; ks < 4; ++ks) o = __builtin_amdgcn_mfma_f32_16x16x32_bf16(lds_frag8x2(qp + ks * 64, qp + ks * 64 + 32), Sf[ks], o, 0, 0, 0);
                    const LAS unsigned char* atp = lds + GB_AT + (16 * mt + n16) * 144 + 8 * q4;
#pragma unroll
                    for (int kt = 0; kt < 2; ++kt) if (kt == 0 || mt >= 2) o = __builtin_amdgcn_mfma_f32_16x16x32_bf16(lds_frag8x2(atp + kt * 64, atp + kt * 64 + 32), Vf[kt], o, 0, 0, 0);
#pragma unroll
                    for (int i = 0; i < 4; ++i) *(LAS float*)(lds + GB_O + (16 * mt + 4 * q4 + i) * 528 + (16 * wid + n16) * 4) = o[i];
                }
                const float eg = __expf(glast);
#pragma unroll
                for (int st = 0; st < 8; ++st) { S[st] = S[st] * eg;
                    const LAS unsigned char* kp = lds + GB_KD + (16 * st + n16) * 144 + 8 * q4;
#pragma unroll
                    for (int kt = 0; kt < 2; ++kt) S[st] = __builtin_amdgcn_mfma_f32_16x16x32_bf16(lds_frag8x2(kp + kt * 64, kp + kt * 64 + 32), Vf[kt], S[st], 0, 0, 0); }
            }
            if (n + 1 < 32) GB_CUMSUM(par ^ 1);
            __syncthreads();
            {
                float o[16];
#pragma unroll
                for (int q = 0; q < 4; ++q) { const f32x4 v = *(const LAS f32x4*)(lds + GB_O + r * 528 + (c0 + 4 * q) * 4); o[4 * q] = v[0]; o[4 * q + 1] = v[1]; o[4 * q + 2] = v[2]; o[4 * q + 3] = v[3]; }
                const float rstd = rsqrtf(sumsq16_8lanes(o) * (1.f / 128.f) + RMS_EPS);
                float gt[16]; unpack16(gk0, gk1, gt);
                float res[16];
#pragma unroll
                for (int c = 0; c < 16; ++c) res[c] = o[c] * rstd * normw[c0 + c] * silu(gt[c]);
                u32x4 a, bq; pack16(res, a, bq);
                *(u32x4*)(hp + 2048) = a; *(u32x4*)(hp + 2048 + 8) = bq;
            }
        }
        __syncthreads();
    }
}
#undef GB_CUMSUM
#undef GB_LOAD

__device__ __forceinline__ void diff_prep_phase(int widk, bf16_t* H  , const int* positions, bf16_t* VT  , LAS unsigned char* lds) {
    MK_IDS();
    LAS unsigned char* scr = lds + wid * 16384;
    for (int item = gw; item < NB * 32 * 16; item += NGW) {
        const int dvh = item & 1, h = (item >> 1) & 7, tb = (item >> 4) & 31, b = item >> 9;
        const bf16_t* src = H + ((size_t)b * T + tb * 64) * DIFF_N + 2048 + h * 128 + dvh * 64;
#pragma unroll
        for (int i = 0; i < 8; ++i) { const int row = (lane >> 3) + 8 * i, ch = lane & 7; *(LAS u32x4*)(scr + row * 144 + ch * 16) = *(const u32x4*)(src + (size_t)row * DIFF_N + ch * 8); }
        LDS_WAIT();
        bf16_t* dst = VT + (((size_t)b * 8 + h) * 128 + dvh * 64 + lane) * T + tb * 64;
#pragma unroll
        for (int k = 0; k < 8; ++k) { unsigned short v[8];
#pragma unroll
            for (int e = 0; e < 8; ++e) v[e] = *(const LAS bf16_t*)(scr + (8 * k + e) * 144 + lane * 2);
            u32x4 w; w.x = v[0] | ((unsigned)v[1] << 16); w.y = v[2] | ((unsigned)v[3] << 16); w.z = v[4] | ((unsigned)v[5] << 16); w.w = v[6] | ((unsigned)v[7] << 16);
            *(u32x4*)(dst + 8 * k) = w; }
        LDS_WAIT();
    }
}

constexpr int AT_STAGE = 36864, AT_K = 0, AT_V = 64 * 272, AT_OSTG = 2 * AT_STAGE;
static_assert(AT_OSTG + 128 * 272 <= 131072, "attention LDS map");
__device__ __forceinline__ void diff_attn_phase(int widk, const bf16_t* H, const bf16_t* VT, bf16_t* O, const float* lq1, const float* lk1, const float* lq2, const float* lk2, const float* subw, float lambda_init,
                                                LAS unsigned char* lds) {
    MK_IDS();
    const float lam = __expf(wave_sum(lq1[lane] * lk1[lane])) - __expf(wave_sum(lq2[lane] * lk2[lane])) + lambda_init;
    const int c = wid >> 2, rg = wid & 3, l31 = lane & 31, hi = lane >> 5;
    for (int bh = blockIdx.x; bh < 256; bh += gridDim.x) {
        const int b = bh >> 3, h = bh & 7;
        const bf16_t* Kg = H + (size_t)b * T * DIFF_N + 1024 + h * 128;
        const bf16_t* Vg = VT + (size_t)bh * 128 * T;
        for (int ui = 0; ui < 16; ++ui) {
            const int qb = (ui & 1) ? (15 - (ui >> 1)) : (ui >> 1);
            const int q0w = 128 * qb + 32 * rg, nt = 2 * qb + 2;
            bf16x8 qf[4];
            { const bf16_t* qp = H + ((size_t)b * T + q0w + l31) * DIFF_N + h * 128 + c * 64 + 8 * hi;
#pragma unroll
              for (int d0 = 0; d0 < 4; ++d0) qf[d0] = *(const bf16x8*)(qp + 16 * d0); }
            f32x16 o[4];
#pragma unroll
            for (int d = 0; d < 4; ++d) o[d] = (f32x16){};
            float mrun = -1e30f, lrun = 0.f;
            u32x4 pk[2], pv[2];
#define AT_LOAD(j) do { _Pragma("unroll") for (int i_ = 0; i_ < 2; ++i_) { const int ci = tid + 512 * i_; \
                pk[i_] = *(const u32x4*)(Kg + (size_t)((j) * 64 + (ci >> 4)) * DIFF_N + (ci & 15) * 8); \
                pv[i_] = *(const u32x4*)(Vg + (size_t)(ci >> 3) * T + (j) * 64 + (ci & 7) * 8); } } while (0)
            AT_LOAD(0);
            for (int j = 0; j < nt; ++j) {
                LAS unsigned char* st = lds + (j & 1) * AT_STAGE;
#pragma unroll
                for (int i_ = 0; i_ < 2; ++i_) { const int ci = tid + 512 * i_;
                    *(LAS u32x4*)(st + AT_K + (ci >> 4) * 272 + (ci & 15) * 16) = pk[i_];
                    { LAS unsigned char* vd = st + AT_V + (ci >> 3) * 136 + (ci & 7) * 16; *(LAS u32x2*)vd = (u32x2){pv[i_].x, pv[i_].y}; *(LAS u32x2*)(vd + 8) = (u32x2){pv[i_].z, pv[i_].w}; } }
                __syncthreads();
                if (j + 1 < nt) AT_LOAD(j + 1);
                if (64 * j <= q0w + 31) {
                    bf16x8 kf[2][4];
#pragma unroll
                    for (int kb = 0; kb < 2; ++kb) { const LAS unsigned char* kp = st + AT_K + (32 * kb + l31) * 272 + c * 128 + hi * 16;
#pragma unroll
                        for (int d0 = 0; d0 < 4; ++d0) kf[kb][d0] = lds_frag16(kp + d0 * 32); }
                    f32x16 p[2]; p[0] = (f32x16){}; p[1] = (f32x16){};
#pragma unroll
                    for (int d0 = 0; d0 < 4; ++d0) { p[0] = __builtin_amdgcn_mfma_f32_32x32x16_bf16(kf[0][d0], qf[d0], p[0], 0, 0, 0); p[1] = __builtin_amdgcn_mfma_f32_32x32x16_bf16(kf[1][d0], qf[d0], p[1], 0, 0, 0); }
                    const LAS unsigned char* vbase = st + AT_V + l31 * 136 + 8 * hi;
                    bf16x8 va[4], vb[4];
#define AT_LOADV(dst, t_) do { _Pragma("unroll") for (int d = 0; d < 4; ++d) dst[d] = lds_frag8x2(vbase + d * 32 * 136 + (t_) * 32, vbase + d * 32 * 136 + (t_) * 32 + 16); } while (0)
#define AT_MMA(src, pf_) do { _Pragma("unroll") for (int d = 0; d < 4; ++d) o[d] = __builtin_amdgcn_mfma_f32_32x32x16_bf16(src[d], pf_, o[d], 0, 0, 0); } while (0)
                    AT_LOADV(va, 0);
                    asm volatile("" ::: "memory");
                    if (64 * j + 63 > q0w) {
                        const int q = q0w + l31;
#pragma unroll
                        for (int kb = 0; kb < 2; ++kb)
#pragma unroll
                            for (int r = 0; r < 16; ++r) { const int kv = 64 * j + 32 * kb + crow(r, hi); if (kv > q) p[kb][r] = -1e30f; }
                    }
                    float mx0 = fmaxf(p[0][0], p[1][0]), mx1 = fmaxf(p[0][1], p[1][1]);
#pragma unroll
                    for (int r = 2; r < 16; r += 2) { mx0 = fmaxf(mx0, fmaxf(p[0][r], p[1][r])); mx1 = fmaxf(mx1, fmaxf(p[0][r + 1], p[1][r + 1])); }
                    float mx = fmaxf(mx0, mx1);
                    mx = fmaxf(mx, __shfl_xor(mx, 32));
                    const float mnew = fmaxf(mrun, mx);
                    if (__any(mnew > mrun)) {
                        const float al = __builtin_amdgcn_exp2f(mrun - mnew); lrun *= al;
#pragma unroll
                        for (int d = 0; d < 4; ++d) o[d] = o[d] * al;
                    }
                    mrun = mnew;
                    float ls0 = 0.f, ls1 = 0.f, ls2 = 0.f, ls3 = 0.f;
#pragma unroll
                    for (int kb = 0; kb < 2; ++kb)
#pragma unroll
                        for (int r = 0; r < 16; r += 4) { p[kb][r] = __builtin_amdgcn_exp2f(p[kb][r] - mnew); p[kb][r + 1] = __builtin_amdgcn_exp2f(p[kb][r + 1] - mnew);
                            p[kb][r + 2] = __builtin_amdgcn_exp2f(p[kb][r + 2] - mnew); p[kb][r + 3] = __builtin_amdgcn_exp2f(p[kb][r + 3] - mnew);
                            ls0 += p[kb][r]; ls1 += p[kb][r + 1]; ls2 += p[kb][r + 2]; ls3 += p[kb][r + 3]; }
                    lrun += (ls0 + ls1) + (ls2 + ls3);
                    bf16x8 pf[4];
#pragma unroll
                    for (int t = 0; t < 4; ++t) { const int kb = t >> 1, s8 = (t & 1) * 8;
                        u32x4 w; w.x = cvt_pk_bf16(p[kb][s8], p[kb][s8 + 1]); w.y = cvt_pk_bf16(p[kb][s8 + 2], p[kb][s8 + 3]);
                        w.z = cvt_pk_bf16(p[kb][s8 + 4], p[kb][s8 + 5]); w.w = cvt_pk_bf16(p[kb][s8 + 6], p[kb][s8 + 7]); pf[t] = __builtin_bit_cast(bf16x8, w); }
                    asm volatile("" ::: "memory");
                    AT_LOADV(vb, 1); asm volatile("" ::: "memory"); AT_MMA(va, pf[0]);
                    AT_LOADV(va, 2); asm volatile("" ::: "memory"); AT_MMA(vb, pf[1]);
                    AT_LOADV(vb, 3); asm volatile("" ::: "memory"); AT_MMA(va, pf[2]);
                    AT_MMA(vb, pf[3]);
#undef AT_LOADV
#undef AT_MMA
                }
            }
#undef AT_LOAD
            const float ltot = lrun + __shfl_xor(lrun, 32);
            const float inv = (c ? lam : 1.f) / ltot;
            __syncthreads();
            LAS float* xch = (LAS float*)lds + rg * 4096;
            if (c == 1) {
#pragma unroll
                for (int d = 0; d < 4; ++d)
#pragma unroll
                    for (int r = 0; r < 16; ++r) xch[(d * 16 + r) * 64 + lane] = o[d][r] * inv;
            }
            __syncthreads();
            if (c == 0) {
                float ss = 0.f;
#pragma unroll
                for (int d = 0; d < 4; ++d)
#pragma unroll
                    for (int r = 0; r < 16; ++r) { const float v = o[d][r] * inv - xch[(d * 16 + r) * 64 + lane]; o[d][r] = v; ss += v * v; }
                ss += __shfl_xor(ss, 32);
                const float rstd = rsqrtf(ss * (1.f / 128.f) + RMS_EPS) * (1.f - lambda_init);
                LAS unsigned char* op = lds + AT_OSTG + (rg * 32 + l31) * 272 + 8 * hi;
#pragma unroll
                for (int d = 0; d < 4; ++d)
#pragma unroll
                    for (int g = 0; g < 4; ++g) { const int dv = 32 * d + 8 * g + 4 * hi; const f32x4 sw = *(const f32x4*)(subw + dv);
                        u32x2 w; w.x = cvt_pk_bf16(o[d][4 * g] * rstd * sw[0], o[d][4 * g + 1] * rstd * sw[1]); w.y = cvt_pk_bf16(o[d][4 * g + 2] * rstd * sw[2], o[d][4 * g + 3] * rstd * sw[3]);
                        *(LAS u32x2*)(op + (32 * d + 8 * g) * 2) = w; }
            }
            __syncthreads();
            {
                const LAS unsigned char* sp = lds + AT_OSTG + (rg * 32 + c * 16) * 272;
                bf16_t* gp = O + ((size_t)b * T + 128 * qb + rg * 32 + c * 16) * D + h * 128;
#pragma unroll
                for (int i = 0; i < 4; ++i) { const int idx = i * 64 + lane, row = idx >> 4, ch = idx & 15;
                    *(u32x4*)(gp + (size_t)row * D + ch * 8) = *(const LAS u32x4*)(sp + row * 272 + ch * 16); }
            }
        }
    }
}

template <bool FUSED_LN> __global__ void __launch_bounds__(NTHR, 2) fwd_megakernel(Params p) {
    extern __shared__ __attribute__((aligned(16))) unsigned char lds_raw[];
    LAS unsigned char* lds = (LAS unsigned char*)lds_raw;
    cg::grid_group grid = cg::this_grid();
    const int widk = __builtin_amdgcn_readfirstlane((int)threadIdx.x >> 6);
    volatile LAS unsigned* bst = (volatile LAS unsigned*)(lds + 131072 + 1024);
    if (threadIdx.x < 2) bst[threadIdx.x] = 0u;
    if (blockIdx.x == 0) { for (unsigned i = threadIdx.x; i < WS_CTL_BYTES / 4; i += NTHR) ((unsigned*)p.ws)[i] = 0u; }
    __syncthreads();
    const int G = gridDim.x;
    constexpr bool fused_ln = FUSED_LN;
    unsigned char* ws = p.ws; unsigned char* wsw = ws + WS_W;
    bf16_t* XN = (bf16_t*)(ws + WS_XN); bf16_t* Hb = (bf16_t*)(ws + WS_H);
    float* Gb = (float*)(ws + WS_GB); float* BETAb = Gb + (size_t)M * 8;

    unsigned long long pt0 = 0, pticks = 0; (void)pt0;
    TBEG(4);
#ifndef NO_PRO
    REPS(4) prologue(widk, p, lds);
#endif
    grid.sync(); TEND(4);
    const XcdBarrier xbar = xcd_barrier_post((unsigned*)p.ws, bst);
    for (int layer = 0; layer < DEPTH; ++layer) {
        const int j = layer >> 1;
        const float* resid = (layer == 0) ? p.in[0] : p.out;
        if ((layer & 1) == 0) {
            TBEG(1);
            {   pg8::Gemm g{XN, (const bf16_t*)(wsw + W_GWIN) + (size_t)j * 4096 * 1024, M, GDN_NMAIN, D, D}; pg8::StaticOrder S; S.init(M, GDN_NMAIN, G, (int)blockIdx.x);
                pg8::EpiBf16 E{Hb, GDN_NMAIN};
                REPS(1) PH_GEMMB pg8::gemm_phase<pg8::EpiBf16, pg8::StaticOrder, true, true, D, D, true>(widk, lds, g, S, E); }
#ifndef NO_AB
            REPS(4) gdn_ab_phase(widk, XN, (const bf16_t*)(wsw + W_GWAB) + (size_t)j * 16 * 1024, p.in[4] + j * 8, p.in[5] + j * 8, Gb, BETAb);
#endif
            xcd_barrier(xbar, widk); TEND(1); TBEG(2);
#ifndef NO_GA
            gdn_phase_a(widk, Hb, Gb, BETAb, p.in[3] + (size_t)j * 4 * 3072, (bf16_t*)(ws + WS_UT) + (size_t)32 * 1024 * 1024, (bf16_t*)(ws + WS_UT), lds);
#endif
            xcd_barrier(xbar, widk);
#ifndef NO_GB
            gdn_phase_b(widk, Hb, Gb, BETAb, p.in[6] + j * 128, (const bf16_t*)(ws + WS_UT) + (size_t)32 * 1024 * 1024, (const bf16_t*)(ws + WS_UT), lds);
#endif
            xcd_barrier(xbar, widk); TEND(2); TBEG(5);
            {   pg8::Gemm g{Hb + 2048, (const bf16_t*)(wsw + W_GWOUT) + (size_t)j * 1024 * 1024, M, D, D, GDN_NMAIN}; pg8::StaticOrder S; S.init(M, D, G, (int)blockIdx.x);
                if constexpr (fused_ln) {
                    if (layer == 0) { pg8::EpiResidLn<false, false> E{p.in[0], p.out, XN, p.in[19] + layer * D, p.in[20] + layer * D, ALPHA, LN_EPS, (unsigned*)(ws + WS_XBUF), (unsigned*)(ws + WS_CNT) + (size_t)(2 * layer) * 4096, (LAS float*)(lds + 131072 + 2048)};
                        pg8::gemm_phase<pg8::EpiResidLn<false, false>, pg8::StaticOrder, true, true, D, GDN_NMAIN>(widk, lds, g, S, E); }
                    else { pg8::EpiResidLn<true, false> E{nullptr, p.out, XN, p.in[19] + layer * D, p.in[20] + layer * D, ALPHA, LN_EPS, (unsigned*)(ws + WS_XBUF), (unsigned*)(ws + WS_CNT) + (size_t)(2 * layer) * 4096, (LAS float*)(lds + 131072 + 2048)};
                        pg8::gemm_phase<pg8::EpiResidLn<true, false>, pg8::StaticOrder, true, true, D, GDN_NMAIN>(widk, lds, g, S, E); } }
                else { pg8::EpiResid E{resid, p.out, D, ALPHA};
                    PH_GEMMR pg8::gemm_phase<pg8::EpiResid, pg8::StaticOrder, true, true, D, GDN_NMAIN>(widk, lds, g, S, E); } }
        } else {
            const float lambda_init = 0.8f - 0.6f * expf(-0.3f * (float)layer);
            TBEG(1);
            {   pg8::Gemm g{XN, (const bf16_t*)(wsw + W_DWIN) + (size_t)j * 3072 * 1024, M, DIFF_N, D, D}; pg8::StaticOrder S; S.init(M, DIFF_N, G, (int)blockIdx.x);
                pg8::EpiRope E{Hb, (const unsigned*)(ws + WS_ROPE), 0.125f * LOG2E, (bf16_t*)(ws + WS_VT)};
                pg8::gemm_phase<pg8::EpiRope, pg8::StaticOrder, true, true, D, D, true>(widk, lds, g, S, E); }
            xcd_barrier(xbar, widk); TEND(1); TBEG(4);
#ifndef NO_ATT
            REPS(3) diff_attn_phase(widk, Hb, (const bf16_t*)(ws + WS_VT), (bf16_t*)(ws + WS_O), p.in[9] + j * 64, p.in[10] + j * 64, p.in[11] + j * 64, p.in[12] + j * 64, p.in[13] + j * 128, lambda_init, lds);
#endif
            xcd_barrier(xbar, widk); TEND(3); TBEG(5);
            {   pg8::Gemm g{(const bf16_t*)(ws + WS_O), (const bf16_t*)(wsw + W_DWOUT) + (size_t)j * 1024 * 1024, M, D, D, D}; pg8::StaticOrder S; S.init(M, D, G, (int)blockIdx.x);
                if constexpr (fused_ln) { pg8::EpiResidLn<true, false> E{nullptr, p.out, XN, p.in[19] + layer * D, p.in[20] + layer * D, ALPHA, LN_EPS, (unsigned*)(ws + WS_XBUF), (unsigned*)(ws + WS_CNT) + (size_t)(2 * layer) * 4096, (LAS float*)(lds + 131072 + 2048)};
                    pg8::gemm_phase<pg8::EpiResidLn<true, false>, pg8::StaticOrder, true, true, D, D>(widk, lds, g, S, E); }
                else { pg8::EpiResid E{resid, p.out, D, ALPHA};
                    PH_GEMMR pg8::gemm_phase<pg8::EpiResid, pg8::StaticOrder, true, true, D, D>(widk, lds, g, S, E); } }
        }
        xcd_barrier(xbar, widk); TEND(5);
        if constexpr (!fused_ln) { ln_phase(widk, p.out, XN, p.in[19] + layer * D, p.in[20] + layer * D); xcd_barrier(xbar, widk); }
        {
            bf16_t* ACT = (bf16_t*)(ws + WS_ACT); float* HALO = (float*)(ws + WS_HALO); float* HALO2 = (float*)(ws + WS_HALO2);
            const float* fcw = p.in[16] + (size_t)layer * 3 * FFN_N; const float* fcb = p.in[17] + (size_t)layer * FFN_N;
            TBEG(6);
            {   pg8::Gemm g{XN, (const bf16_t*)(wsw + W_FUP) + (size_t)layer * 5632 * 1024, M, FFN_N, D, D}; pg8::StaticOrder S; S.init(M, FFN_N, G, (int)blockIdx.x);
                pg8::EpiFfnAct E{ACT, fcw, fcb, HALO, HALO2, (LAS float*)(lds + 131072 + 2048)};
                pg8::gemm_phase<pg8::EpiFfnAct, pg8::StaticOrder, true, true, D, D, true>(widk, lds, g, S, E); }
            xcd_barrier(xbar, widk); TEND(6); TBEG(4);
            ffn_fixup_phase(widk, ACT, HALO, HALO2, fcw, fcb);
            xcd_barrier(xbar, widk); TEND(4); TBEG(7);
            {   pg8::Gemm g{ACT, (const bf16_t*)(wsw + W_FDOWN) + (size_t)layer * 1024 * 2816, M, D, FFN_H, FFN_H}; pg8::StaticOrder S; S.init(M, D, G, (int)blockIdx.x);
                if constexpr (fused_ln) {
                    if (layer == DEPTH - 1) { pg8::EpiResidLn<true, true> E{nullptr, p.out, XN, p.in[21] + layer * D, p.in[22] + layer * D, ALPHA, LN_EPS, (unsigned*)(ws + WS_XBUF), (unsigned*)(ws + WS_CNT) + (size_t)(2 * layer + 1) * 4096, (LAS float*)(lds + 131072 + 2048)};
                        pg8::gemm_phase<pg8::EpiResidLn<true, true>, pg8::StaticOrder, true, true, FFN_H, FFN_H>(widk, lds, g, S, E); }
                    else { pg8::EpiResidLn<true, false> E{nullptr, p.out, XN, p.in[21] + layer * D, p.in[22] + layer * D, ALPHA, LN_EPS, (unsigned*)(ws + WS_XBUF), (unsigned*)(ws + WS_CNT) + (size_t)(2 * layer + 1) * 4096, (LAS float*)(lds + 131072 + 2048)};
                        pg8::gemm_phase<pg8::EpiResidLn<true, false>, pg8::StaticOrder, true, true, FFN_H, FFN_H>(widk, lds, g, S, E); } }
                else { pg8::EpiResid E{p.out, p.out, D, ALPHA};
                    pg8::gemm_phase<pg8::EpiResid, pg8::StaticOrder, true, true, FFN_H, FFN_H>(widk, lds, g, S, E); } }
        }
        xcd_barrier(xbar, widk); TEND(7);
        if constexpr (!fused_ln) { ln_phase(widk, p.out, XN, p.in[21] + layer * D, p.in[22] + layer * D); xcd_barrier(xbar, widk); }
    }
    if (PROBE_T) { const unsigned long long ts = __builtin_amdgcn_s_memrealtime(); while (__builtin_amdgcn_s_memrealtime() - ts < pticks) __builtin_amdgcn_s_sleep(8); }
}
}

extern "C" void kernel_launch(void* const* d_in, const int* in_sizes, int n_in, void* d_out, int out_size, void* d_ws, size_t ws_size, hipStream_t stream) {
    static int grid = 0;
    if (grid == 0) {
        if (n_in != 23 || ws_size < mk::WS_END) { fprintf(stderr, "kernel_launch: unexpected n_in %d / ws_size %zu (need %zu)\n", n_in, ws_size, (size_t)mk::WS_END); grid = -1; return; }
        int dev = 0, cus = 0, per_cu = 0;
        (void)hipGetDevice(&dev); (void)hipDeviceGetAttribute(&cus, hipDeviceAttributeMultiprocessorCount, dev);
        const void* kfn = (const void*)mk::fwd_megakernel<true>; const void* kfn2 = (const void*)mk::fwd_megakernel<false>;
        if (hipFuncSetAttribute(kfn, hipFuncAttributeMaxDynamicSharedMemorySize, mk::LDS_BYTES) != hipSuccess || hipFuncSetAttribute(kfn2, hipFuncAttributeMaxDynamicSharedMemorySize, mk::LDS_BYTES) != hipSuccess) { fprintf(stderr, "kernel_launch: hipFuncSetAttribute failed\n"); grid = -1; return; }
        if (hipOccupancyMaxActiveBlocksPerMultiprocessor(&per_cu, kfn, mk::NTHR, mk::LDS_BYTES) != hipSuccess || per_cu < 1) { fprintf(stderr, "kernel_launch: occupancy query gave %d\n", per_cu); per_cu = 1; }
        (void)hipGetLastError();
        grid = cus * per_cu;
        fprintf(stderr, "kernel_launch: grid %d (cus %d x %d)\n", grid, cus, per_cu);
    }
    if (grid < 0) return;
    mk::Params p{};
    for (int i = 0; i < 23; ++i) p.in[i] = (const float*)d_in[i];
    p.positions = (const int*)d_in[1]; p.out = (float*)d_out; p.ws = (unsigned char*)d_ws;
    void* args[] = {&p};
    hipError_t e = hipLaunchCooperativeKernel(grid == 256 ? (const void*)mk::fwd_megakernel<true> : (const void*)mk::fwd_megakernel<false>, dim3(grid), dim3(mk::NTHR), args, mk::LDS_BYTES, stream);
    if (e != hipSuccess) fprintf(stderr, "cooperative launch failed: %s (grid %d)\n", hipGetErrorString(e), grid);
}
```
